# Optimizing an MI355X kernel written in HIP

```python
import math
import jax, jax.numpy as jnp
from jax import lax
import numpy as np

D_MODEL = 2048
BATCH = 4
SEQ = 2048
DEPTH = 4

N_A_LAYERS = DEPTH // 2
N_B_LAYERS = DEPTH - N_A_LAYERS
HG_EXPAND = 128
HG_HEADS = D_MODEL // HG_EXPAND
HG_DK = HG_EXPAND
HG_DV = D_MODEL // HG_HEADS
HG_CHUNK = 64
ATT_HEAD_DIM = 64
ATT_Q_HEADS = D_MODEL // ATT_HEAD_DIM
ATT_KV_HEADS = ATT_Q_HEADS // 8
ATT_GROUP = ATT_Q_HEADS // ATT_KV_HEADS
WINDOW = 128
ATT_BLOCK = WINDOW
N_BUCKETS = 32
REL_MAX_DISTANCE = 128
N_GROUPS = 4
EXPERTS_PER_GROUP = 8
N_EXPERTS = N_GROUPS * EXPERTS_PER_GROUP
TOP_K = 2
D_EXPERT = D_MODEL // 4
MOE_BLOCK = 128
DEEPNORM_ALPHA = (2 * DEPTH) ** 0.25
DEEPNORM_BETA = (8 * DEPTH) ** -0.25
LN_EPS = 1e-5
RMS_EPS = 1e-6
NEG_BIG = -1e30
MIN_FORGET = 1e-30

kernel_name = "yoco_hgrn2_swa_sink_hmoe_deepnorm"

F32 = jnp.float32


def _layernorm(x, g, b):
    xf = x.astype(F32)
    mu = jnp.mean(xf, -1, keepdims=True)
    var = jnp.mean(jnp.square(xf - mu), -1, keepdims=True)
    y = (xf - mu) * lax.rsqrt(var + LN_EPS) * g.astype(F32) + b.astype(F32)
    return y.astype(x.dtype)


def _hgrn2(x, w_in, lower_bound, norm_g, w_out):
    bsz, seq, _ = x.shape
    n_chunks = seq // HG_CHUNK
    q, f, i, g = jnp.split(x @ w_in, 4, axis=-1)
    f = f.astype(F32)
    lb = lower_bound
    sig = jax.nn.sigmoid(f)
    forget = lb + (1.0 - lb) * sig
    log_forget = jnp.log(jnp.maximum(forget, MIN_FORGET))
    k = (1.0 - lb) * (1.0 - sig)

    def to_chunks(t):
        return t.astype(F32).reshape(bsz, n_chunks, HG_CHUNK, HG_HEADS, -1).transpose(1, 0, 3, 2, 4)

    qc, kc, vc, gc = to_chunks(q), to_chunks(k), to_chunks(i), to_chunks(log_forget)
    causal = jnp.tril(jnp.ones((HG_CHUNK, HG_CHUNK), bool))

    def chunk_step(state, inp):
        q_c, k_c, v_c, g_c = inp
        b = jnp.cumsum(g_c, axis=2)
        b_last = b[:, :, -1:, :]
        o_inter = jnp.einsum('bhtk,bhkv->bhtv', q_c * jnp.exp(b), state)
        rel = jnp.where(causal[None, None, :, :, None],
                        b[:, :, :, None, :] - b[:, :, None, :, :], NEG_BIG)
        scores = jnp.einsum('bhtk,bhsk,bhtsk->bhts', q_c, k_c, jnp.exp(rel))
        o_intra = jnp.einsum('bhts,bhsv->bhtv', scores, v_c)
        new_state = (jnp.exp(b_last[:, :, 0, :, None]) * state
                     + jnp.einsum('bhsk,bhsv->bhkv', k_c * jnp.exp(b_last - b), v_c))
        return new_state, o_inter + o_intra

    s0 = jnp.zeros((bsz, HG_HEADS, HG_DK, HG_DV), F32)
    _, o = lax.scan(chunk_step, s0, (qc, kc, vc, gc))
    o = o.transpose(1, 0, 3, 2, 4).reshape(bsz, seq, HG_HEADS, HG_DV)
    o = o * lax.rsqrt(jnp.mean(jnp.square(o), -1, keepdims=True) + RMS_EPS)
    o = o * norm_g.astype(F32).reshape(HG_HEADS, HG_DV)
    o = o.reshape(bsz, seq, D_MODEL) * jax.nn.silu(g.astype(F32))
    return o.astype(x.dtype) @ w_out


def _t5_bucket(dist):
    n = jnp.clip(dist, 0, REL_MAX_DISTANCE - 1)
    max_exact = N_BUCKETS // 2
    large = max_exact + (jnp.log(jnp.maximum(n, max_exact).astype(F32) / max_exact)
                         / math.log(REL_MAX_DISTANCE / max_exact)
                         * (N_BUCKETS - max_exact)).astype(jnp.int32)
    large = jnp.minimum(large, N_BUCKETS - 1)
    return jnp.where(n < max_exact, n, large)


def _band_bias_and_mask(rel_bias, seq):
    n_blocks = seq // ATT_BLOCK
    qi = jnp.arange(ATT_BLOCK)[:, None]
    kj = jnp.arange(2 * ATT_BLOCK)[None, :]
    dist = qi + ATT_BLOCK - kj
    in_window = (dist >= 0) & (dist < WINDOW)
    bias = rel_bias.astype(F32)[_t5_bucket(dist)]
    bias = bias.transpose(2, 0, 1).reshape(1, ATT_KV_HEADS, ATT_GROUP, 1, ATT_BLOCK, 2 * ATT_BLOCK)
    blk = jnp.arange(n_blocks)[:, None, None]
    mask = in_window[None] & ((blk > 0) | (kj[None] >= ATT_BLOCK))
    return bias, mask


def _shared_kv(x, w_kv):
    bsz, seq, _ = x.shape
    n_blocks = seq // ATT_BLOCK
    k, v = jnp.split(x @ w_kv, 2, axis=-1)

    def windows(t):
        t = t.reshape(bsz, seq, ATT_KV_HEADS, ATT_HEAD_DIM)
        t = jnp.pad(t, ((0, 0), (ATT_BLOCK, 0), (0, 0), (0, 0)))
        t = t.reshape(bsz, n_blocks + 1, ATT_BLOCK, ATT_KV_HEADS, ATT_HEAD_DIM)
        return jnp.concatenate([t[:, :-1], t[:, 1:]], axis=2)

    return windows(k), windows(v)


def _swa_sink(x, k_win, v_win, w_q, sinks, w_out, bias, mask):
    bsz, seq, _ = x.shape
    n_blocks = seq // ATT_BLOCK
    q = (x @ w_q).reshape(bsz, n_blocks, ATT_BLOCK, ATT_KV_HEADS, ATT_GROUP, ATT_HEAD_DIM)
    s = jnp.einsum('bnqhgd,bnkhd->bhgnqk', q, k_win).astype(F32) * (ATT_HEAD_DIM ** -0.5) + bias
    s = jnp.where(mask, s, NEG_BIG)
    sink = sinks.astype(F32).reshape(1, ATT_KV_HEADS, ATT_GROUP, 1, 1, 1)
    m = jnp.maximum(jnp.max(s, -1, keepdims=True), sink)
    p = jnp.exp(s - m)
    w = p / (jnp.sum(p, -1, keepdims=True) + jnp.exp(sink - m))
    o = jnp.einsum('bhgnqk,bnkhd->bnqhgd', w.astype(x.dtype), v_win)
    return o.reshape(bsz, seq, ATT_Q_HEADS * ATT_HEAD_DIM) @ w_out


def _hier_moe(x, w_rg, b_rg, w_re, b_re, w_gate, w_up, w_down):
    bsz, seq, d = x.shape
    n_tok = bsz * seq
    xf = x.reshape(n_tok, d)
    g_logits = (xf @ w_rg).astype(F32) + b_rg.astype(F32)
    g_prob = jax.nn.softmax(g_logits, -1)
    grp = jnp.argmax(g_logits, -1).astype(jnp.int32)
    p_grp = jnp.take_along_axis(g_prob, grp[:, None], -1)
    e_logits = ((xf @ w_re).astype(F32) + b_re.astype(F32)).reshape(n_tok, N_GROUPS, EXPERTS_PER_GROUP)
    e_in_grp = jnp.take_along_axis(e_logits, grp[:, None, None], 1)[:, 0]
    top_v, top_i = lax.top_k(e_in_grp, TOP_K)
    gates = p_grp * jax.nn.softmax(top_v, -1)
    expert = grp[:, None] * EXPERTS_PER_GROUP + top_i.astype(jnp.int32)

    n_asg = n_tok * TOP_K
    e_flat = expert.reshape(-1)
    g_flat = gates.reshape(-1)
    tok_flat = jnp.repeat(jnp.arange(n_tok, dtype=jnp.int32), TOP_K)
    order = jnp.argsort(e_flat)
    e_sorted = e_flat[order]
    counts = jnp.zeros((N_EXPERTS,), jnp.int32).at[e_flat].add(1)
    starts = jnp.cumsum(counts) - counts
    padded = (counts + MOE_BLOCK - 1) // MOE_BLOCK * MOE_BLOCK
    pad_ends = jnp.cumsum(padded)
    pad_starts = pad_ends - padded
    rank = jnp.arange(n_asg, dtype=jnp.int32) - starts[e_sorted]
    dest = pad_starts[e_sorted] + rank
    n_blocks = -(-n_asg // MOE_BLOCK) + N_EXPERTS
    n_slots = n_blocks * MOE_BLOCK
    slot_tok = jnp.full((n_slots,), n_tok, jnp.int32).at[dest].set(tok_flat[order])
    slot_gate = jnp.zeros((n_slots,), F32).at[dest].set(g_flat[order])
    blk_start = jnp.arange(n_blocks, dtype=jnp.int32) * MOE_BLOCK
    blk_expert = jnp.minimum(jnp.searchsorted(pad_ends, blk_start, side='right'), N_EXPERTS - 1)
    x_pad = jnp.concatenate([xf, jnp.zeros((1, d), xf.dtype)], 0)
    xs = x_pad[slot_tok].reshape(n_blocks, MOE_BLOCK, d)

    def expert_block(args):
        xb, e = args
        h = jax.nn.silu(xb @ w_gate[e]) * (xb @ w_up[e])
        return h @ w_down[e]

    ys = lax.map(expert_block, (xs, blk_expert)).reshape(n_slots, d)
    out = jnp.zeros((n_tok + 1, d), F32).at[slot_tok].add(ys.astype(F32) * slot_gate[:, None])[:n_tok]
    return out.reshape(bsz, seq, d).astype(x.dtype)


def setup_inputs(seed: int = 0) -> dict:
    key = jax.random.key(seed)
    ks = jax.random.split(key, 24)
    d = D_MODEL
    kvw = ATT_KV_HEADS * ATT_HEAD_DIM

    def nrm(k, shape, fan_in, scale=1.0):
        return jax.random.normal(k, shape, F32) * (scale * fan_in ** -0.5)

    x = jax.random.normal(ks[0], (BATCH, SEQ, d), F32)
    a_w_in = nrm(ks[1], (N_A_LAYERS, d, 4 * d), d)
    a_w_in = a_w_in.at[:, :, 2 * d:3 * d].multiply(DEEPNORM_BETA)
    a_lower_bound = jax.random.normal(ks[2], (N_A_LAYERS, d), F32)
    a_norm_g = 1.0 + 0.02 * jax.random.normal(ks[3], (N_A_LAYERS, d), F32)
    a_w_out = nrm(ks[4], (N_A_LAYERS, d, d), d, DEEPNORM_BETA)
    b_w_kv = nrm(ks[5], (d, 2 * kvw), d)
    b_w_kv = b_w_kv.at[:, kvw:].multiply(DEEPNORM_BETA)
    b_w_q = nrm(ks[6], (N_B_LAYERS, d, ATT_Q_HEADS * ATT_HEAD_DIM), d)
    b_sinks = jax.random.normal(ks[7], (N_B_LAYERS, ATT_Q_HEADS), F32)
    b_w_out = nrm(ks[8], (N_B_LAYERS, ATT_Q_HEADS * ATT_HEAD_DIM, d), d, DEEPNORM_BETA)
    rel_bias = 0.5 * jax.random.normal(ks[9], (N_BUCKETS, ATT_Q_HEADS), F32)
    moe_w_rg = nrm(ks[10], (DEPTH, d, N_GROUPS), d)
    moe_b_rg = 0.01 * jax.random.normal(ks[11], (DEPTH, N_GROUPS), F32)
    moe_w_re = nrm(ks[12], (DEPTH, d, N_EXPERTS), d)
    moe_b_re = 0.01 * jax.random.normal(ks[13], (DEPTH, N_EXPERTS), F32)
    moe_w_gate = nrm(ks[14], (DEPTH, N_EXPERTS, d, D_EXPERT), d)
    moe_w_up = nrm(ks[15], (DEPTH, N_EXPERTS, d, D_EXPERT), d)
    moe_w_down = nrm(ks[16], (DEPTH, N_EXPERTS, D_EXPERT, d), D_EXPERT, DEEPNORM_BETA)
    ln_g = 1.0 + 0.02 * jax.random.normal(ks[17], (2 * DEPTH, d), F32)
    ln_b = 0.02 * jax.random.normal(ks[18], (2 * DEPTH, d), F32)
    return {"x": x, "a_w_in": a_w_in, "a_lower_bound": a_lower_bound, "a_norm_g": a_norm_g,
            "a_w_out": a_w_out, "b_w_kv": b_w_kv, "b_w_q": b_w_q, "b_sinks": b_sinks,
            "b_w_out": b_w_out, "rel_bias": rel_bias, "moe_w_rg": moe_w_rg, "moe_b_rg": moe_b_rg,
            "moe_w_re": moe_w_re, "moe_b_re": moe_b_re, "moe_w_gate": moe_w_gate,
            "moe_w_up": moe_w_up, "moe_w_down": moe_w_down, "ln_g": ln_g, "ln_b": ln_b}


def reference(x, a_w_in, a_lower_bound, a_norm_g, a_w_out, b_w_kv, b_w_q, b_sinks, b_w_out,
              rel_bias, moe_w_rg, moe_b_rg, moe_w_re, moe_b_re, moe_w_gate, moe_w_up,
              moe_w_down, ln_g, ln_b):
    lb_sm = jax.nn.softmax(a_lower_bound.astype(F32), axis=0)
    lower_bounds = jnp.cumsum(lb_sm, axis=0) - lb_sm[0]
    att_bias, att_mask = _band_bias_and_mask(rel_bias, x.shape[1])
    k_win = None
    v_win = None
    for layer in range(DEPTH):
        if layer < N_A_LAYERS:
            h = _hgrn2(x, a_w_in[layer], lower_bounds[layer], a_norm_g[layer], a_w_out[layer])
        else:
            if layer == N_A_LAYERS:
                k_win, v_win = _shared_kv(x, b_w_kv)
            j = layer - N_A_LAYERS
            h = _swa_sink(x, k_win, v_win, b_w_q[j], b_sinks[j], b_w_out[j], att_bias, att_mask)
        x = _layernorm(DEEPNORM_ALPHA * x + h, ln_g[2 * layer], ln_b[2 * layer])
        f = _hier_moe(x, moe_w_rg[layer], moe_b_rg[layer], moe_w_re[layer], moe_b_re[layer],
                      moe_w_gate[layer], moe_w_up[layer], moe_w_down[layer])
        x = _layernorm(DEEPNORM_ALPHA * x + f, ln_g[2 * layer + 1], ln_b[2 * layer + 1])
    return x
```

```cpp
#include <hip/hip_runtime.h>
#include <cstdio>
#include <cstdint>

typedef unsigned short bf16_t;
typedef short bf16x8 __attribute__((ext_vector_type(8)));
typedef float f32x4 __attribute__((ext_vector_type(4)));

constexpr int BATCH = 4, SEQ = 2048, D = 2048, T = BATCH * SEQ, DEPTH = 4, NA = 2;
constexpr int HG_H = 16, HG_DK = 128;
constexpr int AT_HD = 64, AT_HQ = 32, AT_HKV = 4, AT_G = 8, KVW = AT_HKV * AT_HD;
constexpr int NGRP = 4, EPG = 8, NEXP = 32, DEXP = 512;
constexpr float ALPHA = 1.6817928305074290f;
constexpr float LN_EPS = 1e-5f, RMS_EPS = 1e-6f;

constexpr size_t MiB = 1u << 20;
constexpr size_t WS_CTL = 0, CTL_BYTES = 1 * MiB;
constexpr size_t WS_XF = 1 * MiB;
constexpr size_t WS_XB = WS_XF + 64 * MiB;
constexpr size_t WS_QB = WS_XB + 32 * MiB;
constexpr size_t WS_KB = WS_QB + 32 * MiB;
constexpr size_t WS_VB = WS_KB + 32 * MiB;
constexpr size_t WS_GT = WS_VB + 32 * MiB;
constexpr size_t WS_GL = WS_GT + 32 * MiB;
constexpr size_t WS_OF = WS_GL + 64 * MiB;
constexpr size_t WS_OG = WS_OF + 64 * MiB;
constexpr size_t WS_HM = WS_OG + 32 * MiB;
constexpr size_t WS_KC = WS_HM + 64 * MiB;
constexpr size_t WS_VC = WS_KC + 4 * MiB;
constexpr size_t WS_LIST = WS_VC + 4 * MiB;
constexpr size_t WS_TG = WS_LIST + 1 * MiB;
constexpr size_t WS_HS = WS_TG + 1 * MiB;
constexpr size_t WS_Y = WS_HS + 24 * MiB;
constexpr size_t WS_END = WS_Y + 64 * MiB;
constexpr int CW_CNT = 1024;

__device__ __forceinline__ unsigned f2bf(float f) { unsigned u = __builtin_bit_cast(unsigned, f); return (u + 0x7fffu + ((u >> 16) & 1u)) >> 16; }
__device__ __forceinline__ float bf2f(bf16_t b) { return __builtin_bit_cast(float, ((unsigned)b) << 16); }
__device__ __forceinline__ float wave_sum(float v) {
#pragma unroll
    for (int o = 1; o < 64; o <<= 1) v += __shfl_xor(v, o);
    return v;
}
__device__ __forceinline__ float wave_max(float v) {
#pragma unroll
    for (int o = 1; o < 64; o <<= 1) v = fmaxf(v, __shfl_xor(v, o));
    return v;
}
__device__ __forceinline__ float sigmoidf_(float x) { return 1.0f / (1.0f + __expf(-x)); }

struct RowsPlain { int M, pad; __device__ bool tile(int by, int bz, int& m0, int& mcnt) const { m0 = by * 128; mcnt = M - m0; return m0 < M; } __device__ int arow(int bz, int m) const { return m; } };

template <class Rows, class Epi, bool DUAL>
__global__ __launch_bounds__(256) void gemm_simple(const bf16_t* __restrict__ A, const float* __restrict__ W, const float* __restrict__ W2, size_t wstride_z, int lda, int ldw, int N, int K, Rows rows, Epi epi) {
    __shared__ __attribute__((aligned(16))) bf16_t As[128][40];
    __shared__ __attribute__((aligned(16))) bf16_t Bs[128][40];
    __shared__ __attribute__((aligned(16))) bf16_t Bs2[DUAL ? 128 : 1][40];
    int m0, mcnt;
    if (!rows.tile(blockIdx.y, blockIdx.z, m0, mcnt)) return;
    const int n0 = blockIdx.x * 128;
    const int tid = threadIdx.x, lane = tid & 63, wid = tid >> 6, wm = wid >> 1, wn = wid & 1;
    const float* Wz = W + wstride_z * blockIdx.z;
    const float* W2z = DUAL ? W2 + wstride_z * blockIdx.z : nullptr;
    f32x4 acc[4][4], acc2[DUAL ? 4 : 1][DUAL ? 4 : 1];
#pragma unroll
    for (int i = 0; i < 4; ++i)
#pragma unroll
        for (int j = 0; j < 4; ++j) { acc[i][j] = (f32x4){0.f, 0.f, 0.f, 0.f}; if constexpr (DUAL) acc2[i][j] = (f32x4){0.f, 0.f, 0.f, 0.f}; }
    const bf16_t* arp[2]; int ar[2], ac[2];
#pragma unroll
    for (int i = 0; i < 2; ++i) { const int idx = tid + i * 256; ar[i] = idx >> 2; ac[i] = (idx & 3) * 8; int mm = ar[i] < mcnt ? ar[i] : 0; arp[i] = A + (size_t)rows.arow(blockIdx.z, m0 + mm) * lda + ac[i]; }
    for (int k0 = 0; k0 < K; k0 += 32) {
#pragma unroll
        for (int i = 0; i < 2; ++i) *(uint4*)&As[ar[i]][ac[i]] = *(const uint4*)(arp[i] + k0);
#pragma unroll
        for (int i = 0; i < 4; ++i) { const int idx = tid + i * 256, kk = idx >> 5, n4 = (idx & 31) * 4;
            const float4 w = *(const float4*)(Wz + (size_t)(k0 + kk) * ldw + n0 + n4);
            Bs[n4 + 0][kk] = (bf16_t)f2bf(w.x); Bs[n4 + 1][kk] = (bf16_t)f2bf(w.y); Bs[n4 + 2][kk] = (bf16_t)f2bf(w.z); Bs[n4 + 3][kk] = (bf16_t)f2bf(w.w);
            if constexpr (DUAL) { const float4 w2 = *(const float4*)(W2z + (size_t)(k0 + kk) * ldw + n0 + n4);
                Bs2[n4 + 0][kk] = (bf16_t)f2bf(w2.x); Bs2[n4 + 1][kk] = (bf16_t)f2bf(w2.y); Bs2[n4 + 2][kk] = (bf16_t)f2bf(w2.z); Bs2[n4 + 3][kk] = (bf16_t)f2bf(w2.w); } }
        __syncthreads();
        bf16x8 a[4], b[4];
#pragma unroll
        for (int i = 0; i < 4; ++i) a[i] = *(const bf16x8*)&As[wm * 64 + i * 16 + (lane & 15)][8 * (lane >> 4)];
#pragma unroll
        for (int j = 0; j < 4; ++j) b[j] = *(const bf16x8*)&Bs[wn * 64 + j * 16 + (lane & 15)][8 * (lane >> 4)];
#pragma unroll
        for (int i = 0; i < 4; ++i)
#pragma unroll
            for (int j = 0; j < 4; ++j) acc[i][j] = __builtin_amdgcn_mfma_f32_16x16x32_bf16(a[i], b[j], acc[i][j], 0, 0, 0);
        if constexpr (DUAL) {
#pragma unroll
            for (int j = 0; j < 4; ++j) b[j] = *(const bf16x8*)&Bs2[wn * 64 + j * 16 + (lane & 15)][8 * (lane >> 4)];
#pragma unroll
            for (int i = 0; i < 4; ++i)
#pragma unroll
                for (int j = 0; j < 4; ++j) acc2[i][j] = __builtin_amdgcn_mfma_f32_16x16x32_bf16(a[i], b[j], acc2[i][j], 0, 0, 0);
        }
        __syncthreads();
    }
#pragma unroll
    for (int i = 0; i < 4; ++i)
#pragma unroll
        for (int j = 0; j < 4; ++j)
#pragma unroll
            for (int r = 0; r < 4; ++r) { const int mm = wm * 64 + i * 16 + (lane >> 4) * 4 + r, nn = n0 + wn * 64 + j * 16 + (lane & 15);
                float u2 = 0.f; if constexpr (DUAL) u2 = acc2[i][j][r];
                if (mm < mcnt) epi(blockIdx.z, m0 + mm, nn, acc[i][j][r], u2); }
}

struct EpiHgrnIn {
    bf16_t *Qb, *Kb, *Vb, *Gt; float* Gl; const float* lbraw; int layer, pad;
    __device__ void operator()(int, int m, int n, float v, float) const {
        const int seg = n >> 11, c = n & 2047; const size_t o = (size_t)m * D + c;
        if (seg == 0) Qb[o] = (bf16_t)f2bf(v);
        else if (seg == 1) { const float lb = layer == 0 ? 0.f : sigmoidf_(lbraw[D + c] - lbraw[c]); const float sg = sigmoidf_(v);
            const float fg = lb + (1.f - lb) * sg; Gl[o] = __logf(fmaxf(fg, 1e-30f)); Kb[o] = (bf16_t)f2bf((1.f - lb) * (1.f - sg)); }
        else if (seg == 2) Vb[o] = (bf16_t)f2bf(v);
        else Gt[o] = (bf16_t)f2bf(v * sigmoidf_(v));
    }
};
struct EpiF32 { float* C; int ldc, pad; __device__ void operator()(int, int m, int n, float v, float) const { C[(size_t)m * ldc + n] = v; } };
struct EpiBf16 { bf16_t* C; int ldc; float scale; __device__ void operator()(int, int m, int n, float v, float) const { C[(size_t)m * ldc + n] = (bf16_t)f2bf(v * scale); } };
struct EpiKV { bf16_t *Kc, *Vc; __device__ void operator()(int, int m, int n, float v, float) const { if (n < KVW) Kc[(size_t)m * KVW + n] = (bf16_t)f2bf(v); else Vc[(size_t)m * KVW + n - KVW] = (bf16_t)f2bf(v); } };

struct RowsMoeGather { const int* cnt; const int* list;
    __device__ bool tile(int by, int bz, int& m0, int& mcnt) const { const int c = cnt[bz]; m0 = by * 128; mcnt = c - m0; return m0 < c; }
    __device__ int arow(int bz, int m) const { return list[bz * T + m] >> 1; } };
struct RowsMoeSlots { const int* cnt;
    __device__ bool tile(int by, int bz, int& m0, int& mcnt) const { const int c = cnt[bz]; m0 = by * 128; mcnt = c - m0; return m0 < c; }
    __device__ int arow(int bz, int m) const { int base = 0; for (int e = 0; e < bz; ++e) base += (cnt[e] + 255) & ~255; return base + m; } };
struct EpiMoeH { bf16_t* Hs; const int* cnt;
    __device__ void operator()(int z, int m, int n, float g, float u) const { int base = 0; for (int e = 0; e < z; ++e) base += (cnt[e] + 255) & ~255;
        Hs[(size_t)(base + m) * DEXP + n] = (bf16_t)f2bf(g * sigmoidf_(g) * u); } };
struct EpiMoeY { bf16_t* Y; const int* list; const float* tg;
    __device__ void operator()(int z, int m, int n, float v, float) const { const int a = list[z * T + m]; Y[(size_t)a * D + n] = (bf16_t)f2bf(v * tg[a]); } };

__global__ void k_cvt_x(const float* __restrict__ x, bf16_t* __restrict__ xb, size_t n) {
    for (size_t i = (size_t)blockIdx.x * blockDim.x + threadIdx.x; i < n / 4; i += (size_t)gridDim.x * blockDim.x) { const float4 v = ((const float4*)x)[i];
        ((uint2*)xb)[i] = make_uint2(f2bf(v.x) | (f2bf(v.y) << 16), f2bf(v.z) | (f2bf(v.w) << 16)); }
}

template <int MODE>
__global__ __launch_bounds__(256) void k_ln(const float* xin, const float* __restrict__ hm, const bf16_t* __restrict__ Y, const float* __restrict__ lng, const float* __restrict__ lnb,
                                           float* xf, bf16_t* __restrict__ xb,
                                           const float* __restrict__ wrg, const float* __restrict__ brg, const float* __restrict__ wre, const float* __restrict__ bre,
                                           int* __restrict__ cnt, int* __restrict__ list, float* __restrict__ tg) {
    const int lane = threadIdx.x & 63, row = blockIdx.x * 4 + (threadIdx.x >> 6);
    if (row >= T) return;
    float v[32];
    float s = 0.f;
#pragma unroll
    for (int j = 0; j < 8; ++j) { const int c = 4 * lane + 256 * j; const float4 a = *(const float4*)(xin + (size_t)row * D + c);
        float4 h;
        if (MODE == 0) h = *(const float4*)(hm + (size_t)row * D + c);
        else { const uint2 y0 = *(const uint2*)(Y + (size_t)(row * 2) * D + c), y1 = *(const uint2*)(Y + (size_t)(row * 2 + 1) * D + c);
            h.x = bf2f((bf16_t)(y0.x & 0xffff)) + bf2f((bf16_t)(y1.x & 0xffff)); h.y = bf2f((bf16_t)(y0.x >> 16)) + bf2f((bf16_t)(y1.x >> 16));
            h.z = bf2f((bf16_t)(y0.y & 0xffff)) + bf2f((bf16_t)(y1.y & 0xffff)); h.w = bf2f((bf16_t)(y0.y >> 16)) + bf2f((bf16_t)(y1.y >> 16)); }
        v[4 * j + 0] = ALPHA * a.x + h.x; v[4 * j + 1] = ALPHA * a.y + h.y; v[4 * j + 2] = ALPHA * a.z + h.z; v[4 * j + 3] = ALPHA * a.w + h.w;
        s += (v[4 * j] + v[4 * j + 1]) + (v[4 * j + 2] + v[4 * j + 3]); }
    const float mean = wave_sum(s) * (1.f / D);
    float q = 0.f;
#pragma unroll
    for (int j = 0; j < 32; ++j) { v[j] -= mean; q += v[j] * v[j]; }
    const float rstd = 1.0f / sqrtf(wave_sum(q) * (1.f / D) + LN_EPS);
#pragma unroll
    for (int j = 0; j < 8; ++j) { const int c = 4 * lane + 256 * j; const float4 g = *(const float4*)(lng + c), b = *(const float4*)(lnb + c);
        v[4 * j + 0] = v[4 * j + 0] * rstd * g.x + b.x; v[4 * j + 1] = v[4 * j + 1] * rstd * g.y + b.y; v[4 * j + 2] = v[4 * j + 2] * rstd * g.z + b.z; v[4 * j + 3] = v[4 * j + 3] * rstd * g.w + b.w;
        *(float4*)(xf + (size_t)row * D + c) = make_float4(v[4 * j], v[4 * j + 1], v[4 * j + 2], v[4 * j + 3]);
        if (xb) *(uint2*)(xb + (size_t)row * D + c) = make_uint2(f2bf(v[4 * j]) | (f2bf(v[4 * j + 1]) << 16), f2bf(v[4 * j + 2]) | (f2bf(v[4 * j + 3]) << 16)); }
    if (MODE == 0) {
        float gl[4] = {0.f, 0.f, 0.f, 0.f};
#pragma unroll
        for (int j = 0; j < 8; ++j)
#pragma unroll
            for (int i = 0; i < 4; ++i) { const int c = 4 * lane + 256 * j + i; const float4 w = *(const float4*)(wrg + (size_t)c * NGRP); const float x = v[4 * j + i];
                gl[0] += x * w.x; gl[1] += x * w.y; gl[2] += x * w.z; gl[3] += x * w.w; }
#pragma unroll
        for (int g = 0; g < 4; ++g) gl[g] = wave_sum(gl[g]) + brg[g];
        int grp = 0; float gmax = gl[0];
#pragma unroll
        for (int g = 1; g < 4; ++g) if (gl[g] > gmax) { gmax = gl[g]; grp = g; }
        float gden = 0.f;
#pragma unroll
        for (int g = 0; g < 4; ++g) gden += __expf(gl[g] - gmax);
        const float pgrp = 1.0f / gden;
        float el[8] = {0.f, 0.f, 0.f, 0.f, 0.f, 0.f, 0.f, 0.f};
#pragma unroll
        for (int j = 0; j < 8; ++j)
#pragma unroll
            for (int i = 0; i < 4; ++i) { const int c = 4 * lane + 256 * j + i; const float4 w0 = *(const float4*)(wre + (size_t)c * NEXP + grp * 8), w1 = *(const float4*)(wre + (size_t)c * NEXP + grp * 8 + 4); const float x = v[4 * j + i];
                el[0] += x * w0.x; el[1] += x * w0.y; el[2] += x * w0.z; el[3] += x * w0.w; el[4] += x * w1.x; el[5] += x * w1.y; el[6] += x * w1.z; el[7] += x * w1.w; }
#pragma unroll
        for (int e = 0; e < 8; ++e) el[e] = wave_sum(el[e]) + bre[grp * 8 + e];
        int i0 = 0; float v0 = el[0];
#pragma unroll
        for (int e = 1; e < 8; ++e) if (el[e] > v0) { v0 = el[e]; i0 = e; }
        int i1 = -1; float v1 = -3.0e38f;
#pragma unroll
        for (int e = 0; e < 8; ++e) if (e != i0 && el[e] > v1) { v1 = el[e]; i1 = e; }
        const float e1 = __expf(v1 - v0), den = 1.f + e1;
        const float g0 = pgrp / den, g1 = pgrp * e1 / den;
        if (lane == 0) {
            const int ea = grp * 8 + i0, eb = grp * 8 + i1;
            const int pa = atomicAdd(&cnt[ea], 1); list[ea * T + pa] = row * 2; tg[row * 2] = g0;
            const int pb = atomicAdd(&cnt[eb], 1); list[eb * T + pb] = row * 2 + 1; tg[row * 2 + 1] = g1;
        }
    }
}

__global__ __launch_bounds__(256) void k_hgrn_seq(const bf16_t* __restrict__ Qb, const bf16_t* __restrict__ Kb, const bf16_t* __restrict__ Vb, const float* __restrict__ Gl, float* __restrict__ Of) {
    const int lane = threadIdx.x & 63, w = threadIdx.x >> 6;
    const int bh = blockIdx.x >> 5, vg = blockIdx.x & 31, b = bh >> 4, h = bh & 15, vcol = h * 128 + vg * 4 + w;
    float S0 = 0.f, S1 = 0.f;
    const size_t base = (size_t)b * SEQ * D;
    for (int t = 0; t < SEQ; ++t) {
        const size_t ro = base + (size_t)t * D + h * 128;
        const float f0 = __expf(Gl[ro + lane]), f1 = __expf(Gl[ro + lane + 64]);
        const float k0 = bf2f(Kb[ro + lane]), k1 = bf2f(Kb[ro + lane + 64]);
        const float q0 = bf2f(Qb[ro + lane]), q1 = bf2f(Qb[ro + lane + 64]);
        const float vv = bf2f(Vb[base + (size_t)t * D + vcol]);
        S0 = f0 * S0 + k0 * vv; S1 = f1 * S1 + k1 * vv;
        const float o = wave_sum(S0 * q0 + S1 * q1);
        if (lane == 0) Of[base + (size_t)t * D + vcol] = o;
    }
}
__global__ __launch_bounds__(256) void k_hgrn_norm(const float* __restrict__ Of, const bf16_t* __restrict__ Gt, const float* __restrict__ ng, bf16_t* __restrict__ Og) {
    const int lane = threadIdx.x & 63; const size_t item = (size_t)blockIdx.x * 4 + (threadIdx.x >> 6);
    const size_t row = item >> 4; const int h = (int)(item & 15);
    const size_t o = row * D + h * 128;
    const float a = Of[o + lane], b = Of[o + lane + 64];
    const float r = 1.0f / sqrtf(wave_sum(a * a + b * b) * (1.f / 128.f) + RMS_EPS);
    Og[o + lane] = (bf16_t)f2bf(a * r * ng[h * 128 + lane] * bf2f(Gt[o + lane]));
    Og[o + lane + 64] = (bf16_t)f2bf(b * r * ng[h * 128 + lane + 64] * bf2f(Gt[o + lane + 64]));
}

__device__ __forceinline__ int t5_bucket(int n) { if (n < 16) return n; int l = 16 + (int)(__logf((float)n * (1.f / 16.f)) / 2.0794415416798357f * 16.f); return l < 31 ? l : 31; }
__global__ __launch_bounds__(256) void k_attn(const bf16_t* __restrict__ Qb, const bf16_t* __restrict__ Kc, const bf16_t* __restrict__ Vc, const float* __restrict__ sinks, const float* __restrict__ relb, bf16_t* __restrict__ Og) {
    const int lane = threadIdx.x & 63; const size_t item = (size_t)blockIdx.x * 4 + (threadIdx.x >> 6);
    const int row = (int)(item >> 5), hq = (int)(item & 31), kvh = hq >> 3, tpos = row & (SEQ - 1);
    float qv[64];
    { const uint4* qp = (const uint4*)(Qb + (size_t)row * D + hq * 64);
#pragma unroll
      for (int i = 0; i < 8; ++i) { const uint4 u = qp[i]; const unsigned w[4] = {u.x, u.y, u.z, u.w};
#pragma unroll
          for (int j = 0; j < 4; ++j) { qv[8 * i + 2 * j] = bf2f((bf16_t)(w[j] & 0xffff)); qv[8 * i + 2 * j + 1] = bf2f((bf16_t)(w[j] >> 16)); } } }
    float sc[2];
#pragma unroll
    for (int r = 0; r < 2; ++r) { const int dist = lane + 64 * r, s = tpos - dist;
        if (s >= 0) { const uint4* kp = (const uint4*)(Kc + (size_t)(row - dist) * KVW + kvh * 64); float d = 0.f;
#pragma unroll
            for (int i = 0; i < 8; ++i) { const uint4 u = kp[i]; const unsigned w[4] = {u.x, u.y, u.z, u.w};
#pragma unroll
                for (int j = 0; j < 4; ++j) { d += qv[8 * i + 2 * j] * bf2f((bf16_t)(w[j] & 0xffff)); d += qv[8 * i + 2 * j + 1] * bf2f((bf16_t)(w[j] >> 16)); } }
            sc[r] = d * 0.125f + relb[t5_bucket(dist) * AT_HQ + hq]; }
        else sc[r] = -1e30f; }
    const float sink = sinks[hq];
    const float m = fmaxf(wave_max(fmaxf(sc[0], sc[1])), sink);
    float p0 = __expf(sc[0] - m), p1 = __expf(sc[1] - m);
    if (tpos - lane < 0) p0 = 0.f; if (tpos - lane - 64 < 0) p1 = 0.f;
    const float den = wave_sum(p0 + p1) + __expf(sink - m);
    p0 /= den; p1 /= den;
    float o = 0.f;
    for (int dist = 0; dist < 128; ++dist) { const float w = __shfl(dist < 64 ? p0 : p1, dist & 63); const int s = tpos - dist;
        if (s >= 0) o += w * bf2f(Vc[(size_t)(row - dist) * KVW + kvh * 64 + lane]); }
    Og[(size_t)row * D + hq * 64 + lane] = (bf16_t)f2bf(o);
}

extern "C" void kernel_launch(void* const* d_in, const int* in_sizes, int n_in, void* d_out, int out_size, void* d_ws, size_t ws_size, hipStream_t stream) {
    if (n_in != 19 || out_size != T * D || ws_size < WS_END) { fprintf(stderr, "kernel_launch: unexpected arguments\n"); return; }
    const float* x = (const float*)d_in[0]; const float* a_w_in = (const float*)d_in[1]; const float* a_lb = (const float*)d_in[2]; const float* a_ng = (const float*)d_in[3];
    const float* a_w_out = (const float*)d_in[4]; const float* b_w_kv = (const float*)d_in[5]; const float* b_w_q = (const float*)d_in[6]; const float* b_sinks = (const float*)d_in[7];
    const float* b_w_out = (const float*)d_in[8]; const float* rel_bias = (const float*)d_in[9]; const float* w_rg = (const float*)d_in[10]; const float* b_rg = (const float*)d_in[11];
    const float* w_re = (const float*)d_in[12]; const float* b_re = (const float*)d_in[13]; const float* w_gate = (const float*)d_in[14]; const float* w_up = (const float*)d_in[15];
    const float* w_down = (const float*)d_in[16]; const float* ln_g = (const float*)d_in[17]; const float* ln_b = (const float*)d_in[18];
    unsigned char* ws = (unsigned char*)d_ws;
    float* Xf = (float*)(ws + WS_XF); bf16_t* Xb = (bf16_t*)(ws + WS_XB); bf16_t* Qb = (bf16_t*)(ws + WS_QB); bf16_t* Kb = (bf16_t*)(ws + WS_KB); bf16_t* Vb = (bf16_t*)(ws + WS_VB);
    bf16_t* Gt = (bf16_t*)(ws + WS_GT); float* Gl = (float*)(ws + WS_GL); float* Of = (float*)(ws + WS_OF); bf16_t* Og = (bf16_t*)(ws + WS_OG); float* Hm = (float*)(ws + WS_HM);
    bf16_t* Kc = (bf16_t*)(ws + WS_KC); bf16_t* Vc = (bf16_t*)(ws + WS_VC); int* list = (int*)(ws + WS_LIST); float* tg = (float*)(ws + WS_TG); bf16_t* Hs = (bf16_t*)(ws + WS_HS); bf16_t* Y = (bf16_t*)(ws + WS_Y);
    int* ctl = (int*)(ws + WS_CTL);
    (void)hipMemsetAsync(ws + WS_CTL, 0, CTL_BYTES, stream);
    k_cvt_x<<<2048, 256, 0, stream>>>(x, Xb, (size_t)T * D);
    const float* xcur = x;
    for (int L = 0; L < DEPTH; ++L) {
        if (L < NA) {
            EpiHgrnIn e1{Qb, Kb, Vb, Gt, Gl, a_lb, L, 0};
            gemm_simple<RowsPlain, EpiHgrnIn, false><<<dim3(4 * D / 128, T / 128, 1), 256, 0, stream>>>(Xb, a_w_in + (size_t)L * D * 4 * D, nullptr, 0, D, 4 * D, 4 * D, D, RowsPlain{T, 0}, e1);
            k_hgrn_seq<<<64 * 32, 256, 0, stream>>>(Qb, Kb, Vb, Gl, Of);
            k_hgrn_norm<<<T * HG_H / 4, 256, 0, stream>>>(Of, Gt, a_ng + (size_t)L * D, Og);
            gemm_simple<RowsPlain, EpiF32, false><<<dim3(D / 128, T / 128, 1), 256, 0, stream>>>(Og, a_w_out + (size_t)L * D * D, nullptr, 0, D, D, D, D, RowsPlain{T, 0}, EpiF32{Hm, D, 0});
        } else {
            const int j = L - NA;
            if (j == 0) gemm_simple<RowsPlain, EpiKV, false><<<dim3(2 * KVW / 128, T / 128, 1), 256, 0, stream>>>(Xb, b_w_kv, nullptr, 0, D, 2 * KVW, 2 * KVW, D, RowsPlain{T, 0}, EpiKV{Kc, Vc});
            gemm_simple<RowsPlain, EpiBf16, false><<<dim3(D / 128, T / 128, 1), 256, 0, stream>>>(Xb, b_w_q + (size_t)j * D * D, nullptr, 0, D, D, D, D, RowsPlain{T, 0}, EpiBf16{Qb, D, 1.0f});
            k_attn<<<T * AT_HQ / 4, 256, 0, stream>>>(Qb, Kc, Vc, b_sinks + j * AT_HQ, rel_bias, Og);
            gemm_simple<RowsPlain, EpiF32, false><<<dim3(D / 128, T / 128, 1), 256, 0, stream>>>(Og, b_w_out + (size_t)j * D * D, nullptr, 0, D, D, D, D, RowsPlain{T, 0}, EpiF32{Hm, D, 0});
        }
        int* cnt = ctl + CW_CNT + 64 * L;
        k_ln<0><<<T / 4, 256, 0, stream>>>(xcur, Hm, nullptr, ln_g + (size_t)(2 * L) * D, ln_b + (size_t)(2 * L) * D, Xf, Xb,
                                          w_rg + (size_t)L * D * NGRP, b_rg + L * NGRP, w_re + (size_t)L * D * NEXP, b_re + L * NEXP, cnt, list, tg);
        xcur = Xf;
        gemm_simple<RowsMoeGather, EpiMoeH, true><<<dim3(DEXP / 128, T / 128, NEXP), 256, 0, stream>>>(Xb, w_gate + (size_t)L * NEXP * D * DEXP, w_up + (size_t)L * NEXP * D * DEXP, (size_t)D * DEXP, D, DEXP, DEXP, D,
                                                                                                      RowsMoeGather{cnt, list}, EpiMoeH{Hs, cnt});
        gemm_simple<RowsMoeSlots, EpiMoeY, false><<<dim3(D / 128, T / 128, NEXP), 256, 0, stream>>>(Hs, w_down + (size_t)L * NEXP * DEXP * D, nullptr, (size_t)DEXP * D, DEXP, D, D, DEXP,
                                                                                                   RowsMoeSlots{cnt}, EpiMoeY{Y, list, tg});
        float* xo = (L == DEPTH - 1) ? (float*)d_out : Xf;
        k_ln<1><<<T / 4, 256, 0, stream>>>(Xf, nullptr, Y, ln_g + (size_t)(2 * L + 1) * D, ln_b + (size_t)(2 * L + 1) * D, xo, (L == DEPTH - 1) ? nullptr : Xb,
                                          nullptr, nullptr, nullptr, nullptr, nullptr, nullptr, nullptr);
    }
}
```

```cpp
#include <hip/hip_runtime.h>
#include <cstdio>
#include <cstdint>

typedef unsigned short bf16_t;
typedef short bf16x8 __attribute__((ext_vector_type(8)));
typedef float f32x4 __attribute__((ext_vector_type(4)));

constexpr int BATCH = 4, SEQ = 2048, D = 2048, T = BATCH * SEQ, DEPTH = 4, NA = 2;
constexpr int HG_H = 16, HG_DK = 128;
constexpr int AT_HD = 64, AT_HQ = 32, AT_HKV = 4, AT_G = 8, KVW = AT_HKV * AT_HD;
constexpr int NGRP = 4, EPG = 8, NEXP = 32, DEXP = 512;
constexpr float ALPHA = 1.6817928305074290f;
constexpr float LN_EPS = 1e-5f, RMS_EPS = 1e-6f;

constexpr size_t MiB = 1u << 20;
constexpr size_t WS_CTL = 0, CTL_BYTES = 1 * MiB;
constexpr size_t WS_XF = 1 * MiB;
constexpr size_t WS_XB = WS_XF + 64 * MiB;
constexpr size_t WS_QB = WS_XB + 32 * MiB;
constexpr size_t WS_KB = WS_QB + 32 * MiB;
constexpr size_t WS_VB = WS_KB + 32 * MiB;
constexpr size_t WS_GT = WS_VB + 32 * MiB;
constexpr size_t WS_GL = WS_GT + 32 * MiB;
constexpr size_t WS_OF = WS_GL + 64 * MiB;
constexpr size_t WS_OG = WS_OF + 64 * MiB;
constexpr size_t WS_HM = WS_OG + 32 * MiB;
constexpr size_t WS_KC = WS_HM + 32 * MiB;
constexpr size_t WS_VC = WS_KC + 4 * MiB;
constexpr size_t WS_LIST = WS_VC + 4 * MiB;
constexpr size_t WS_TG = WS_LIST + 1 * MiB;
constexpr size_t WS_HS = WS_TG + 1 * MiB;
constexpr size_t WS_Y = WS_HS + 24 * MiB;
constexpr size_t WS_WIN = WS_Y + 64 * MiB;
constexpr size_t WS_WOUT = WS_WIN + 64 * MiB;
constexpr size_t WS_WKV = WS_WOUT + 16 * MiB;
constexpr size_t WS_WQ = WS_WKV + 2 * MiB;
constexpr size_t WS_WO = WS_WQ + 16 * MiB;
constexpr size_t WS_WGU = WS_WO + 16 * MiB;
constexpr size_t WS_WD = WS_WGU + 512 * MiB;
constexpr size_t WS_UT = WS_WD + 256 * MiB;
constexpr size_t WS_SST = WS_UT + 64 * MiB;
constexpr size_t WS_DG = WS_SST + 64 * MiB;
constexpr size_t WS_END = WS_DG + 1 * MiB;
constexpr int CW_CNT = 1024;

__device__ __forceinline__ unsigned f2bf(float f) { unsigned u = __builtin_bit_cast(unsigned, f); return (u + 0x7fffu + ((u >> 16) & 1u)) >> 16; }
__device__ __forceinline__ float bf2f(bf16_t b) { return __builtin_bit_cast(float, ((unsigned)b) << 16); }
__device__ __forceinline__ float wave_sum(float v) {
#pragma unroll
    for (int o = 1; o < 64; o <<= 1) v += __shfl_xor(v, o);
    return v;
}
__device__ __forceinline__ float wave_max(float v) {
#pragma unroll
    for (int o = 1; o < 64; o <<= 1) v = fmaxf(v, __shfl_xor(v, o));
    return v;
}
__device__ __forceinline__ float sigmoidf_(float x) { return 1.0f / (1.0f + __expf(-x)); }
__device__ __forceinline__ int opaque_tid() { int t = threadIdx.x; asm volatile("" : "+v"(t)); return t; }

#define LAS __attribute__((address_space(3)))
typedef unsigned u32x4 __attribute__((ext_vector_type(4)));
namespace pg8 {
constexpr int BM = 256, BK = 64, HALF = 128, HTB = HALF * BK * 2, STAGE_BYTES = 8 * HTB;
__host__ __device__ __forceinline__ int lds_byte(int r, int c) { const int st = (r >> 4) * 2 + (c >> 5), rr = r & 15, cc = c & 31, ob = rr * 64 + cc * 2; return st * 1024 + (ob ^ (((ob >> 9) & 1) << 5)); }
__host__ __device__ __forceinline__ void stage_rc(int b, int& R, int& C) { const int st = b / 1024, sb = b % 1024, swz = sb ^ (((sb >> 9) & 1) << 5); R = (st >> 1) * 16 + swz / 64; C = (st & 1) * 32 + (swz % 64) / 2; }
__host__ __device__ __forceinline__ int perm32(int rho) { const int n = rho >> 4, i = rho & 15; return 8 * (i >> 2) + 4 * n + (i & 3); }
struct Unit { int pm, pn, e, rows, tm, ui; };
typedef float f32x2_ __attribute__((ext_vector_type(2)));
typedef __bf16 bf16x2_ __attribute__((ext_vector_type(2)));
__device__ __forceinline__ unsigned cvt_pk_bf16(float lo, float hi) { const f32x2_ v = {lo, hi}; return __builtin_bit_cast(unsigned, __builtin_convertvector(v, bf16x2_)); }

struct DenseSched {
    int nM, nN, nwg, G, c, K;
    __device__ void init(int M, int N, int K_, int G_, int c_) { nM = M / BM; nN = N / BM; nwg = nM * nN; G = G_; c = c_; K = K_; }
    __device__ bool next(int i, Unit& u) const {
        const long L = (long)i * G + c; if (L >= nwg) return false;
        int wgid = (int)L; { const int q = nwg / 8, r = nwg % 8, xcd = wgid % 8, off = wgid / 8; wgid = (xcd < r ? xcd * (q + 1) : r * (q + 1) + (xcd - r) * q) + off; }
        const int nig = 8 * nN, gid = wgid / nig, fm = gid * 8, gsz = (nM - fm) < 8 ? (nM - fm) : 8;
        u.pm = fm + ((wgid % nig) % gsz); u.pn = (wgid % nig) / gsz; u.e = 0; u.rows = 256; u.tm = 0; u.ui = i; return true;
    }
    __device__ __forceinline__ unsigned a_off(const Unit& u, int half, int R) const { return (unsigned)((u.pm * 256 + half * 128 + R) * K) * 2u; }
};

template <class Epi, class Sched>
__device__ __forceinline__ void gemm_phase(LAS unsigned char* lds, const bf16_t* A, const bf16_t* Bt, int K, size_t bstride, const Sched& S, const Epi& E) {
    const int tid = opaque_tid(), wid = __builtin_amdgcn_readfirstlane(tid >> 6), lane = tid & 63, wr = wid >> 2, wc = wid & 3, fr = lane & 15, fq = lane >> 4;
    const int nt = K / BK;
    int sR[2], sC2[2]; unsigned voffB[2];
#pragma unroll
    for (int i = 0; i < 2; ++i) { int R, C; stage_rc(tid * 16 + i * 8192, R, C); const int Rb = (R & ~31) + perm32(R & 31); sR[i] = R; sC2[i] = C * 2; voffB[i] = (unsigned)(Rb * K + C) * 2u; }
    const size_t kstep = (size_t)(BK * 2);
    const size_t hstep = (size_t)HALF * K * 2;
    const size_t tstep = 2 * hstep;
    const unsigned ldsw = (unsigned)wid * 1024u;
    const int aoff = lds_byte(wr * 64 + fr, fq * 8), boff = lds_byte(wc * 32 + fr, fq * 8);
#define PG8_SA(b, h) (((b) * 2 + (h)) * HTB)
#define PG8_SB(b, h) ((4 + (b) * 2 + (h)) * HTB)
#define PG8_STAGE(bufoff, gbase, voff) do { _Pragma("unroll") for (int _i = 0; _i < 2; ++_i) \
        __builtin_amdgcn_global_load_lds((const unsigned*)((const char*)(gbase) + (voff)[_i]), (LAS unsigned*)(lds + (bufoff) + ldsw + _i * 8192), 16, 0, 0); } while (0)
#define PG8_LDA(dst, b, h) do { _Pragma("unroll") for (int m = 0; m < 4; ++m) _Pragma("unroll") for (int k = 0; k < 2; ++k) dst[m][k] = *(const LAS bf16x8*)(lds + PG8_SA(b, h) + aoff + m * 2048 + k * 1024); } while (0)
#define PG8_LDB(dst, b, h) do { _Pragma("unroll") for (int n = 0; n < 2; ++n) _Pragma("unroll") for (int k = 0; k < 2; ++k) dst[n][k] = *(const LAS bf16x8*)(lds + PG8_SB(b, h) + boff + n * 2048 + k * 1024); } while (0)
#define PG8_MMA(ai, bj, At, Bt_) do { __builtin_amdgcn_s_setprio(1); _Pragma("unroll") for (int m = 0; m < 4; ++m) _Pragma("unroll") for (int n = 0; n < 2; ++n) _Pragma("unroll") for (int k = 0; k < 2; ++k) \
        acc[ai][bj][m][n] = __builtin_amdgcn_mfma_f32_16x16x32_bf16(Bt_[n][k], At[m][k], acc[ai][bj][m][n], 0, 0, 0); __builtin_amdgcn_s_setprio(0); } while (0)
#define PG8_WAIT_V(n) asm volatile("s_waitcnt vmcnt(" #n ")" ::: "memory")
#define PG8_WAIT_L(n) asm volatile("s_waitcnt lgkmcnt(" #n ")" ::: "memory")
#define PG8_BAR __builtin_amdgcn_s_barrier()
#define PG8_SCHED __builtin_amdgcn_sched_barrier(0)
    Unit cur, nxt; int ui = 0;
    if (!S.next(0, cur)) return;
    f32x4 acc[2][2][4][2];
#pragma unroll
    for (int a = 0; a < 2; ++a)
#pragma unroll
        for (int b = 0; b < 2; ++b)
#pragma unroll
            for (int m = 0; m < 4; ++m)
#pragma unroll
                for (int n = 0; n < 2; ++n) acc[a][b][m][n] = (f32x4){0.f, 0.f, 0.f, 0.f};
    bf16x8 At[4][2], B0[2][2], B1[2][2];
    unsigned voffA0[2], voffA1[2];
#pragma unroll
    for (int i = 0; i < 2; ++i) { voffA0[i] = S.a_off(cur, 0, sR[i]) + sC2[i]; voffA1[i] = S.a_off(cur, 1, sR[i]) + sC2[i]; }
    const char* const Ab = (const char*)A;
    const char* cB = (const char*)Bt + (size_t)cur.e * bstride + (size_t)cur.pn * tstep;
    PG8_STAGE(PG8_SB(0, 0), cB, voffB); PG8_STAGE(PG8_SB(0, 1), cB + hstep, voffB); PG8_STAGE(PG8_SA(0, 0), Ab, voffA0); PG8_STAGE(PG8_SA(0, 1), Ab, voffA1);
    if (wr == 1) PG8_BAR;
    PG8_WAIT_V(2); PG8_BAR;
    PG8_STAGE(PG8_SB(1, 0), cB + kstep, voffB); PG8_STAGE(PG8_SA(1, 0), Ab + kstep, voffA0); PG8_STAGE(PG8_SB(1, 1), cB + hstep + kstep, voffB);
    PG8_WAIT_V(6); PG8_BAR;
    for (;;) {
        const bool has_next = S.next(ui + 1, nxt);
        const char* nB = has_next ? (const char*)Bt + (size_t)nxt.e * bstride + (size_t)nxt.pn * tstep : cB;
        for (int t = 0; t < nt; t += 2) {
            const bool last = (t == nt - 2);
            const char* a1 = Ab + (size_t)(t + 1) * kstep;
            const char* a2 = last ? Ab : Ab + (size_t)(t + 2) * kstep; const char* b2 = last ? nB : cB + (size_t)(t + 2) * kstep;
            const char* a3 = a2 + kstep; const char* b3 = b2 + kstep;
            PG8_LDB(B0, 0, 0); PG8_LDB(B1, 0, 1); PG8_SCHED; PG8_LDA(At, 0, 0); PG8_STAGE(PG8_SA(1, 1), a1, voffA1);
            if (last && has_next) {
#pragma unroll
                for (int i = 0; i < 2; ++i) { voffA0[i] = S.a_off(nxt, 0, sR[i]) + sC2[i]; voffA1[i] = S.a_off(nxt, 1, sR[i]) + sC2[i]; }
            }
            PG8_WAIT_V(8); PG8_WAIT_L(0); PG8_BAR; PG8_MMA(0, 0, At, B0); PG8_MMA(0, 1, At, B1); PG8_BAR; PG8_SCHED;
            PG8_LDA(At, 0, 1); PG8_STAGE(PG8_SB(0, 0), b2, voffB); PG8_STAGE(PG8_SB(0, 1), b2 + hstep, voffB); PG8_STAGE(PG8_SA(0, 0), a2, voffA0);
            PG8_WAIT_V(8); PG8_WAIT_L(0); PG8_BAR; PG8_MMA(1, 0, At, B0); PG8_MMA(1, 1, At, B1); PG8_BAR; PG8_SCHED;
            PG8_LDB(B0, 1, 0); PG8_LDB(B1, 1, 1); PG8_SCHED; PG8_LDA(At, 1, 0); PG8_STAGE(PG8_SA(0, 1), a2, voffA1);
            PG8_WAIT_V(8); PG8_WAIT_L(0); PG8_BAR; PG8_MMA(0, 0, At, B0); PG8_MMA(0, 1, At, B1); PG8_BAR; PG8_SCHED;
            PG8_LDA(At, 1, 1); PG8_STAGE(PG8_SB(1, 0), b3, voffB); PG8_STAGE(PG8_SB(1, 1), b3 + hstep, voffB); PG8_STAGE(PG8_SA(1, 0), a3, voffA0);
            PG8_WAIT_V(8); PG8_WAIT_L(0); PG8_BAR; PG8_MMA(1, 0, At, B0); PG8_MMA(1, 1, At, B1); PG8_BAR; PG8_SCHED;
        }
        if (wr == 0) PG8_BAR;
        E(acc, cur, wr, wc, fr, fq);
        if (!has_next) break;
#pragma unroll
        for (int a = 0; a < 2; ++a)
#pragma unroll
            for (int b = 0; b < 2; ++b)
#pragma unroll
                for (int m = 0; m < 4; ++m)
#pragma unroll
                    for (int n = 0; n < 2; ++n) acc[a][b][m][n] = (f32x4){0.f, 0.f, 0.f, 0.f};
        cur = nxt; cB = nB; ++ui;
        if (wr == 1) PG8_BAR;
    }
    PG8_WAIT_V(0);
    PG8_BAR;
#undef PG8_SA
#undef PG8_SB
#undef PG8_STAGE
#undef PG8_LDA
#undef PG8_LDB
#undef PG8_MMA
#undef PG8_WAIT_V
#undef PG8_WAIT_L
#undef PG8_BAR
#undef PG8_SCHED
}

#define PG8_ROWS_COLS const int row0 = u.pm * BM + wr * 64 + fr; const int col0 = wc * 32 + 8 * fq
__device__ __forceinline__ u32x4 pack8(const f32x4 v0, const f32x4 v1) { u32x4 w; w.x = cvt_pk_bf16(v0[0], v0[1]); w.y = cvt_pk_bf16(v0[2], v0[3]); w.z = cvt_pk_bf16(v1[0], v1[1]); w.w = cvt_pk_bf16(v1[2], v1[3]); return w; }
struct EpiStore {
    bf16_t* O; bf16_t* O2; int ldc, split; float scale; int pad;
    __device__ __forceinline__ void operator()(const f32x4 (&acc)[2][2][4][2], const Unit& u, int wr, int wc, int fr, int fq) const {
        PG8_ROWS_COLS; bf16_t* base = u.pn >= split ? O2 + (size_t)(u.pn - split) * BM : O + (size_t)u.pn * BM;
#pragma unroll
        for (int ai = 0; ai < 2; ++ai)
#pragma unroll
            for (int m = 0; m < 4; ++m) { bf16_t* rowp = base + (size_t)(row0 + ai * HALF + m * 16) * ldc + col0;
#pragma unroll
                for (int bj = 0; bj < 2; ++bj) *(u32x4*)(rowp + bj * HALF) = pack8(acc[ai][bj][m][0] * scale, acc[ai][bj][m][1] * scale); }
    }
};
struct EpiHgrn {
    bf16_t *Qb, *Kb, *Vb, *Gt; float* Gl; const float* lbraw; int layer, pad;
    __device__ __forceinline__ void operator()(const f32x4 (&acc)[2][2][4][2], const Unit& u, int wr, int wc, int fr, int fq) const {
        PG8_ROWS_COLS; const int seg = u.pn >> 3, ct = (u.pn & 7) * BM + col0;
        if (seg == 0 || seg == 2) { bf16_t* base = (seg == 0 ? Qb : Vb) + ct;
#pragma unroll
            for (int ai = 0; ai < 2; ++ai)
#pragma unroll
                for (int m = 0; m < 4; ++m) { bf16_t* rowp = base + (size_t)(row0 + ai * HALF + m * 16) * D;
#pragma unroll
                    for (int bj = 0; bj < 2; ++bj) *(u32x4*)(rowp + bj * HALF) = pack8(acc[ai][bj][m][0], acc[ai][bj][m][1]); }
        } else if (seg == 3) {
#pragma unroll
            for (int ai = 0; ai < 2; ++ai)
#pragma unroll
                for (int m = 0; m < 4; ++m) { bf16_t* rowp = Gt + ct + (size_t)(row0 + ai * HALF + m * 16) * D;
#pragma unroll
                    for (int bj = 0; bj < 2; ++bj) { f32x4 v[2];
#pragma unroll
                        for (int n = 0; n < 2; ++n)
#pragma unroll
                            for (int j = 0; j < 4; ++j) { const float x = acc[ai][bj][m][n][j]; v[n][j] = x * sigmoidf_(x); }
                        *(u32x4*)(rowp + bj * HALF) = pack8(v[0], v[1]); } }
        } else {
#pragma unroll
            for (int bj = 0; bj < 2; ++bj) { float lb[8];
#pragma unroll
                for (int j = 0; j < 8; ++j) { const int c = ct + bj * HALF + j; lb[j] = layer == 0 ? 0.f : sigmoidf_(lbraw[D + c] - lbraw[c]); }
#pragma unroll
                for (int ai = 0; ai < 2; ++ai)
#pragma unroll
                    for (int m = 0; m < 4; ++m) { const size_t o = (size_t)(row0 + ai * HALF + m * 16) * D + ct + bj * HALF; f32x4 kv[2], gv[2];
#pragma unroll
                        for (int n = 0; n < 2; ++n)
#pragma unroll
                            for (int j = 0; j < 4; ++j) { const float l = lb[4 * n + j], sg = sigmoidf_(acc[ai][bj][m][n][j]); gv[n][j] = __logf(fmaxf(l + (1.f - l) * sg, 1e-30f)); kv[n][j] = (1.f - l) * (1.f - sg); }
                        *(u32x4*)(Kb + o) = pack8(kv[0], kv[1]); *(f32x4*)(Gl + o) = gv[0]; *(f32x4*)(Gl + o + 4) = gv[1]; } }
        }
    }
};


constexpr int MOE_MAXU = 4, MOE_TAB_INTS = 128 + 256 * MOE_MAXU;
struct MoeSched {
    const LAS int* tab; const int* list; int NT, G, c, K, gather, pad;
    __device__ bool next(int i, Unit& u) const {
        const int L = i * G + c, TM = tab[32]; if (L >= TM * NT) return false;
        const int mt = L / NT; int e = 0; while (tab[e + 1] <= mt) ++e;
        u.pm = mt; u.pn = L - mt * NT; u.e = e; u.tm = mt - tab[e]; const int left = tab[64 + e] - 256 * u.tm; u.rows = left < 256 ? left : 256; u.ui = i; return true;
    }
    __device__ __forceinline__ int entry(const Unit& u, int r) const {
        const int a = tab[128 + 256 * u.ui + r]; return a >= 0 ? a : tab[128 + 256 * u.ui];
    }
    __device__ __forceinline__ unsigned a_off(const Unit& u, int half, int R) const {
        if (gather) return (unsigned)((entry(u, half * 128 + R) >> 1) * K) * 2u;
        return (unsigned)((u.pm * 256 + half * 128 + R) * K) * 2u;
    }
    __device__ void build(LAS int* t, const int* cnt) const {
        const int tid = opaque_tid();
        if (tid < 32) t[64 + tid] = cnt[tid];
        __syncthreads();
        if (tid == 0) { int p = 0; for (int e = 0; e < 32; ++e) { t[e] = p; p += (t[64 + e] + 255) >> 8; } t[32] = p; }
        __syncthreads();
        for (int i = 0; i < MOE_MAXU; ++i) { Unit u; if (!next(i, u)) break;
            if (tid < 256) { const int r = 256 * u.tm + tid; t[128 + 256 * i + tid] = r < t[64 + u.e] ? list[u.e * T + r] : -1; } }
        __syncthreads();
    }
};
struct EpiMoeH {
    bf16_t* Hs;
    __device__ __forceinline__ void operator()(const f32x4 (&acc)[2][2][4][2], const Unit& u, int wr, int wc, int fr, int fq) const {
        const int col0 = u.pn * 128 + wc * 32 + 8 * fq;
#pragma unroll
        for (int ai = 0; ai < 2; ++ai)
#pragma unroll
            for (int m = 0; m < 4; ++m) { const int rl = ai * HALF + wr * 64 + m * 16 + fr; f32x4 v[2];
#pragma unroll
                for (int n = 0; n < 2; ++n)
#pragma unroll
                    for (int j = 0; j < 4; ++j) { const float g = acc[ai][0][m][n][j]; v[n][j] = g * sigmoidf_(g) * acc[ai][1][m][n][j]; }
                if (rl < u.rows) *(u32x4*)(Hs + (size_t)(u.pm * 256 + rl) * DEXP + col0) = pack8(v[0], v[1]); }
    }
};
struct EpiMoeY {
    bf16_t* Y; const float* tg; MoeSched S;
    __device__ __forceinline__ void operator()(const f32x4 (&acc)[2][2][4][2], const Unit& u, int wr, int wc, int fr, int fq) const {
        const int col0 = u.pn * BM + wc * 32 + 8 * fq;
#pragma unroll
        for (int ai = 0; ai < 2; ++ai)
#pragma unroll
            for (int m = 0; m < 4; ++m) { const int rl = ai * HALF + wr * 64 + m * 16 + fr;
                if (rl < u.rows) { const int a = S.entry(u, rl); const float g = tg[a]; bf16_t* rowp = Y + (size_t)a * D + col0;
#pragma unroll
                    for (int bj = 0; bj < 2; ++bj) *(u32x4*)(rowp + bj * HALF) = pack8(acc[ai][bj][m][0] * g, acc[ai][bj][m][1] * g); } }
    }
};

__device__ __forceinline__ void transpose_item(const float* W, int K, int N, bf16_t* WT, int dst_row0, LAS float* scr, int kb, int nb, int lane) {
    const int k0 = 64 * kb, n0 = 32 * nb;
#pragma unroll 8
    for (int i = 0; i < 32; ++i) { const int kk = 2 * i + (lane >> 5); scr[kk * 33 + (lane & 31)] = W[(size_t)(k0 + kk) * N + n0 + (lane & 31)]; }
    asm volatile("s_waitcnt lgkmcnt(0)" ::: "memory");
    const int c = lane & 7;
#pragma unroll
    for (int j = 0; j < 4; ++j) { const int n = (lane >> 3) + 8 * j; const LAS float* s = scr + (8 * c) * 33 + n;
        u32x4 o; o.x = f2bf(s[0 * 33]) | (f2bf(s[1 * 33]) << 16); o.y = f2bf(s[2 * 33]) | (f2bf(s[3 * 33]) << 16); o.z = f2bf(s[4 * 33]) | (f2bf(s[5 * 33]) << 16); o.w = f2bf(s[6 * 33]) | (f2bf(s[7 * 33]) << 16);
        *(u32x4*)(WT + (size_t)(dst_row0 + n) * K + k0 + 8 * c) = o; }
    asm volatile("s_waitcnt lgkmcnt(0)" ::: "memory");
}
}

typedef short s16x4 __attribute__((ext_vector_type(4)));
typedef LAS s16x4 lds_s16x4;
constexpr int HRS = 272, ARS = 144;
constexpr int H1_QH = 0, H1_KH0 = H1_QH + 64 * HRS, H1_KH1 = H1_KH0 + 16 * HRS, H1_KH2 = H1_KH1 + 32 * HRS, H1_KH3 = H1_KH2 + 48 * HRS, H1_KT = H1_KH3 + 64 * HRS,
              H1_VS = H1_KT + 64 * HRS, H1_AS = H1_VS + 64 * HRS, H1_TOT = H1_AS + 64 * ARS, H1_BYTES = H1_TOT + 2048;
constexpr int NUNIT = BATCH * HG_H * (SEQ / 64);
__device__ __forceinline__ bf16x8 tr_frag16(const LAS unsigned char* tile, int rs, int r0, int c0, int lane) {
    const int g = lane >> 4, i = lane & 15, q = i >> 2, p = i & 3;
    const LAS unsigned char* a = tile + (r0 + 8 * g + q) * rs + (c0 + 4 * p) * 2;
    const s16x4 lo = __builtin_amdgcn_ds_read_tr16_b64_v4i16((lds_s16x4*)a);
    const s16x4 hi = __builtin_amdgcn_ds_read_tr16_b64_v4i16((lds_s16x4*)(a + 4 * rs));
    return (bf16x8){lo[0], lo[1], lo[2], lo[3], hi[0], hi[1], hi[2], hi[3]};
}
__device__ __forceinline__ bf16x8 row_frag16(const LAS unsigned char* tile, int rs, int r0, int c0, int lane) {
    return *(const LAS bf16x8*)(tile + (r0 + (lane & 15)) * rs + (c0 + 8 * (lane >> 4)) * 2);
}
#define MFMA16(a, b, c) __builtin_amdgcn_mfma_f32_16x16x32_bf16((a), (b), (c), 0, 0, 0)
typedef unsigned u32x2 __attribute__((ext_vector_type(2)));
__device__ __forceinline__ u32x2 pack4(const f32x4 v) { u32x2 r; r.x = pg8::cvt_pk_bf16(v[0], v[1]); r.y = pg8::cvt_pk_bf16(v[2], v[3]); return r; }

struct HgArgs { bf16_t *Qb, *Kb, *Vb, *Gt, *OI, *UT, *Sst, *Og; float *Gl, *Dg; const float* ng; };

__device__ __forceinline__ void h1_phase(LAS unsigned char* lds, const HgArgs& a, int vcu, int G) {
    const int tid = opaque_tid(), lane = tid & 63, wid = __builtin_amdgcn_readfirstlane(tid >> 6);
    const int ch = tid & 127, J = __builtin_amdgcn_readfirstlane(tid >> 7);
    LAS float* tot = (LAS float*)(lds + H1_TOT);
    for (int unit = vcu; unit < NUNIT; unit += G) {
        const int bh = unit >> 5, c = unit & 31, b = bh >> 4, h = bh & 15;
        const size_t gbase = ((size_t)b * SEQ + c * 64) * D + h * 128;
        float L[16]; { float l = 0.f;
#pragma unroll
            for (int i = 0; i < 16; ++i) { l += a.Gl[gbase + (size_t)(16 * J + i) * D + ch]; L[i] = l; } }
        tot[J * 128 + ch] = L[15];
#pragma unroll
        for (int i = 0; i < 2; ++i) { const int id = tid + 512 * i, r = id >> 4, ck = id & 15; *(LAS u32x4*)(lds + H1_VS + r * HRS + ck * 16) = *(const u32x4*)(a.Vb + gbase + (size_t)r * D + ck * 8); }
        for (int id = tid; id < 64 * ARS / 16; id += 512) *(LAS u32x4*)(lds + H1_AS + id * 16) = (u32x4){0u, 0u, 0u, 0u};
        __syncthreads();
        float tj[4]; tj[0] = tot[ch]; tj[1] = tot[128 + ch]; tj[2] = tot[256 + ch]; tj[3] = tot[384 + ch];
        float aJ = 0.f;
#pragma unroll
        for (int M = 0; M < 3; ++M) if (M < J) aJ += tj[M];
        const int khJ = J == 0 ? H1_KH0 : J == 1 ? H1_KH1 : J == 2 ? H1_KH2 : H1_KH3;
#pragma unroll
        for (int i = 0; i < 16; ++i) {
            const int t = 16 * J + i; const size_t go = gbase + (size_t)t * D + ch;
            const float q = bf2f(a.Qb[go]), k = bf2f(a.Kb[go]), Li = L[i], rem = L[15] - Li;
            *(LAS bf16_t*)(lds + H1_QH + t * HRS + ch * 2) = (bf16_t)f2bf(q * __expf(Li));
            a.Qb[go] = (bf16_t)f2bf(q * __expf(Li + aJ));
            *(LAS bf16_t*)(lds + khJ + t * HRS + ch * 2) = (bf16_t)f2bf(k * __expf(fminf(-Li, 60.f)));
#pragma unroll
            for (int I = 1; I <= 4; ++I) {
                if (I > J) { float sx = rem;
#pragma unroll
                    for (int M = 1; M < 4; ++M) if (M > J && M < I) sx += tj[M];
                    constexpr int offs[5] = {H1_KH0, H1_KH1, H1_KH2, H1_KH3, H1_KT};
                    *(LAS bf16_t*)(lds + offs[I] + t * HRS + ch * 2) = (bf16_t)f2bf(k * __expf(sx)); }
            }
        }
        if (J == 0) a.Dg[(size_t)unit * 128 + ch] = __expf((tj[0] + tj[1]) + (tj[2] + tj[3]));
        __syncthreads();
        for (int blk = wid; blk < 10; blk += 8) {
            const int I = blk < 1 ? 0 : blk < 3 ? 1 : blk < 6 ? 2 : 3, Jb = blk - (I * (I + 1)) / 2;
            const int khI = I == 0 ? H1_KH0 : I == 1 ? H1_KH1 : I == 2 ? H1_KH2 : H1_KH3;
            f32x4 acc = {0.f, 0.f, 0.f, 0.f};
#pragma unroll
            for (int ks = 0; ks < 4; ++ks) acc = MFMA16(row_frag16(lds + khI, HRS, 16 * Jb, 32 * ks, lane), row_frag16(lds + H1_QH, HRS, 16 * I, 32 * ks, lane), acc);
            const int tl = 16 * I + (lane & 15), s0 = 16 * Jb + 4 * (lane >> 4);
#pragma unroll
            for (int r = 0; r < 4; ++r) if (s0 + r > tl) acc[r] = 0.f;
            *(LAS u32x2*)(lds + H1_AS + tl * ARS + s0 * 2) = pack4(acc);
        }
        __syncthreads();
        {
            bf16x8 vtr[2];
#pragma unroll
            for (int ks = 0; ks < 2; ++ks) vtr[ks] = tr_frag16(lds + H1_VS, HRS, 32 * ks, 16 * wid, lane);
#pragma unroll
            for (int rb = 0; rb < 4; ++rb) { f32x4 acc = {0.f, 0.f, 0.f, 0.f};
#pragma unroll
                for (int ks = 0; ks < 2; ++ks) if (!(ks == 1 && rb < 2)) acc = MFMA16(vtr[ks], row_frag16(lds + H1_AS, ARS, 16 * rb, 32 * ks, lane), acc);
                *(u32x2*)(a.OI + gbase + (size_t)(16 * rb + (lane & 15)) * D + 16 * wid + 4 * (lane >> 4)) = pack4(acc); }
#pragma unroll
            for (int cb = 0; cb < 8; ++cb) { f32x4 acc = {0.f, 0.f, 0.f, 0.f};
#pragma unroll
                for (int ks = 0; ks < 2; ++ks) acc = MFMA16(tr_frag16(lds + H1_KT, HRS, 32 * ks, 16 * cb, lane), vtr[ks], acc);
                *(u32x2*)(a.UT + ((size_t)unit * 128 + 16 * wid + (lane & 15)) * 128 + 16 * cb + 4 * (lane >> 4)) = pack4(acc); }
        }
        __syncthreads();
    }
}
__device__ __forceinline__ void h2_phase(const HgArgs& a, int vcu, int G) {
    for (int item = vcu * 512 + opaque_tid(); item < BATCH * HG_H * 2048; item += G * 512) {
        const int bh = item >> 11, vec = item & 2047, ch0 = (vec & 15) * 8;
        float st[8];
#pragma unroll
        for (int j = 0; j < 8; ++j) st[j] = 0.f;
        for (int c = 0; c < 32; ++c) { const size_t u = (size_t)bh * 32 + c;
            *(u32x4*)(a.Sst + u * 16384 + vec * 8) = pg8::pack8((f32x4){st[0], st[1], st[2], st[3]}, (f32x4){st[4], st[5], st[6], st[7]});
            if (c < 31) { const uint4 uu = *(const uint4*)(a.UT + u * 16384 + vec * 8); const float4 d0 = *(const float4*)(a.Dg + u * 128 + ch0), d1 = *(const float4*)(a.Dg + u * 128 + ch0 + 4);
                const unsigned w[4] = {uu.x, uu.y, uu.z, uu.w}; const float dd[8] = {d0.x, d0.y, d0.z, d0.w, d1.x, d1.y, d1.z, d1.w};
#pragma unroll
                for (int j = 0; j < 4; ++j) { st[2 * j] = dd[2 * j] * st[2 * j] + bf2f((bf16_t)(w[j] & 0xffff)); st[2 * j + 1] = dd[2 * j + 1] * st[2 * j + 1] + bf2f((bf16_t)(w[j] >> 16)); } }
        }
    }
}
__device__ __forceinline__ void h3_phase(const HgArgs& a, int vcu, int G) {
    const int tid = opaque_tid(), lane = tid & 63, wid = __builtin_amdgcn_readfirstlane(tid >> 6);
    for (int pair = vcu; pair < NUNIT / 2; pair += G) {
        const int unit = pair * 2 + (wid >> 2), rb = wid & 3;
        const int bh = unit >> 5, c = unit & 31, b = bh >> 4, h = bh & 15;
        const size_t ro = ((size_t)b * SEQ + c * 64 + 16 * rb + (lane & 15)) * D + h * 128;
        bf16x8 qf[4];
#pragma unroll
        for (int ks = 0; ks < 4; ++ks) qf[ks] = *(const bf16x8*)(a.Qb + ro + 32 * ks + 8 * (lane >> 4));
        f32x4 o[8]; float ss = 0.f;
#pragma unroll
        for (int cb = 0; cb < 8; ++cb) { f32x4 acc = {0.f, 0.f, 0.f, 0.f};
            const bf16_t* sp = a.Sst + ((size_t)unit * 128 + 16 * cb + (lane & 15)) * 128 + 8 * (lane >> 4);
#pragma unroll
            for (int ks = 0; ks < 4; ++ks) acc = MFMA16(*(const bf16x8*)(sp + 32 * ks), qf[ks], acc);
            const uint2 oi = *(const uint2*)(a.OI + ro + 16 * cb + 4 * (lane >> 4));
            acc[0] += bf2f((bf16_t)(oi.x & 0xffff)); acc[1] += bf2f((bf16_t)(oi.x >> 16)); acc[2] += bf2f((bf16_t)(oi.y & 0xffff)); acc[3] += bf2f((bf16_t)(oi.y >> 16));
            o[cb] = acc; ss += (acc[0] * acc[0] + acc[1] * acc[1]) + (acc[2] * acc[2] + acc[3] * acc[3]); }
        ss += __shfl_xor(ss, 16); ss += __shfl_xor(ss, 32);
        const float r = 1.0f / sqrtf(ss * (1.f / 128.f) + RMS_EPS);
#pragma unroll
        for (int cb = 0; cb < 8; ++cb) { const int vc = 16 * cb + 4 * (lane >> 4); const float4 g = *(const float4*)(a.ng + h * 128 + vc); const uint2 gt = *(const uint2*)(a.Gt + ro + vc);
            f32x4 v; v[0] = o[cb][0] * r * g.x * bf2f((bf16_t)(gt.x & 0xffff)); v[1] = o[cb][1] * r * g.y * bf2f((bf16_t)(gt.x >> 16)); v[2] = o[cb][2] * r * g.z * bf2f((bf16_t)(gt.y & 0xffff)); v[3] = o[cb][3] * r * g.w * bf2f((bf16_t)(gt.y >> 16));
            *(u32x2*)(a.Og + ro + vc) = pack4(v); }
    }
}

#define XB_TMO      128
#define XB_XCNT(j)  (256  + 64 * (j))
#define XB_XSUB(j)  (1280 + 64 * (j))
#define XB_XGEN(j)  (2304 + 64 * (j))
#define XB_TOP      3328
#define XB_TOPGEN   3392
#define XCD_BAR_WORDS 3456
#define XB_SPIN_CAP (1u << 18)
__device__ __forceinline__ unsigned xb_ld(unsigned* p)              { return __hip_atomic_load(p, __ATOMIC_RELAXED, __HIP_MEMORY_SCOPE_AGENT); }
__device__ __forceinline__ unsigned xb_add(unsigned* p, unsigned v) { return __hip_atomic_fetch_add(p, v, __ATOMIC_RELAXED, __HIP_MEMORY_SCOPE_AGENT); }
__device__ __forceinline__ unsigned xb_xcc_id() { return (unsigned)__builtin_amdgcn_s_getreg((3 << 11) | 20) & 0xFu; }
#define XB_SPIN(cond, bar) do { unsigned _sp = 0; while (cond) { __builtin_amdgcn_s_sleep(1); \
    if ((++_sp & 255u) == 0u) { if (xb_ld(&(bar)[XB_TMO])) break; if (_sp > XB_SPIN_CAP) { atomicAdd(&(bar)[XB_TMO], 1u); break; } } } } while (0)
struct XcdBarrier { unsigned* bar; unsigned x; volatile LAS unsigned* st; };
__device__ __forceinline__ XcdBarrier xcd_barrier_post(unsigned* bar, volatile LAS unsigned* st) {
    XcdBarrier b; b.bar = bar; b.x = xb_xcc_id(); b.st = st;
    if (threadIdx.x == 0) (void)xb_add(&bar[XB_XCNT(b.x)], 1u);
    return b;
}
__device__ __forceinline__ void xcd_barrier_complete(unsigned* bar, unsigned x, unsigned& nloc, unsigned& nx) {
    const unsigned G = gridDim.x * gridDim.y * gridDim.z;
    unsigned sum, cnt, mine, sp = 0u;
    for (;;) {
        sum = 0u; cnt = 0u; mine = 0u;
#pragma unroll
        for (unsigned j = 0; j < 16; ++j) { const unsigned c = xb_ld(&bar[XB_XCNT(j)]); sum += c; cnt += (c > 0u) ? 1u : 0u; mine = (j == x) ? c : mine; }
        if (sum == G) break;
        __builtin_amdgcn_s_sleep(1);
        if ((++sp & 255u) == 0u) { if (xb_ld(&bar[XB_TMO])) break; if (sp > XB_SPIN_CAP) { atomicAdd(&bar[XB_TMO], 1u); break; } }
    }
    nloc = mine > 0u ? mine : 1u; nx = cnt > 0u ? cnt : 1u;
}
__device__ __forceinline__ void xcd_barrier(const XcdBarrier& b) {
    asm volatile("s_waitcnt vmcnt(0)" ::: "memory");
    __syncthreads();
    if (threadIdx.x == 0) {
        unsigned* bar = b.bar;
        __builtin_amdgcn_s_waitcnt(0);
        unsigned nloc = b.st[0], nx = b.st[1];
        if (nloc == 0u) { xcd_barrier_complete(bar, b.x, nloc, nx); b.st[0] = nloc; b.st[1] = nx; }
        const unsigned old = xb_add(&bar[XB_XSUB(b.x)], 1u);
        const unsigned gen = old / nloc;
        if (old + 1u == (gen + 1u) * nloc) {
            __builtin_amdgcn_fence(__ATOMIC_RELEASE, "agent");
            asm volatile("s_waitcnt vmcnt(0)" ::: "memory");
            const unsigned og = xb_add(&bar[XB_TOP], 1u);
            const unsigned tg = og / nx;
            if (og + 1u == (tg + 1u) * nx) xb_add(&bar[XB_TOPGEN], 1u);
            else XB_SPIN(xb_ld(&bar[XB_TOPGEN]) == tg, bar);
            __builtin_amdgcn_fence(__ATOMIC_ACQUIRE, "agent");
            xb_add(&bar[XB_XGEN(b.x)], 1u);
            asm volatile("s_waitcnt vmcnt(0)" ::: "memory");
        } else {
            XB_SPIN(xb_ld(&bar[XB_XGEN(b.x)]) == gen, bar);
            __builtin_amdgcn_fence(__ATOMIC_ACQUIRE, "agent");
            asm volatile("s_waitcnt vmcnt(0)" ::: "memory");
        }
    }
    __syncthreads();
}

struct Ptrs {
    const float *x, *a_w_in, *a_lb, *a_ng, *a_w_out, *b_w_kv, *b_w_q, *b_sinks, *b_w_out, *rel_bias, *w_rg, *b_rg, *w_re, *b_re, *w_gate, *w_up, *w_down, *ln_g, *ln_b;
    float* out; unsigned char* ws;
};
__device__ __forceinline__ void prologue_phase(LAS unsigned char* lds, const Ptrs& p, int vcu, int G) {
    const int tid = opaque_tid(), lane = tid & 63, wave = __builtin_amdgcn_readfirstlane(tid >> 6);
    LAS float* scr = (LAS float*)(lds + wave * 8448);
    const int gw = vcu * 8 + wave, NGW = G * 8;
    bf16_t* Win_t = (bf16_t*)(p.ws + WS_WIN); bf16_t* Wout_t = (bf16_t*)(p.ws + WS_WOUT); bf16_t* Wkv_t = (bf16_t*)(p.ws + WS_WKV); bf16_t* Wq_t = (bf16_t*)(p.ws + WS_WQ); bf16_t* Wo_t = (bf16_t*)(p.ws + WS_WO);
    bf16_t* Wgu_t = (bf16_t*)(p.ws + WS_WGU); bf16_t* Wd_t = (bf16_t*)(p.ws + WS_WD);
    constexpr int I_IN = 2 * 32 * 256, I_AO = 2 * 32 * 64, I_KV = 32 * 16, I_Q = 2 * 32 * 64, I_O = 2 * 32 * 64, I_G = 128 * 32 * 16, I_U = I_G, I_D = 128 * 8 * 64;
    constexpr int NITEMS = I_IN + I_AO + I_KV + I_Q + I_O + I_G + I_U + I_D;
    for (int it = gw; it < NITEMS; it += NGW) {
        int r = it;
        if (r < I_IN) { const int mat = r / (32 * 256), q = r % (32 * 256), kb = q / 256, nb = q % 256; pg8::transpose_item(p.a_w_in + (size_t)mat * D * 4 * D, D, 4 * D, Win_t + (size_t)mat * 4 * D * D, 32 * nb, scr, kb, nb, lane); continue; } r -= I_IN;
        if (r < I_AO) { const int mat = r / (32 * 64), q = r % (32 * 64), kb = q / 64, nb = q % 64; pg8::transpose_item(p.a_w_out + (size_t)mat * D * D, D, D, Wout_t + (size_t)mat * D * D, 32 * nb, scr, kb, nb, lane); continue; } r -= I_AO;
        if (r < I_KV) { const int kb = r / 16, nb = r % 16; pg8::transpose_item(p.b_w_kv, D, 2 * KVW, Wkv_t, 32 * nb, scr, kb, nb, lane); continue; } r -= I_KV;
        if (r < I_Q) { const int mat = r / (32 * 64), q = r % (32 * 64), kb = q / 64, nb = q % 64; pg8::transpose_item(p.b_w_q + (size_t)mat * D * D, D, D, Wq_t + (size_t)mat * D * D, 32 * nb, scr, kb, nb, lane); continue; } r -= I_Q;
        if (r < I_O) { const int mat = r / (32 * 64), q = r % (32 * 64), kb = q / 64, nb = q % 64; pg8::transpose_item(p.b_w_out + (size_t)mat * D * D, D, D, Wo_t + (size_t)mat * D * D, 32 * nb, scr, kb, nb, lane); continue; } r -= I_O;
        if (r < I_G + I_U) { const int up = r >= I_G; if (up) r -= I_G; const int mat = r / (32 * 16), q = r % (32 * 16), kb = q / 16, nb = q % 16;
            const int n0 = 32 * nb, drow = (n0 >> 7) * 256 + (n0 & 127) + (up ? 128 : 0);
            pg8::transpose_item((up ? p.w_up : p.w_gate) + (size_t)mat * D * DEXP, D, DEXP, Wgu_t + (size_t)mat * 2 * DEXP * D, drow, scr, kb, nb, lane); continue; } r -= I_G + I_U;
        { const int mat = r / (8 * 64), q = r % (8 * 64), kb = q / 64, nb = q % 64; pg8::transpose_item(p.w_down + (size_t)mat * DEXP * D, DEXP, D, Wd_t + (size_t)mat * D * DEXP, 32 * nb, scr, kb, nb, lane); }
    }
    bf16_t* xb = (bf16_t*)(p.ws + WS_XB);
    for (size_t i = (size_t)vcu * 512 + tid; i < (size_t)T * D / 4; i += (size_t)G * 512) { const float4 v = ((const float4*)p.x)[i];
        u32x2 o; o.x = pg8::cvt_pk_bf16(v.x, v.y); o.y = pg8::cvt_pk_bf16(v.z, v.w); ((u32x2*)xb)[i] = o; }
}

template <int MODE>
__device__ __forceinline__ void ln_phase(const float* xin, const bf16_t* hm, const bf16_t* Y, const float* lng, const float* lnb, float* xf, bf16_t* xb,
                                         const float* wrg, const float* brg, const float* wre, const float* bre, int* cnt, int* list, float* tg, int vcu, int G) {
    const int tid = opaque_tid();
    for (int row = vcu * 8 + (tid >> 6); row < T; row += G * 8) {
        const int lane = opaque_tid() & 63;
        float v[32];
        float s = 0.f;
#pragma unroll
        for (int j = 0; j < 8; ++j) { const int c = 4 * lane + 256 * j; const float4 a = *(const float4*)(xin + (size_t)row * D + c);
            float4 h;
            if (MODE == 0) { const uint2 y0 = *(const uint2*)(hm + (size_t)row * D + c); h.x = bf2f((bf16_t)(y0.x & 0xffff)); h.y = bf2f((bf16_t)(y0.x >> 16)); h.z = bf2f((bf16_t)(y0.y & 0xffff)); h.w = bf2f((bf16_t)(y0.y >> 16)); }
            else { const uint2 y0 = *(const uint2*)(Y + (size_t)(row * 2) * D + c), y1 = *(const uint2*)(Y + (size_t)(row * 2 + 1) * D + c);
                h.x = bf2f((bf16_t)(y0.x & 0xffff)) + bf2f((bf16_t)(y1.x & 0xffff)); h.y = bf2f((bf16_t)(y0.x >> 16)) + bf2f((bf16_t)(y1.x >> 16));
                h.z = bf2f((bf16_t)(y0.y & 0xffff)) + bf2f((bf16_t)(y1.y & 0xffff)); h.w = bf2f((bf16_t)(y0.y >> 16)) + bf2f((bf16_t)(y1.y >> 16)); }
            v[4 * j + 0] = ALPHA * a.x + h.x; v[4 * j + 1] = ALPHA * a.y + h.y; v[4 * j + 2] = ALPHA * a.z + h.z; v[4 * j + 3] = ALPHA * a.w + h.w;
            s += (v[4 * j] + v[4 * j + 1]) + (v[4 * j + 2] + v[4 * j + 3]); }
        const float mean = wave_sum(s) * (1.f / D);
        float q = 0.f;
#pragma unroll
        for (int j = 0; j < 32; ++j) { v[j] -= mean; q += v[j] * v[j]; }
        const float rstd = 1.0f / sqrtf(wave_sum(q) * (1.f / D) + LN_EPS);
#pragma unroll
        for (int j = 0; j < 8; ++j) { const int c = 4 * lane + 256 * j; const float4 g = *(const float4*)(lng + c), b = *(const float4*)(lnb + c);
            v[4 * j + 0] = v[4 * j + 0] * rstd * g.x + b.x; v[4 * j + 1] = v[4 * j + 1] * rstd * g.y + b.y; v[4 * j + 2] = v[4 * j + 2] * rstd * g.z + b.z; v[4 * j + 3] = v[4 * j + 3] * rstd * g.w + b.w;
            *(float4*)(xf + (size_t)row * D + c) = make_float4(v[4 * j], v[4 * j + 1], v[4 * j + 2], v[4 * j + 3]);
            if (xb) { u32x2 o; o.x = pg8::cvt_pk_bf16(v[4 * j], v[4 * j + 1]); o.y = pg8::cvt_pk_bf16(v[4 * j + 2], v[4 * j + 3]); *(u32x2*)(xb + (size_t)row * D + c) = o; } }
        if (MODE == 0) {
            float gl[4] = {0.f, 0.f, 0.f, 0.f};
#pragma unroll
            for (int j = 0; j < 8; ++j)
#pragma unroll
                for (int i = 0; i < 4; ++i) { const int c = 4 * lane + 256 * j + i; const float4 w = *(const float4*)(wrg + (size_t)c * NGRP); const float x = v[4 * j + i];
                    gl[0] += x * w.x; gl[1] += x * w.y; gl[2] += x * w.z; gl[3] += x * w.w; }
#pragma unroll
            for (int g = 0; g < 4; ++g) gl[g] = wave_sum(gl[g]) + brg[g];
            int grp = 0; float gmax = gl[0];
#pragma unroll
            for (int g = 1; g < 4; ++g) if (gl[g] > gmax) { gmax = gl[g]; grp = g; }
            float gden = 0.f;
#pragma unroll
            for (int g = 0; g < 4; ++g) gden += __expf(gl[g] - gmax);
            const float pgrp = 1.0f / gden;
            float el[8] = {0.f, 0.f, 0.f, 0.f, 0.f, 0.f, 0.f, 0.f};
#pragma unroll
            for (int j = 0; j < 8; ++j)
#pragma unroll
                for (int i = 0; i < 4; ++i) { const int c = 4 * lane + 256 * j + i; const float4 w0 = *(const float4*)(wre + (size_t)c * NEXP + grp * 8), w1 = *(const float4*)(wre + (size_t)c * NEXP + grp * 8 + 4); const float x = v[4 * j + i];
                    el[0] += x * w0.x; el[1] += x * w0.y; el[2] += x * w0.z; el[3] += x * w0.w; el[4] += x * w1.x; el[5] += x * w1.y; el[6] += x * w1.z; el[7] += x * w1.w; }
#pragma unroll
            for (int e = 0; e < 8; ++e) el[e] = wave_sum(el[e]) + bre[grp * 8 + e];
            int i0 = 0; float v0 = el[0];
#pragma unroll
            for (int e = 1; e < 8; ++e) if (el[e] > v0) { v0 = el[e]; i0 = e; }
            int i1 = -1; float v1 = -3.0e38f;
#pragma unroll
            for (int e = 0; e < 8; ++e) if (e != i0 && el[e] > v1) { v1 = el[e]; i1 = e; }
            const float e1 = __expf(v1 - v0), den = 1.f + e1;
            const float g0 = pgrp / den, g1 = pgrp * e1 / den;
            if (lane == 0) {
                const int ea = grp * 8 + i0, eb = grp * 8 + i1;
                const int pa = atomicAdd(&cnt[ea], 1); list[ea * T + pa] = row * 2; tg[row * 2] = g0;
                const int pb = atomicAdd(&cnt[eb], 1); list[eb * T + pb] = row * 2 + 1; tg[row * 2 + 1] = g1;
            }
        }
    }
}

__device__ __forceinline__ int t5_bucket(int n) { if (n < 16) return n; int l = 16 + (int)(__logf((float)n * (1.f / 16.f)) / 2.0794415416798357f * 16.f); return l < 31 ? l : 31; }
__device__ __forceinline__ void attn_naive_phase(const bf16_t* Qb, const bf16_t* Kc, const bf16_t* Vc, const float* sinks, const float* relb, bf16_t* Og, int vcu, int G) {
    const int tid = opaque_tid(), lane = tid & 63;
    for (int item = vcu * 8 + (tid >> 6); item < T * AT_HQ; item += G * 8) {
        const int row = item >> 5, hq = item & 31, kvh = hq >> 3, tpos = row & (SEQ - 1);
        float qv[64];
        { const uint4* qp = (const uint4*)(Qb + (size_t)row * D + hq * 64);
#pragma unroll
          for (int i = 0; i < 8; ++i) { const uint4 u = qp[i]; const unsigned w[4] = {u.x, u.y, u.z, u.w};
#pragma unroll
              for (int j = 0; j < 4; ++j) { qv[8 * i + 2 * j] = bf2f((bf16_t)(w[j] & 0xffff)); qv[8 * i + 2 * j + 1] = bf2f((bf16_t)(w[j] >> 16)); } } }
        float sc[2];
#pragma unroll
        for (int r = 0; r < 2; ++r) { const int dist = lane + 64 * r, s = tpos - dist;
            if (s >= 0) { const uint4* kp = (const uint4*)(Kc + (size_t)(row - dist) * KVW + kvh * 64); float d = 0.f;
#pragma unroll
                for (int i = 0; i < 8; ++i) { const uint4 u = kp[i]; const unsigned w[4] = {u.x, u.y, u.z, u.w};
#pragma unroll
                    for (int j = 0; j < 4; ++j) { d += qv[8 * i + 2 * j] * bf2f((bf16_t)(w[j] & 0xffff)); d += qv[8 * i + 2 * j + 1] * bf2f((bf16_t)(w[j] >> 16)); } }
                sc[r] = d * 0.125f + relb[t5_bucket(dist) * AT_HQ + hq]; }
            else sc[r] = -1e30f; }
        const float sink = sinks[hq];
        const float m = fmaxf(wave_max(fmaxf(sc[0], sc[1])), sink);
        float p0 = __expf(sc[0] - m), p1 = __expf(sc[1] - m);
        if (tpos - lane < 0) p0 = 0.f;
        if (tpos - lane - 64 < 0) p1 = 0.f;
        const float den = wave_sum(p0 + p1) + __expf(sink - m);
        p0 /= den; p1 /= den;
        float o = 0.f;
        for (int dist = 0; dist < 128; ++dist) { const float w = __shfl(dist < 64 ? p0 : p1, dist & 63); const int s = tpos - dist;
            if (s >= 0) o += w * bf2f(Vc[(size_t)(row - dist) * KVW + kvh * 64 + lane]); }
        Og[(size_t)row * D + hq * 64 + lane] = (bf16_t)f2bf(o);
    }
}

constexpr int LDS_STAGE = 0;
constexpr int LDS_MOETAB = pg8::STAGE_BYTES;
constexpr int LDS_MISC = LDS_MOETAB + pg8::MOE_TAB_INTS * 4;
constexpr int LDS_BYTES = 147456;
static_assert(LDS_MISC + 256 <= LDS_BYTES && H1_BYTES <= pg8::STAGE_BYTES && 8 * 8448 <= pg8::STAGE_BYTES, "LDS map");
constexpr int CW_BAR = 4096;
constexpr int N_PHASES = 1 + NA * 9 + (DEPTH - NA) * 7;

struct MegaArgs { const float* in[19]; float* out; unsigned char* ws; int ph_lo, ph_hi; };

__global__ void __launch_bounds__(512, 2) mega_fwd(MegaArgs args) {
    extern __shared__ __attribute__((aligned(16))) unsigned char lds_raw[];
    LAS unsigned char* lds = (LAS unsigned char*)lds_raw;
    volatile LAS unsigned* MISC = (volatile LAS unsigned*)(lds + LDS_MISC);
    const int tid = threadIdx.x, G = gridDim.x, bx = blockIdx.x, vcu = (G % 8 == 0) ? (bx % 8) * (G / 8) + bx / 8 : bx;
    unsigned char* const ws = args.ws;
    if (tid < 64) MISC[tid] = 0u;
    __syncthreads();
    const int lo = args.ph_lo, hi = args.ph_hi;
    XcdBarrier bar; bar.bar = (unsigned*)(ws + WS_CTL) + CW_BAR; bar.x = 0; bar.st = nullptr;
    if (hi - lo > 1) bar = xcd_barrier_post((unsigned*)(ws + WS_CTL) + CW_BAR, MISC + 8);
#define WSP(type, off) ((type*)(args.ws + (off)))
    int ph = 0;
#define PH_BEGIN if (lo <= ph && ph < hi) {
#define PH_END   if (ph + 1 < hi) xcd_barrier(bar); } ++ph;

    PH_BEGIN { Ptrs p; p.x = args.in[0]; p.a_w_in = args.in[1]; p.a_w_out = args.in[4]; p.b_w_kv = args.in[5]; p.b_w_q = args.in[6]; p.b_w_out = args.in[8]; p.w_gate = args.in[14]; p.w_up = args.in[15]; p.w_down = args.in[16]; p.ws = args.ws;
               prologue_phase(lds, p, vcu, G); } PH_END

    for (int L = 0; L < DEPTH; ++L) {
        if (L < NA) {
            PH_BEGIN { pg8::DenseSched S; S.init(T, 4 * D, D, G, bx); pg8::EpiHgrn E{WSP(bf16_t, WS_QB), WSP(bf16_t, WS_KB), WSP(bf16_t, WS_VB), WSP(bf16_t, WS_GT), WSP(float, WS_GL), args.in[2], L, 0};
                       pg8::gemm_phase<pg8::EpiHgrn, pg8::DenseSched>(lds, WSP(bf16_t, WS_XB), WSP(bf16_t, WS_WIN) + (size_t)L * 4 * D * D, D, 0, S, E); } PH_END
#define HGARGS HgArgs{WSP(bf16_t, WS_QB), WSP(bf16_t, WS_KB), WSP(bf16_t, WS_VB), WSP(bf16_t, WS_GT), WSP(bf16_t, WS_OF), WSP(bf16_t, WS_UT), WSP(bf16_t, WS_SST), WSP(bf16_t, WS_OG), WSP(float, WS_GL), WSP(float, WS_DG), args.in[3] + (size_t)L * D}
            PH_BEGIN { const HgArgs ha = HGARGS; h1_phase(lds, ha, vcu, G); } PH_END
            PH_BEGIN { const HgArgs ha = HGARGS; h2_phase(ha, vcu, G); } PH_END
            PH_BEGIN { const HgArgs ha = HGARGS; h3_phase(ha, vcu, G); } PH_END
            PH_BEGIN { pg8::DenseSched S; S.init(T, D, D, G, bx); pg8::EpiStore E{WSP(bf16_t, WS_HM), WSP(bf16_t, WS_HM), D, 1 << 30, 1.0f, 0};
                       pg8::gemm_phase<pg8::EpiStore, pg8::DenseSched>(lds, WSP(bf16_t, WS_OG), WSP(bf16_t, WS_WOUT) + (size_t)L * D * D, D, 0, S, E); } PH_END
        } else {
            const int j = L - NA;
            PH_BEGIN { if (j == 0) { pg8::DenseSched S; S.init(T, 2 * KVW, D, G, bx); pg8::EpiStore E{WSP(bf16_t, WS_KC), WSP(bf16_t, WS_VC), KVW, 1, 1.0f, 0};
                                     pg8::gemm_phase<pg8::EpiStore, pg8::DenseSched>(lds, WSP(bf16_t, WS_XB), WSP(bf16_t, WS_WKV), D, 0, S, E); }
                       pg8::DenseSched S; S.init(T, D, D, G, bx); pg8::EpiStore E{WSP(bf16_t, WS_QB), WSP(bf16_t, WS_QB), D, 1 << 30, 1.0f, 0};
                       pg8::gemm_phase<pg8::EpiStore, pg8::DenseSched>(lds, WSP(bf16_t, WS_XB), WSP(bf16_t, WS_WQ) + (size_t)j * D * D, D, 0, S, E); } PH_END
            PH_BEGIN attn_naive_phase(WSP(bf16_t, WS_QB), WSP(bf16_t, WS_KC), WSP(bf16_t, WS_VC), args.in[7] + j * AT_HQ, args.in[9], WSP(bf16_t, WS_OG), vcu, G); PH_END
            PH_BEGIN { pg8::DenseSched S; S.init(T, D, D, G, bx); pg8::EpiStore E{WSP(bf16_t, WS_HM), WSP(bf16_t, WS_HM), D, 1 << 30, 1.0f, 0};
                       pg8::gemm_phase<pg8::EpiStore, pg8::DenseSched>(lds, WSP(bf16_t, WS_OG), WSP(bf16_t, WS_WO) + (size_t)j * D * D, D, 0, S, E); } PH_END
        }
        PH_BEGIN ln_phase<0>(L == 0 ? args.in[0] : WSP(float, WS_XF), WSP(bf16_t, WS_HM), nullptr, args.in[17] + (size_t)(2 * L) * D, args.in[18] + (size_t)(2 * L) * D, WSP(float, WS_XF), WSP(bf16_t, WS_XB),
                             args.in[10] + (size_t)L * D * NGRP, args.in[11] + L * NGRP, args.in[12] + (size_t)L * D * NEXP, args.in[13] + L * NEXP, WSP(int, WS_CTL) + CW_CNT + 64 * L, WSP(int, WS_LIST), WSP(float, WS_TG), vcu, G); PH_END
        PH_BEGIN { LAS int* tab = (LAS int*)(lds + LDS_MOETAB); pg8::MoeSched S{tab, WSP(int, WS_LIST), 4, G, vcu, D, 1, 0}; S.build(tab, WSP(int, WS_CTL) + CW_CNT + 64 * L);
                   pg8::gemm_phase<pg8::EpiMoeH, pg8::MoeSched>(lds, WSP(bf16_t, WS_XB), WSP(bf16_t, WS_WGU) + (size_t)L * NEXP * 2 * DEXP * D, D, (size_t)2 * DEXP * D * 2, S, pg8::EpiMoeH{WSP(bf16_t, WS_HS)}); } PH_END
        PH_BEGIN { LAS int* tab = (LAS int*)(lds + LDS_MOETAB); pg8::MoeSched S{tab, WSP(int, WS_LIST), 8, G, vcu, DEXP, 0, 0}; S.build(tab, WSP(int, WS_CTL) + CW_CNT + 64 * L);
                   pg8::gemm_phase<pg8::EpiMoeY, pg8::MoeSched>(lds, WSP(bf16_t, WS_HS), WSP(bf16_t, WS_WD) + (size_t)L * NEXP * D * DEXP, DEXP, (size_t)D * DEXP * 2, S, pg8::EpiMoeY{WSP(bf16_t, WS_Y), WSP(float, WS_TG), S}); } PH_END
        PH_BEGIN ln_phase<1>(WSP(float, WS_XF), nullptr, WSP(bf16_t, WS_Y), args.in[17] + (size_t)(2 * L + 1) * D, args.in[18] + (size_t)(2 * L + 1) * D, L == DEPTH - 1 ? args.out : WSP(float, WS_XF), L == DEPTH - 1 ? nullptr : WSP(bf16_t, WS_XB),
                             nullptr, nullptr, nullptr, nullptr, nullptr, nullptr, nullptr, vcu, G); PH_END
    }
#undef HGARGS
#undef WSP
#undef PH_BEGIN
#undef PH_END
}

#ifndef MK_PER_PHASE
#define MK_PER_PHASE 0
#endif
extern "C" void kernel_launch(void* const* d_in, const int* in_sizes, int n_in, void* d_out, int out_size, void* d_ws, size_t ws_size, hipStream_t stream) {
    static int grid = 0;
    if (grid == 0) {
        if (n_in != 19 || out_size != T * D || ws_size < WS_END) { fprintf(stderr, "kernel_launch: unexpected arguments (n_in %d, out %d, ws %zu < %zu)\n", n_in, out_size, ws_size, (size_t)WS_END); grid = -1; return; }
        int dev = 0, cus = 0, per_cu = 0;
        if (hipGetDevice(&dev) != hipSuccess || hipDeviceGetAttribute(&cus, hipDeviceAttributeMultiprocessorCount, dev) != hipSuccess) { grid = -1; return; }
        if (hipFuncSetAttribute((const void*)mega_fwd, hipFuncAttributeMaxDynamicSharedMemorySize, LDS_BYTES) != hipSuccess) { fprintf(stderr, "kernel_launch: hipFuncSetAttribute failed\n"); grid = -1; return; }
        if (hipOccupancyMaxActiveBlocksPerMultiprocessor(&per_cu, (const void*)mega_fwd, 512, LDS_BYTES) != hipSuccess || per_cu < 1) { fprintf(stderr, "kernel_launch: occupancy query reports %d\n", per_cu); }
        (void)hipGetLastError();
        grid = cus;
    }
    if (grid < 0) return;
    (void)hipMemsetAsync((char*)d_ws + WS_CTL, 0, CTL_BYTES, stream);
    MegaArgs a{};
    for (int i = 0; i < 19; ++i) a.in[i] = (const float*)d_in[i];
    a.out = (float*)d_out; a.ws = (unsigned char*)d_ws;
#if MK_PER_PHASE
    for (int ph = 0; ph < N_PHASES; ++ph) { a.ph_lo = ph; a.ph_hi = ph + 1; hipLaunchKernelGGL(mega_fwd, dim3(grid), dim3(512), LDS_BYTES, stream, a); }
#else
    a.ph_lo = 0; a.ph_hi = N_PHASES;
    hipLaunchKernelGGL(mega_fwd, dim3(grid), dim3(512), LDS_BYTES, stream, a);
#endif
}
```

```cpp
#include <hip/hip_runtime.h>
#include <cstdio>
#include <cstdint>

typedef unsigned short bf16_t;
typedef short bf16x8 __attribute__((ext_vector_type(8)));
typedef float f32x4 __attribute__((ext_vector_type(4)));

constexpr int BATCH = 4, SEQ = 2048, D = 2048, T = BATCH * SEQ, DEPTH = 4, NA = 2;
constexpr int HG_H = 16, HG_DK = 128;
constexpr int AT_HD = 64, AT_HQ = 32, AT_HKV = 4, AT_G = 8, KVW = AT_HKV * AT_HD;
constexpr int NGRP = 4, EPG = 8, NEXP = 32, DEXP = 512;
constexpr float ALPHA = 1.6817928305074290f;
constexpr float LN_EPS = 1e-5f, RMS_EPS = 1e-6f;

constexpr size_t MiB = 1u << 20;
constexpr size_t WS_CTL = 0, CTL_BYTES = 1 * MiB;
constexpr size_t WS_XF = 1 * MiB;
constexpr size_t WS_XB = WS_XF + 64 * MiB;
constexpr size_t WS_QB = WS_XB + 32 * MiB;
constexpr size_t WS_KB = WS_QB + 32 * MiB;
constexpr size_t WS_VB = WS_KB + 32 * MiB;
constexpr size_t WS_GT = WS_VB + 32 * MiB;
constexpr size_t WS_GL = WS_GT + 32 * MiB;
constexpr size_t WS_OF = WS_GL + 64 * MiB;
constexpr size_t WS_OG = WS_OF + 64 * MiB;
constexpr size_t WS_HM = WS_OG + 32 * MiB;
constexpr size_t WS_KC = WS_HM + 32 * MiB;
constexpr size_t WS_VC = WS_KC + 4 * MiB;
constexpr size_t WS_LIST = WS_VC + 4 * MiB;
constexpr size_t WS_TG = WS_LIST + 1 * MiB;
constexpr size_t WS_HS = WS_TG + 1 * MiB;
constexpr size_t WS_Y = WS_HS + 24 * MiB;
constexpr size_t WS_WIN = WS_Y + 64 * MiB;
constexpr size_t WS_WOUT = WS_WIN + 64 * MiB;
constexpr size_t WS_WKV = WS_WOUT + 16 * MiB;
constexpr size_t WS_WQ = WS_WKV + 2 * MiB;
constexpr size_t WS_WO = WS_WQ + 16 * MiB;
constexpr size_t WS_WGU = WS_WO + 16 * MiB;
constexpr size_t WS_WD = WS_WGU + 512 * MiB;
constexpr size_t WS_UT = WS_WD + 256 * MiB;
constexpr size_t WS_SST = WS_UT + 64 * MiB;
constexpr size_t WS_DG = WS_SST + 64 * MiB;
constexpr size_t WS_END = WS_DG + 1 * MiB;
constexpr int CW_CNT = 1024;

__device__ __forceinline__ unsigned f2bf(float f) { unsigned u = __builtin_bit_cast(unsigned, f); return (u + 0x7fffu + ((u >> 16) & 1u)) >> 16; }
__device__ __forceinline__ float bf2f(bf16_t b) { return __builtin_bit_cast(float, ((unsigned)b) << 16); }
__device__ __forceinline__ float wave_sum(float v) {
#pragma unroll
    for (int o = 1; o < 64; o <<= 1) v += __shfl_xor(v, o);
    return v;
}
__device__ __forceinline__ float wave_max(float v) {
#pragma unroll
    for (int o = 1; o < 64; o <<= 1) v = fmaxf(v, __shfl_xor(v, o));
    return v;
}
__device__ __forceinline__ float sigmoidf_(float x) { return 1.0f / (1.0f + __expf(-x)); }
__device__ __forceinline__ int opaque_tid() { int t = threadIdx.x; asm volatile("" : "+v"(t)); return t; }

#define LAS __attribute__((address_space(3)))
typedef unsigned u32x4 __attribute__((ext_vector_type(4)));
namespace pg8 {
constexpr int BM = 256, BK = 64, HALF = 128, HTB = HALF * BK * 2, STAGE_BYTES = 8 * HTB;
__host__ __device__ __forceinline__ int lds_byte(int r, int c) { const int st = (r >> 4) * 2 + (c >> 5), rr = r & 15, cc = c & 31, ob = rr * 64 + cc * 2; return st * 1024 + (ob ^ (((ob >> 9) & 1) << 5)); }
__host__ __device__ __forceinline__ void stage_rc(int b, int& R, int& C) { const int st = b / 1024, sb = b % 1024, swz = sb ^ (((sb >> 9) & 1) << 5); R = (st >> 1) * 16 + swz / 64; C = (st & 1) * 32 + (swz % 64) / 2; }
__host__ __device__ __forceinline__ int perm32(int rho) { const int n = rho >> 4, i = rho & 15; return 8 * (i >> 2) + 4 * n + (i & 3); }
struct Unit { int pm, pn, e, rows, tm, ui; };
typedef float f32x2_ __attribute__((ext_vector_type(2)));
typedef __bf16 bf16x2_ __attribute__((ext_vector_type(2)));
__device__ __forceinline__ unsigned cvt_pk_bf16(float lo, float hi) { const f32x2_ v = {lo, hi}; return __builtin_bit_cast(unsigned, __builtin_convertvector(v, bf16x2_)); }

struct DenseSched {
    int nM, nN, nwg, G, c, K;
    __device__ __forceinline__ void init(int M, int N, int K_, int G_, int c_) { nM = M / BM; nN = N / BM; nwg = nM * nN; G = G_; c = c_; K = K_; }
    __device__ __forceinline__ bool next(int i, Unit& u) const {
        const long L = (long)i * G + c; if (L >= nwg) return false;
        int wgid = (int)L; { const int q = nwg / 8, r = nwg % 8, xcd = wgid % 8, off = wgid / 8; wgid = (xcd < r ? xcd * (q + 1) : r * (q + 1) + (xcd - r) * q) + off; }
        const int nig = 8 * nN, gid = wgid / nig, fm = gid * 8, gsz = (nM - fm) < 8 ? (nM - fm) : 8;
        u.pm = fm + ((wgid % nig) % gsz); u.pn = (wgid % nig) / gsz; u.e = 0; u.rows = 256; u.tm = 0; u.ui = i; return true;
    }
    __device__ __forceinline__ unsigned a_off(const Unit& u, int half, int R) const { return (unsigned)((u.pm * 256 + half * 128 + R) * K) * 2u; }
};

template <class Epi, class Sched>
__device__ __forceinline__ void gemm_phase(LAS unsigned char* lds, const bf16_t* A, const bf16_t* Bt, int K, size_t bstride, const Sched& S, const Epi& E) {
    const int tid = opaque_tid(), wid = __builtin_amdgcn_readfirstlane(tid >> 6), lane = tid & 63, wr = wid >> 2, wc = wid & 3, fr = lane & 15, fq = lane >> 4;
    const int nt = K / BK;
    int sR[2], sC2[2]; unsigned voffB[2];
#pragma unroll
    for (int i = 0; i < 2; ++i) { int R, C; stage_rc(tid * 16 + i * 8192, R, C); const int Rb = (R & ~31) + perm32(R & 31); sR[i] = R; sC2[i] = C * 2; voffB[i] = (unsigned)(Rb * K + C) * 2u; }
    const size_t kstep = (size_t)(BK * 2);
    const size_t hstep = (size_t)HALF * K * 2;
    const size_t tstep = 2 * hstep;
    const unsigned ldsw = (unsigned)wid * 1024u;
    const int aoff = lds_byte(wr * 64 + fr, fq * 8), boff = lds_byte(wc * 32 + fr, fq * 8);
#define PG8_SA(b, h) (((b) * 2 + (h)) * HTB)
#define PG8_SB(b, h) ((4 + (b) * 2 + (h)) * HTB)
#define PG8_STAGE(bufoff, gbase, voff) do { _Pragma("unroll") for (int _i = 0; _i < 2; ++_i) \
        __builtin_amdgcn_global_load_lds((const unsigned*)((const char*)(gbase) + (voff)[_i]), (LAS unsigned*)(lds + (bufoff) + ldsw + _i * 8192), 16, 0, 0); } while (0)
#define PG8_LDA(dst, b, h) do { _Pragma("unroll") for (int m = 0; m < 4; ++m) _Pragma("unroll") for (int k = 0; k < 2; ++k) dst[m][k] = *(const LAS bf16x8*)(lds + PG8_SA(b, h) + aoff + m * 2048 + k * 1024); } while (0)
#define PG8_LDB(dst, b, h) do { _Pragma("unroll") for (int n = 0; n < 2; ++n) _Pragma("unroll") for (int k = 0; k < 2; ++k) dst[n][k] = *(const LAS bf16x8*)(lds + PG8_SB(b, h) + boff + n * 2048 + k * 1024); } while (0)
#define PG8_MMA(ai, bj, At, Bt_) do { __builtin_amdgcn_s_setprio(1); _Pragma("unroll") for (int m = 0; m < 4; ++m) _Pragma("unroll") for (int n = 0; n < 2; ++n) _Pragma("unroll") for (int k = 0; k < 2; ++k) \
        acc[ai][bj][m][n] = __builtin_amdgcn_mfma_f32_16x16x32_bf16(Bt_[n][k], At[m][k], acc[ai][bj][m][n], 0, 0, 0); __builtin_amdgcn_s_setprio(0); } while (0)
#define PG8_WAIT_V(n) asm volatile("s_waitcnt vmcnt(" #n ")" ::: "memory")
#define PG8_WAIT_L(n) asm volatile("s_waitcnt lgkmcnt(" #n ")" ::: "memory")
#define PG8_BAR __builtin_amdgcn_s_barrier()
#define PG8_SCHED __builtin_amdgcn_sched_barrier(0)
    Unit cur, nxt; int ui = 0;
    if (!S.next(0, cur)) return;
    f32x4 acc[2][2][4][2];
#pragma unroll
    for (int a = 0; a < 2; ++a)
#pragma unroll
        for (int b = 0; b < 2; ++b)
#pragma unroll
            for (int m = 0; m < 4; ++m)
#pragma unroll
                for (int n = 0; n < 2; ++n) acc[a][b][m][n] = (f32x4){0.f, 0.f, 0.f, 0.f};
    bf16x8 At[4][2], B0[2][2], B1[2][2];
    unsigned voffA0[2], voffA1[2];
#pragma unroll
    for (int i = 0; i < 2; ++i) { voffA0[i] = S.a_off(cur, 0, sR[i]) + sC2[i]; voffA1[i] = S.a_off(cur, 1, sR[i]) + sC2[i]; }
    const char* const Ab = (const char*)A;
    const char* cB = (const char*)Bt + (size_t)cur.e * bstride + (size_t)cur.pn * tstep;
    PG8_STAGE(PG8_SB(0, 0), cB, voffB); PG8_STAGE(PG8_SB(0, 1), cB + hstep, voffB); PG8_STAGE(PG8_SA(0, 0), Ab, voffA0); PG8_STAGE(PG8_SA(0, 1), Ab, voffA1);
    if (wr == 1) PG8_BAR;
    PG8_WAIT_V(2); PG8_BAR;
    PG8_STAGE(PG8_SB(1, 0), cB + kstep, voffB); PG8_STAGE(PG8_SA(1, 0), Ab + kstep, voffA0); PG8_STAGE(PG8_SB(1, 1), cB + hstep + kstep, voffB);
    PG8_WAIT_V(6); PG8_BAR;
    for (;;) {
        const bool has_next = S.next(ui + 1, nxt);
        const char* nB = has_next ? (const char*)Bt + (size_t)nxt.e * bstride + (size_t)nxt.pn * tstep : cB;
        for (int t = 0; t < nt; t += 2) {
            const bool last = (t == nt - 2);
            const char* a1 = Ab + (size_t)(t + 1) * kstep;
            const char* a2 = last ? Ab : Ab + (size_t)(t + 2) * kstep; const char* b2 = last ? nB : cB + (size_t)(t + 2) * kstep;
            const char* a3 = a2 + kstep; const char* b3 = b2 + kstep;
            PG8_LDB(B0, 0, 0); PG8_LDB(B1, 0, 1); PG8_SCHED; PG8_LDA(At, 0, 0); PG8_STAGE(PG8_SA(1, 1), a1, voffA1);
            if (last && has_next) {
#pragma unroll
                for (int i = 0; i < 2; ++i) { voffA0[i] = S.a_off(nxt, 0, sR[i]) + sC2[i]; voffA1[i] = S.a_off(nxt, 1, sR[i]) + sC2[i]; }
            }
            PG8_WAIT_V(8); PG8_WAIT_L(0); PG8_BAR; PG8_MMA(0, 0, At, B0); PG8_MMA(0, 1, At, B1); PG8_BAR; PG8_SCHED;
            PG8_LDA(At, 0, 1); PG8_STAGE(PG8_SB(0, 0), b2, voffB); PG8_STAGE(PG8_SB(0, 1), b2 + hstep, voffB); PG8_STAGE(PG8_SA(0, 0), a2, voffA0);
            PG8_WAIT_V(8); PG8_WAIT_L(0); PG8_BAR; PG8_MMA(1, 0, At, B0); PG8_MMA(1, 1, At, B1); PG8_BAR; PG8_SCHED;
            PG8_LDB(B0, 1, 0); PG8_LDB(B1, 1, 1); PG8_SCHED; PG8_LDA(At, 1, 0); PG8_STAGE(PG8_SA(0, 1), a2, voffA1);
            PG8_WAIT_V(8); PG8_WAIT_L(0); PG8_BAR; PG8_MMA(0, 0, At, B0); PG8_MMA(0, 1, At, B1); PG8_BAR; PG8_SCHED;
            PG8_LDA(At, 1, 1); PG8_STAGE(PG8_SB(1, 0), b3, voffB); PG8_STAGE(PG8_SB(1, 1), b3 + hstep, voffB); PG8_STAGE(PG8_SA(1, 0), a3, voffA0);
            PG8_WAIT_V(8); PG8_WAIT_L(0); PG8_BAR; PG8_MMA(1, 0, At, B0); PG8_MMA(1, 1, At, B1); PG8_BAR; PG8_SCHED;
        }
        if (wr == 0) PG8_BAR;
        E(acc, cur, wr, wc, fr, fq);
        if (!has_next) break;
#pragma unroll
        for (int a = 0; a < 2; ++a)
#pragma unroll
            for (int b = 0; b < 2; ++b)
#pragma unroll
                for (int m = 0; m < 4; ++m)
#pragma unroll
                    for (int n = 0; n < 2; ++n) acc[a][b][m][n] = (f32x4){0.f, 0.f, 0.f, 0.f};
        cur = nxt; cB = nB; ++ui;
        if (wr == 1) PG8_BAR;
    }
    PG8_WAIT_V(0);
    PG8_BAR;
#undef PG8_SA
#undef PG8_SB
#undef PG8_STAGE
#undef PG8_LDA
#undef PG8_LDB
#undef PG8_MMA
#undef PG8_WAIT_V
#undef PG8_WAIT_L
#undef PG8_BAR
#undef PG8_SCHED
}

#define PG8_ROWS_COLS const int row0 = u.pm * BM + wr * 64 + fr; const int col0 = wc * 32 + 8 * fq
__device__ __forceinline__ u32x4 pack8(const f32x4 v0, const f32x4 v1) { u32x4 w; w.x = cvt_pk_bf16(v0[0], v0[1]); w.y = cvt_pk_bf16(v0[2], v0[3]); w.z = cvt_pk_bf16(v1[0], v1[1]); w.w = cvt_pk_bf16(v1[2], v1[3]); return w; }
struct EpiStore {
    bf16_t* O; bf16_t* O2; int ldc, split; float scale; int pad;
    __device__ __forceinline__ void operator()(const f32x4 (&acc)[2][2][4][2], const Unit& u, int wr, int wc, int fr, int fq) const {
        PG8_ROWS_COLS; bf16_t* base = u.pn >= split ? O2 + (size_t)(u.pn - split) * BM : O + (size_t)u.pn * BM;
#pragma unroll
        for (int ai = 0; ai < 2; ++ai)
#pragma unroll
            for (int m = 0; m < 4; ++m) { bf16_t* rowp = base + (size_t)(row0 + ai * HALF + m * 16) * ldc + col0;
#pragma unroll
                for (int bj = 0; bj < 2; ++bj) *(u32x4*)(rowp + bj * HALF) = pack8(acc[ai][bj][m][0] * scale, acc[ai][bj][m][1] * scale); }
    }
};
struct EpiHgrn {
    bf16_t *Qb, *Kb, *Vb, *Gt; float* Gl; const float* lbraw; int layer, pad;
    __device__ __forceinline__ void operator()(const f32x4 (&acc)[2][2][4][2], const Unit& u, int wr, int wc, int fr, int fq) const {
        PG8_ROWS_COLS; const int seg = u.pn >> 3, ct = (u.pn & 7) * BM + col0;
        if (seg == 0 || seg == 2) { bf16_t* base = (seg == 0 ? Qb : Vb) + ct;
#pragma unroll
            for (int ai = 0; ai < 2; ++ai)
#pragma unroll
                for (int m = 0; m < 4; ++m) { bf16_t* rowp = base + (size_t)(row0 + ai * HALF + m * 16) * D;
#pragma unroll
                    for (int bj = 0; bj < 2; ++bj) *(u32x4*)(rowp + bj * HALF) = pack8(acc[ai][bj][m][0], acc[ai][bj][m][1]); }
        } else if (seg == 3) {
#pragma unroll
            for (int ai = 0; ai < 2; ++ai)
#pragma unroll
                for (int m = 0; m < 4; ++m) { bf16_t* rowp = Gt + ct + (size_t)(row0 + ai * HALF + m * 16) * D;
#pragma unroll
                    for (int bj = 0; bj < 2; ++bj) { f32x4 v[2];
#pragma unroll
                        for (int n = 0; n < 2; ++n)
#pragma unroll
                            for (int j = 0; j < 4; ++j) { const float x = acc[ai][bj][m][n][j]; v[n][j] = x * sigmoidf_(x); }
                        *(u32x4*)(rowp + bj * HALF) = pack8(v[0], v[1]); } }
        } else {
#pragma unroll
            for (int bj = 0; bj < 2; ++bj) { float lb[8];
#pragma unroll
                for (int j = 0; j < 8; ++j) { const int c = ct + bj * HALF + j; lb[j] = layer == 0 ? 0.f : sigmoidf_(lbraw[D + c] - lbraw[c]); }
#pragma unroll
                for (int ai = 0; ai < 2; ++ai)
#pragma unroll
                    for (int m = 0; m < 4; ++m) { const size_t o = (size_t)(row0 + ai * HALF + m * 16) * D + ct + bj * HALF; f32x4 kv[2], gv[2];
#pragma unroll
                        for (int n = 0; n < 2; ++n)
#pragma unroll
                            for (int j = 0; j < 4; ++j) { const float l = lb[4 * n + j], sg = sigmoidf_(acc[ai][bj][m][n][j]); gv[n][j] = __logf(fmaxf(l + (1.f - l) * sg, 1e-30f)); kv[n][j] = (1.f - l) * (1.f - sg); }
                        *(u32x4*)(Kb + o) = pack8(kv[0], kv[1]); *(f32x4*)(Gl + o) = gv[0]; *(f32x4*)(Gl + o + 4) = gv[1]; } }
        }
    }
};


constexpr int MOE_MAXU = 4, MOE_TAB_INTS = 128 + 256 * MOE_MAXU;
struct MoeSched {
    const LAS int* tab; const int* list; int NT, G, c, K, gather, pad;
    __device__ __forceinline__ bool next(int i, Unit& u) const {
        const int L = i * G + c, TM = tab[32]; if (L >= TM * NT) return false;
        const int mt = L / NT; int e = 0; while (tab[e + 1] <= mt) ++e;
        u.pm = mt; u.pn = L - mt * NT; u.e = e; u.tm = mt - tab[e]; const int left = tab[64 + e] - 256 * u.tm; u.rows = left < 256 ? left : 256; u.ui = i; return true;
    }
    __device__ __forceinline__ int entry(const Unit& u, int r) const {
        const int a = tab[128 + 256 * u.ui + r]; return a >= 0 ? a : tab[128 + 256 * u.ui];
    }
    __device__ __forceinline__ unsigned a_off(const Unit& u, int half, int R) const {
        if (gather) return (unsigned)((entry(u, half * 128 + R) >> 1) * K) * 2u;
        return (unsigned)((u.pm * 256 + half * 128 + R) * K) * 2u;
    }
    __device__ __forceinline__ void build(LAS int* t, const int* cnt) const {
        const int tid = opaque_tid();
        if (tid < 32) t[64 + tid] = cnt[tid];
        __syncthreads();
        if (tid == 0) { int p = 0; for (int e = 0; e < 32; ++e) { t[e] = p; p += (t[64 + e] + 255) >> 8; } t[32] = p; }
        __syncthreads();
        for (int i = 0; i < MOE_MAXU; ++i) { Unit u; if (!next(i, u)) break;
            if (tid < 256) { const int r = 256 * u.tm + tid; t[128 + 256 * i + tid] = r < t[64 + u.e] ? list[u.e * T + r] : -1; } }
        __syncthreads();
    }
};
struct EpiMoeH {
    bf16_t* Hs;
    __device__ __forceinline__ void operator()(const f32x4 (&acc)[2][2][4][2], const Unit& u, int wr, int wc, int fr, int fq) const {
        const int col0 = u.pn * 128 + wc * 32 + 8 * fq;
#pragma unroll
        for (int ai = 0; ai < 2; ++ai)
#pragma unroll
            for (int m = 0; m < 4; ++m) { const int rl = ai * HALF + wr * 64 + m * 16 + fr; f32x4 v[2];
#pragma unroll
                for (int n = 0; n < 2; ++n)
#pragma unroll
                    for (int j = 0; j < 4; ++j) { const float g = acc[ai][0][m][n][j]; v[n][j] = g * sigmoidf_(g) * acc[ai][1][m][n][j]; }
                if (rl < u.rows) *(u32x4*)(Hs + (size_t)(u.pm * 256 + rl) * DEXP + col0) = pack8(v[0], v[1]); }
    }
};
struct EpiMoeY {
    bf16_t* Y; const float* tg; MoeSched S;
    __device__ __forceinline__ void operator()(const f32x4 (&acc)[2][2][4][2], const Unit& u, int wr, int wc, int fr, int fq) const {
        const int col0 = u.pn * BM + wc * 32 + 8 * fq;
#pragma unroll
        for (int ai = 0; ai < 2; ++ai)
#pragma unroll
            for (int m = 0; m < 4; ++m) { const int rl = ai * HALF + wr * 64 + m * 16 + fr;
                if (rl < u.rows) { const int a = S.entry(u, rl); const float g = tg[a]; bf16_t* rowp = Y + (size_t)a * D + col0;
#pragma unroll
                    for (int bj = 0; bj < 2; ++bj) *(u32x4*)(rowp + bj * HALF) = pack8(acc[ai][bj][m][0] * g, acc[ai][bj][m][1] * g); } }
    }
};

__device__ __forceinline__ void transpose_item(const float* W, int K, int N, bf16_t* WT, int dst_row0, LAS float* scr, int kb, int nb, int lane) {
    const int k0 = 64 * kb, n0 = 32 * nb;
#pragma unroll 8
    for (int i = 0; i < 32; ++i) { const int kk = 2 * i + (lane >> 5); scr[kk * 33 + (lane & 31)] = W[(size_t)(k0 + kk) * N + n0 + (lane & 31)]; }
    asm volatile("s_waitcnt lgkmcnt(0)" ::: "memory");
    const int c = lane & 7;
#pragma unroll
    for (int j = 0; j < 4; ++j) { const int n = (lane >> 3) + 8 * j; const LAS float* s = scr + (8 * c) * 33 + n;
        u32x4 o; o.x = f2bf(s[0 * 33]) | (f2bf(s[1 * 33]) << 16); o.y = f2bf(s[2 * 33]) | (f2bf(s[3 * 33]) << 16); o.z = f2bf(s[4 * 33]) | (f2bf(s[5 * 33]) << 16); o.w = f2bf(s[6 * 33]) | (f2bf(s[7 * 33]) << 16);
        *(u32x4*)(WT + (size_t)(dst_row0 + n) * K + k0 + 8 * c) = o; }
    asm volatile("s_waitcnt lgkmcnt(0)" ::: "memory");
}
}

typedef short s16x4 __attribute__((ext_vector_type(4)));
typedef LAS s16x4 lds_s16x4;
constexpr int HRS = 272, ARS = 144;
constexpr int H1_QH = 0, H1_KH0 = H1_QH + 64 * HRS, H1_KH1 = H1_KH0 + 16 * HRS, H1_KH2 = H1_KH1 + 32 * HRS, H1_KH3 = H1_KH2 + 48 * HRS, H1_KT = H1_KH3 + 64 * HRS,
              H1_VS = H1_KT + 64 * HRS, H1_AS = H1_VS + 64 * HRS, H1_TOT = H1_AS + 64 * ARS, H1_BYTES = H1_TOT + 2048;
constexpr int NUNIT = BATCH * HG_H * (SEQ / 64);
__device__ __forceinline__ bf16x8 tr_frag16(const LAS unsigned char* tile, int rs, int r0, int c0, int lane) {
    const int g = lane >> 4, i = lane & 15, q = i >> 2, p = i & 3;
    const LAS unsigned char* a = tile + (r0 + 8 * g + q) * rs + (c0 + 4 * p) * 2;
    const s16x4 lo = __builtin_amdgcn_ds_read_tr16_b64_v4i16((lds_s16x4*)a);
    const s16x4 hi = __builtin_amdgcn_ds_read_tr16_b64_v4i16((lds_s16x4*)(a + 4 * rs));
    return (bf16x8){lo[0], lo[1], lo[2], lo[3], hi[0], hi[1], hi[2], hi[3]};
}
__device__ __forceinline__ bf16x8 row_frag16(const LAS unsigned char* tile, int rs, int r0, int c0, int lane) {
    return *(const LAS bf16x8*)(tile + (r0 + (lane & 15)) * rs + (c0 + 8 * (lane >> 4)) * 2);
}
#define MFMA16(a, b, c) __builtin_amdgcn_mfma_f32_16x16x32_bf16((a), (b), (c), 0, 0, 0)
typedef unsigned u32x2 __attribute__((ext_vector_type(2)));
__device__ __forceinline__ u32x2 pack4(const f32x4 v) { u32x2 r; r.x = pg8::cvt_pk_bf16(v[0], v[1]); r.y = pg8::cvt_pk_bf16(v[2], v[3]); return r; }

struct HgArgs { bf16_t *Qb, *Kb, *Vb, *Gt, *OI, *UT, *Sst, *Og; float *Gl, *Dg; const float* ng; };

__device__ __forceinline__ void h1_phase(LAS unsigned char* lds, const HgArgs& a, int vcu, int G) {
    const int tid = opaque_tid(), lane = tid & 63, wid = __builtin_amdgcn_readfirstlane(tid >> 6);
    const int ch = tid & 127, J = __builtin_amdgcn_readfirstlane(tid >> 7);
    LAS float* tot = (LAS float*)(lds + H1_TOT);
    for (int unit = vcu; unit < NUNIT; unit += G) {
        const int bh = unit >> 5, c = unit & 31, b = bh >> 4, h = bh & 15;
        const size_t gbase = ((size_t)b * SEQ + c * 64) * D + h * 128;
        float L[16]; { float l = 0.f;
#pragma unroll
            for (int i = 0; i < 16; ++i) { l += a.Gl[gbase + (size_t)(16 * J + i) * D + ch]; L[i] = l; } }
        tot[J * 128 + ch] = L[15];
#pragma unroll
        for (int i = 0; i < 2; ++i) { const int id = tid + 512 * i, r = id >> 4, ck = id & 15; *(LAS u32x4*)(lds + H1_VS + r * HRS + ck * 16) = *(const u32x4*)(a.Vb + gbase + (size_t)r * D + ck * 8); }
        for (int id = tid; id < 64 * ARS / 16; id += 512) *(LAS u32x4*)(lds + H1_AS + id * 16) = (u32x4){0u, 0u, 0u, 0u};
        __syncthreads();
        float tj[4]; tj[0] = tot[ch]; tj[1] = tot[128 + ch]; tj[2] = tot[256 + ch]; tj[3] = tot[384 + ch];
        float aJ = 0.f;
#pragma unroll
        for (int M = 0; M < 3; ++M) if (M < J) aJ += tj[M];
        const int khJ = J == 0 ? H1_KH0 : J == 1 ? H1_KH1 : J == 2 ? H1_KH2 : H1_KH3;
#pragma unroll
        for (int i = 0; i < 16; ++i) {
            const int t = 16 * J + i; const size_t go = gbase + (size_t)t * D + ch;
            const float q = bf2f(a.Qb[go]), k = bf2f(a.Kb[go]), Li = L[i], rem = L[15] - Li;
            *(LAS bf16_t*)(lds + H1_QH + t * HRS + ch * 2) = (bf16_t)f2bf(q * __expf(Li));
            a.Qb[go] = (bf16_t)f2bf(q * __expf(Li + aJ));
            *(LAS bf16_t*)(lds + khJ + t * HRS + ch * 2) = (bf16_t)f2bf(k * __expf(fminf(-Li, 60.f)));
#pragma unroll
            for (int I = 1; I <= 4; ++I) {
                if (I > J) { float sx = rem;
#pragma unroll
                    for (int M = 1; M < 4; ++M) if (M > J && M < I) sx += tj[M];
                    constexpr int offs[5] = {H1_KH0, H1_KH1, H1_KH2, H1_KH3, H1_KT};
                    *(LAS bf16_t*)(lds + offs[I] + t * HRS + ch * 2) = (bf16_t)f2bf(k * __expf(sx)); }
            }
        }
        if (J == 0) a.Dg[(size_t)unit * 128 + ch] = __expf((tj[0] + tj[1]) + (tj[2] + tj[3]));
        __syncthreads();
        for (int blk = wid; blk < 10; blk += 8) {
            const int I = blk < 1 ? 0 : blk < 3 ? 1 : blk < 6 ? 2 : 3, Jb = blk - (I * (I + 1)) / 2;
            const int khI = I == 0 ? H1_KH0 : I == 1 ? H1_KH1 : I == 2 ? H1_KH2 : H1_KH3;
            f32x4 acc = {0.f, 0.f, 0.f, 0.f};
#pragma unroll
            for (int ks = 0; ks < 4; ++ks) acc = MFMA16(row_frag16(lds + khI, HRS, 16 * Jb, 32 * ks, lane), row_frag16(lds + H1_QH, HRS, 16 * I, 32 * ks, lane), acc);
            const int tl = 16 * I + (lane & 15), s0 = 16 * Jb + 4 * (lane >> 4);
#pragma unroll
            for (int r = 0; r < 4; ++r) if (s0 + r > tl) acc[r] = 0.f;
            *(LAS u32x2*)(lds + H1_AS + tl * ARS + s0 * 2) = pack4(acc);
        }
        __syncthreads();
        {
            bf16x8 vtr[2];
#pragma unroll
            for (int ks = 0; ks < 2; ++ks) vtr[ks] = tr_frag16(lds + H1_VS, HRS, 32 * ks, 16 * wid, lane);
#pragma unroll
            for (int rb = 0; rb < 4; ++rb) { f32x4 acc = {0.f, 0.f, 0.f, 0.f};
#pragma unroll
                for (int ks = 0; ks < 2; ++ks) if (!(ks == 1 && rb < 2)) acc = MFMA16(vtr[ks], row_frag16(lds + H1_AS, ARS, 16 * rb, 32 * ks, lane), acc);
                *(u32x2*)(a.OI + gbase + (size_t)(16 * rb + (lane & 15)) * D + 16 * wid + 4 * (lane >> 4)) = pack4(acc); }
#pragma unroll
            for (int cb = 0; cb < 8; ++cb) { f32x4 acc = {0.f, 0.f, 0.f, 0.f};
#pragma unroll
                for (int ks = 0; ks < 2; ++ks) acc = MFMA16(tr_frag16(lds + H1_KT, HRS, 32 * ks, 16 * cb, lane), vtr[ks], acc);
                *(u32x2*)(a.UT + ((size_t)unit * 128 + 16 * wid + (lane & 15)) * 128 + 16 * cb + 4 * (lane >> 4)) = pack4(acc); }
        }
        __syncthreads();
    }
}
__device__ __forceinline__ void h2_phase(const HgArgs& a, int vcu, int G) {
    for (int item = vcu * 512 + opaque_tid(); item < BATCH * HG_H * 2048; item += G * 512) {
        const int bh = item >> 11, vec = item & 2047, ch0 = (vec & 15) * 8;
        float st[8];
#pragma unroll
        for (int j = 0; j < 8; ++j) st[j] = 0.f;
        for (int c = 0; c < 32; ++c) { const size_t u = (size_t)bh * 32 + c;
            *(u32x4*)(a.Sst + u * 16384 + vec * 8) = pg8::pack8((f32x4){st[0], st[1], st[2], st[3]}, (f32x4){st[4], st[5], st[6], st[7]});
            if (c < 31) { const uint4 uu = *(const uint4*)(a.UT + u * 16384 + vec * 8); const float4 d0 = *(const float4*)(a.Dg + u * 128 + ch0), d1 = *(const float4*)(a.Dg + u * 128 + ch0 + 4);
                const unsigned w[4] = {uu.x, uu.y, uu.z, uu.w}; const float dd[8] = {d0.x, d0.y, d0.z, d0.w, d1.x, d1.y, d1.z, d1.w};
#pragma unroll
                for (int j = 0; j < 4; ++j) { st[2 * j] = dd[2 * j] * st[2 * j] + bf2f((bf16_t)(w[j] & 0xffff)); st[2 * j + 1] = dd[2 * j + 1] * st[2 * j + 1] + bf2f((bf16_t)(w[j] >> 16)); } }
        }
    }
}
__device__ __forceinline__ void h3_phase(const HgArgs& a, int vcu, int G) {
    const int tid = opaque_tid(), lane = tid & 63, wid = __builtin_amdgcn_readfirstlane(tid >> 6);
    for (int pair = vcu; pair < NUNIT / 2; pair += G) {
        const int unit = pair * 2 + (wid >> 2), rb = wid & 3;
        const int bh = unit >> 5, c = unit & 31, b = bh >> 4, h = bh & 15;
        const size_t ro = ((size_t)b * SEQ + c * 64 + 16 * rb + (lane & 15)) * D + h * 128;
        bf16x8 qf[4];
#pragma unroll
        for (int ks = 0; ks < 4; ++ks) qf[ks] = *(const bf16x8*)(a.Qb + ro + 32 * ks + 8 * (lane >> 4));
        f32x4 o[8]; float ss = 0.f;
#pragma unroll
        for (int cb = 0; cb < 8; ++cb) { f32x4 acc = {0.f, 0.f, 0.f, 0.f};
            const bf16_t* sp = a.Sst + ((size_t)unit * 128 + 16 * cb + (lane & 15)) * 128 + 8 * (lane >> 4);
#pragma unroll
            for (int ks = 0; ks < 4; ++ks) acc = MFMA16(*(const bf16x8*)(sp + 32 * ks), qf[ks], acc);
            const uint2 oi = *(const uint2*)(a.OI + ro + 16 * cb + 4 * (lane >> 4));
            acc[0] += bf2f((bf16_t)(oi.x & 0xffff)); acc[1] += bf2f((bf16_t)(oi.x >> 16)); acc[2] += bf2f((bf16_t)(oi.y & 0xffff)); acc[3] += bf2f((bf16_t)(oi.y >> 16));
            o[cb] = acc; ss += (acc[0] * acc[0] + acc[1] * acc[1]) + (acc[2] * acc[2] + acc[3] * acc[3]); }
        ss += __shfl_xor(ss, 16); ss += __shfl_xor(ss, 32);
        const float r = 1.0f / sqrtf(ss * (1.f / 128.f) + RMS_EPS);
#pragma unroll
        for (int cb = 0; cb < 8; ++cb) { const int vc = 16 * cb + 4 * (lane >> 4); const float4 g = *(const float4*)(a.ng + h * 128 + vc); const uint2 gt = *(const uint2*)(a.Gt + ro + vc);
            f32x4 v; v[0] = o[cb][0] * r * g.x * bf2f((bf16_t)(gt.x & 0xffff)); v[1] = o[cb][1] * r * g.y * bf2f((bf16_t)(gt.x >> 16)); v[2] = o[cb][2] * r * g.z * bf2f((bf16_t)(gt.y & 0xffff)); v[3] = o[cb][3] * r * g.w * bf2f((bf16_t)(gt.y >> 16));
            *(u32x2*)(a.Og + ro + vc) = pack4(v); }
    }
}

#define XB_TMO      128
#define XB_XCNT(j)  (256  + 64 * (j))
#define XB_XSUB(j)  (1280 + 64 * (j))
#define XB_XGEN(j)  (2304 + 64 * (j))
#define XB_TOP      3328
#define XB_TOPGEN   3392
#define XCD_BAR_WORDS 3456
#define XB_SPIN_CAP (1u << 18)
__device__ __forceinline__ unsigned xb_ld(unsigned* p)              { return __hip_atomic_load(p, __ATOMIC_RELAXED, __HIP_MEMORY_SCOPE_AGENT); }
__device__ __forceinline__ unsigned xb_add(unsigned* p, unsigned v) { return __hip_atomic_fetch_add(p, v, __ATOMIC_RELAXED, __HIP_MEMORY_SCOPE_AGENT); }
__device__ __forceinline__ unsigned xb_xcc_id() { return (unsigned)__builtin_amdgcn_s_getreg((3 << 11) | 20) & 0xFu; }
#define XB_SPIN(cond, bar) do { unsigned _sp = 0; while (cond) { __builtin_amdgcn_s_sleep(1); \
    if ((++_sp & 255u) == 0u) { if (xb_ld(&(bar)[XB_TMO])) break; if (_sp > XB_SPIN_CAP) { atomicAdd(&(bar)[XB_TMO], 1u); break; } } } } while (0)
struct XcdBarrier { unsigned* bar; unsigned x; volatile LAS unsigned* st; };
__device__ __forceinline__ XcdBarrier xcd_barrier_post(unsigned* bar, volatile LAS unsigned* st) {
    XcdBarrier b; b.bar = bar; b.x = xb_xcc_id(); b.st = st;
    if (threadIdx.x == 0) (void)xb_add(&bar[XB_XCNT(b.x)], 1u);
    return b;
}
__device__ __forceinline__ void xcd_barrier_complete(unsigned* bar, unsigned x, unsigned& nloc, unsigned& nx) {
    const unsigned G = gridDim.x * gridDim.y * gridDim.z;
    unsigned sum, cnt, mine, sp = 0u;
    for (;;) {
        sum = 0u; cnt = 0u; mine = 0u;
#pragma unroll
        for (unsigned j = 0; j < 16; ++j) { const unsigned c = xb_ld(&bar[XB_XCNT(j)]); sum += c; cnt += (c > 0u) ? 1u : 0u; mine = (j == x) ? c : mine; }
        if (sum == G) break;
        __builtin_amdgcn_s_sleep(1);
        if ((++sp & 255u) == 0u) { if (xb_ld(&bar[XB_TMO])) break; if (sp > XB_SPIN_CAP) { atomicAdd(&bar[XB_TMO], 1u); break; } }
    }
    nloc = mine > 0u ? mine : 1u; nx = cnt > 0u ? cnt : 1u;
}
__device__ __forceinline__ void xcd_barrier(const XcdBarrier& b) {
    asm volatile("s_waitcnt vmcnt(0)" ::: "memory");
    __syncthreads();
    if (threadIdx.x == 0) {
        unsigned* bar = b.bar;
        __builtin_amdgcn_s_waitcnt(0);
        unsigned nloc = b.st[0], nx = b.st[1];
        if (nloc == 0u) { xcd_barrier_complete(bar, b.x, nloc, nx); b.st[0] = nloc; b.st[1] = nx; }
        const unsigned old = xb_add(&bar[XB_XSUB(b.x)], 1u);
        const unsigned gen = old / nloc;
        if (old + 1u == (gen + 1u) * nloc) {
            __builtin_amdgcn_fence(__ATOMIC_RELEASE, "agent");
            asm volatile("s_waitcnt vmcnt(0)" ::: "memory");
            const unsigned og = xb_add(&bar[XB_TOP], 1u);
            const unsigned tg = og / nx;
            if (og + 1u == (tg + 1u) * nx) xb_add(&bar[XB_TOPGEN], 1u);
            else XB_SPIN(xb_ld(&bar[XB_TOPGEN]) == tg, bar);
            __builtin_amdgcn_fence(__ATOMIC_ACQUIRE, "agent");
            xb_add(&bar[XB_XGEN(b.x)], 1u);
            asm volatile("s_waitcnt vmcnt(0)" ::: "memory");
        } else {
            XB_SPIN(xb_ld(&bar[XB_XGEN(b.x)]) == gen, bar);
            __builtin_amdgcn_fence(__ATOMIC_ACQUIRE, "agent");
            asm volatile("s_waitcnt vmcnt(0)" ::: "memory");
        }
    }
    __syncthreads();
}

struct Ptrs {
    const float *x, *a_w_in, *a_lb, *a_ng, *a_w_out, *b_w_kv, *b_w_q, *b_sinks, *b_w_out, *rel_bias, *w_rg, *b_rg, *w_re, *b_re, *w_gate, *w_up, *w_down, *ln_g, *ln_b;
    float* out; unsigned char* ws;
};
__device__ __forceinline__ void prologue_phase(LAS unsigned char* lds, const Ptrs& p, int vcu, int G) {
    const int tid = opaque_tid(), lane = tid & 63, wave = __builtin_amdgcn_readfirstlane(tid >> 6);
    LAS float* scr = (LAS float*)(lds + wave * 8448);
    const int gw = vcu * 8 + wave, NGW = G * 8;
    bf16_t* Win_t = (bf16_t*)(p.ws + WS_WIN); bf16_t* Wout_t = (bf16_t*)(p.ws + WS_WOUT); bf16_t* Wkv_t = (bf16_t*)(p.ws + WS_WKV); bf16_t* Wq_t = (bf16_t*)(p.ws + WS_WQ); bf16_t* Wo_t = (bf16_t*)(p.ws + WS_WO);
    bf16_t* Wgu_t = (bf16_t*)(p.ws + WS_WGU); bf16_t* Wd_t = (bf16_t*)(p.ws + WS_WD);
    constexpr int I_IN = 2 * 32 * 256, I_AO = 2 * 32 * 64, I_KV = 32 * 16, I_Q = 2 * 32 * 64, I_O = 2 * 32 * 64, I_G = 128 * 32 * 16, I_U = I_G, I_D = 128 * 8 * 64;
    constexpr int NITEMS = I_IN + I_AO + I_KV + I_Q + I_O + I_G + I_U + I_D;
    for (int it = gw; it < NITEMS; it += NGW) {
        int r = it;
        if (r < I_IN) { const int mat = r / (32 * 256), q = r % (32 * 256), kb = q / 256, nb = q % 256; pg8::transpose_item(p.a_w_in + (size_t)mat * D * 4 * D, D, 4 * D, Win_t + (size_t)mat * 4 * D * D, 32 * nb, scr, kb, nb, lane); continue; } r -= I_IN;
        if (r < I_AO) { const int mat = r / (32 * 64), q = r % (32 * 64), kb = q / 64, nb = q % 64; pg8::transpose_item(p.a_w_out + (size_t)mat * D * D, D, D, Wout_t + (size_t)mat * D * D, 32 * nb, scr, kb, nb, lane); continue; } r -= I_AO;
        if (r < I_KV) { const int kb = r / 16, nb = r % 16; pg8::transpose_item(p.b_w_kv, D, 2 * KVW, Wkv_t, 32 * nb, scr, kb, nb, lane); continue; } r -= I_KV;
        if (r < I_Q) { const int mat = r / (32 * 64), q = r % (32 * 64), kb = q / 64, nb = q % 64; pg8::transpose_item(p.b_w_q + (size_t)mat * D * D, D, D, Wq_t + (size_t)mat * D * D, 32 * nb, scr, kb, nb, lane); continue; } r -= I_Q;
        if (r < I_O) { const int mat = r / (32 * 64), q = r % (32 * 64), kb = q / 64, nb = q % 64; pg8::transpose_item(p.b_w_out + (size_t)mat * D * D, D, D, Wo_t + (size_t)mat * D * D, 32 * nb, scr, kb, nb, lane); continue; } r -= I_O;
        if (r < I_G + I_U) { const int up = r >= I_G; if (up) r -= I_G; const int mat = r / (32 * 16), q = r % (32 * 16), kb = q / 16, nb = q % 16;
            const int n0 = 32 * nb, drow = (n0 >> 7) * 256 + (n0 & 127) + (up ? 128 : 0);
            pg8::transpose_item((up ? p.w_up : p.w_gate) + (size_t)mat * D * DEXP, D, DEXP, Wgu_t + (size_t)mat * 2 * DEXP * D, drow, scr, kb, nb, lane); continue; } r -= I_G + I_U;
        { const int mat = r / (8 * 64), q = r % (8 * 64), kb = q / 64, nb = q % 64; pg8::transpose_item(p.w_down + (size_t)mat * DEXP * D, DEXP, D, Wd_t + (size_t)mat * D * DEXP, 32 * nb, scr, kb, nb, lane); }
    }
    bf16_t* xb = (bf16_t*)(p.ws + WS_XB);
    for (size_t i = (size_t)vcu * 512 + tid; i < (size_t)T * D / 4; i += (size_t)G * 512) { const float4 v = ((const float4*)p.x)[i];
        u32x2 o; o.x = pg8::cvt_pk_bf16(v.x, v.y); o.y = pg8::cvt_pk_bf16(v.z, v.w); ((u32x2*)xb)[i] = o; }
}

template <int MODE>
__device__ __forceinline__ void ln_phase(const float* xin, const bf16_t* hm, const bf16_t* Y, const float* lng, const float* lnb, float* xf, bf16_t* xb,
                                         const float* wrg, const float* brg, const float* wre, const float* bre, int* cnt, int* list, float* tg, int vcu, int G) {
    const int tid = opaque_tid();
    for (int row = vcu * 8 + (tid >> 6); row < T; row += G * 8) {
        const int lane = opaque_tid() & 63;
        float v[32];
        float s = 0.f;
#pragma unroll
        for (int j = 0; j < 8; ++j) { const int c = 4 * lane + 256 * j; const float4 a = *(const float4*)(xin + (size_t)row * D + c);
            float4 h;
            if (MODE == 0) { const uint2 y0 = *(const uint2*)(hm + (size_t)row * D + c); h.x = bf2f((bf16_t)(y0.x & 0xffff)); h.y = bf2f((bf16_t)(y0.x >> 16)); h.z = bf2f((bf16_t)(y0.y & 0xffff)); h.w = bf2f((bf16_t)(y0.y >> 16)); }
            else { const uint2 y0 = *(const uint2*)(Y + (size_t)(row * 2) * D + c), y1 = *(const uint2*)(Y + (size_t)(row * 2 + 1) * D + c);
                h.x = bf2f((bf16_t)(y0.x & 0xffff)) + bf2f((bf16_t)(y1.x & 0xffff)); h.y = bf2f((bf16_t)(y0.x >> 16)) + bf2f((bf16_t)(y1.x >> 16));
                h.z = bf2f((bf16_t)(y0.y & 0xffff)) + bf2f((bf16_t)(y1.y & 0xffff)); h.w = bf2f((bf16_t)(y0.y >> 16)) + bf2f((bf16_t)(y1.y >> 16)); }
            v[4 * j + 0] = ALPHA * a.x + h.x; v[4 * j + 1] = ALPHA * a.y + h.y; v[4 * j + 2] = ALPHA * a.z + h.z; v[4 * j + 3] = ALPHA * a.w + h.w;
            s += (v[4 * j] + v[4 * j + 1]) + (v[4 * j + 2] + v[4 * j + 3]); }
        const float mean = wave_sum(s) * (1.f / D);
        float q = 0.f;
#pragma unroll
        for (int j = 0; j < 32; ++j) { v[j] -= mean; q += v[j] * v[j]; }
        const float rstd = 1.0f / sqrtf(wave_sum(q) * (1.f / D) + LN_EPS);
#pragma unroll
        for (int j = 0; j < 8; ++j) { const int c = 4 * lane + 256 * j; const float4 g = *(const float4*)(lng + c), b = *(const float4*)(lnb + c);
            v[4 * j + 0] = v[4 * j + 0] * rstd * g.x + b.x; v[4 * j + 1] = v[4 * j + 1] * rstd * g.y + b.y; v[4 * j + 2] = v[4 * j + 2] * rstd * g.z + b.z; v[4 * j + 3] = v[4 * j + 3] * rstd * g.w + b.w;
            *(float4*)(xf + (size_t)row * D + c) = make_float4(v[4 * j], v[4 * j + 1], v[4 * j + 2], v[4 * j + 3]);
            if (xb) { u32x2 o; o.x = pg8::cvt_pk_bf16(v[4 * j], v[4 * j + 1]); o.y = pg8::cvt_pk_bf16(v[4 * j + 2], v[4 * j + 3]); *(u32x2*)(xb + (size_t)row * D + c) = o; } }
        if (MODE == 0) {
            float gl[4] = {0.f, 0.f, 0.f, 0.f};
#pragma unroll
            for (int j = 0; j < 8; ++j)
#pragma unroll
                for (int i = 0; i < 4; ++i) { const int c = 4 * lane + 256 * j + i; const float4 w = *(const float4*)(wrg + (size_t)c * NGRP); const float x = v[4 * j + i];
                    gl[0] += x * w.x; gl[1] += x * w.y; gl[2] += x * w.z; gl[3] += x * w.w; }
#pragma unroll
            for (int g = 0; g < 4; ++g) gl[g] = wave_sum(gl[g]) + brg[g];
            int grp = 0; float gmax = gl[0];
#pragma unroll
            for (int g = 1; g < 4; ++g) if (gl[g] > gmax) { gmax = gl[g]; grp = g; }
            float gden = 0.f;
#pragma unroll
            for (int g = 0; g < 4; ++g) gden += __expf(gl[g] - gmax);
            const float pgrp = 1.0f / gden;
            float el[8] = {0.f, 0.f, 0.f, 0.f, 0.f, 0.f, 0.f, 0.f};
#pragma unroll
            for (int j = 0; j < 8; ++j)
#pragma unroll
                for (int i = 0; i < 4; ++i) { const int c = 4 * lane + 256 * j + i; const float4 w0 = *(const float4*)(wre + (size_t)c * NEXP + grp * 8), w1 = *(const float4*)(wre + (size_t)c * NEXP + grp * 8 + 4); const float x = v[4 * j + i];
                    el[0] += x * w0.x; el[1] += x * w0.y; el[2] += x * w0.z; el[3] += x * w0.w; el[4] += x * w1.x; el[5] += x * w1.y; el[6] += x * w1.z; el[7] += x * w1.w; }
#pragma unroll
            for (int e = 0; e < 8; ++e) el[e] = wave_sum(el[e]) + bre[grp * 8 + e];
            int i0 = 0; float v0 = el[0];
#pragma unroll
            for (int e = 1; e < 8; ++e) if (el[e] > v0) { v0 = el[e]; i0 = e; }
            int i1 = -1; float v1 = -3.0e38f;
#pragma unroll
            for (int e = 0; e < 8; ++e) if (e != i0 && el[e] > v1) { v1 = el[e]; i1 = e; }
            const float e1 = __expf(v1 - v0), den = 1.f + e1;
            const float g0 = pgrp / den, g1 = pgrp * e1 / den;
            if (lane == 0) {
                const int ea = grp * 8 + i0, eb = grp * 8 + i1;
                const int pa = atomicAdd(&cnt[ea], 1); list[ea * T + pa] = row * 2; tg[row * 2] = g0;
                const int pb = atomicAdd(&cnt[eb], 1); list[eb * T + pb] = row * 2 + 1; tg[row * 2 + 1] = g1;
            }
        }
    }
}

typedef float f32x16 __attribute__((ext_vector_type(16)));
#define MFMA32(a, b, c) __builtin_amdgcn_mfma_f32_32x32x16_bf16((a), (b), (c), 0, 0, 0)
constexpr int KRS = 144, AT_K = 0, AT_V = 256 * KRS, AT_BIAS = 2 * 256 * KRS, AT_BYTES = AT_BIAS + 8 * 128 * 4;
__device__ __forceinline__ int t5_bucket(int n) { if (n < 16) return n; int l = 16 + (int)(__logf((float)n * (1.f / 16.f)) / 2.0794415416798357f * 16.f); return l < 31 ? l : 31; }
__device__ __forceinline__ void attn_phase(LAS unsigned char* lds, const bf16_t* Qb, const bf16_t* Kc, const bf16_t* Vc, const float* sinks, const float* relb, bf16_t* Og, int vcu, int G) {
    const int tid = opaque_tid(), lane = tid & 63, wid = __builtin_amdgcn_readfirstlane(tid >> 6), r = lane & 31, h = lane >> 5;
    LAS float* biasT = (LAS float*)(lds + AT_BIAS);
    for (int unit = vcu; unit < BATCH * AT_HKV * (SEQ / 128); unit += G) {
        const int b = unit >> 6, kvh = (unit >> 4) & 3, qblk = unit & 15, hq = kvh * 8 + wid;
        const int row0 = b * SEQ + qblk * 128;
#pragma unroll
        for (int it = 0; it < 4; ++it) { const int id = tid + 512 * it, i = id >> 3, ck = id & 7;
            u32x4 kv = {0u, 0u, 0u, 0u}, vv = {0u, 0u, 0u, 0u};
            if (qblk > 0 || i >= 128) { const size_t go = (size_t)(row0 - 128 + i) * KVW + kvh * 64 + ck * 8; kv = *(const u32x4*)(Kc + go); vv = *(const u32x4*)(Vc + go); }
            *(LAS u32x4*)(lds + AT_K + i * KRS + ck * 16) = kv; *(LAS u32x4*)(lds + AT_V + i * KRS + ck * 16) = vv; }
        for (int id = tid; id < 1024; id += 512) biasT[id] = relb[t5_bucket(id & 127) * AT_HQ + kvh * 8 + (id >> 7)];
        __syncthreads();
        const float sink = sinks[hq];
        for (int qs = 0; qs < 4; ++qs) {
            bf16x8 qf[4]; { const bf16_t* qp = Qb + (size_t)(row0 + 32 * qs + r) * D + hq * 64 + 8 * h;
#pragma unroll
                for (int ks = 0; ks < 4; ++ks) qf[ks] = *(const bf16x8*)(qp + 16 * ks); }
            f32x16 S[5];
#pragma unroll
            for (int kbi = 0; kbi < 5; ++kbi) {
#pragma unroll
                for (int e = 0; e < 16; ++e) S[kbi][e] = 0.f;
#pragma unroll
                for (int ks = 0; ks < 4; ++ks) S[kbi] = MFMA32(*(const LAS bf16x8*)(lds + AT_K + (32 * (qs + kbi) + r) * KRS + (16 * ks + 8 * h) * 2), qf[ks], S[kbi]); }
            float m = -1e30f;
#pragma unroll
            for (int kbi = 0; kbi < 5; ++kbi)
#pragma unroll
                for (int e = 0; e < 16; ++e) { const int keyb = 32 * (qs + kbi) + (e & 3) + 8 * (e >> 2) + 4 * h, dist = 128 + 32 * qs + r - keyb;
                    const bool valid = dist >= 0 && dist < 128 && (qblk > 0 || keyb >= 128);
                    const float sv = valid ? S[kbi][e] * 0.125f + biasT[wid * 128 + (dist & 127)] : -1e30f;
                    S[kbi][e] = sv; m = fmaxf(m, sv); }
            m = fmaxf(m, __shfl_xor(m, 32)); m = fmaxf(m, sink);
            float l = 0.f;
#pragma unroll
            for (int kbi = 0; kbi < 5; ++kbi)
#pragma unroll
                for (int e = 0; e < 16; ++e) { const float pv = __expf(S[kbi][e] - m); S[kbi][e] = pv; l += pv; }
            l += __shfl_xor(l, 32); l += __expf(sink - m);
            f32x16 O[2];
#pragma unroll
            for (int e = 0; e < 16; ++e) { O[0][e] = 0.f; O[1][e] = 0.f; }
            const int i16 = lane & 15, qq = i16 >> 2, pp = i16 & 3, gg = (lane >> 4) & 1;
#pragma unroll
            for (int kbi = 0; kbi < 5; ++kbi)
#pragma unroll
                for (int s2 = 0; s2 < 2; ++s2) {
                    u32x4 pk; pk.x = pg8::cvt_pk_bf16(S[kbi][8 * s2 + 0], S[kbi][8 * s2 + 1]); pk.y = pg8::cvt_pk_bf16(S[kbi][8 * s2 + 2], S[kbi][8 * s2 + 3]);
                    pk.z = pg8::cvt_pk_bf16(S[kbi][8 * s2 + 4], S[kbi][8 * s2 + 5]); pk.w = pg8::cvt_pk_bf16(S[kbi][8 * s2 + 6], S[kbi][8 * s2 + 7]);
                    const bf16x8 pf = __builtin_bit_cast(bf16x8, pk);
#pragma unroll
                    for (int db = 0; db < 2; ++db) { const LAS unsigned char* va = lds + AT_V + (32 * (qs + kbi) + 16 * s2 + 4 * h + qq) * KRS + (32 * db + 16 * gg + 4 * pp) * 2;
                        const s16x4 lo = __builtin_amdgcn_ds_read_tr16_b64_v4i16((lds_s16x4*)va), hi = __builtin_amdgcn_ds_read_tr16_b64_v4i16((lds_s16x4*)(va + 8 * KRS));
                        const bf16x8 vf = {lo[0], lo[1], lo[2], lo[3], hi[0], hi[1], hi[2], hi[3]};
                        O[db] = MFMA32(vf, pf, O[db]); } }
            const float inv = 1.0f / l;
            bf16_t* op = Og + (size_t)(row0 + 32 * qs + r) * D + hq * 64 + 4 * h;
#pragma unroll
            for (int db = 0; db < 2; ++db)
#pragma unroll
                for (int g4 = 0; g4 < 4; ++g4) { f32x4 v; v[0] = O[db][4 * g4] * inv; v[1] = O[db][4 * g4 + 1] * inv; v[2] = O[db][4 * g4 + 2] * inv; v[3] = O[db][4 * g4 + 3] * inv;
                    *(u32x2*)(op + 32 * db + 8 * g4) = pack4(v); }
        }
        __syncthreads();
    }
}

constexpr int LDS_STAGE = 0;
constexpr int LDS_MOETAB = pg8::STAGE_BYTES;
constexpr int LDS_MISC = LDS_MOETAB + pg8::MOE_TAB_INTS * 4;
constexpr int LDS_BYTES = 147456;
static_assert(LDS_MISC + 256 <= LDS_BYTES && H1_BYTES <= pg8::STAGE_BYTES && 8 * 8448 <= pg8::STAGE_BYTES && AT_BYTES <= pg8::STAGE_BYTES, "LDS map");
constexpr int CW_BAR = 4096;
constexpr int N_PHASES = 1 + NA * 9 + (DEPTH - NA) * 7;

struct MegaArgs { const float* in[19]; float* out; unsigned char* ws; int ph_lo, ph_hi; };

__global__ void __launch_bounds__(512, 2) mega_fwd(MegaArgs args) {
    extern __shared__ __attribute__((aligned(16))) unsigned char lds_raw[];
    LAS unsigned char* lds = (LAS unsigned char*)lds_raw;
    volatile LAS unsigned* MISC = (volatile LAS unsigned*)(lds + LDS_MISC);
    const int tid = threadIdx.x, G = gridDim.x, bx = blockIdx.x, vcu = (G % 8 == 0) ? (bx % 8) * (G / 8) + bx / 8 : bx;
    unsigned char* const ws = args.ws;
    if (tid < 64) MISC[tid] = 0u;
    __syncthreads();
    const int lo = args.ph_lo, hi = args.ph_hi;
    XcdBarrier bar; bar.bar = (unsigned*)(ws + WS_CTL) + CW_BAR; bar.x = 0; bar.st = nullptr;
    if (hi - lo > 1) bar = xcd_barrier_post((unsigned*)(ws + WS_CTL) + CW_BAR, MISC + 8);
#define WSP(type, off) ((type*)(args.ws + (off)))
    int ph = 0;
#define PH_BEGIN if (lo <= ph && ph < hi) {
#define PH_END   if (ph + 1 < hi) xcd_barrier(bar); } ++ph;

    PH_BEGIN { Ptrs p; p.x = args.in[0]; p.a_w_in = args.in[1]; p.a_w_out = args.in[4]; p.b_w_kv = args.in[5]; p.b_w_q = args.in[6]; p.b_w_out = args.in[8]; p.w_gate = args.in[14]; p.w_up = args.in[15]; p.w_down = args.in[16]; p.ws = args.ws;
               prologue_phase(lds, p, vcu, G); } PH_END

    for (int L = 0; L < DEPTH; ++L) {
        if (L < NA) {
            PH_BEGIN { pg8::DenseSched S; S.init(T, 4 * D, D, G, bx); pg8::EpiHgrn E{WSP(bf16_t, WS_QB), WSP(bf16_t, WS_KB), WSP(bf16_t, WS_VB), WSP(bf16_t, WS_GT), WSP(float, WS_GL), args.in[2], L, 0};
                       pg8::gemm_phase<pg8::EpiHgrn, pg8::DenseSched>(lds, WSP(bf16_t, WS_XB), WSP(bf16_t, WS_WIN) + (size_t)L * 4 * D * D, D, 0, S, E); } PH_END
#define HGARGS HgArgs{WSP(bf16_t, WS_QB), WSP(bf16_t, WS_KB), WSP(bf16_t, WS_VB), WSP(bf16_t, WS_GT), WSP(bf16_t, WS_OF), WSP(bf16_t, WS_UT), WSP(bf16_t, WS_SST), WSP(bf16_t, WS_OG), WSP(float, WS_GL), WSP(float, WS_DG), args.in[3] + (size_t)L * D}
            PH_BEGIN { const HgArgs ha = HGARGS; h1_phase(lds, ha, vcu, G); } PH_END
            PH_BEGIN { const HgArgs ha = HGARGS; h2_phase(ha, vcu, G); } PH_END
            PH_BEGIN { const HgArgs ha = HGARGS; h3_phase(ha, vcu, G); } PH_END
            PH_BEGIN { pg8::DenseSched S; S.init(T, D, D, G, bx); pg8::EpiStore E{WSP(bf16_t, WS_HM), WSP(bf16_t, WS_HM), D, 1 << 30, 1.0f, 0};
                       pg8::gemm_phase<pg8::EpiStore, pg8::DenseSched>(lds, WSP(bf16_t, WS_OG), WSP(bf16_t, WS_WOUT) + (size_t)L * D * D, D, 0, S, E); } PH_END
        } else {
            const int j = L - NA;
            PH_BEGIN { if (j == 0) { pg8::DenseSched S; S.init(T, 2 * KVW, D, G, bx); pg8::EpiStore E{WSP(bf16_t, WS_KC), WSP(bf16_t, WS_VC), KVW, 1, 1.0f, 0};
                                     pg8::gemm_phase<pg8::EpiStore, pg8::DenseSched>(lds, WSP(bf16_t, WS_XB), WSP(bf16_t, WS_WKV), D, 0, S, E); }
                       pg8::DenseSched S; S.init(T, D, D, G, bx); pg8::EpiStore E{WSP(bf16_t, WS_QB), WSP(bf16_t, WS_QB), D, 1 << 30, 1.0f, 0};
                       pg8::gemm_phase<pg8::EpiStore, pg8::DenseSched>(lds, WSP(bf16_t, WS_XB), WSP(bf16_t, WS_WQ) + (size_t)j * D * D, D, 0, S, E); } PH_END
            PH_BEGIN attn_phase(lds, WSP(bf16_t, WS_QB), WSP(bf16_t, WS_KC), WSP(bf16_t, WS_VC), args.in[7] + j * AT_HQ, args.in[9], WSP(bf16_t, WS_OG), vcu, G); PH_END
            PH_BEGIN { pg8::DenseSched S; S.init(T, D, D, G, bx); pg8::EpiStore E{WSP(bf16_t, WS_HM), WSP(bf16_t, WS_HM), D, 1 << 30, 1.0f, 0};
                       pg8::gemm_phase<pg8::EpiStore, pg8::DenseSched>(lds, WSP(bf16_t, WS_OG), WSP(bf16_t, WS_WO) + (size_t)j * D * D, D, 0, S, E); } PH_END
        }
        PH_BEGIN ln_phase<0>(L == 0 ? args.in[0] : WSP(float, WS_XF), WSP(bf16_t, WS_HM), nullptr, args.in[17] + (size_t)(2 * L) * D, args.in[18] + (size_t)(2 * L) * D, WSP(float, WS_XF), WSP(bf16_t, WS_XB),
                             args.in[10] + (size_t)L * D * NGRP, args.in[11] + L * NGRP, args.in[12] + (size_t)L * D * NEXP, args.in[13] + L * NEXP, WSP(int, WS_CTL) + CW_CNT + 64 * L, WSP(int, WS_LIST), WSP(float, WS_TG), vcu, G); PH_END
        PH_BEGIN { LAS int* tab = (LAS int*)(lds + LDS_MOETAB); pg8::MoeSched S{tab, WSP(int, WS_LIST), 4, G, vcu, D, 1, 0}; S.build(tab, WSP(int, WS_CTL) + CW_CNT + 64 * L);
                   pg8::gemm_phase<pg8::EpiMoeH, pg8::MoeSched>(lds, WSP(bf16_t, WS_XB), WSP(bf16_t, WS_WGU) + (size_t)L * NEXP * 2 * DEXP * D, D, (size_t)2 * DEXP * D * 2, S, pg8::EpiMoeH{WSP(bf16_t, WS_HS)}); } PH_END
        PH_BEGIN { LAS int* tab = (LAS int*)(lds + LDS_MOETAB); pg8::MoeSched S{tab, WSP(int, WS_LIST), 8, G, vcu, DEXP, 0, 0}; S.build(tab, WSP(int, WS_CTL) + CW_CNT + 64 * L);
                   pg8::gemm_phase<pg8::EpiMoeY, pg8::MoeSched>(lds, WSP(bf16_t, WS_HS), WSP(bf16_t, WS_WD) + (size_t)L * NEXP * D * DEXP, DEXP, (size_t)D * DEXP * 2, S, pg8::EpiMoeY{WSP(bf16_t, WS_Y), WSP(float, WS_TG), S}); } PH_END
        PH_BEGIN ln_phase<1>(WSP(float, WS_XF), nullptr, WSP(bf16_t, WS_Y), args.in[17] + (size_t)(2 * L + 1) * D, args.in[18] + (size_t)(2 * L + 1) * D, L == DEPTH - 1 ? args.out : WSP(float, WS_XF), L == DEPTH - 1 ? nullptr : WSP(bf16_t, WS_XB),
                             nullptr, nullptr, nullptr, nullptr, nullptr, nullptr, nullptr, vcu, G); PH_END
    }
#undef HGARGS
#undef WSP
#undef PH_BEGIN
#undef PH_END
}

#ifndef MK_PER_PHASE
#define MK_PER_PHASE 0
#endif
extern "C" void kernel_launch(void* const* d_in, const int* in_sizes, int n_in, void* d_out, int out_size, void* d_ws, size_t ws_size, hipStream_t stream) {
    static int grid = 0;
    if (grid == 0) {
        if (n_in != 19 || out_size != T * D || ws_size < WS_END) { fprintf(stderr, "kernel_launch: unexpected arguments (n_in %d, out %d, ws %zu < %zu)\n", n_in, out_size, ws_size, (size_t)WS_END); grid = -1; return; }
        int dev = 0, cus = 0, per_cu = 0;
        if (hipGetDevice(&dev) != hipSuccess || hipDeviceGetAttribute(&cus, hipDeviceAttributeMultiprocessorCount, dev) != hipSuccess) { grid = -1; return; }
        if (hipFuncSetAttribute((const void*)mega_fwd, hipFuncAttributeMaxDynamicSharedMemorySize, LDS_BYTES) != hipSuccess) { fprintf(stderr, "kernel_launch: hipFuncSetAttribute failed\n"); grid = -1; return; }
        if (hipOccupancyMaxActiveBlocksPerMultiprocessor(&per_cu, (const void*)mega_fwd, 512, LDS_BYTES) != hipSuccess || per_cu < 1) { fprintf(stderr, "kernel_launch: occupancy query reports %d\n", per_cu); }
        (void)hipGetLastError();
        grid = cus;
    }
    if (grid < 0) return;
    (void)hipMemsetAsync((char*)d_ws + WS_CTL, 0, CTL_BYTES, stream);
    MegaArgs a{};
    for (int i = 0; i < 19; ++i) a.in[i] = (const float*)d_in[i];
    a.out = (float*)d_out; a.ws = (unsigned char*)d_ws;
#if MK_PER_PHASE
    for (int ph = 0; ph < N_PHASES; ++ph) { a.ph_lo = ph; a.ph_hi = ph + 1; hipLaunchKernelGGL(mega_fwd, dim3(grid), dim3(512), LDS_BYTES, stream, a); }
#else
    a.ph_lo = 0; a.ph_hi = N_PHASES;
    hipLaunchKernelGGL(mega_fwd, dim3(grid), dim3(512), LDS_BYTES, stream, a);
#endif
}
```

```cpp
#include <hip/hip_runtime.h>
#include <cstdio>
#include <cstdint>

typedef unsigned short bf16_t;
typedef short bf16x8 __attribute__((ext_vector_type(8)));
typedef float f32x4 __attribute__((ext_vector_type(4)));

constexpr int BATCH = 4, SEQ = 2048, D = 2048, T = BATCH * SEQ, DEPTH = 4, NA = 2;
constexpr int HG_H = 16, HG_DK = 128;
constexpr int AT_HD = 64, AT_HQ = 32, AT_HKV = 4, AT_G = 8, KVW = AT_HKV * AT_HD;
constexpr int NGRP = 4, EPG = 8, NEXP = 32, DEXP = 512;
constexpr float ALPHA = 1.6817928305074290f;
constexpr float LN_EPS = 1e-5f, RMS_EPS = 1e-6f;

constexpr size_t MiB = 1u << 20;
constexpr size_t WS_CTL = 0, CTL_BYTES = 1 * MiB;
constexpr size_t WS_XF = 1 * MiB;
constexpr size_t WS_XB = WS_XF + 64 * MiB;
constexpr size_t WS_QB = WS_XB + 32 * MiB;
constexpr size_t WS_KB = WS_QB + 32 * MiB;
constexpr size_t WS_VB = WS_KB + 32 * MiB;
constexpr size_t WS_GT = WS_VB + 32 * MiB;
constexpr size_t WS_GL = WS_GT + 32 * MiB;
constexpr size_t WS_OF = WS_GL + 64 * MiB;
constexpr size_t WS_OG = WS_OF + 64 * MiB;
constexpr size_t WS_HM = WS_OG + 32 * MiB;
constexpr size_t WS_KC = WS_HM + 32 * MiB;
constexpr size_t WS_VC = WS_KC + 4 * MiB;
constexpr size_t WS_LIST = WS_VC + 4 * MiB;
constexpr size_t WS_TG = WS_LIST + 1 * MiB;
constexpr size_t WS_HS = WS_TG + 1 * MiB;
constexpr size_t WS_Y = WS_HS + 24 * MiB;
constexpr size_t WS_WIN = WS_Y + 64 * MiB;
constexpr size_t WS_WOUT = WS_WIN + 64 * MiB;
constexpr size_t WS_WKV = WS_WOUT + 16 * MiB;
constexpr size_t WS_WQ = WS_WKV + 2 * MiB;
constexpr size_t WS_WO = WS_WQ + 16 * MiB;
constexpr size_t WS_WGU = WS_WO + 16 * MiB;
constexpr size_t WS_WD = WS_WGU + 512 * MiB;
constexpr size_t WS_UT = WS_WD + 256 * MiB;
constexpr size_t WS_SST = WS_UT + 64 * MiB;
constexpr size_t WS_DG = WS_SST + 64 * MiB;
constexpr size_t WS_WR = WS_DG + 1 * MiB;
constexpr size_t WS_HIST = WS_WR + 2 * MiB;
constexpr size_t WS_TRASH = WS_HIST + 1 * MiB;
constexpr size_t WS_END = WS_TRASH + 256 * MiB;
constexpr int CW_CNT = 1024;

__device__ __forceinline__ unsigned f2bf(float f) { unsigned u = __builtin_bit_cast(unsigned, f); return (u + 0x7fffu + ((u >> 16) & 1u)) >> 16; }
__device__ __forceinline__ float bf2f(bf16_t b) { return __builtin_bit_cast(float, ((unsigned)b) << 16); }
__device__ __forceinline__ float wave_sum(float v) {
#pragma unroll
    for (int o = 1; o < 64; o <<= 1) v += __shfl_xor(v, o);
    return v;
}
__device__ __forceinline__ float wave_max(float v) {
#pragma unroll
    for (int o = 1; o < 64; o <<= 1) v = fmaxf(v, __shfl_xor(v, o));
    return v;
}
__device__ __forceinline__ float sigmoidf_(float x) { return 1.0f / (1.0f + __expf(-x)); }
__device__ __forceinline__ int opaque_tid() { int t = threadIdx.x; asm volatile("" : "+v"(t)); return t; }

#define LAS __attribute__((address_space(3)))
typedef unsigned u32x4 __attribute__((ext_vector_type(4)));
namespace pg8 {
constexpr int BM = 256, BK = 64, HALF = 128, HTB = HALF * BK * 2, STAGE_BYTES = 8 * HTB;
__host__ __device__ __forceinline__ int lds_byte(int r, int c) { const int st = (r >> 4) * 2 + (c >> 5), rr = r & 15, cc = c & 31, ob = rr * 64 + cc * 2; return st * 1024 + (ob ^ (((ob >> 9) & 1) << 5)); }
__host__ __device__ __forceinline__ void stage_rc(int b, int& R, int& C) { const int st = b / 1024, sb = b % 1024, swz = sb ^ (((sb >> 9) & 1) << 5); R = (st >> 1) * 16 + swz / 64; C = (st & 1) * 32 + (swz % 64) / 2; }
__host__ __device__ __forceinline__ int perm32(int rho) { const int n = rho >> 4, i = rho & 15; return 8 * (i >> 2) + 4 * n + (i & 3); }
struct Unit { int pm, pn, e, rows, tm, ui; };
typedef float f32x2_ __attribute__((ext_vector_type(2)));
typedef __bf16 bf16x2_ __attribute__((ext_vector_type(2)));
__device__ __forceinline__ unsigned cvt_pk_bf16(float lo, float hi) { const f32x2_ v = {lo, hi}; return __builtin_bit_cast(unsigned, __builtin_convertvector(v, bf16x2_)); }

struct DenseSched {
    int nM, nN, nwg, G, c, K;
    __device__ __forceinline__ void init(int M, int N, int K_, int G_, int c_) { nM = M / BM; nN = N / BM; nwg = nM * nN; G = G_; c = c_; K = K_; }
    __device__ __forceinline__ bool next(int i, Unit& u) const {
        const long L = (long)i * G + c; if (L >= nwg) return false;
        int wgid = (int)L; { const int q = nwg / 8, r = nwg % 8, xcd = wgid % 8, off = wgid / 8; wgid = (xcd < r ? xcd * (q + 1) : r * (q + 1) + (xcd - r) * q) + off; }
        const int nig = 8 * nN, gid = wgid / nig, fm = gid * 8, gsz = (nM - fm) < 8 ? (nM - fm) : 8;
        u.pm = fm + ((wgid % nig) % gsz); u.pn = (wgid % nig) / gsz; u.e = 0; u.rows = 256; u.tm = 0; u.ui = i; return true;
    }
    __device__ __forceinline__ unsigned a_off(const Unit& u, int half, int R) const { return (unsigned)((u.pm * 256 + half * 128 + R) * K) * 2u; }
};

template <class Epi, class Sched>
__device__ __forceinline__ void gemm_phase(LAS unsigned char* lds, const bf16_t* A, const bf16_t* Bt, int K, size_t bstride, const Sched& S, const Epi& E) {
    const int tid = opaque_tid(), wid = __builtin_amdgcn_readfirstlane(tid >> 6), lane = tid & 63, wr = wid >> 2, wc = wid & 3, fr = lane & 15, fq = lane >> 4;
    const int nt = K / BK;
    int sR[2], sC2[2]; unsigned voffB[2];
#pragma unroll
    for (int i = 0; i < 2; ++i) { int R, C; stage_rc(tid * 16 + i * 8192, R, C); const int Rb = (R & ~31) + perm32(R & 31); sR[i] = R; sC2[i] = C * 2; voffB[i] = (unsigned)(Rb * K + C) * 2u; }
    const size_t kstep = (size_t)(BK * 2);
    const size_t hstep = (size_t)HALF * K * 2;
    const size_t tstep = 2 * hstep;
    const unsigned ldsw = (unsigned)wid * 1024u;
    const int aoff = lds_byte(wr * 64 + fr, fq * 8), boff = lds_byte(wc * 32 + fr, fq * 8);
#define PG8_SA(b, h) (((b) * 2 + (h)) * HTB)
#define PG8_SB(b, h) ((4 + (b) * 2 + (h)) * HTB)
#define PG8_STAGE(bufoff, gbase, voff) do { _Pragma("unroll") for (int _i = 0; _i < 2; ++_i) \
        __builtin_amdgcn_global_load_lds((const unsigned*)((const char*)(gbase) + (voff)[_i]), (LAS unsigned*)(lds + (bufoff) + ldsw + _i * 8192), 16, 0, 0); } while (0)
#define PG8_LDA(dst, b, h) do { _Pragma("unroll") for (int m = 0; m < 4; ++m) _Pragma("unroll") for (int k = 0; k < 2; ++k) dst[m][k] = *(const LAS bf16x8*)(lds + PG8_SA(b, h) + aoff + m * 2048 + k * 1024); } while (0)
#define PG8_LDB(dst, b, h) do { _Pragma("unroll") for (int n = 0; n < 2; ++n) _Pragma("unroll") for (int k = 0; k < 2; ++k) dst[n][k] = *(const LAS bf16x8*)(lds + PG8_SB(b, h) + boff + n * 2048 + k * 1024); } while (0)
#define PG8_MMA(ai, bj, At, Bt_) do { __builtin_amdgcn_s_setprio(1); _Pragma("unroll") for (int m = 0; m < 4; ++m) _Pragma("unroll") for (int n = 0; n < 2; ++n) _Pragma("unroll") for (int k = 0; k < 2; ++k) \
        acc[ai][bj][m][n] = __builtin_amdgcn_mfma_f32_16x16x32_bf16(Bt_[n][k], At[m][k], acc[ai][bj][m][n], 0, 0, 0); __builtin_amdgcn_s_setprio(0); } while (0)
#define PG8_WAIT_V(n) asm volatile("s_waitcnt vmcnt(" #n ")" ::: "memory")
#define PG8_WAIT_L(n) asm volatile("s_waitcnt lgkmcnt(" #n ")" ::: "memory")
#define PG8_BAR __builtin_amdgcn_s_barrier()
#define PG8_SCHED __builtin_amdgcn_sched_barrier(0)
    Unit cur, nxt; int ui = 0;
    if (!S.next(0, cur)) return;
    f32x4 acc[2][2][4][2];
#pragma unroll
    for (int a = 0; a < 2; ++a)
#pragma unroll
        for (int b = 0; b < 2; ++b)
#pragma unroll
            for (int m = 0; m < 4; ++m)
#pragma unroll
                for (int n = 0; n < 2; ++n) acc[a][b][m][n] = (f32x4){0.f, 0.f, 0.f, 0.f};
    bf16x8 At[4][2], B0[2][2], B1[2][2];
    unsigned voffA0[2], voffA1[2];
#pragma unroll
    for (int i = 0; i < 2; ++i) { voffA0[i] = S.a_off(cur, 0, sR[i]) + sC2[i]; voffA1[i] = S.a_off(cur, 1, sR[i]) + sC2[i]; }
    const char* const Ab = (const char*)A;
    const char* cB = (const char*)Bt + (size_t)cur.e * bstride + (size_t)cur.pn * tstep;
    PG8_STAGE(PG8_SB(0, 0), cB, voffB); PG8_STAGE(PG8_SB(0, 1), cB + hstep, voffB); PG8_STAGE(PG8_SA(0, 0), Ab, voffA0); PG8_STAGE(PG8_SA(0, 1), Ab, voffA1);
    if (wr == 1) PG8_BAR;
    PG8_WAIT_V(2); PG8_BAR;
    PG8_STAGE(PG8_SB(1, 0), cB + kstep, voffB); PG8_STAGE(PG8_SA(1, 0), Ab + kstep, voffA0); PG8_STAGE(PG8_SB(1, 1), cB + hstep + kstep, voffB);
    PG8_WAIT_V(6); PG8_BAR;
    for (;;) {
        const bool has_next = S.next(ui + 1, nxt);
        const char* nB = has_next ? (const char*)Bt + (size_t)nxt.e * bstride + (size_t)nxt.pn * tstep : cB;
        for (int t = 0; t < nt; t += 2) {
            const bool last = (t == nt - 2);
            const char* a1 = Ab + (size_t)(t + 1) * kstep;
            const char* a2 = last ? Ab : Ab + (size_t)(t + 2) * kstep; const char* b2 = last ? nB : cB + (size_t)(t + 2) * kstep;
            const char* a3 = a2 + kstep; const char* b3 = b2 + kstep;
            PG8_LDB(B0, 0, 0); PG8_LDB(B1, 0, 1); PG8_SCHED; PG8_LDA(At, 0, 0); PG8_STAGE(PG8_SA(1, 1), a1, voffA1);
            if (last && has_next) {
#pragma unroll
                for (int i = 0; i < 2; ++i) { voffA0[i] = S.a_off(nxt, 0, sR[i]) + sC2[i]; voffA1[i] = S.a_off(nxt, 1, sR[i]) + sC2[i]; }
            }
            PG8_WAIT_V(8); PG8_WAIT_L(0); PG8_BAR; PG8_MMA(0, 0, At, B0); PG8_MMA(0, 1, At, B1); PG8_BAR; PG8_SCHED;
            PG8_LDA(At, 0, 1); PG8_STAGE(PG8_SB(0, 0), b2, voffB); PG8_STAGE(PG8_SB(0, 1), b2 + hstep, voffB); PG8_STAGE(PG8_SA(0, 0), a2, voffA0);
            PG8_WAIT_V(8); PG8_WAIT_L(0); PG8_BAR; PG8_MMA(1, 0, At, B0); PG8_MMA(1, 1, At, B1); PG8_BAR; PG8_SCHED;
            PG8_LDB(B0, 1, 0); PG8_LDB(B1, 1, 1); PG8_SCHED; PG8_LDA(At, 1, 0); PG8_STAGE(PG8_SA(0, 1), a2, voffA1);
            PG8_WAIT_V(8); PG8_WAIT_L(0); PG8_BAR; PG8_MMA(0, 0, At, B0); PG8_MMA(0, 1, At, B1); PG8_BAR; PG8_SCHED;
            PG8_LDA(At, 1, 1); PG8_STAGE(PG8_SB(1, 0), b3, voffB); PG8_STAGE(PG8_SB(1, 1), b3 + hstep, voffB); PG8_STAGE(PG8_SA(1, 0), a3, voffA0);
            PG8_WAIT_V(8); PG8_WAIT_L(0); PG8_BAR; PG8_MMA(1, 0, At, B0); PG8_MMA(1, 1, At, B1); PG8_BAR; PG8_SCHED;
        }
        if (wr == 0) PG8_BAR;
        E(acc, cur, wr, wc, fr, fq);
        if (!has_next) break;
#pragma unroll
        for (int a = 0; a < 2; ++a)
#pragma unroll
            for (int b = 0; b < 2; ++b)
#pragma unroll
                for (int m = 0; m < 4; ++m)
#pragma unroll
                    for (int n = 0; n < 2; ++n) acc[a][b][m][n] = (f32x4){0.f, 0.f, 0.f, 0.f};
        cur = nxt; cB = nB; ++ui;
        if (wr == 1) PG8_BAR;
    }
    PG8_WAIT_V(0);
    PG8_BAR;
#undef PG8_SA
#undef PG8_SB
#undef PG8_STAGE
#undef PG8_LDA
#undef PG8_LDB
#undef PG8_MMA
#undef PG8_WAIT_V
#undef PG8_WAIT_L
#undef PG8_BAR
#undef PG8_SCHED
}

#define PG8_ROWS_COLS const int row0 = u.pm * BM + wr * 64 + fr; const int col0 = wc * 32 + 8 * fq
__device__ __forceinline__ u32x4 pack8(const f32x4 v0, const f32x4 v1) { u32x4 w; w.x = cvt_pk_bf16(v0[0], v0[1]); w.y = cvt_pk_bf16(v0[2], v0[3]); w.z = cvt_pk_bf16(v1[0], v1[1]); w.w = cvt_pk_bf16(v1[2], v1[3]); return w; }
struct EpiStore {
    bf16_t* O; bf16_t* O2; int ldc, split; float scale; int pad;
    __device__ __forceinline__ void operator()(const f32x4 (&acc)[2][2][4][2], const Unit& u, int wr, int wc, int fr, int fq) const {
        PG8_ROWS_COLS; bf16_t* base = u.pn >= split ? O2 + (size_t)(u.pn - split) * BM : O + (size_t)u.pn * BM;
#pragma unroll
        for (int ai = 0; ai < 2; ++ai)
#pragma unroll
            for (int m = 0; m < 4; ++m) { bf16_t* rowp = base + (size_t)(row0 + ai * HALF + m * 16) * ldc + col0;
#pragma unroll
                for (int bj = 0; bj < 2; ++bj) *(u32x4*)(rowp + bj * HALF) = pack8(acc[ai][bj][m][0] * scale, acc[ai][bj][m][1] * scale); }
    }
};
struct EpiHgrn {
    bf16_t *Qb, *Kb, *Vb, *Gt; float* Gl; const float* lbraw; int layer, pad;
    __device__ __forceinline__ void operator()(const f32x4 (&acc)[2][2][4][2], const Unit& u, int wr, int wc, int fr, int fq) const {
        PG8_ROWS_COLS; const int seg = u.pn >> 3, ct = (u.pn & 7) * BM + col0;
        if (seg == 0 || seg == 2) { bf16_t* base = (seg == 0 ? Qb : Vb) + ct;
#pragma unroll
            for (int ai = 0; ai < 2; ++ai)
#pragma unroll
                for (int m = 0; m < 4; ++m) { bf16_t* rowp = base + (size_t)(row0 + ai * HALF + m * 16) * D;
#pragma unroll
                    for (int bj = 0; bj < 2; ++bj) *(u32x4*)(rowp + bj * HALF) = pack8(acc[ai][bj][m][0], acc[ai][bj][m][1]); }
        } else if (seg == 3) {
#pragma unroll
            for (int ai = 0; ai < 2; ++ai)
#pragma unroll
                for (int m = 0; m < 4; ++m) { bf16_t* rowp = Gt + ct + (size_t)(row0 + ai * HALF + m * 16) * D;
#pragma unroll
                    for (int bj = 0; bj < 2; ++bj) { f32x4 v[2];
#pragma unroll
                        for (int n = 0; n < 2; ++n)
#pragma unroll
                            for (int j = 0; j < 4; ++j) { const float x = acc[ai][bj][m][n][j]; v[n][j] = x * sigmoidf_(x); }
                        *(u32x4*)(rowp + bj * HALF) = pack8(v[0], v[1]); } }
        } else {
#pragma unroll
            for (int bj = 0; bj < 2; ++bj) { float lb[8];
#pragma unroll
                for (int j = 0; j < 8; ++j) { const int c = ct + bj * HALF + j; lb[j] = layer == 0 ? 0.f : sigmoidf_(lbraw[D + c] - lbraw[c]); }
#pragma unroll
                for (int ai = 0; ai < 2; ++ai)
#pragma unroll
                    for (int m = 0; m < 4; ++m) { const size_t o = (size_t)(row0 + ai * HALF + m * 16) * D + ct + bj * HALF; f32x4 kv[2], gv[2];
#pragma unroll
                        for (int n = 0; n < 2; ++n)
#pragma unroll
                            for (int j = 0; j < 4; ++j) { const float l = lb[4 * n + j], sg = sigmoidf_(acc[ai][bj][m][n][j]); gv[n][j] = __logf(fmaxf(l + (1.f - l) * sg, 1e-30f)); kv[n][j] = (1.f - l) * (1.f - sg); }
                        *(u32x4*)(Kb + o) = pack8(kv[0], kv[1]); *(f32x4*)(Gl + o) = gv[0]; *(f32x4*)(Gl + o + 4) = gv[1]; } }
        }
    }
};


constexpr int MOE_MAXU = 4, MOE_TAB_INTS = 128 + 256 * MOE_MAXU;
struct MoeSched {
    const LAS int* tab; int NT, G, c, K, gather;
    __device__ __forceinline__ bool next(int i, Unit& u) const {
        const int L = i * G + c, TM = tab[32]; if (L >= TM * NT) return false;
        const int mt = L / NT; int e = 0; while (tab[e + 1] <= mt) ++e;
        u.pm = mt; u.pn = L - mt * NT; u.e = e; u.tm = mt - tab[e]; const int left = tab[64 + e] - 256 * u.tm; u.rows = left < 256 ? left : 256; u.ui = i; return true;
    }
    __device__ __forceinline__ int entry(const Unit& u, int r) const {
        const int a = tab[128 + 256 * u.ui + r]; return a >= 0 ? a : tab[128 + 256 * u.ui];
    }
    __device__ __forceinline__ unsigned a_off(const Unit& u, int half, int R) const {
        if (gather) return (unsigned)((entry(u, half * 128 + R) >> 1) * K) * 2u;
        return (unsigned)((u.pm * 256 + half * 128 + R) * K) * 2u;
    }
    __device__ __forceinline__ void build(LAS int* t, LAS int* scr, const int* hist, const int* inv) const {
        const int tid = opaque_tid(), lane = tid & 63, wv = tid >> 6;
        { const int e = tid & 31, part = tid >> 5; int sum = 0;
#pragma unroll 4
          for (int b = part * 16; b < part * 16 + 16; ++b) sum += hist[b * 32 + e];
          scr[tid] = sum; }
        __syncthreads();
        if (tid < 32) { int sum = 0; for (int part = 0; part < 16; ++part) sum += scr[part * 32 + tid]; t[64 + tid] = sum; }
        __syncthreads();
        if (tid == 0) { int p = 0; for (int e = 0; e < 32; ++e) { t[e] = p; p += (t[64 + e] + 255) >> 8; } t[32] = p; }
        __syncthreads();
        for (int i = 0; i < MOE_MAXU; ++i) { Unit u; if (!next(i, u)) break;
            int hv = 0, incl = 0;
            if (tid < 256) { hv = hist[tid * 32 + u.e]; incl = hv;
#pragma unroll
                for (int o = 1; o < 64; o <<= 1) { const int tv = __shfl_up(incl, o); if (lane >= o) incl += tv; }
                if (lane == 63) scr[wv] = incl; }
            __syncthreads();
            if (tid < 256) { int off = 0; for (int w2 = 0; w2 < wv; ++w2) off += scr[w2]; scr[512 + tid] = off + incl - hv; if (tid == 255) scr[512 + 256] = off + incl; }
            __syncthreads();
            if (tid < 256) { const int pos = 256 * u.tm + tid; int ent = -1;
                if (pos < t[64 + u.e]) { int lo = 0, hi = 256;
                    while (hi - lo > 1) { const int mid = (lo + hi) >> 1; if (scr[512 + mid] <= pos) lo = mid; else hi = mid; }
                    ent = inv[(lo * 32 + u.e) * 32 + (pos - scr[512 + lo])]; }
                t[128 + 256 * i + tid] = ent; }
            __syncthreads();
        }
    }
};
struct EpiMoeH {
    bf16_t* Hs;
    __device__ __forceinline__ void operator()(const f32x4 (&acc)[2][2][4][2], const Unit& u, int wr, int wc, int fr, int fq) const {
        const int col0 = u.pn * 128 + wc * 32 + 8 * fq;
#pragma unroll
        for (int ai = 0; ai < 2; ++ai)
#pragma unroll
            for (int m = 0; m < 4; ++m) { const int rl = ai * HALF + wr * 64 + m * 16 + fr; f32x4 v[2];
#pragma unroll
                for (int n = 0; n < 2; ++n)
#pragma unroll
                    for (int j = 0; j < 4; ++j) { const float g = acc[ai][0][m][n][j]; v[n][j] = g * sigmoidf_(g) * acc[ai][1][m][n][j]; }
                if (rl < u.rows) *(u32x4*)(Hs + (size_t)(u.pm * 256 + rl) * DEXP + col0) = pack8(v[0], v[1]); }
    }
};
struct EpiMoeY {
    bf16_t* Y; const float* tg; MoeSched S;
    __device__ __forceinline__ void operator()(const f32x4 (&acc)[2][2][4][2], const Unit& u, int wr, int wc, int fr, int fq) const {
        const int col0 = u.pn * BM + wc * 32 + 8 * fq;
#pragma unroll
        for (int ai = 0; ai < 2; ++ai)
#pragma unroll
            for (int m = 0; m < 4; ++m) { const int rl = ai * HALF + wr * 64 + m * 16 + fr;
                if (rl < u.rows) { const int a = S.entry(u, rl); const float g = tg[a]; bf16_t* rowp = Y + (size_t)a * D + col0;
#pragma unroll
                    for (int bj = 0; bj < 2; ++bj) *(u32x4*)(rowp + bj * HALF) = pack8(acc[ai][bj][m][0] * g, acc[ai][bj][m][1] * g); } }
    }
};

__device__ __forceinline__ void transpose_item(const float* W, int K, int N, bf16_t* WT, int dst_row0, LAS float* scr, int kb, int nb, int lane) {
    const int k0 = 64 * kb, n0 = 32 * nb;
#pragma unroll 8
    for (int i = 0; i < 32; ++i) { const int kk = 2 * i + (lane >> 5); scr[kk * 33 + (lane & 31)] = W[(size_t)(k0 + kk) * N + n0 + (lane & 31)]; }
    asm volatile("s_waitcnt lgkmcnt(0)" ::: "memory");
    const int c = lane & 7;
#pragma unroll
    for (int j = 0; j < 4; ++j) { const int n = (lane >> 3) + 8 * j; const LAS float* s = scr + (8 * c) * 33 + n;
        u32x4 o; o.x = f2bf(s[0 * 33]) | (f2bf(s[1 * 33]) << 16); o.y = f2bf(s[2 * 33]) | (f2bf(s[3 * 33]) << 16); o.z = f2bf(s[4 * 33]) | (f2bf(s[5 * 33]) << 16); o.w = f2bf(s[6 * 33]) | (f2bf(s[7 * 33]) << 16);
        *(u32x4*)(WT + (size_t)(dst_row0 + n) * K + k0 + 8 * c) = o; }
    asm volatile("s_waitcnt lgkmcnt(0)" ::: "memory");
}
}

typedef short s16x4 __attribute__((ext_vector_type(4)));
typedef LAS s16x4 lds_s16x4;
constexpr int HRS = 272, ARS = 144;
constexpr int H1_QH = 0, H1_KH0 = H1_QH + 64 * HRS, H1_KH1 = H1_KH0 + 16 * HRS, H1_KH2 = H1_KH1 + 32 * HRS, H1_KH3 = H1_KH2 + 48 * HRS, H1_KT = H1_KH3 + 64 * HRS,
              H1_VS = H1_KT + 64 * HRS, H1_AS = H1_VS + 64 * HRS, H1_TOT = H1_AS + 64 * ARS, H1_BYTES = H1_TOT + 2048;
constexpr int NUNIT = BATCH * HG_H * (SEQ / 64);
__device__ __forceinline__ bf16x8 tr_frag16(const LAS unsigned char* tile, int rs, int r0, int c0, int lane) {
    const int g = lane >> 4, i = lane & 15, q = i >> 2, p = i & 3;
    const LAS unsigned char* a = tile + (r0 + 8 * g + q) * rs + (c0 + 4 * p) * 2;
    const s16x4 lo = __builtin_amdgcn_ds_read_tr16_b64_v4i16((lds_s16x4*)a);
    const s16x4 hi = __builtin_amdgcn_ds_read_tr16_b64_v4i16((lds_s16x4*)(a + 4 * rs));
    return (bf16x8){lo[0], lo[1], lo[2], lo[3], hi[0], hi[1], hi[2], hi[3]};
}
__device__ __forceinline__ bf16x8 row_frag16(const LAS unsigned char* tile, int rs, int r0, int c0, int lane) {
    return *(const LAS bf16x8*)(tile + (r0 + (lane & 15)) * rs + (c0 + 8 * (lane >> 4)) * 2);
}
#define MFMA16(a, b, c) __builtin_amdgcn_mfma_f32_16x16x32_bf16((a), (b), (c), 0, 0, 0)
typedef unsigned u32x2 __attribute__((ext_vector_type(2)));
__device__ __forceinline__ u32x2 pack4(const f32x4 v) { u32x2 r; r.x = pg8::cvt_pk_bf16(v[0], v[1]); r.y = pg8::cvt_pk_bf16(v[2], v[3]); return r; }

struct HgArgs { bf16_t *Qb, *Kb, *Vb, *Gt, *OI, *UT, *Sst, *Og; float *Gl, *Dg; const float* ng; bf16_t* Qt; };

__device__ __forceinline__ void h1_phase(LAS unsigned char* lds, const HgArgs& a, int vcu, int G) {
    const int tid = opaque_tid(), lane = tid & 63, wid = __builtin_amdgcn_readfirstlane(tid >> 6);
    const int ch = tid & 127, J = __builtin_amdgcn_readfirstlane(tid >> 7);
    LAS float* tot = (LAS float*)(lds + H1_TOT);
    for (int unit = vcu; unit < NUNIT; unit += G) {
        const int bh = unit >> 5, c = unit & 31, b = bh >> 4, h = bh & 15;
        const size_t gbase = ((size_t)b * SEQ + c * 64) * D + h * 128;
        float L[16]; { float l = 0.f;
#pragma unroll
            for (int i = 0; i < 16; ++i) { l += a.Gl[gbase + (size_t)(16 * J + i) * D + ch]; L[i] = l; } }
        tot[J * 128 + ch] = L[15];
#pragma unroll
        for (int i = 0; i < 2; ++i) { const int id = tid + 512 * i, r = id >> 4, ck = id & 15; *(LAS u32x4*)(lds + H1_VS + r * HRS + ck * 16) = *(const u32x4*)(a.Vb + gbase + (size_t)r * D + ck * 8); }
        for (int id = tid; id < 64 * ARS / 16; id += 512) *(LAS u32x4*)(lds + H1_AS + id * 16) = (u32x4){0u, 0u, 0u, 0u};
        __syncthreads();
        float tj[4]; tj[0] = tot[ch]; tj[1] = tot[128 + ch]; tj[2] = tot[256 + ch]; tj[3] = tot[384 + ch];
        float aJ = 0.f;
#pragma unroll
        for (int M = 0; M < 3; ++M) if (M < J) aJ += tj[M];
        const int khJ = J == 0 ? H1_KH0 : J == 1 ? H1_KH1 : J == 2 ? H1_KH2 : H1_KH3;
#pragma unroll
        for (int i = 0; i < 16; ++i) {
            const int t = 16 * J + i; const size_t go = gbase + (size_t)t * D + ch;
            const float q = bf2f(a.Qb[go]), k = bf2f(a.Kb[go]), Li = L[i], rem = L[15] - Li;
            *(LAS bf16_t*)(lds + H1_QH + t * HRS + ch * 2) = (bf16_t)f2bf(q * __expf(Li));
            a.Qt[go] = (bf16_t)f2bf(q * __expf(Li + aJ));
            *(LAS bf16_t*)(lds + khJ + t * HRS + ch * 2) = (bf16_t)f2bf(k * __expf(fminf(-Li, 60.f)));
#pragma unroll
            for (int I = 1; I <= 4; ++I) {
                if (I > J) { float sx = rem;
#pragma unroll
                    for (int M = 1; M < 4; ++M) if (M > J && M < I) sx += tj[M];
                    constexpr int offs[5] = {H1_KH0, H1_KH1, H1_KH2, H1_KH3, H1_KT};
                    *(LAS bf16_t*)(lds + offs[I] + t * HRS + ch * 2) = (bf16_t)f2bf(k * __expf(sx)); }
            }
        }
        if (J == 0) a.Dg[(size_t)unit * 128 + ch] = __expf((tj[0] + tj[1]) + (tj[2] + tj[3]));
        __syncthreads();
        for (int blk = wid; blk < 10; blk += 8) {
            const int I = blk < 1 ? 0 : blk < 3 ? 1 : blk < 6 ? 2 : 3, Jb = blk - (I * (I + 1)) / 2;
            const int khI = I == 0 ? H1_KH0 : I == 1 ? H1_KH1 : I == 2 ? H1_KH2 : H1_KH3;
            f32x4 acc = {0.f, 0.f, 0.f, 0.f};
#pragma unroll
            for (int ks = 0; ks < 4; ++ks) acc = MFMA16(row_frag16(lds + khI, HRS, 16 * Jb, 32 * ks, lane), row_frag16(lds + H1_QH, HRS, 16 * I, 32 * ks, lane), acc);
            const int tl = 16 * I + (lane & 15), s0 = 16 * Jb + 4 * (lane >> 4);
#pragma unroll
            for (int r = 0; r < 4; ++r) if (s0 + r > tl) acc[r] = 0.f;
            *(LAS u32x2*)(lds + H1_AS + tl * ARS + s0 * 2) = pack4(acc);
        }
        __syncthreads();
        {
            bf16x8 vtr[2];
#pragma unroll
            for (int ks = 0; ks < 2; ++ks) vtr[ks] = tr_frag16(lds + H1_VS, HRS, 32 * ks, 16 * wid, lane);
#pragma unroll
            for (int rb = 0; rb < 4; ++rb) { f32x4 acc = {0.f, 0.f, 0.f, 0.f};
#pragma unroll
                for (int ks = 0; ks < 2; ++ks) if (!(ks == 1 && rb < 2)) acc = MFMA16(vtr[ks], row_frag16(lds + H1_AS, ARS, 16 * rb, 32 * ks, lane), acc);
                *(u32x2*)(a.OI + gbase + (size_t)(16 * rb + (lane & 15)) * D + 16 * wid + 4 * (lane >> 4)) = pack4(acc); }
#pragma unroll
            for (int cb = 0; cb < 8; ++cb) { f32x4 acc = {0.f, 0.f, 0.f, 0.f};
#pragma unroll
                for (int ks = 0; ks < 2; ++ks) acc = MFMA16(tr_frag16(lds + H1_KT, HRS, 32 * ks, 16 * cb, lane), vtr[ks], acc);
                *(u32x2*)(a.UT + ((size_t)unit * 128 + 16 * wid + (lane & 15)) * 128 + 16 * cb + 4 * (lane >> 4)) = pack4(acc); }
        }
        __syncthreads();
    }
}
__device__ __forceinline__ void h2_phase(const HgArgs& a, int vcu, int G) {
    for (int item = vcu * 512 + opaque_tid(); item < BATCH * HG_H * 2048; item += G * 512) {
        const int bh = item >> 11, vec = item & 2047, ch0 = (vec & 15) * 8;
        float st[8];
#pragma unroll
        for (int j = 0; j < 8; ++j) st[j] = 0.f;
        for (int c = 0; c < 32; ++c) { const size_t u = (size_t)bh * 32 + c;
            *(u32x4*)(a.Sst + u * 16384 + vec * 8) = pg8::pack8((f32x4){st[0], st[1], st[2], st[3]}, (f32x4){st[4], st[5], st[6], st[7]});
            if (c < 31) { const uint4 uu = *(const uint4*)(a.UT + u * 16384 + vec * 8); const float4 d0 = *(const float4*)(a.Dg + u * 128 + ch0), d1 = *(const float4*)(a.Dg + u * 128 + ch0 + 4);
                const unsigned w[4] = {uu.x, uu.y, uu.z, uu.w}; const float dd[8] = {d0.x, d0.y, d0.z, d0.w, d1.x, d1.y, d1.z, d1.w};
#pragma unroll
                for (int j = 0; j < 4; ++j) { st[2 * j] = dd[2 * j] * st[2 * j] + bf2f((bf16_t)(w[j] & 0xffff)); st[2 * j + 1] = dd[2 * j + 1] * st[2 * j + 1] + bf2f((bf16_t)(w[j] >> 16)); } }
        }
    }
}
__device__ __forceinline__ void h3_phase(const HgArgs& a, int vcu, int G) {
    const int tid = opaque_tid(), lane = tid & 63, wid = __builtin_amdgcn_readfirstlane(tid >> 6);
    for (int pair = vcu; pair < NUNIT / 2; pair += G) {
        const int unit = pair * 2 + (wid >> 2), rb = wid & 3;
        const int bh = unit >> 5, c = unit & 31, b = bh >> 4, h = bh & 15;
        const size_t ro = ((size_t)b * SEQ + c * 64 + 16 * rb + (lane & 15)) * D + h * 128;
        bf16x8 qf[4];
#pragma unroll
        for (int ks = 0; ks < 4; ++ks) qf[ks] = *(const bf16x8*)(a.Qt + ro + 32 * ks + 8 * (lane >> 4));
        f32x4 o[8]; float ss = 0.f;
#pragma unroll
        for (int cb = 0; cb < 8; ++cb) { f32x4 acc = {0.f, 0.f, 0.f, 0.f};
            const bf16_t* sp = a.Sst + ((size_t)unit * 128 + 16 * cb + (lane & 15)) * 128 + 8 * (lane >> 4);
#pragma unroll
            for (int ks = 0; ks < 4; ++ks) acc = MFMA16(*(const bf16x8*)(sp + 32 * ks), qf[ks], acc);
            const uint2 oi = *(const uint2*)(a.OI + ro + 16 * cb + 4 * (lane >> 4));
            acc[0] += bf2f((bf16_t)(oi.x & 0xffff)); acc[1] += bf2f((bf16_t)(oi.x >> 16)); acc[2] += bf2f((bf16_t)(oi.y & 0xffff)); acc[3] += bf2f((bf16_t)(oi.y >> 16));
            o[cb] = acc; ss += (acc[0] * acc[0] + acc[1] * acc[1]) + (acc[2] * acc[2] + acc[3] * acc[3]); }
        ss += __shfl_xor(ss, 16); ss += __shfl_xor(ss, 32);
        const float r = 1.0f / sqrtf(ss * (1.f / 128.f) + RMS_EPS);
#pragma unroll
        for (int cb = 0; cb < 8; ++cb) { const int vc = 16 * cb + 4 * (lane >> 4); const float4 g = *(const float4*)(a.ng + h * 128 + vc); const uint2 gt = *(const uint2*)(a.Gt + ro + vc);
            f32x4 v; v[0] = o[cb][0] * r * g.x * bf2f((bf16_t)(gt.x & 0xffff)); v[1] = o[cb][1] * r * g.y * bf2f((bf16_t)(gt.x >> 16)); v[2] = o[cb][2] * r * g.z * bf2f((bf16_t)(gt.y & 0xffff)); v[3] = o[cb][3] * r * g.w * bf2f((bf16_t)(gt.y >> 16));
            *(u32x2*)(a.Og + ro + vc) = pack4(v); }
    }
}

#define XB_TMO      128
#define XB_XCNT(j)  (256  + 64 * (j))
#define XB_XSUB(j)  (1280 + 64 * (j))
#define XB_XGEN(j)  (2304 + 64 * (j))
#define XB_TOP      3328
#define XB_TOPGEN   3392
#define XCD_BAR_WORDS 3456
#define XB_SPIN_CAP (1u << 18)
__device__ __forceinline__ unsigned xb_ld(unsigned* p)              { return __hip_atomic_load(p, __ATOMIC_RELAXED, __HIP_MEMORY_SCOPE_AGENT); }
__device__ __forceinline__ unsigned xb_add(unsigned* p, unsigned v) { return __hip_atomic_fetch_add(p, v, __ATOMIC_RELAXED, __HIP_MEMORY_SCOPE_AGENT); }
__device__ __forceinline__ unsigned xb_xcc_id() { return (unsigned)__builtin_amdgcn_s_getreg((3 << 11) | 20) & 0xFu; }
#define XB_SPIN(cond, bar) do { unsigned _sp = 0; while (cond) { __builtin_amdgcn_s_sleep(1); \
    if ((++_sp & 255u) == 0u) { if (xb_ld(&(bar)[XB_TMO])) break; if (_sp > XB_SPIN_CAP) { atomicAdd(&(bar)[XB_TMO], 1u); break; } } } } while (0)
struct XcdBarrier { unsigned* bar; unsigned x; volatile LAS unsigned* st; };
__device__ __forceinline__ XcdBarrier xcd_barrier_post(unsigned* bar, volatile LAS unsigned* st) {
    XcdBarrier b; b.bar = bar; b.x = xb_xcc_id(); b.st = st;
    if (threadIdx.x == 0) (void)xb_add(&bar[XB_XCNT(b.x)], 1u);
    return b;
}
__device__ __forceinline__ void xcd_barrier_complete(unsigned* bar, unsigned x, unsigned& nloc, unsigned& nx) {
    const unsigned G = gridDim.x * gridDim.y * gridDim.z;
    unsigned sum, cnt, mine, sp = 0u;
    for (;;) {
        sum = 0u; cnt = 0u; mine = 0u;
#pragma unroll
        for (unsigned j = 0; j < 16; ++j) { const unsigned c = xb_ld(&bar[XB_XCNT(j)]); sum += c; cnt += (c > 0u) ? 1u : 0u; mine = (j == x) ? c : mine; }
        if (sum == G) break;
        __builtin_amdgcn_s_sleep(1);
        if ((++sp & 255u) == 0u) { if (xb_ld(&bar[XB_TMO])) break; if (sp > XB_SPIN_CAP) { atomicAdd(&bar[XB_TMO], 1u); break; } }
    }
    nloc = mine > 0u ? mine : 1u; nx = cnt > 0u ? cnt : 1u;
}
__device__ __forceinline__ void xcd_barrier(const XcdBarrier& b) {
    asm volatile("s_waitcnt vmcnt(0)" ::: "memory");
    __syncthreads();
    if (threadIdx.x == 0) {
        unsigned* bar = b.bar;
        __builtin_amdgcn_s_waitcnt(0);
        unsigned nloc = b.st[0], nx = b.st[1];
        if (nloc == 0u) { xcd_barrier_complete(bar, b.x, nloc, nx); b.st[0] = nloc; b.st[1] = nx; }
        const unsigned old = xb_add(&bar[XB_XSUB(b.x)], 1u);
        const unsigned gen = old / nloc;
        if (old + 1u == (gen + 1u) * nloc) {
            __builtin_amdgcn_fence(__ATOMIC_RELEASE, "agent");
            asm volatile("s_waitcnt vmcnt(0)" ::: "memory");
            const unsigned og = xb_add(&bar[XB_TOP], 1u);
            const unsigned tg = og / nx;
            if (og + 1u == (tg + 1u) * nx) xb_add(&bar[XB_TOPGEN], 1u);
            else XB_SPIN(xb_ld(&bar[XB_TOPGEN]) == tg, bar);
            __builtin_amdgcn_fence(__ATOMIC_ACQUIRE, "agent");
            xb_add(&bar[XB_XGEN(b.x)], 1u);
            asm volatile("s_waitcnt vmcnt(0)" ::: "memory");
        } else {
            XB_SPIN(xb_ld(&bar[XB_XGEN(b.x)]) == gen, bar);
            __builtin_amdgcn_fence(__ATOMIC_ACQUIRE, "agent");
            asm volatile("s_waitcnt vmcnt(0)" ::: "memory");
        }
    }
    __syncthreads();
}

struct Ptrs {
    const float *x, *a_w_in, *a_lb, *a_ng, *a_w_out, *b_w_kv, *b_w_q, *b_sinks, *b_w_out, *rel_bias, *w_rg, *b_rg, *w_re, *b_re, *w_gate, *w_up, *w_down, *ln_g, *ln_b;
    float* out; unsigned char* ws;
};
__device__ __forceinline__ void prologue_phase(LAS unsigned char* lds, const Ptrs& p, int vcu, int G) {
    const int tid = opaque_tid(), lane = tid & 63, wave = __builtin_amdgcn_readfirstlane(tid >> 6);
    LAS float* scr = (LAS float*)(lds + wave * 8448);
    const int gw = vcu * 8 + wave, NGW = G * 8;
    bf16_t* Win_t = (bf16_t*)(p.ws + WS_WIN); bf16_t* Wout_t = (bf16_t*)(p.ws + WS_WOUT); bf16_t* Wkv_t = (bf16_t*)(p.ws + WS_WKV); bf16_t* Wq_t = (bf16_t*)(p.ws + WS_WQ); bf16_t* Wo_t = (bf16_t*)(p.ws + WS_WO);
    bf16_t* Wgu_t = (bf16_t*)(p.ws + WS_WGU); bf16_t* Wd_t = (bf16_t*)(p.ws + WS_WD);
    constexpr int I_IN = 2 * 32 * 256, I_AO = 2 * 32 * 64, I_KV = 32 * 16, I_Q = 2 * 32 * 64, I_O = 2 * 32 * 64, I_G = 128 * 32 * 16, I_U = I_G, I_D = 128 * 8 * 64;
    constexpr int NITEMS = I_IN + I_AO + I_KV + I_Q + I_O + I_G + I_U + I_D;
    for (int it = gw; it < NITEMS; it += NGW) {
        int r = it;
        if (r < I_IN) { const int mat = r / (32 * 256), q = r % (32 * 256), kb = q / 256, nb = q % 256; pg8::transpose_item(p.a_w_in + (size_t)mat * D * 4 * D, D, 4 * D, Win_t + (size_t)mat * 4 * D * D, 32 * nb, scr, kb, nb, lane); continue; } r -= I_IN;
        if (r < I_AO) { const int mat = r / (32 * 64), q = r % (32 * 64), kb = q / 64, nb = q % 64; pg8::transpose_item(p.a_w_out + (size_t)mat * D * D, D, D, Wout_t + (size_t)mat * D * D, 32 * nb, scr, kb, nb, lane); continue; } r -= I_AO;
        if (r < I_KV) { const int kb = r / 16, nb = r % 16; pg8::transpose_item(p.b_w_kv, D, 2 * KVW, Wkv_t, 32 * nb, scr, kb, nb, lane); continue; } r -= I_KV;
        if (r < I_Q) { const int mat = r / (32 * 64), q = r % (32 * 64), kb = q / 64, nb = q % 64; pg8::transpose_item(p.b_w_q + (size_t)mat * D * D, D, D, Wq_t + (size_t)mat * D * D, 32 * nb, scr, kb, nb, lane); continue; } r -= I_Q;
        if (r < I_O) { const int mat = r / (32 * 64), q = r % (32 * 64), kb = q / 64, nb = q % 64; pg8::transpose_item(p.b_w_out + (size_t)mat * D * D, D, D, Wo_t + (size_t)mat * D * D, 32 * nb, scr, kb, nb, lane); continue; } r -= I_O;
        if (r < I_G + I_U) { const int up = r >= I_G; if (up) r -= I_G; const int mat = r / (32 * 16), q = r % (32 * 16), kb = q / 16, nb = q % 16;
            const int n0 = 32 * nb, drow = (n0 >> 7) * 256 + (n0 & 127) + (up ? 128 : 0);
            pg8::transpose_item((up ? p.w_up : p.w_gate) + (size_t)mat * D * DEXP, D, DEXP, Wgu_t + (size_t)mat * 2 * DEXP * D, drow, scr, kb, nb, lane); continue; } r -= I_G + I_U;
        { const int mat = r / (8 * 64), q = r % (8 * 64), kb = q / 64, nb = q % 64; pg8::transpose_item(p.w_down + (size_t)mat * DEXP * D, DEXP, D, Wd_t + (size_t)mat * D * DEXP, 32 * nb, scr, kb, nb, lane); }
    }
    { float* WRt = (float*)(p.ws + WS_WR);
      for (int i = vcu * 512 + tid; i < DEPTH * 36 * D; i += G * 512) { const int L = i / (36 * D), o = (i / D) % 36, d = i % D;
          WRt[i] = o < 4 ? p.w_rg[((size_t)L * D + d) * NGRP + o] : p.w_re[((size_t)L * D + d) * NEXP + (o - 4)]; } }
    bf16_t* xb = (bf16_t*)(p.ws + WS_XB);
    for (size_t i = (size_t)vcu * 512 + tid; i < (size_t)T * D / 4; i += (size_t)G * 512) { const float4 v = ((const float4*)p.x)[i];
        u32x2 o; o.x = pg8::cvt_pk_bf16(v.x, v.y); o.y = pg8::cvt_pk_bf16(v.z, v.w); ((u32x2*)xb)[i] = o; }
}

template <int MODE>
__device__ __forceinline__ void ln_phase(const float* xin, const bf16_t* hm, const bf16_t* Y, const float* lng, const float* lnb, float* xf, bf16_t* xb,
                                         const float* wrg, const float* brg, const float* wre, const float* bre, int* cnt, int* list, float* tg, int vcu, int G) {
    const int tid = opaque_tid();
    for (int row = vcu * 8 + (tid >> 6); row < T; row += G * 8) {
        const int lane = opaque_tid() & 63;
        float v[32];
        float s = 0.f;
#pragma unroll
        for (int j = 0; j < 8; ++j) { const int c = 4 * lane + 256 * j; const float4 a = *(const float4*)(xin + (size_t)row * D + c);
            float4 h;
            if (MODE == 0) { const uint2 y0 = *(const uint2*)(hm + (size_t)row * D + c); h.x = bf2f((bf16_t)(y0.x & 0xffff)); h.y = bf2f((bf16_t)(y0.x >> 16)); h.z = bf2f((bf16_t)(y0.y & 0xffff)); h.w = bf2f((bf16_t)(y0.y >> 16)); }
            else { const uint2 y0 = *(const uint2*)(Y + (size_t)(row * 2) * D + c), y1 = *(const uint2*)(Y + (size_t)(row * 2 + 1) * D + c);
                h.x = bf2f((bf16_t)(y0.x & 0xffff)) + bf2f((bf16_t)(y1.x & 0xffff)); h.y = bf2f((bf16_t)(y0.x >> 16)) + bf2f((bf16_t)(y1.x >> 16));
                h.z = bf2f((bf16_t)(y0.y & 0xffff)) + bf2f((bf16_t)(y1.y & 0xffff)); h.w = bf2f((bf16_t)(y0.y >> 16)) + bf2f((bf16_t)(y1.y >> 16)); }
            v[4 * j + 0] = ALPHA * a.x + h.x; v[4 * j + 1] = ALPHA * a.y + h.y; v[4 * j + 2] = ALPHA * a.z + h.z; v[4 * j + 3] = ALPHA * a.w + h.w;
            s += (v[4 * j] + v[4 * j + 1]) + (v[4 * j + 2] + v[4 * j + 3]); }
        const float mean = wave_sum(s) * (1.f / D);
        float q = 0.f;
#pragma unroll
        for (int j = 0; j < 32; ++j) { v[j] -= mean; q += v[j] * v[j]; }
        const float rstd = 1.0f / sqrtf(wave_sum(q) * (1.f / D) + LN_EPS);
#pragma unroll
        for (int j = 0; j < 8; ++j) { const int c = 4 * lane + 256 * j; const float4 g = *(const float4*)(lng + c), b = *(const float4*)(lnb + c);
            v[4 * j + 0] = v[4 * j + 0] * rstd * g.x + b.x; v[4 * j + 1] = v[4 * j + 1] * rstd * g.y + b.y; v[4 * j + 2] = v[4 * j + 2] * rstd * g.z + b.z; v[4 * j + 3] = v[4 * j + 3] * rstd * g.w + b.w;
            *(float4*)(xf + (size_t)row * D + c) = make_float4(v[4 * j], v[4 * j + 1], v[4 * j + 2], v[4 * j + 3]);
            if (xb) { u32x2 o; o.x = pg8::cvt_pk_bf16(v[4 * j], v[4 * j + 1]); o.y = pg8::cvt_pk_bf16(v[4 * j + 2], v[4 * j + 3]); *(u32x2*)(xb + (size_t)row * D + c) = o; } }
        if (MODE == 0) {
            float gl[4] = {0.f, 0.f, 0.f, 0.f};
#pragma unroll
            for (int j = 0; j < 8; ++j)
#pragma unroll
                for (int i = 0; i < 4; ++i) { const int c = 4 * lane + 256 * j + i; const float4 w = *(const float4*)(wrg + (size_t)c * NGRP); const float x = v[4 * j + i];
                    gl[0] += x * w.x; gl[1] += x * w.y; gl[2] += x * w.z; gl[3] += x * w.w; }
#pragma unroll
            for (int g = 0; g < 4; ++g) gl[g] = wave_sum(gl[g]) + brg[g];
            int grp = 0; float gmax = gl[0];
#pragma unroll
            for (int g = 1; g < 4; ++g) if (gl[g] > gmax) { gmax = gl[g]; grp = g; }
            float gden = 0.f;
#pragma unroll
            for (int g = 0; g < 4; ++g) gden += __expf(gl[g] - gmax);
            const float pgrp = 1.0f / gden;
            float el[8] = {0.f, 0.f, 0.f, 0.f, 0.f, 0.f, 0.f, 0.f};
#pragma unroll
            for (int j = 0; j < 8; ++j)
#pragma unroll
                for (int i = 0; i < 4; ++i) { const int c = 4 * lane + 256 * j + i; const float4 w0 = *(const float4*)(wre + (size_t)c * NEXP + grp * 8), w1 = *(const float4*)(wre + (size_t)c * NEXP + grp * 8 + 4); const float x = v[4 * j + i];
                    el[0] += x * w0.x; el[1] += x * w0.y; el[2] += x * w0.z; el[3] += x * w0.w; el[4] += x * w1.x; el[5] += x * w1.y; el[6] += x * w1.z; el[7] += x * w1.w; }
#pragma unroll
            for (int e = 0; e < 8; ++e) el[e] = wave_sum(el[e]) + bre[grp * 8 + e];
            int i0 = 0; float v0 = el[0];
#pragma unroll
            for (int e = 1; e < 8; ++e) if (el[e] > v0) { v0 = el[e]; i0 = e; }
            int i1 = -1; float v1 = -3.0e38f;
#pragma unroll
            for (int e = 0; e < 8; ++e) if (e != i0 && el[e] > v1) { v1 = el[e]; i1 = e; }
            const float e1 = __expf(v1 - v0), den = 1.f + e1;
            const float g0 = pgrp / den, g1 = pgrp * e1 / den;
            if (lane == 0) {
                const int ea = grp * 8 + i0, eb = grp * 8 + i1;
                const int pa = atomicAdd(&cnt[ea], 1); list[ea * T + pa] = row * 2; tg[row * 2] = g0;
                const int pb = atomicAdd(&cnt[eb], 1); list[eb * T + pb] = row * 2 + 1; tg[row * 2 + 1] = g1;
            }
        }
    }
}


typedef float f32x2v __attribute__((ext_vector_type(2)));
__device__ __forceinline__ float wave_sum4(float& a, float& b, float& c, float& d) {
#pragma unroll
    for (int o = 1; o < 64; o <<= 1) { const float ta = __shfl_xor(a, o), tb = __shfl_xor(b, o), tc = __shfl_xor(c, o), td = __shfl_xor(d, o); a += ta; b += tb; c += tc; d += td; }
    return a;
}
__device__ __forceinline__ void ln_router_phase(const float* xin, const bf16_t* hm, const float* lng, const float* lnb, float* xf, bf16_t* xb,
                                                const float* WRt, const float* brg, const float* bre, LAS int* lhist, int* hist, int* inv, float* tg, int vcu, int G) {
    const int tid = opaque_tid(), lane = tid & 63;
    if (tid < 32) lhist[tid] = 0;
    __syncthreads();
    for (int grp4 = vcu * 8 + (tid >> 6); grp4 < T / 4; grp4 += G * 8) {
        const int row0 = grp4 * 4;
        f32x4 v[4][8];
#pragma unroll
        for (int r = 0; r < 4; ++r) {
            float s = 0.f;
#pragma unroll
            for (int j = 0; j < 8; ++j) { const int c = 4 * lane + 256 * j; const f32x4 a = *(const f32x4*)(xin + (size_t)(row0 + r) * D + c); const u32x2 y0 = *(const u32x2*)(hm + (size_t)(row0 + r) * D + c);
                f32x4 hh; hh[0] = bf2f((bf16_t)(y0.x & 0xffff)); hh[1] = bf2f((bf16_t)(y0.x >> 16)); hh[2] = bf2f((bf16_t)(y0.y & 0xffff)); hh[3] = bf2f((bf16_t)(y0.y >> 16));
                v[r][j] = a * ALPHA + hh; s += (v[r][j][0] + v[r][j][1]) + (v[r][j][2] + v[r][j][3]); }
            const float mean = wave_sum(s) * (1.f / D);
            float q = 0.f;
#pragma unroll
            for (int j = 0; j < 8; ++j) { v[r][j] = v[r][j] - mean; q += (v[r][j][0] * v[r][j][0] + v[r][j][1] * v[r][j][1]) + (v[r][j][2] * v[r][j][2] + v[r][j][3] * v[r][j][3]); }
            const float rstd = 1.0f / sqrtf(wave_sum(q) * (1.f / D) + LN_EPS);
#pragma unroll
            for (int j = 0; j < 8; ++j) { const int c = 4 * lane + 256 * j; const f32x4 g = *(const f32x4*)(lng + c), bb = *(const f32x4*)(lnb + c);
                v[r][j] = v[r][j] * rstd * g + bb;
                *(f32x4*)(xf + (size_t)(row0 + r) * D + c) = v[r][j];
                u32x2 o; o.x = pg8::cvt_pk_bf16(v[r][j][0], v[r][j][1]); o.y = pg8::cvt_pk_bf16(v[r][j][2], v[r][j][3]); *(u32x2*)(xb + (size_t)(row0 + r) * D + c) = o; }
        }
        float gm[4], gs[4], v0[4], v1[4]; int grp[4], i0[4], i1[4];
#pragma unroll
        for (int r = 0; r < 4; ++r) { gm[r] = -3.0e38f; gs[r] = 0.f; grp[r] = 0; v0[r] = -3.0e38f; v1[r] = -3.0e38f; i0[r] = 0; i1[r] = 0; }
#pragma unroll 1
        for (int o = 0; o < 36; ++o) {
            const int gi = (o - 4) >> 3, e = (o - 4) & 7;
            if (o >= 4 && gi != grp[0] && gi != grp[1] && gi != grp[2] && gi != grp[3]) continue;
            f32x4 w[8]; const float* wp = WRt + (size_t)o * D + 4 * lane;
#pragma unroll
            for (int j = 0; j < 8; ++j) w[j] = *(const f32x4*)(wp + 256 * j);
            float p[4];
#pragma unroll
            for (int r = 0; r < 4; ++r) { f32x4 acc = v[r][0] * w[0];
#pragma unroll
                for (int j = 1; j < 8; ++j) acc += v[r][j] * w[j];
                p[r] = (acc[0] + acc[1]) + (acc[2] + acc[3]); }
            wave_sum4(p[0], p[1], p[2], p[3]);
            if (o < 4) { const float bo = brg[o];
#pragma unroll
                for (int r = 0; r < 4; ++r) { const float val = p[r] + bo;
                    if (val > gm[r]) { gs[r] = gs[r] * __expf(gm[r] - val) + 1.f; gm[r] = val; grp[r] = o; } else gs[r] += __expf(val - gm[r]); }
            } else { const float be = bre[o - 4];
#pragma unroll
                for (int r = 0; r < 4; ++r) if (grp[r] == gi) { const float val = p[r] + be;
                    if (val > v0[r]) { v1[r] = v0[r]; i1[r] = i0[r]; v0[r] = val; i0[r] = e; } else if (val > v1[r]) { v1[r] = val; i1[r] = e; } }
            }
        }
#pragma unroll
        for (int r = 0; r < 4; ++r) {
            const float e1 = __expf(v1[r] - v0[r]), den = 1.f + e1, pg = 1.0f / gs[r];
            const float g0 = pg / den, g1 = pg * e1 / den;
            if (lane == 0) { const int row = row0 + r, ea = grp[r] * 8 + i0[r], eb = grp[r] * 8 + i1[r];
                const int pa = __hip_atomic_fetch_add(lhist + ea, 1, __ATOMIC_RELAXED, __HIP_MEMORY_SCOPE_WORKGROUP); inv[(vcu * 32 + ea) * 32 + pa] = row * 2; tg[row * 2] = g0;
                const int pb = __hip_atomic_fetch_add(lhist + eb, 1, __ATOMIC_RELAXED, __HIP_MEMORY_SCOPE_WORKGROUP); inv[(vcu * 32 + eb) * 32 + pb] = row * 2 + 1; tg[row * 2 + 1] = g1; }
        }
    }
    __syncthreads();
    if (tid < 32) hist[vcu * 32 + tid] = lhist[tid];
}

typedef float f32x16 __attribute__((ext_vector_type(16)));
#define MFMA32(a, b, c) __builtin_amdgcn_mfma_f32_32x32x16_bf16((a), (b), (c), 0, 0, 0)
constexpr int KRS = 144, AT_K = 0, AT_V = 256 * KRS, AT_BIAS = 2 * 256 * KRS, AT_BYTES = AT_BIAS + 8 * 128 * 4;
__device__ __forceinline__ int t5_bucket(int n) { if (n < 16) return n; int l = 16 + (int)(__logf((float)n * (1.f / 16.f)) / 2.0794415416798357f * 16.f); return l < 31 ? l : 31; }
__device__ __forceinline__ void attn_phase(LAS unsigned char* lds, const bf16_t* Qb, const bf16_t* Kc, const bf16_t* Vc, const float* sinks, const float* relb, bf16_t* Og, int vcu, int G) {
    const int tid = opaque_tid(), lane = tid & 63, wid = __builtin_amdgcn_readfirstlane(tid >> 6), r = lane & 31, h = lane >> 5;
    LAS float* biasT = (LAS float*)(lds + AT_BIAS);
    for (int unit = vcu; unit < BATCH * AT_HKV * (SEQ / 128); unit += G) {
        const int b = unit >> 6, kvh = (unit >> 4) & 3, qblk = unit & 15, hq = kvh * 8 + wid;
        const int row0 = b * SEQ + qblk * 128;
#pragma unroll
        for (int it = 0; it < 4; ++it) { const int id = tid + 512 * it, i = id >> 3, ck = id & 7;
            u32x4 kv = {0u, 0u, 0u, 0u}, vv = {0u, 0u, 0u, 0u};
            if (qblk > 0 || i >= 128) { const size_t go = (size_t)(row0 - 128 + i) * KVW + kvh * 64 + ck * 8; kv = *(const u32x4*)(Kc + go); vv = *(const u32x4*)(Vc + go); }
            *(LAS u32x4*)(lds + AT_K + i * KRS + ck * 16) = kv; *(LAS u32x4*)(lds + AT_V + i * KRS + ck * 16) = vv; }
        for (int id = tid; id < 1024; id += 512) biasT[id] = relb[t5_bucket(id & 127) * AT_HQ + kvh * 8 + (id >> 7)];
        __syncthreads();
        const float sink = sinks[hq];
        for (int qs = 0; qs < 4; ++qs) {
            bf16x8 qf[4]; { const bf16_t* qp = Qb + (size_t)(row0 + 32 * qs + r) * D + hq * 64 + 8 * h;
#pragma unroll
                for (int ks = 0; ks < 4; ++ks) qf[ks] = *(const bf16x8*)(qp + 16 * ks); }
            f32x16 S[5];
#pragma unroll
            for (int kbi = 0; kbi < 5; ++kbi) {
#pragma unroll
                for (int e = 0; e < 16; ++e) S[kbi][e] = 0.f;
#pragma unroll
                for (int ks = 0; ks < 4; ++ks) S[kbi] = MFMA32(*(const LAS bf16x8*)(lds + AT_K + (32 * (qs + kbi) + r) * KRS + (16 * ks + 8 * h) * 2), qf[ks], S[kbi]); }
            float m = -1e30f;
#pragma unroll
            for (int kbi = 0; kbi < 5; ++kbi)
#pragma unroll
                for (int e = 0; e < 16; ++e) { const int keyb = 32 * (qs + kbi) + (e & 3) + 8 * (e >> 2) + 4 * h, dist = 128 + 32 * qs + r - keyb;
                    const bool valid = dist >= 0 && dist < 128 && (qblk > 0 || keyb >= 128);
                    const float sv = valid ? S[kbi][e] * 0.125f + biasT[wid * 128 + (dist & 127)] : -1e30f;
                    S[kbi][e] = sv; m = fmaxf(m, sv); }
            m = fmaxf(m, __shfl_xor(m, 32)); m = fmaxf(m, sink);
            float l = 0.f;
#pragma unroll
            for (int kbi = 0; kbi < 5; ++kbi)
#pragma unroll
                for (int e = 0; e < 16; ++e) { const float pv = __expf(S[kbi][e] - m); S[kbi][e] = pv; l += pv; }
            l += __shfl_xor(l, 32); l += __expf(sink - m);
            f32x16 O[2];
#pragma unroll
            for (int e = 0; e < 16; ++e) { O[0][e] = 0.f; O[1][e] = 0.f; }
            const int i16 = lane & 15, qq = i16 >> 2, pp = i16 & 3, gg = (lane >> 4) & 1;
#pragma unroll
            for (int kbi = 0; kbi < 5; ++kbi)
#pragma unroll
                for (int s2 = 0; s2 < 2; ++s2) {
                    u32x4 pk; pk.x = pg8::cvt_pk_bf16(S[kbi][8 * s2 + 0], S[kbi][8 * s2 + 1]); pk.y = pg8::cvt_pk_bf16(S[kbi][8 * s2 + 2], S[kbi][8 * s2 + 3]);
                    pk.z = pg8::cvt_pk_bf16(S[kbi][8 * s2 + 4], S[kbi][8 * s2 + 5]); pk.w = pg8::cvt_pk_bf16(S[kbi][8 * s2 + 6], S[kbi][8 * s2 + 7]);
                    const bf16x8 pf = __builtin_bit_cast(bf16x8, pk);
#pragma unroll
                    for (int db = 0; db < 2; ++db) { const LAS unsigned char* va = lds + AT_V + (32 * (qs + kbi) + 16 * s2 + 4 * h + qq) * KRS + (32 * db + 16 * gg + 4 * pp) * 2;
                        const s16x4 lo = __builtin_amdgcn_ds_read_tr16_b64_v4i16((lds_s16x4*)va), hi = __builtin_amdgcn_ds_read_tr16_b64_v4i16((lds_s16x4*)(va + 8 * KRS));
                        const bf16x8 vf = {lo[0], lo[1], lo[2], lo[3], hi[0], hi[1], hi[2], hi[3]};
                        O[db] = MFMA32(vf, pf, O[db]); } }
            const float inv = 1.0f / l;
            bf16_t* op = Og + (size_t)(row0 + 32 * qs + r) * D + hq * 64 + 4 * h;
#pragma unroll
            for (int db = 0; db < 2; ++db)
#pragma unroll
                for (int g4 = 0; g4 < 4; ++g4) { f32x4 v; v[0] = O[db][4 * g4] * inv; v[1] = O[db][4 * g4 + 1] * inv; v[2] = O[db][4 * g4 + 2] * inv; v[3] = O[db][4 * g4 + 3] * inv;
                    *(u32x2*)(op + 32 * db + 8 * g4) = pack4(v); }
        }
        __syncthreads();
    }
}

constexpr int LDS_STAGE = 0;
constexpr int LDS_MOETAB = pg8::STAGE_BYTES;
constexpr int LDS_MISC = LDS_MOETAB + pg8::MOE_TAB_INTS * 4;
constexpr int LDS_BYTES = 147456;
static_assert(LDS_MISC + 256 <= LDS_BYTES && H1_BYTES <= pg8::STAGE_BYTES && 8 * 8448 <= pg8::STAGE_BYTES && AT_BYTES <= pg8::STAGE_BYTES, "LDS map");
constexpr int CW_BAR = 4096;
constexpr int N_PHASES = 1 + NA * 9 + (DEPTH - NA) * 7;

struct MegaArgs { const float* in[19]; float* out; unsigned char* ws; int ph_lo, ph_hi; };

__global__ void __launch_bounds__(512, 2) mega_fwd(MegaArgs args) {
    extern __shared__ __attribute__((aligned(16))) unsigned char lds_raw[];
    LAS unsigned char* lds = (LAS unsigned char*)lds_raw;
    volatile LAS unsigned* MISC = (volatile LAS unsigned*)(lds + LDS_MISC);
    const int tid = threadIdx.x, G = gridDim.x, bx = blockIdx.x, vcu = (G % 8 == 0) ? (bx % 8) * (G / 8) + bx / 8 : bx;
    unsigned char* const ws = args.ws;
    if (tid < 64) MISC[tid] = 0u;
    __syncthreads();
    const int lo = args.ph_lo, hi = args.ph_hi;
    XcdBarrier bar; bar.bar = (unsigned*)(ws + WS_CTL) + CW_BAR; bar.x = 0; bar.st = nullptr;
    if (hi - lo > 1) bar = xcd_barrier_post((unsigned*)(ws + WS_CTL) + CW_BAR, MISC + 8);
#define WSP(type, off) ((type*)(args.ws + (off)))
    int ph = 0;
#ifndef PROBE_DUP
#define PROBE_DUP 0
#endif
#define PHASE_T(dupbit, trash_body, ...) if (lo <= ph && ph < hi) { if ((PROBE_DUP >> (dupbit)) & 1) { trash_body; xcd_barrier(bar); } __VA_ARGS__; if (ph + 1 < hi) xcd_barrier(bar); } ++ph;
#define PHASE(dupbit, ...) if (lo <= ph && ph < hi) { __VA_ARGS__; if ((PROBE_DUP >> (dupbit)) & 1) { xcd_barrier(bar); __VA_ARGS__; } if (ph + 1 < hi) xcd_barrier(bar); } ++ph;

    PHASE(0, { Ptrs p; p.x = args.in[0]; p.a_w_in = args.in[1]; p.a_w_out = args.in[4]; p.b_w_kv = args.in[5]; p.b_w_q = args.in[6]; p.b_w_out = args.in[8]; p.w_gate = args.in[14]; p.w_up = args.in[15]; p.w_down = args.in[16]; p.w_rg = args.in[10]; p.w_re = args.in[12]; p.ws = args.ws;
               prologue_phase(lds, p, vcu, G); })

    for (int L = 0; L < DEPTH; ++L) {
        if (L < NA) {
            PHASE(1, { pg8::DenseSched S; S.init(T, 4 * D, D, G, bx); pg8::EpiHgrn E{WSP(bf16_t, WS_QB), WSP(bf16_t, WS_KB), WSP(bf16_t, WS_VB), WSP(bf16_t, WS_GT), WSP(float, WS_GL), args.in[2], L, 0};
                       pg8::gemm_phase<pg8::EpiHgrn, pg8::DenseSched>(lds, WSP(bf16_t, WS_XB), WSP(bf16_t, WS_WIN) + (size_t)L * 4 * D * D, D, 0, S, E); })
#define HGARGS HgArgs{WSP(bf16_t, WS_QB), WSP(bf16_t, WS_KB), WSP(bf16_t, WS_VB), WSP(bf16_t, WS_GT), WSP(bf16_t, WS_OF), WSP(bf16_t, WS_UT), WSP(bf16_t, WS_SST), WSP(bf16_t, WS_OG), WSP(float, WS_GL), WSP(float, WS_DG), args.in[3] + (size_t)L * D, WSP(bf16_t, WS_QB)}
            PHASE_T(6, { HgArgs ha = HGARGS; ha.Qt = WSP(bf16_t, WS_TRASH); ha.OI = WSP(bf16_t, WS_TRASH + 32 * MiB); ha.UT = WSP(bf16_t, WS_TRASH + 64 * MiB); ha.Dg = WSP(float, WS_TRASH + 128 * MiB); h1_phase(lds, ha, vcu, G); },
                    { const HgArgs ha = HGARGS; h1_phase(lds, ha, vcu, G); })
            PHASE(3, { const HgArgs ha = HGARGS; h2_phase(ha, vcu, G); })
            PHASE(3, { const HgArgs ha = HGARGS; h3_phase(ha, vcu, G); })
            PHASE(1, { pg8::DenseSched S; S.init(T, D, D, G, bx); pg8::EpiStore E{WSP(bf16_t, WS_HM), WSP(bf16_t, WS_HM), D, 1 << 30, 1.0f, 0};
                       pg8::gemm_phase<pg8::EpiStore, pg8::DenseSched>(lds, WSP(bf16_t, WS_OG), WSP(bf16_t, WS_WOUT) + (size_t)L * D * D, D, 0, S, E); })
        } else {
            const int j = L - NA;
            PHASE(1, { if (j == 0) { pg8::DenseSched S; S.init(T, 2 * KVW, D, G, bx); pg8::EpiStore E{WSP(bf16_t, WS_KC), WSP(bf16_t, WS_VC), KVW, 1, 1.0f, 0};
                                     pg8::gemm_phase<pg8::EpiStore, pg8::DenseSched>(lds, WSP(bf16_t, WS_XB), WSP(bf16_t, WS_WKV), D, 0, S, E); }
                       pg8::DenseSched S; S.init(T, D, D, G, bx); pg8::EpiStore E{WSP(bf16_t, WS_QB), WSP(bf16_t, WS_QB), D, 1 << 30, 1.0f, 0};
                       pg8::gemm_phase<pg8::EpiStore, pg8::DenseSched>(lds, WSP(bf16_t, WS_XB), WSP(bf16_t, WS_WQ) + (size_t)j * D * D, D, 0, S, E); })
            PHASE(3, attn_phase(lds, WSP(bf16_t, WS_QB), WSP(bf16_t, WS_KC), WSP(bf16_t, WS_VC), args.in[7] + j * AT_HQ, args.in[9], WSP(bf16_t, WS_OG), vcu, G))
            PHASE(1, { pg8::DenseSched S; S.init(T, D, D, G, bx); pg8::EpiStore E{WSP(bf16_t, WS_HM), WSP(bf16_t, WS_HM), D, 1 << 30, 1.0f, 0};
                       pg8::gemm_phase<pg8::EpiStore, pg8::DenseSched>(lds, WSP(bf16_t, WS_OG), WSP(bf16_t, WS_WO) + (size_t)j * D * D, D, 0, S, E); })
        }
        PHASE_T(4, ln_router_phase(L == 0 ? args.in[0] : WSP(float, WS_XF), WSP(bf16_t, WS_HM), args.in[17] + (size_t)(2 * L) * D, args.in[18] + (size_t)(2 * L) * D, WSP(float, WS_TRASH), WSP(bf16_t, WS_TRASH + 64 * MiB), WSP(float, WS_WR) + (size_t)L * 36 * D, args.in[11] + L * NGRP, args.in[13] + L * NEXP, (LAS int*)lds, WSP(int, WS_TRASH + 100 * MiB), WSP(int, WS_TRASH + 96 * MiB), WSP(float, WS_TRASH + 98 * MiB), vcu, G),
                ln_router_phase(L == 0 ? args.in[0] : WSP(float, WS_XF), WSP(bf16_t, WS_HM), args.in[17] + (size_t)(2 * L) * D, args.in[18] + (size_t)(2 * L) * D, WSP(float, WS_XF), WSP(bf16_t, WS_XB), WSP(float, WS_WR) + (size_t)L * 36 * D, args.in[11] + L * NGRP, args.in[13] + L * NEXP, (LAS int*)lds, WSP(int, WS_HIST), WSP(int, WS_LIST), WSP(float, WS_TG), vcu, G))
        PHASE(2, { LAS int* tab = (LAS int*)(lds + LDS_MOETAB); pg8::MoeSched S{tab, 4, G, vcu, D, 1}; S.build(tab, (LAS int*)lds, WSP(int, WS_HIST), WSP(int, WS_LIST));
                   pg8::gemm_phase<pg8::EpiMoeH, pg8::MoeSched>(lds, WSP(bf16_t, WS_XB), WSP(bf16_t, WS_WGU) + (size_t)L * NEXP * 2 * DEXP * D, D, (size_t)2 * DEXP * D * 2, S, pg8::EpiMoeH{WSP(bf16_t, WS_HS)}); })
        PHASE(2, { LAS int* tab = (LAS int*)(lds + LDS_MOETAB); pg8::MoeSched S{tab, 8, G, vcu, DEXP, 0}; S.build(tab, (LAS int*)lds, WSP(int, WS_HIST), WSP(int, WS_LIST));
                   pg8::gemm_phase<pg8::EpiMoeY, pg8::MoeSched>(lds, WSP(bf16_t, WS_HS), WSP(bf16_t, WS_WD) + (size_t)L * NEXP * D * DEXP, DEXP, (size_t)D * DEXP * 2, S, pg8::EpiMoeY{WSP(bf16_t, WS_Y), WSP(float, WS_TG), S}); })
        PHASE_T(5, ln_phase<1>(WSP(float, WS_XF), nullptr, WSP(bf16_t, WS_Y), args.in[17] + (size_t)(2 * L + 1) * D, args.in[18] + (size_t)(2 * L + 1) * D, WSP(float, WS_TRASH), WSP(bf16_t, WS_TRASH + 64 * MiB),
                             nullptr, nullptr, nullptr, nullptr, nullptr, nullptr, nullptr, vcu, G),
                ln_phase<1>(WSP(float, WS_XF), nullptr, WSP(bf16_t, WS_Y), args.in[17] + (size_t)(2 * L + 1) * D, args.in[18] + (size_t)(2 * L + 1) * D, L == DEPTH - 1 ? args.out : WSP(float, WS_XF), L == DEPTH - 1 ? nullptr : WSP(bf16_t, WS_XB),
                             nullptr, nullptr, nullptr, nullptr, nullptr, nullptr, nullptr, vcu, G))
    }
#undef HGARGS
#undef WSP
#undef PHASE
#undef PHASE_T
}

#ifndef MK_PER_PHASE
#define MK_PER_PHASE 0
#endif
extern "C" void kernel_launch(void* const* d_in, const int* in_sizes, int n_in, void* d_out, int out_size, void* d_ws, size_t ws_size, hipStream_t stream) {
    static int grid = 0;
    if (grid == 0) {
        if (n_in != 19 || out_size != T * D || ws_size < WS_END) { fprintf(stderr, "kernel_launch: unexpected arguments (n_in %d, out %d, ws %zu < %zu)\n", n_in, out_size, ws_size, (size_t)WS_END); grid = -1; return; }
        int dev = 0, cus = 0, per_cu = 0;
        if (hipGetDevice(&dev) != hipSuccess || hipDeviceGetAttribute(&cus, hipDeviceAttributeMultiprocessorCount, dev) != hipSuccess) { grid = -1; return; }
        if (hipFuncSetAttribute((const void*)mega_fwd, hipFuncAttributeMaxDynamicSharedMemorySize, LDS_BYTES) != hipSuccess) { fprintf(stderr, "kernel_launch: hipFuncSetAttribute failed\n"); grid = -1; return; }
        if (hipOccupancyMaxActiveBlocksPerMultiprocessor(&per_cu, (const void*)mega_fwd, 512, LDS_BYTES) != hipSuccess || per_cu < 1) { fprintf(stderr, "kernel_launch: occupancy query reports %d\n", per_cu); }
        (void)hipGetLastError();
        grid = cus;
        if (grid != 256) { fprintf(stderr, "kernel_launch: built for 256 CUs (the routing tables assume 256 workgroups of 32 token rows); this device reports %d\n", cus); grid = -1; return; }
    }
    if (grid < 0) return;
    (void)hipMemsetAsync((char*)d_ws + WS_CTL, 0, CTL_BYTES, stream);
    MegaArgs a{};
    for (int i = 0; i < 19; ++i) a.in[i] = (const float*)d_in[i];
    a.out = (float*)d_out; a.ws = (unsigned char*)d_ws;
#if MK_PER_PHASE
    for (int ph = 0; ph < N_PHASES; ++ph) { a.ph_lo = ph; a.ph_hi = ph + 1; hipLaunchKernelGGL(mega_fwd, dim3(grid), dim3(512), LDS_BYTES, stream, a); }
#else
    a.ph_lo = 0; a.ph_hi = N_PHASES;
    hipLaunchKernelGGL(mega_fwd, dim3(grid), dim3(512), LDS_BYTES, stream, a);
#endif
}
```

```cpp
#include <hip/hip_runtime.h>
#include <cstdio>
#include <cstdint>

typedef unsigned short bf16_t;
typedef short bf16x8 __attribute__((ext_vector_type(8)));
typedef float f32x4 __attribute__((ext_vector_type(4)));

constexpr int BATCH = 4, SEQ = 2048, D = 2048, T = BATCH * SEQ, DEPTH = 4, NA = 2;
constexpr int HG_H = 16, HG_DK = 128;
constexpr int AT_HD = 64, AT_HQ = 32, AT_HKV = 4, AT_G = 8, KVW = AT_HKV * AT_HD;
constexpr int NGRP = 4, EPG = 8, NEXP = 32, DEXP = 512;
constexpr float ALPHA = 1.6817928305074290f;
constexpr float LN_EPS = 1e-5f, RMS_EPS = 1e-6f;

constexpr size_t MiB = 1u << 20;
constexpr size_t WS_CTL = 0, CTL_BYTES = 1 * MiB;
constexpr size_t WS_XF = 1 * MiB;
constexpr size_t WS_XB = WS_XF + 64 * MiB;
constexpr size_t WS_QB = WS_XB + 32 * MiB;
constexpr size_t WS_KB = WS_QB + 32 * MiB;
constexpr size_t WS_VB = WS_KB + 32 * MiB;
constexpr size_t WS_GT = WS_VB + 32 * MiB;
constexpr size_t WS_GL = WS_GT + 32 * MiB;
constexpr size_t WS_OF = WS_GL + 64 * MiB;
constexpr size_t WS_OG = WS_OF + 64 * MiB;
constexpr size_t WS_HM = WS_OG + 32 * MiB;
constexpr size_t WS_KC = WS_HM + 32 * MiB;
constexpr size_t WS_VC = WS_KC + 4 * MiB;
constexpr size_t WS_LIST = WS_VC + 4 * MiB;
constexpr size_t WS_TG = WS_LIST + 1 * MiB;
constexpr size_t WS_HS = WS_TG + 1 * MiB;
constexpr size_t WS_Y = WS_HS + 24 * MiB;
constexpr size_t WS_WIN = WS_Y + 64 * MiB;
constexpr size_t WS_WOUT = WS_WIN + 64 * MiB;
constexpr size_t WS_WKV = WS_WOUT + 16 * MiB;
constexpr size_t WS_WQ = WS_WKV + 2 * MiB;
constexpr size_t WS_WO = WS_WQ + 16 * MiB;
constexpr size_t WS_WGU = WS_WO + 16 * MiB;
constexpr size_t WS_WD = WS_WGU + 512 * MiB;
constexpr size_t WS_UT = WS_WD + 256 * MiB;
constexpr size_t WS_SST = WS_UT + 64 * MiB;
constexpr size_t WS_DG = WS_SST + 64 * MiB;
constexpr size_t WS_WR = WS_DG + 1 * MiB;
constexpr size_t WS_HIST = WS_WR + 2 * MiB;
constexpr size_t WS_TRASH = WS_HIST + 1 * MiB;
constexpr size_t WS_END = WS_TRASH + 256 * MiB;
constexpr int CW_CNT = 1024;

__device__ __forceinline__ unsigned f2bf(float f) { unsigned u = __builtin_bit_cast(unsigned, f); return (u + 0x7fffu + ((u >> 16) & 1u)) >> 16; }
__device__ __forceinline__ float bf2f(bf16_t b) { return __builtin_bit_cast(float, ((unsigned)b) << 16); }
__device__ __forceinline__ float wave_sum(float v) {
#pragma unroll
    for (int o = 1; o < 64; o <<= 1) v += __shfl_xor(v, o);
    return v;
}
__device__ __forceinline__ float wave_max(float v) {
#pragma unroll
    for (int o = 1; o < 64; o <<= 1) v = fmaxf(v, __shfl_xor(v, o));
    return v;
}
__device__ __forceinline__ float sigmoidf_(float x) { return 1.0f / (1.0f + __expf(-x)); }
__device__ __forceinline__ int opaque_tid() { int t = threadIdx.x; asm volatile("" : "+v"(t)); return t; }

#define LAS __attribute__((address_space(3)))
typedef unsigned u32x4 __attribute__((ext_vector_type(4)));
namespace pg8 {
constexpr int BM = 256, BK = 64, HALF = 128, HTB = HALF * BK * 2, STAGE_BYTES = 8 * HTB;
__host__ __device__ __forceinline__ int lds_byte(int r, int c) { const int st = (r >> 4) * 2 + (c >> 5), rr = r & 15, cc = c & 31, ob = rr * 64 + cc * 2; return st * 1024 + (ob ^ (((ob >> 9) & 1) << 5)); }
__host__ __device__ __forceinline__ void stage_rc(int b, int& R, int& C) { const int st = b / 1024, sb = b % 1024, swz = sb ^ (((sb >> 9) & 1) << 5); R = (st >> 1) * 16 + swz / 64; C = (st & 1) * 32 + (swz % 64) / 2; }
__host__ __device__ __forceinline__ int perm32(int rho) { const int n = rho >> 4, i = rho & 15; return 8 * (i >> 2) + 4 * n + (i & 3); }
struct Unit { int pm, pn, e, rows, tm, ui; };
typedef float f32x2_ __attribute__((ext_vector_type(2)));
typedef __bf16 bf16x2_ __attribute__((ext_vector_type(2)));
__device__ __forceinline__ unsigned cvt_pk_bf16(float lo, float hi) { const f32x2_ v = {lo, hi}; return __builtin_bit_cast(unsigned, __builtin_convertvector(v, bf16x2_)); }

struct DenseSched {
    int nM, nN, nwg, G, c, K;
    __device__ __forceinline__ void init(int M, int N, int K_, int G_, int c_) { nM = M / BM; nN = N / BM; nwg = nM * nN; G = G_; c = c_; K = K_; }
    __device__ __forceinline__ bool next(int i, Unit& u) const {
        const long L = (long)i * G + c; if (L >= nwg) return false;
        int wgid = (int)L; { const int q = nwg / 8, r = nwg % 8, xcd = wgid % 8, off = wgid / 8; wgid = (xcd < r ? xcd * (q + 1) : r * (q + 1) + (xcd - r) * q) + off; }
        const int nig = 8 * nN, gid = wgid / nig, fm = gid * 8, gsz = (nM - fm) < 8 ? (nM - fm) : 8;
        u.pm = fm + ((wgid % nig) % gsz); u.pn = (wgid % nig) / gsz; u.e = 0; u.rows = 256; u.tm = 0; u.ui = i; return true;
    }
    __device__ __forceinline__ unsigned a_off(const Unit& u, int half, int R) const { return (unsigned)((u.pm * 256 + half * 128 + R) * K) * 2u; }
};

template <class Epi, class Sched>
__device__ __forceinline__ void gemm_phase(LAS unsigned char* lds, const bf16_t* A, const bf16_t* Bt, int K, size_t bstride, const Sched& S, const Epi& E) {
    const int tid = opaque_tid(), wid = __builtin_amdgcn_readfirstlane(tid >> 6), lane = tid & 63, wr = wid >> 2, wc = wid & 3, fr = lane & 15, fq = lane >> 4;
    const int nt = K / BK;
    int sR[2], sC2[2]; unsigned voffB[2];
#pragma unroll
    for (int i = 0; i < 2; ++i) { int R, C; stage_rc(tid * 16 + i * 8192, R, C); const int Rb = (R & ~31) + perm32(R & 31); sR[i] = R; sC2[i] = C * 2; voffB[i] = (unsigned)(Rb * K + C) * 2u; }
    const size_t kstep = (size_t)(BK * 2);
    const size_t hstep = (size_t)HALF * K * 2;
    const size_t tstep = 2 * hstep;
    const unsigned ldsw = (unsigned)wid * 1024u;
    const int aoff = lds_byte(wr * 64 + fr, fq * 8), boff = lds_byte(wc * 32 + fr, fq * 8);
#define PG8_SA(b, h) (((b) * 2 + (h)) * HTB)
#define PG8_SB(b, h) ((4 + (b) * 2 + (h)) * HTB)
#define PG8_STAGE(bufoff, gbase, voff) do { _Pragma("unroll") for (int _i = 0; _i < 2; ++_i) \
        __builtin_amdgcn_global_load_lds((const unsigned*)((const char*)(gbase) + (voff)[_i]), (LAS unsigned*)(lds + (bufoff) + ldsw + _i * 8192), 16, 0, 0); } while (0)
#define PG8_LDA(dst, b, h) do { _Pragma("unroll") for (int m = 0; m < 4; ++m) _Pragma("unroll") for (int k = 0; k < 2; ++k) dst[m][k] = *(const LAS bf16x8*)(lds + PG8_SA(b, h) + aoff + m * 2048 + k * 1024); } while (0)
#define PG8_LDB(dst, b, h) do { _Pragma("unroll") for (int n = 0; n < 2; ++n) _Pragma("unroll") for (int k = 0; k < 2; ++k) dst[n][k] = *(const LAS bf16x8*)(lds + PG8_SB(b, h) + boff + n * 2048 + k * 1024); } while (0)
#define PG8_MMA(ai, bj, At, Bt_) do { __builtin_amdgcn_s_setprio(1); _Pragma("unroll") for (int m = 0; m < 4; ++m) _Pragma("unroll") for (int n = 0; n < 2; ++n) _Pragma("unroll") for (int k = 0; k < 2; ++k) \
        acc[ai][bj][m][n] = __builtin_amdgcn_mfma_f32_16x16x32_bf16(Bt_[n][k], At[m][k], acc[ai][bj][m][n], 0, 0, 0); __builtin_amdgcn_s_setprio(0); } while (0)
#define PG8_WAIT_V(n) asm volatile("s_waitcnt vmcnt(" #n ")" ::: "memory")
#define PG8_WAIT_L(n) asm volatile("s_waitcnt lgkmcnt(" #n ")" ::: "memory")
#define PG8_BAR __builtin_amdgcn_s_barrier()
#define PG8_SCHED __builtin_amdgcn_sched_barrier(0)
    Unit cur, nxt; int ui = 0;
    if (!S.next(0, cur)) return;
    f32x4 acc[2][2][4][2];
#pragma unroll
    for (int a = 0; a < 2; ++a)
#pragma unroll
        for (int b = 0; b < 2; ++b)
#pragma unroll
            for (int m = 0; m < 4; ++m)
#pragma unroll
                for (int n = 0; n < 2; ++n) acc[a][b][m][n] = (f32x4){0.f, 0.f, 0.f, 0.f};
    bf16x8 At[4][2], B0[2][2], B1[2][2];
    unsigned voffA0[2], voffA1[2];
#pragma unroll
    for (int i = 0; i < 2; ++i) { voffA0[i] = S.a_off(cur, 0, sR[i]) + sC2[i]; voffA1[i] = S.a_off(cur, 1, sR[i]) + sC2[i]; }
    const char* const Ab = (const char*)A;
    const char* cB = (const char*)Bt + (size_t)cur.e * bstride + (size_t)cur.pn * tstep;
    PG8_STAGE(PG8_SB(0, 0), cB, voffB); PG8_STAGE(PG8_SB(0, 1), cB + hstep, voffB); PG8_STAGE(PG8_SA(0, 0), Ab, voffA0); PG8_STAGE(PG8_SA(0, 1), Ab, voffA1);
    if (wr == 1) PG8_BAR;
    PG8_WAIT_V(2); PG8_BAR;
    PG8_STAGE(PG8_SB(1, 0), cB + kstep, voffB); PG8_STAGE(PG8_SA(1, 0), Ab + kstep, voffA0); PG8_STAGE(PG8_SB(1, 1), cB + hstep + kstep, voffB);
    PG8_WAIT_V(6); PG8_BAR;
    for (;;) {
        const bool has_next = S.next(ui + 1, nxt);
        const char* nB = has_next ? (const char*)Bt + (size_t)nxt.e * bstride + (size_t)nxt.pn * tstep : cB;
        for (int t = 0; t < nt; t += 2) {
            const bool last = (t == nt - 2);
            const char* a1 = Ab + (size_t)(t + 1) * kstep;
            const char* a2 = last ? Ab : Ab + (size_t)(t + 2) * kstep; const char* b2 = last ? nB : cB + (size_t)(t + 2) * kstep;
            const char* a3 = a2 + kstep; const char* b3 = b2 + kstep;
            PG8_LDB(B0, 0, 0); PG8_LDB(B1, 0, 1); PG8_SCHED; PG8_LDA(At, 0, 0); PG8_STAGE(PG8_SA(1, 1), a1, voffA1);
            if (last && has_next) {
#pragma unroll
                for (int i = 0; i < 2; ++i) { voffA0[i] = S.a_off(nxt, 0, sR[i]) + sC2[i]; voffA1[i] = S.a_off(nxt, 1, sR[i]) + sC2[i]; }
            }
            PG8_WAIT_V(8); PG8_WAIT_L(0); PG8_BAR; PG8_MMA(0, 0, At, B0); PG8_MMA(0, 1, At, B1); PG8_BAR; PG8_SCHED;
            PG8_LDA(At, 0, 1); PG8_STAGE(PG8_SB(0, 0), b2, voffB); PG8_STAGE(PG8_SB(0, 1), b2 + hstep, voffB); PG8_STAGE(PG8_SA(0, 0), a2, voffA0);
            PG8_WAIT_V(8); PG8_WAIT_L(0); PG8_BAR; PG8_MMA(1, 0, At, B0); PG8_MMA(1, 1, At, B1); PG8_BAR; PG8_SCHED;
            PG8_LDB(B0, 1, 0); PG8_LDB(B1, 1, 1); PG8_SCHED; PG8_LDA(At, 1, 0); PG8_STAGE(PG8_SA(0, 1), a2, voffA1);
            PG8_WAIT_V(8); PG8_WAIT_L(0); PG8_BAR; PG8_MMA(0, 0, At, B0); PG8_MMA(0, 1, At, B1); PG8_BAR; PG8_SCHED;
            PG8_LDA(At, 1, 1); PG8_STAGE(PG8_SB(1, 0), b3, voffB); PG8_STAGE(PG8_SB(1, 1), b3 + hstep, voffB); PG8_STAGE(PG8_SA(1, 0), a3, voffA0);
            PG8_WAIT_V(8); PG8_WAIT_L(0); PG8_BAR; PG8_MMA(1, 0, At, B0); PG8_MMA(1, 1, At, B1); PG8_BAR; PG8_SCHED;
        }
        if (wr == 0) PG8_BAR;
        E(acc, cur, wr, wc, fr, fq);
        if (!has_next) break;
#pragma unroll
        for (int a = 0; a < 2; ++a)
#pragma unroll
            for (int b = 0; b < 2; ++b)
#pragma unroll
                for (int m = 0; m < 4; ++m)
#pragma unroll
                    for (int n = 0; n < 2; ++n) acc[a][b][m][n] = (f32x4){0.f, 0.f, 0.f, 0.f};
        cur = nxt; cB = nB; ++ui;
        if (wr == 1) PG8_BAR;
    }
    PG8_WAIT_V(0);
    PG8_BAR;
#undef PG8_SA
#undef PG8_SB
#undef PG8_STAGE
#undef PG8_LDA
#undef PG8_LDB
#undef PG8_MMA
#undef PG8_WAIT_V
#undef PG8_WAIT_L
#undef PG8_BAR
#undef PG8_SCHED
}

#define PG8_ROWS_COLS const int row0 = u.pm * BM + wr * 64 + fr; const int col0 = wc * 32 + 8 * fq
__device__ __forceinline__ u32x4 pack8(const f32x4 v0, const f32x4 v1) { u32x4 w; w.x = cvt_pk_bf16(v0[0], v0[1]); w.y = cvt_pk_bf16(v0[2], v0[3]); w.z = cvt_pk_bf16(v1[0], v1[1]); w.w = cvt_pk_bf16(v1[2], v1[3]); return w; }
struct EpiStore {
    bf16_t* O; bf16_t* O2; int ldc, split; float scale; int pad;
    __device__ __forceinline__ void operator()(const f32x4 (&acc)[2][2][4][2], const Unit& u, int wr, int wc, int fr, int fq) const {
        PG8_ROWS_COLS; bf16_t* base = u.pn >= split ? O2 + (size_t)(u.pn - split) * BM : O + (size_t)u.pn * BM;
#pragma unroll
        for (int ai = 0; ai < 2; ++ai)
#pragma unroll
            for (int m = 0; m < 4; ++m) { bf16_t* rowp = base + (size_t)(row0 + ai * HALF + m * 16) * ldc + col0;
#pragma unroll
                for (int bj = 0; bj < 2; ++bj) *(u32x4*)(rowp + bj * HALF) = pack8(acc[ai][bj][m][0] * scale, acc[ai][bj][m][1] * scale); }
    }
};
struct EpiHgrn {
    bf16_t *Qb, *Kb, *Vb, *Gt; float* Gl; const float* lbraw; int layer, pad;
    __device__ __forceinline__ void operator()(const f32x4 (&acc)[2][2][4][2], const Unit& u, int wr, int wc, int fr, int fq) const {
        PG8_ROWS_COLS; const int seg = u.pn >> 3, ct = (u.pn & 7) * BM + col0;
        if (seg == 0 || seg == 2) { bf16_t* base = (seg == 0 ? Qb : Vb) + ct;
#pragma unroll
            for (int ai = 0; ai < 2; ++ai)
#pragma unroll
                for (int m = 0; m < 4; ++m) { bf16_t* rowp = base + (size_t)(row0 + ai * HALF + m * 16) * D;
#pragma unroll
                    for (int bj = 0; bj < 2; ++bj) *(u32x4*)(rowp + bj * HALF) = pack8(acc[ai][bj][m][0], acc[ai][bj][m][1]); }
        } else if (seg == 3) {
#pragma unroll
            for (int ai = 0; ai < 2; ++ai)
#pragma unroll
                for (int m = 0; m < 4; ++m) { bf16_t* rowp = Gt + ct + (size_t)(row0 + ai * HALF + m * 16) * D;
#pragma unroll
                    for (int bj = 0; bj < 2; ++bj) { f32x4 v[2];
#pragma unroll
                        for (int n = 0; n < 2; ++n)
#pragma unroll
                            for (int j = 0; j < 4; ++j) { const float x = acc[ai][bj][m][n][j]; v[n][j] = x * sigmoidf_(x); }
                        *(u32x4*)(rowp + bj * HALF) = pack8(v[0], v[1]); } }
        } else {
#pragma unroll
            for (int bj = 0; bj < 2; ++bj) { float lb[8];
#pragma unroll
                for (int j = 0; j < 8; ++j) { const int c = ct + bj * HALF + j; lb[j] = layer == 0 ? 0.f : sigmoidf_(lbraw[D + c] - lbraw[c]); }
#pragma unroll
                for (int ai = 0; ai < 2; ++ai)
#pragma unroll
                    for (int m = 0; m < 4; ++m) { const size_t o = (size_t)(row0 + ai * HALF + m * 16) * D + ct + bj * HALF; f32x4 kv[2], gv[2];
#pragma unroll
                        for (int n = 0; n < 2; ++n)
#pragma unroll
                            for (int j = 0; j < 4; ++j) { const float l = lb[4 * n + j], sg = sigmoidf_(acc[ai][bj][m][n][j]); gv[n][j] = __log2f(fmaxf(l + (1.f - l) * sg, 1e-30f));   kv[n][j] = (1.f - l) * (1.f - sg); }
                        *(u32x4*)(Kb + o) = pack8(kv[0], kv[1]); *(f32x4*)(Gl + o) = gv[0]; *(f32x4*)(Gl + o + 4) = gv[1]; } }
        }
    }
};


constexpr int MOE_MAXU = 4, MOE_TAB_INTS = 128 + 256 * MOE_MAXU;
struct MoeSched {
    const LAS int* tab; int NT, G, c, K, gather;
    __device__ __forceinline__ bool next(int i, Unit& u) const {
        const int L = i * G + c, TM = tab[32]; if (L >= TM * NT) return false;
        const int mt = L / NT; int e = 0; while (tab[e + 1] <= mt) ++e;
        u.pm = mt; u.pn = L - mt * NT; u.e = e; u.tm = mt - tab[e]; const int left = tab[64 + e] - 256 * u.tm; u.rows = left < 256 ? left : 256; u.ui = i; return true;
    }
    __device__ __forceinline__ int entry(const Unit& u, int r) const {
        const int a = tab[128 + 256 * u.ui + r]; return a >= 0 ? a : tab[128 + 256 * u.ui];
    }
    __device__ __forceinline__ unsigned a_off(const Unit& u, int half, int R) const {
        if (gather) return (unsigned)((entry(u, half * 128 + R) >> 1) * K) * 2u;
        return (unsigned)((u.pm * 256 + half * 128 + R) * K) * 2u;
    }
    __device__ __forceinline__ void build(LAS int* t, LAS int* scr, const int* hist, const int* inv) const {
        const int tid = opaque_tid(), lane = tid & 63, wv = tid >> 6;
        { const int e = tid & 31, part = tid >> 5; int sum = 0;
#pragma unroll 4
          for (int b = part * 16; b < part * 16 + 16; ++b) sum += hist[b * 32 + e];
          scr[tid] = sum; }
        __syncthreads();
        if (tid < 32) { int sum = 0; for (int part = 0; part < 16; ++part) sum += scr[part * 32 + tid]; t[64 + tid] = sum; }
        __syncthreads();
        if (tid == 0) { int p = 0; for (int e = 0; e < 32; ++e) { t[e] = p; p += (t[64 + e] + 255) >> 8; } t[32] = p; }
        __syncthreads();
        for (int i = 0; i < MOE_MAXU; ++i) { Unit u; if (!next(i, u)) break;
            int hv = 0, incl = 0;
            if (tid < 256) { hv = hist[tid * 32 + u.e]; incl = hv;
#pragma unroll
                for (int o = 1; o < 64; o <<= 1) { const int tv = __shfl_up(incl, o); if (lane >= o) incl += tv; }
                if (lane == 63) scr[wv] = incl; }
            __syncthreads();
            if (tid < 256) { int off = 0; for (int w2 = 0; w2 < wv; ++w2) off += scr[w2]; scr[512 + tid] = off + incl - hv; if (tid == 255) scr[512 + 256] = off + incl; }
            __syncthreads();
            if (tid < 256) { const int pos = 256 * u.tm + tid; int ent = -1;
                if (pos < t[64 + u.e]) { int lo = 0, hi = 256;
                    while (hi - lo > 1) { const int mid = (lo + hi) >> 1; if (scr[512 + mid] <= pos) lo = mid; else hi = mid; }
                    ent = inv[(lo * 32 + u.e) * 32 + (pos - scr[512 + lo])]; }
                t[128 + 256 * i + tid] = ent; }
            __syncthreads();
        }
    }
};
struct EpiMoeH {
    bf16_t* Hs;
    __device__ __forceinline__ void operator()(const f32x4 (&acc)[2][2][4][2], const Unit& u, int wr, int wc, int fr, int fq) const {
        const int col0 = u.pn * 128 + wc * 32 + 8 * fq;
#pragma unroll
        for (int ai = 0; ai < 2; ++ai)
#pragma unroll
            for (int m = 0; m < 4; ++m) { const int rl = ai * HALF + wr * 64 + m * 16 + fr; f32x4 v[2];
#pragma unroll
                for (int n = 0; n < 2; ++n)
#pragma unroll
                    for (int j = 0; j < 4; ++j) { const float g = acc[ai][0][m][n][j]; v[n][j] = g * sigmoidf_(g) * acc[ai][1][m][n][j]; }
                if (rl < u.rows) *(u32x4*)(Hs + (size_t)(u.pm * 256 + rl) * DEXP + col0) = pack8(v[0], v[1]); }
    }
};
struct EpiMoeY {
    bf16_t* Y; const float* tg; MoeSched S;
    __device__ __forceinline__ void operator()(const f32x4 (&acc)[2][2][4][2], const Unit& u, int wr, int wc, int fr, int fq) const {
        const int col0 = u.pn * BM + wc * 32 + 8 * fq;
#pragma unroll
        for (int ai = 0; ai < 2; ++ai)
#pragma unroll
            for (int m = 0; m < 4; ++m) { const int rl = ai * HALF + wr * 64 + m * 16 + fr;
                if (rl < u.rows) { const int a = S.entry(u, rl); const float g = tg[a]; bf16_t* rowp = Y + (size_t)a * D + col0;
#pragma unroll
                    for (int bj = 0; bj < 2; ++bj) *(u32x4*)(rowp + bj * HALF) = pack8(acc[ai][bj][m][0] * g, acc[ai][bj][m][1] * g); } }
    }
};

__device__ __forceinline__ void transpose_item(const float* W, int K, int N, bf16_t* WT, int dst_row0, LAS float* scr, int kb, int nb, int lane) {
    const int k0 = 64 * kb, n0 = 32 * nb;
#pragma unroll 8
    for (int i = 0; i < 32; ++i) { const int kk = 2 * i + (lane >> 5); scr[kk * 33 + (lane & 31)] = W[(size_t)(k0 + kk) * N + n0 + (lane & 31)]; }
    asm volatile("s_waitcnt lgkmcnt(0)" ::: "memory");
    const int c = lane & 7;
#pragma unroll
    for (int j = 0; j < 4; ++j) { const int n = (lane >> 3) + 8 * j; const LAS float* s = scr + (8 * c) * 33 + n;
        u32x4 o; o.x = f2bf(s[0 * 33]) | (f2bf(s[1 * 33]) << 16); o.y = f2bf(s[2 * 33]) | (f2bf(s[3 * 33]) << 16); o.z = f2bf(s[4 * 33]) | (f2bf(s[5 * 33]) << 16); o.w = f2bf(s[6 * 33]) | (f2bf(s[7 * 33]) << 16);
        *(u32x4*)(WT + (size_t)(dst_row0 + n) * K + k0 + 8 * c) = o; }
    asm volatile("s_waitcnt lgkmcnt(0)" ::: "memory");
}
}

typedef short s16x4 __attribute__((ext_vector_type(4)));
typedef LAS s16x4 lds_s16x4;
constexpr int HRS = 272, ARS = 144;
constexpr int H1_QH = 0, H1_KH0 = H1_QH + 64 * HRS, H1_KH1 = H1_KH0 + 16 * HRS, H1_KH2 = H1_KH1 + 32 * HRS, H1_KH3 = H1_KH2 + 48 * HRS, H1_KT = H1_KH3 + 64 * HRS,
              H1_VS = H1_KT + 64 * HRS, H1_AS = H1_VS + 64 * HRS, H1_TOT = H1_AS + 64 * ARS, H1_BYTES = H1_TOT + 4096;
constexpr int NUNIT = BATCH * HG_H * (SEQ / 64);
__device__ __forceinline__ bf16x8 tr_frag16(const LAS unsigned char* tile, int rs, int r0, int c0, int lane) {
    const int g = lane >> 4, i = lane & 15, q = i >> 2, p = i & 3;
    const LAS unsigned char* a = tile + (r0 + 8 * g + q) * rs + (c0 + 4 * p) * 2;
    const s16x4 lo = __builtin_amdgcn_ds_read_tr16_b64_v4i16((lds_s16x4*)a);
    const s16x4 hi = __builtin_amdgcn_ds_read_tr16_b64_v4i16((lds_s16x4*)(a + 4 * rs));
    return (bf16x8){lo[0], lo[1], lo[2], lo[3], hi[0], hi[1], hi[2], hi[3]};
}
__device__ __forceinline__ bf16x8 row_frag16(const LAS unsigned char* tile, int rs, int r0, int c0, int lane) {
    return *(const LAS bf16x8*)(tile + (r0 + (lane & 15)) * rs + (c0 + 8 * (lane >> 4)) * 2);
}
#define MFMA16(a, b, c) __builtin_amdgcn_mfma_f32_16x16x32_bf16((a), (b), (c), 0, 0, 0)
typedef unsigned u32x2 __attribute__((ext_vector_type(2)));
__device__ __forceinline__ u32x2 pack4(const f32x4 v) { u32x2 r; r.x = pg8::cvt_pk_bf16(v[0], v[1]); r.y = pg8::cvt_pk_bf16(v[2], v[3]); return r; }

struct HgArgs { bf16_t *Qb, *Kb, *Vb, *Gt, *OI, *UT, *Sst, *Og; float *Gl, *Dg; const float* ng; bf16_t* Qt; };

typedef float f32x2 __attribute__((ext_vector_type(2)));
__device__ __forceinline__ f32x2 exp2v(const f32x2 x) { f32x2 r; r.x = __builtin_amdgcn_exp2f(x.x); r.y = __builtin_amdgcn_exp2f(x.y); return r; }
__device__ __forceinline__ f32x2 bf2v(unsigned w) { f32x2 r; r.x = __builtin_bit_cast(float, w << 16); r.y = __builtin_bit_cast(float, w & 0xffff0000u); return r; }
__device__ __forceinline__ unsigned v2bf(const f32x2 v) { return pg8::cvt_pk_bf16(v.x, v.y); }
struct H1In { f32x2 g[8]; unsigned q[8], k[8]; u32x4 v[2]; };
__device__ __forceinline__ void h1_load(H1In& in, const HgArgs& a, int unit, int tid) {
    const int bh = unit >> 5, c = unit & 31, b = bh >> 4, h = bh & 15, cp = tid & 63, tq = tid >> 6;
    const size_t gbase = ((size_t)b * SEQ + c * 64) * D + h * 128;
#pragma unroll
    for (int i = 0; i < 8; ++i) { const size_t go = gbase + (size_t)(8 * tq + i) * D + 2 * cp; in.g[i] = *(const f32x2*)(a.Gl + go); in.q[i] = *(const unsigned*)(a.Qb + go); in.k[i] = *(const unsigned*)(a.Kb + go); }
#pragma unroll
    for (int i = 0; i < 2; ++i) { const int id = tid + 512 * i, r = id >> 4, ck = id & 15; in.v[i] = *(const u32x4*)(a.Vb + gbase + (size_t)r * D + ck * 8); }
}
__device__ __forceinline__ void h1_phase(LAS unsigned char* lds, const HgArgs& a, int vcu, int G) {
    const int tid = opaque_tid(), lane = tid & 63, wid = __builtin_amdgcn_readfirstlane(tid >> 6);
    const int cp = lane, tq = wid, J = wid >> 1, half = wid & 1;
    LAS f32x2* tot8 = (LAS f32x2*)(lds + H1_TOT);
    H1In in;
    if (vcu < NUNIT) h1_load(in, a, vcu, tid);
    for (int unit = vcu; unit < NUNIT; unit += G) {
        const int bh = unit >> 5, c = unit & 31, b = bh >> 4, h = bh & 15;
        const size_t gbase = ((size_t)b * SEQ + c * 64) * D + h * 128;
        f32x2 L[8]; { f32x2 l = {0.f, 0.f};
#pragma unroll
            for (int i = 0; i < 8; ++i) { l += in.g[i]; L[i] = l; } }
        tot8[tq * 64 + cp] = L[7];
#pragma unroll
        for (int i = 0; i < 2; ++i) { const int id = tid + 512 * i, r = id >> 4, ck = id & 15; *(LAS u32x4*)(lds + H1_VS + r * HRS + ck * 16) = in.v[i]; }
        for (int id = tid; id < 64 * ARS / 16; id += 512) *(LAS u32x4*)(lds + H1_AS + id * 16) = (u32x4){0u, 0u, 0u, 0u};
        __syncthreads();
        f32x2 tj[4];
#pragma unroll
        for (int M = 0; M < 4; ++M) tj[M] = tot8[(2 * M) * 64 + cp] + tot8[(2 * M + 1) * 64 + cp];
        f32x2 off = {0.f, 0.f}; if (half) off = tot8[(tq - 1) * 64 + cp];
        f32x2 aJ = {0.f, 0.f};
#pragma unroll
        for (int M = 0; M < 3; ++M) if (M < J) aJ += tj[M];
        const f32x2 PA = exp2v(aJ), L15 = tj[J == 0 ? 0 : J == 1 ? 1 : J == 2 ? 2 : 3];
        f32x2 cI[5];
#pragma unroll
        for (int I = 1; I <= 4; ++I) { f32x2 sx = {0.f, 0.f};
#pragma unroll
            for (int M = 1; M < 4; ++M) if (M > J && M < I) sx += tj[M];
            cI[I] = exp2v(sx); }
        const int khJ = J == 0 ? H1_KH0 : J == 1 ? H1_KH1 : J == 2 ? H1_KH2 : H1_KH3;
#pragma unroll
        for (int i = 0; i < 8; ++i) {
            const int t = 8 * tq + i; const int lo = t * HRS + cp * 4;
            const f32x2 q = bf2v(in.q[i]), k = bf2v(in.k[i]), Li = L[i] + off;
            const f32x2 ep = exp2v(Li), nl = -Li, en = exp2v((f32x2){fminf(nl.x, 80.f), fminf(nl.y, 80.f)}), rem = exp2v(L15 - Li);
            const f32x2 qh = q * ep, kr = k * rem;
            *(LAS unsigned*)(lds + H1_QH + lo) = v2bf(qh);
            *(unsigned*)(a.Qt + gbase + (size_t)t * D + 2 * cp) = v2bf(qh * PA);
            *(LAS unsigned*)(lds + khJ + lo) = v2bf(k * en);
#pragma unroll
            for (int I = 1; I <= 4; ++I) if (I > J) { constexpr int offs[5] = {H1_KH0, H1_KH1, H1_KH2, H1_KH3, H1_KT}; *(LAS unsigned*)(lds + offs[I] + lo) = v2bf(kr * cI[I]); }
        }
        if (J == 0 && half == 0) *(f32x2*)(a.Dg + (size_t)unit * 128 + 2 * cp) = exp2v((tj[0] + tj[1]) + (tj[2] + tj[3]));
        __syncthreads();
        if (unit + G < NUNIT) h1_load(in, a, unit + G, tid);
        for (int blk = wid; blk < 10; blk += 8) {
            const int I = blk < 1 ? 0 : blk < 3 ? 1 : blk < 6 ? 2 : 3, Jb = blk - (I * (I + 1)) / 2;
            const int khI = I == 0 ? H1_KH0 : I == 1 ? H1_KH1 : I == 2 ? H1_KH2 : H1_KH3;
            f32x4 acc = {0.f, 0.f, 0.f, 0.f};
#pragma unroll
            for (int ks = 0; ks < 4; ++ks) acc = MFMA16(row_frag16(lds + khI, HRS, 16 * Jb, 32 * ks, lane), row_frag16(lds + H1_QH, HRS, 16 * I, 32 * ks, lane), acc);
            const int tl = 16 * I + (lane & 15), s0 = 16 * Jb + 4 * (lane >> 4);
#pragma unroll
            for (int r = 0; r < 4; ++r) if (s0 + r > tl) acc[r] = 0.f;
            *(LAS u32x2*)(lds + H1_AS + tl * ARS + s0 * 2) = pack4(acc);
        }
        __syncthreads();
        {
            bf16x8 vtr[2];
#pragma unroll
            for (int ks = 0; ks < 2; ++ks) vtr[ks] = tr_frag16(lds + H1_VS, HRS, 32 * ks, 16 * wid, lane);
#pragma unroll
            for (int rb = 0; rb < 4; ++rb) { f32x4 acc = {0.f, 0.f, 0.f, 0.f};
#pragma unroll
                for (int ks = 0; ks < 2; ++ks) if (!(ks == 1 && rb < 2)) acc = MFMA16(vtr[ks], row_frag16(lds + H1_AS, ARS, 16 * rb, 32 * ks, lane), acc);
                *(u32x2*)(a.OI + gbase + (size_t)(16 * rb + (lane & 15)) * D + 16 * wid + 4 * (lane >> 4)) = pack4(acc); }
#pragma unroll
            for (int cb = 0; cb < 8; ++cb) { f32x4 acc = {0.f, 0.f, 0.f, 0.f};
#pragma unroll
                for (int ks = 0; ks < 2; ++ks) acc = MFMA16(tr_frag16(lds + H1_KT, HRS, 32 * ks, 16 * cb, lane), vtr[ks], acc);
                *(u32x2*)(a.UT + ((size_t)unit * 128 + 16 * wid + (lane & 15)) * 128 + 16 * cb + 4 * (lane >> 4)) = pack4(acc); }
        }
        __syncthreads();
    }
}
__device__ __forceinline__ void h2_phase(const HgArgs& a, int vcu, int G) {
    for (int item = vcu * 512 + opaque_tid(); item < BATCH * HG_H * 2048; item += G * 512) {
        const int bh = item >> 11, vec = item & 2047, ch0 = (vec & 15) * 8;
        float st[8];
#pragma unroll
        for (int j = 0; j < 8; ++j) st[j] = 0.f;
        for (int c = 0; c < 32; ++c) { const size_t u = (size_t)bh * 32 + c;
            *(u32x4*)(a.Sst + u * 16384 + vec * 8) = pg8::pack8((f32x4){st[0], st[1], st[2], st[3]}, (f32x4){st[4], st[5], st[6], st[7]});
            if (c < 31) { const uint4 uu = *(const uint4*)(a.UT + u * 16384 + vec * 8); const float4 d0 = *(const float4*)(a.Dg + u * 128 + ch0), d1 = *(const float4*)(a.Dg + u * 128 + ch0 + 4);
                const unsigned w[4] = {uu.x, uu.y, uu.z, uu.w}; const float dd[8] = {d0.x, d0.y, d0.z, d0.w, d1.x, d1.y, d1.z, d1.w};
#pragma unroll
                for (int j = 0; j < 4; ++j) { st[2 * j] = dd[2 * j] * st[2 * j] + bf2f((bf16_t)(w[j] & 0xffff)); st[2 * j + 1] = dd[2 * j + 1] * st[2 * j + 1] + bf2f((bf16_t)(w[j] >> 16)); } }
        }
    }
}
__device__ __forceinline__ void h3_phase(const HgArgs& a, int vcu, int G) {
    const int tid = opaque_tid(), lane = tid & 63, wid = __builtin_amdgcn_readfirstlane(tid >> 6);
    for (int pair = vcu; pair < NUNIT / 2; pair += G) {
        const int unit = pair * 2 + (wid >> 2), rb = wid & 3;
        const int bh = unit >> 5, c = unit & 31, b = bh >> 4, h = bh & 15;
        const size_t ro = ((size_t)b * SEQ + c * 64 + 16 * rb + (lane & 15)) * D + h * 128;
        bf16x8 qf[4];
#pragma unroll
        for (int ks = 0; ks < 4; ++ks) qf[ks] = *(const bf16x8*)(a.Qt + ro + 32 * ks + 8 * (lane >> 4));
        f32x4 o[8]; float ss = 0.f;
#pragma unroll
        for (int cb = 0; cb < 8; ++cb) { f32x4 acc = {0.f, 0.f, 0.f, 0.f};
            const bf16_t* sp = a.Sst + ((size_t)unit * 128 + 16 * cb + (lane & 15)) * 128 + 8 * (lane >> 4);
#pragma unroll
            for (int ks = 0; ks < 4; ++ks) acc = MFMA16(*(const bf16x8*)(sp + 32 * ks), qf[ks], acc);
            const uint2 oi = *(const uint2*)(a.OI + ro + 16 * cb + 4 * (lane >> 4));
            acc[0] += bf2f((bf16_t)(oi.x & 0xffff)); acc[1] += bf2f((bf16_t)(oi.x >> 16)); acc[2] += bf2f((bf16_t)(oi.y & 0xffff)); acc[3] += bf2f((bf16_t)(oi.y >> 16));
            o[cb] = acc; ss += (acc[0] * acc[0] + acc[1] * acc[1]) + (acc[2] * acc[2] + acc[3] * acc[3]); }
        ss += __shfl_xor(ss, 16); ss += __shfl_xor(ss, 32);
        const float r = 1.0f / sqrtf(ss * (1.f / 128.f) + RMS_EPS);
#pragma unroll
        for (int cb = 0; cb < 8; ++cb) { const int vc = 16 * cb + 4 * (lane >> 4); const float4 g = *(const float4*)(a.ng + h * 128 + vc); const uint2 gt = *(const uint2*)(a.Gt + ro + vc);
            f32x4 v; v[0] = o[cb][0] * r * g.x * bf2f((bf16_t)(gt.x & 0xffff)); v[1] = o[cb][1] * r * g.y * bf2f((bf16_t)(gt.x >> 16)); v[2] = o[cb][2] * r * g.z * bf2f((bf16_t)(gt.y & 0xffff)); v[3] = o[cb][3] * r * g.w * bf2f((bf16_t)(gt.y >> 16));
            *(u32x2*)(a.Og + ro + vc) = pack4(v); }
    }
}

#define XB_TMO      128
#define XB_XCNT(j)  (256  + 64 * (j))
#define XB_XSUB(j)  (1280 + 64 * (j))
#define XB_XGEN(j)  (2304 + 64 * (j))
#define XB_TOP      3328
#define XB_TOPGEN   3392
#define XCD_BAR_WORDS 3456
#define XB_SPIN_CAP (1u << 18)
__device__ __forceinline__ unsigned xb_ld(unsigned* p)              { return __hip_atomic_load(p, __ATOMIC_RELAXED, __HIP_MEMORY_SCOPE_AGENT); }
__device__ __forceinline__ unsigned xb_add(unsigned* p, unsigned v) { return __hip_atomic_fetch_add(p, v, __ATOMIC_RELAXED, __HIP_MEMORY_SCOPE_AGENT); }
__device__ __forceinline__ unsigned xb_xcc_id() { return (unsigned)__builtin_amdgcn_s_getreg((3 << 11) | 20) & 0xFu; }
#define XB_SPIN(cond, bar) do { unsigned _sp = 0; while (cond) { __builtin_amdgcn_s_sleep(1); \
    if ((++_sp & 255u) == 0u) { if (xb_ld(&(bar)[XB_TMO])) break; if (_sp > XB_SPIN_CAP) { atomicAdd(&(bar)[XB_TMO], 1u); break; } } } } while (0)
struct XcdBarrier { unsigned* bar; unsigned x; volatile LAS unsigned* st; };
__device__ __forceinline__ XcdBarrier xcd_barrier_post(unsigned* bar, volatile LAS unsigned* st) {
    XcdBarrier b; b.bar = bar; b.x = xb_xcc_id(); b.st = st;
    if (threadIdx.x == 0) (void)xb_add(&bar[XB_XCNT(b.x)], 1u);
    return b;
}
__device__ __forceinline__ void xcd_barrier_complete(unsigned* bar, unsigned x, unsigned& nloc, unsigned& nx) {
    const unsigned G = gridDim.x * gridDim.y * gridDim.z;
    unsigned sum, cnt, mine, sp = 0u;
    for (;;) {
        sum = 0u; cnt = 0u; mine = 0u;
#pragma unroll
        for (unsigned j = 0; j < 16; ++j) { const unsigned c = xb_ld(&bar[XB_XCNT(j)]); sum += c; cnt += (c > 0u) ? 1u : 0u; mine = (j == x) ? c : mine; }
        if (sum == G) break;
        __builtin_amdgcn_s_sleep(1);
        if ((++sp & 255u) == 0u) { if (xb_ld(&bar[XB_TMO])) break; if (sp > XB_SPIN_CAP) { atomicAdd(&bar[XB_TMO], 1u); break; } }
    }
    nloc = mine > 0u ? mine : 1u; nx = cnt > 0u ? cnt : 1u;
}
__device__ __forceinline__ void xcd_barrier(const XcdBarrier& b) {
    asm volatile("s_waitcnt vmcnt(0)" ::: "memory");
    __syncthreads();
    if (threadIdx.x == 0) {
        unsigned* bar = b.bar;
        __builtin_amdgcn_s_waitcnt(0);
        unsigned nloc = b.st[0], nx = b.st[1];
        if (nloc == 0u) { xcd_barrier_complete(bar, b.x, nloc, nx); b.st[0] = nloc; b.st[1] = nx; }
        const unsigned old = xb_add(&bar[XB_XSUB(b.x)], 1u);
        const unsigned gen = old / nloc;
        if (old + 1u == (gen + 1u) * nloc) {
            __builtin_amdgcn_fence(__ATOMIC_RELEASE, "agent");
            asm volatile("s_waitcnt vmcnt(0)" ::: "memory");
            const unsigned og = xb_add(&bar[XB_TOP], 1u);
            const unsigned tg = og / nx;
            if (og + 1u == (tg + 1u) * nx) xb_add(&bar[XB_TOPGEN], 1u);
            else XB_SPIN(xb_ld(&bar[XB_TOPGEN]) == tg, bar);
            __builtin_amdgcn_fence(__ATOMIC_ACQUIRE, "agent");
            xb_add(&bar[XB_XGEN(b.x)], 1u);
            asm volatile("s_waitcnt vmcnt(0)" ::: "memory");
        } else {
            XB_SPIN(xb_ld(&bar[XB_XGEN(b.x)]) == gen, bar);
            __builtin_amdgcn_fence(__ATOMIC_ACQUIRE, "agent");
            asm volatile("s_waitcnt vmcnt(0)" ::: "memory");
        }
    }
    __syncthreads();
}

struct Ptrs {
    const float *x, *a_w_in, *a_lb, *a_ng, *a_w_out, *b_w_kv, *b_w_q, *b_sinks, *b_w_out, *rel_bias, *w_rg, *b_rg, *w_re, *b_re, *w_gate, *w_up, *w_down, *ln_g, *ln_b;
    float* out; unsigned char* ws;
};
__device__ __forceinline__ void prologue_phase(LAS unsigned char* lds, const Ptrs& p, int vcu, int G) {
    const int tid = opaque_tid(), lane = tid & 63, wave = __builtin_amdgcn_readfirstlane(tid >> 6);
    LAS float* scr = (LAS float*)(lds + wave * 8448);
    const int gw = vcu * 8 + wave, NGW = G * 8;
    bf16_t* Win_t = (bf16_t*)(p.ws + WS_WIN); bf16_t* Wout_t = (bf16_t*)(p.ws + WS_WOUT); bf16_t* Wkv_t = (bf16_t*)(p.ws + WS_WKV); bf16_t* Wq_t = (bf16_t*)(p.ws + WS_WQ); bf16_t* Wo_t = (bf16_t*)(p.ws + WS_WO);
    bf16_t* Wgu_t = (bf16_t*)(p.ws + WS_WGU); bf16_t* Wd_t = (bf16_t*)(p.ws + WS_WD);
    constexpr int I_IN = 2 * 32 * 256, I_AO = 2 * 32 * 64, I_KV = 32 * 16, I_Q = 2 * 32 * 64, I_O = 2 * 32 * 64, I_G = 128 * 32 * 16, I_U = I_G, I_D = 128 * 8 * 64;
    constexpr int NITEMS = I_IN + I_AO + I_KV + I_Q + I_O + I_G + I_U + I_D;
    for (int it = gw; it < NITEMS; it += NGW) {
        int r = it;
        if (r < I_IN) { const int mat = r / (32 * 256), q = r % (32 * 256), kb = q / 256, nb = q % 256; pg8::transpose_item(p.a_w_in + (size_t)mat * D * 4 * D, D, 4 * D, Win_t + (size_t)mat * 4 * D * D, 32 * nb, scr, kb, nb, lane); continue; } r -= I_IN;
        if (r < I_AO) { const int mat = r / (32 * 64), q = r % (32 * 64), kb = q / 64, nb = q % 64; pg8::transpose_item(p.a_w_out + (size_t)mat * D * D, D, D, Wout_t + (size_t)mat * D * D, 32 * nb, scr, kb, nb, lane); continue; } r -= I_AO;
        if (r < I_KV) { const int kb = r / 16, nb = r % 16; pg8::transpose_item(p.b_w_kv, D, 2 * KVW, Wkv_t, 32 * nb, scr, kb, nb, lane); continue; } r -= I_KV;
        if (r < I_Q) { const int mat = r / (32 * 64), q = r % (32 * 64), kb = q / 64, nb = q % 64; pg8::transpose_item(p.b_w_q + (size_t)mat * D * D, D, D, Wq_t + (size_t)mat * D * D, 32 * nb, scr, kb, nb, lane); continue; } r -= I_Q;
        if (r < I_O) { const int mat = r / (32 * 64), q = r % (32 * 64), kb = q / 64, nb = q % 64; pg8::transpose_item(p.b_w_out + (size_t)mat * D * D, D, D, Wo_t + (size_t)mat * D * D, 32 * nb, scr, kb, nb, lane); continue; } r -= I_O;
        if (r < I_G + I_U) { const int up = r >= I_G; if (up) r -= I_G; const int mat = r / (32 * 16), q = r % (32 * 16), kb = q / 16, nb = q % 16;
            const int n0 = 32 * nb, drow = (n0 >> 7) * 256 + (n0 & 127) + (up ? 128 : 0);
            pg8::transpose_item((up ? p.w_up : p.w_gate) + (size_t)mat * D * DEXP, D, DEXP, Wgu_t + (size_t)mat * 2 * DEXP * D, drow, scr, kb, nb, lane); continue; } r -= I_G + I_U;
        { const int mat = r / (8 * 64), q = r % (8 * 64), kb = q / 64, nb = q % 64; pg8::transpose_item(p.w_down + (size_t)mat * DEXP * D, DEXP, D, Wd_t + (size_t)mat * D * DEXP, 32 * nb, scr, kb, nb, lane); }
    }
    { float* WRt = (float*)(p.ws + WS_WR);
      for (int i = vcu * 512 + tid; i < DEPTH * 36 * D; i += G * 512) { const int L = i / (36 * D), o = (i / D) % 36, d = i % D;
          WRt[i] = o < 4 ? p.w_rg[((size_t)L * D + d) * NGRP + o] : p.w_re[((size_t)L * D + d) * NEXP + (o - 4)]; } }
    bf16_t* xb = (bf16_t*)(p.ws + WS_XB);
    for (size_t i = (size_t)vcu * 512 + tid; i < (size_t)T * D / 4; i += (size_t)G * 512) { const float4 v = ((const float4*)p.x)[i];
        u32x2 o; o.x = pg8::cvt_pk_bf16(v.x, v.y); o.y = pg8::cvt_pk_bf16(v.z, v.w); ((u32x2*)xb)[i] = o; }
}

template <int MODE>
__device__ __forceinline__ void ln_phase(const float* xin, const bf16_t* hm, const bf16_t* Y, const float* lng, const float* lnb, float* xf, bf16_t* xb,
                                         const float* wrg, const float* brg, const float* wre, const float* bre, int* cnt, int* list, float* tg, int vcu, int G) {
    const int tid = opaque_tid();
    for (int row = vcu * 8 + (tid >> 6); row < T; row += G * 8) {
        const int lane = opaque_tid() & 63;
        float v[32];
        float s = 0.f;
#pragma unroll
        for (int j = 0; j < 8; ++j) { const int c = 4 * lane + 256 * j; const float4 a = *(const float4*)(xin + (size_t)row * D + c);
            float4 h;
            if (MODE == 0) { const uint2 y0 = *(const uint2*)(hm + (size_t)row * D + c); h.x = bf2f((bf16_t)(y0.x & 0xffff)); h.y = bf2f((bf16_t)(y0.x >> 16)); h.z = bf2f((bf16_t)(y0.y & 0xffff)); h.w = bf2f((bf16_t)(y0.y >> 16)); }
            else { const uint2 y0 = *(const uint2*)(Y + (size_t)(row * 2) * D + c), y1 = *(const uint2*)(Y + (size_t)(row * 2 + 1) * D + c);
                h.x = bf2f((bf16_t)(y0.x & 0xffff)) + bf2f((bf16_t)(y1.x & 0xffff)); h.y = bf2f((bf16_t)(y0.x >> 16)) + bf2f((bf16_t)(y1.x >> 16));
                h.z = bf2f((bf16_t)(y0.y & 0xffff)) + bf2f((bf16_t)(y1.y & 0xffff)); h.w = bf2f((bf16_t)(y0.y >> 16)) + bf2f((bf16_t)(y1.y >> 16)); }
            v[4 * j + 0] = ALPHA * a.x + h.x; v[4 * j + 1] = ALPHA * a.y + h.y; v[4 * j + 2] = ALPHA * a.z + h.z; v[4 * j + 3] = ALPHA * a.w + h.w;
            s += (v[4 * j] + v[4 * j + 1]) + (v[4 * j + 2] + v[4 * j + 3]); }
        const float mean = wave_sum(s) * (1.f / D);
        float q = 0.f;
#pragma unroll
        for (int j = 0; j < 32; ++j) { v[j] -= mean; q += v[j] * v[j]; }
        const float rstd = 1.0f / sqrtf(wave_sum(q) * (1.f / D) + LN_EPS);
#pragma unroll
        for (int j = 0; j < 8; ++j) { const int c = 4 * lane + 256 * j; const float4 g = *(const float4*)(lng + c), b = *(const float4*)(lnb + c);
            v[4 * j + 0] = v[4 * j + 0] * rstd * g.x + b.x; v[4 * j + 1] = v[4 * j + 1] * rstd * g.y + b.y; v[4 * j + 2] = v[4 * j + 2] * rstd * g.z + b.z; v[4 * j + 3] = v[4 * j + 3] * rstd * g.w + b.w;
            *(float4*)(xf + (size_t)row * D + c) = make_float4(v[4 * j], v[4 * j + 1], v[4 * j + 2], v[4 * j + 3]);
            if (xb) { u32x2 o; o.x = pg8::cvt_pk_bf16(v[4 * j], v[4 * j + 1]); o.y = pg8::cvt_pk_bf16(v[4 * j + 2], v[4 * j + 3]); *(u32x2*)(xb + (size_t)row * D + c) = o; } }
        if (MODE == 0) {
            float gl[4] = {0.f, 0.f, 0.f, 0.f};
#pragma unroll
            for (int j = 0; j < 8; ++j)
#pragma unroll
                for (int i = 0; i < 4; ++i) { const int c = 4 * lane + 256 * j + i; const float4 w = *(const float4*)(wrg + (size_t)c * NGRP); const float x = v[4 * j + i];
                    gl[0] += x * w.x; gl[1] += x * w.y; gl[2] += x * w.z; gl[3] += x * w.w; }
#pragma unroll
            for (int g = 0; g < 4; ++g) gl[g] = wave_sum(gl[g]) + brg[g];
            int grp = 0; float gmax = gl[0];
#pragma unroll
            for (int g = 1; g < 4; ++g) if (gl[g] > gmax) { gmax = gl[g]; grp = g; }
            float gden = 0.f;
#pragma unroll
            for (int g = 0; g < 4; ++g) gden += __expf(gl[g] - gmax);
            const float pgrp = 1.0f / gden;
            float el[8] = {0.f, 0.f, 0.f, 0.f, 0.f, 0.f, 0.f, 0.f};
#pragma unroll
            for (int j = 0; j < 8; ++j)
#pragma unroll
                for (int i = 0; i < 4; ++i) { const int c = 4 * lane + 256 * j + i; const float4 w0 = *(const float4*)(wre + (size_t)c * NEXP + grp * 8), w1 = *(const float4*)(wre + (size_t)c * NEXP + grp * 8 + 4); const float x = v[4 * j + i];
                    el[0] += x * w0.x; el[1] += x * w0.y; el[2] += x * w0.z; el[3] += x * w0.w; el[4] += x * w1.x; el[5] += x * w1.y; el[6] += x * w1.z; el[7] += x * w1.w; }
#pragma unroll
            for (int e = 0; e < 8; ++e) el[e] = wave_sum(el[e]) + bre[grp * 8 + e];
            int i0 = 0; float v0 = el[0];
#pragma unroll
            for (int e = 1; e < 8; ++e) if (el[e] > v0) { v0 = el[e]; i0 = e; }
            int i1 = -1; float v1 = -3.0e38f;
#pragma unroll
            for (int e = 0; e < 8; ++e) if (e != i0 && el[e] > v1) { v1 = el[e]; i1 = e; }
            const float e1 = __expf(v1 - v0), den = 1.f + e1;
            const float g0 = pgrp / den, g1 = pgrp * e1 / den;
            if (lane == 0) {
                const int ea = grp * 8 + i0, eb = grp * 8 + i1;
                const int pa = atomicAdd(&cnt[ea], 1); list[ea * T + pa] = row * 2; tg[row * 2] = g0;
                const int pb = atomicAdd(&cnt[eb], 1); list[eb * T + pb] = row * 2 + 1; tg[row * 2 + 1] = g1;
            }
        }
    }
}


typedef float f32x2v __attribute__((ext_vector_type(2)));
__device__ __forceinline__ float wave_sum4(float& a, float& b, float& c, float& d) {
#pragma unroll
    for (int o = 1; o < 64; o <<= 1) { const float ta = __shfl_xor(a, o), tb = __shfl_xor(b, o), tc = __shfl_xor(c, o), td = __shfl_xor(d, o); a += ta; b += tb; c += tc; d += td; }
    return a;
}
__device__ __forceinline__ void ln_router_phase(const float* xin, const bf16_t* hm, const float* lng, const float* lnb, float* xf, bf16_t* xb,
                                                const float* WRt, const float* brg, const float* bre, LAS int* lhist, int* hist, int* inv, float* tg, int vcu, int G) {
    const int tid = opaque_tid(), lane = tid & 63;
    if (tid < 32) lhist[tid] = 0;
    __syncthreads();
    for (int grp4 = vcu * 8 + (tid >> 6); grp4 < T / 4; grp4 += G * 8) {
        const int row0 = grp4 * 4;
        f32x4 v[4][8];
#pragma unroll
        for (int r = 0; r < 4; ++r) {
            float s = 0.f;
#pragma unroll
            for (int j = 0; j < 8; ++j) { const int c = 4 * lane + 256 * j; const f32x4 a = *(const f32x4*)(xin + (size_t)(row0 + r) * D + c); const u32x2 y0 = *(const u32x2*)(hm + (size_t)(row0 + r) * D + c);
                f32x4 hh; hh[0] = bf2f((bf16_t)(y0.x & 0xffff)); hh[1] = bf2f((bf16_t)(y0.x >> 16)); hh[2] = bf2f((bf16_t)(y0.y & 0xffff)); hh[3] = bf2f((bf16_t)(y0.y >> 16));
                v[r][j] = a * ALPHA + hh; s += (v[r][j][0] + v[r][j][1]) + (v[r][j][2] + v[r][j][3]); }
            const float mean = wave_sum(s) * (1.f / D);
            float q = 0.f;
#pragma unroll
            for (int j = 0; j < 8; ++j) { v[r][j] = v[r][j] - mean; q += (v[r][j][0] * v[r][j][0] + v[r][j][1] * v[r][j][1]) + (v[r][j][2] * v[r][j][2] + v[r][j][3] * v[r][j][3]); }
            const float rstd = 1.0f / sqrtf(wave_sum(q) * (1.f / D) + LN_EPS);
#pragma unroll
            for (int j = 0; j < 8; ++j) { const int c = 4 * lane + 256 * j; const f32x4 g = *(const f32x4*)(lng + c), bb = *(const f32x4*)(lnb + c);
                v[r][j] = v[r][j] * rstd * g + bb;
                *(f32x4*)(xf + (size_t)(row0 + r) * D + c) = v[r][j];
                u32x2 o; o.x = pg8::cvt_pk_bf16(v[r][j][0], v[r][j][1]); o.y = pg8::cvt_pk_bf16(v[r][j][2], v[r][j][3]); *(u32x2*)(xb + (size_t)(row0 + r) * D + c) = o; }
        }
        float gm[4], gs[4], v0[4], v1[4]; int grp[4], i0[4], i1[4];
#pragma unroll
        for (int r = 0; r < 4; ++r) { gm[r] = -3.0e38f; gs[r] = 0.f; grp[r] = 0; v0[r] = -3.0e38f; v1[r] = -3.0e38f; i0[r] = 0; i1[r] = 0; }
#pragma unroll 1
        for (int o = 0; o < 36; ++o) {
            const int gi = (o - 4) >> 3, e = (o - 4) & 7;
            if (o >= 4 && gi != grp[0] && gi != grp[1] && gi != grp[2] && gi != grp[3]) continue;
            f32x4 w[8]; const float* wp = WRt + (size_t)o * D + 4 * lane;
#pragma unroll
            for (int j = 0; j < 8; ++j) w[j] = *(const f32x4*)(wp + 256 * j);
            float p[4];
#pragma unroll
            for (int r = 0; r < 4; ++r) { f32x4 acc = v[r][0] * w[0];
#pragma unroll
                for (int j = 1; j < 8; ++j) acc += v[r][j] * w[j];
                p[r] = (acc[0] + acc[1]) + (acc[2] + acc[3]); }
            wave_sum4(p[0], p[1], p[2], p[3]);
            if (o < 4) { const float bo = brg[o];
#pragma unroll
                for (int r = 0; r < 4; ++r) { const float val = p[r] + bo;
                    if (val > gm[r]) { gs[r] = gs[r] * __expf(gm[r] - val) + 1.f; gm[r] = val; grp[r] = o; } else gs[r] += __expf(val - gm[r]); }
            } else { const float be = bre[o - 4];
#pragma unroll
                for (int r = 0; r < 4; ++r) if (grp[r] == gi) { const float val = p[r] + be;
                    if (val > v0[r]) { v1[r] = v0[r]; i1[r] = i0[r]; v0[r] = val; i0[r] = e; } else if (val > v1[r]) { v1[r] = val; i1[r] = e; } }
            }
        }
#pragma unroll
        for (int r = 0; r < 4; ++r) {
            const float e1 = __expf(v1[r] - v0[r]), den = 1.f + e1, pg = 1.0f / gs[r];
            const float g0 = pg / den, g1 = pg * e1 / den;
            if (lane == 0) { const int row = row0 + r, ea = grp[r] * 8 + i0[r], eb = grp[r] * 8 + i1[r];
                const int pa = __hip_atomic_fetch_add(lhist + ea, 1, __ATOMIC_RELAXED, __HIP_MEMORY_SCOPE_WORKGROUP); inv[(vcu * 32 + ea) * 32 + pa] = row * 2; tg[row * 2] = g0;
                const int pb = __hip_atomic_fetch_add(lhist + eb, 1, __ATOMIC_RELAXED, __HIP_MEMORY_SCOPE_WORKGROUP); inv[(vcu * 32 + eb) * 32 + pb] = row * 2 + 1; tg[row * 2 + 1] = g1; }
        }
    }
    __syncthreads();
    if (tid < 32) hist[vcu * 32 + tid] = lhist[tid];
}

typedef float f32x16 __attribute__((ext_vector_type(16)));
#define MFMA32(a, b, c) __builtin_amdgcn_mfma_f32_32x32x16_bf16((a), (b), (c), 0, 0, 0)
constexpr int KRS = 144, AT_K = 0, AT_V = 256 * KRS, AT_BIAS = 2 * 256 * KRS, AT_BYTES = AT_BIAS + 8 * 128 * 4;
__device__ __forceinline__ int t5_bucket(int n) { if (n < 16) return n; int l = 16 + (int)(__logf((float)n * (1.f / 16.f)) / 2.0794415416798357f * 16.f); return l < 31 ? l : 31; }
__device__ __forceinline__ void attn_phase(LAS unsigned char* lds, const bf16_t* Qb, const bf16_t* Kc, const bf16_t* Vc, const float* sinks, const float* relb, bf16_t* Og, int vcu, int G) {
    const int tid = opaque_tid(), lane = tid & 63, wid = __builtin_amdgcn_readfirstlane(tid >> 6), r = lane & 31, h = lane >> 5;
    LAS float* biasT = (LAS float*)(lds + AT_BIAS);
    for (int unit = vcu; unit < BATCH * AT_HKV * (SEQ / 128); unit += G) {
        const int b = unit >> 6, kvh = (unit >> 4) & 3, qblk = unit & 15, hq = kvh * 8 + wid;
        const int row0 = b * SEQ + qblk * 128;
#pragma unroll
        for (int it = 0; it < 4; ++it) { const int id = tid + 512 * it, i = id >> 3, ck = id & 7;
            u32x4 kv = {0u, 0u, 0u, 0u}, vv = {0u, 0u, 0u, 0u};
            if (qblk > 0 || i >= 128) { const size_t go = (size_t)(row0 - 128 + i) * KVW + kvh * 64 + ck * 8; kv = *(const u32x4*)(Kc + go); vv = *(const u32x4*)(Vc + go); }
            *(LAS u32x4*)(lds + AT_K + i * KRS + ck * 16) = kv; *(LAS u32x4*)(lds + AT_V + i * KRS + ck * 16) = vv; }
        for (int id = tid; id < 1024; id += 512) biasT[id] = relb[t5_bucket(id & 127) * AT_HQ + kvh * 8 + (id >> 7)];
        __syncthreads();
        const float sink = sinks[hq];
        for (int qs = 0; qs < 4; ++qs) {
            bf16x8 qf[4]; { const bf16_t* qp = Qb + (size_t)(row0 + 32 * qs + r) * D + hq * 64 + 8 * h;
#pragma unroll
                for (int ks = 0; ks < 4; ++ks) qf[ks] = *(const bf16x8*)(qp + 16 * ks); }
            f32x16 S[5];
#pragma unroll
            for (int kbi = 0; kbi < 5; ++kbi) {
#pragma unroll
                for (int e = 0; e < 16; ++e) S[kbi][e] = 0.f;
#pragma unroll
                for (int ks = 0; ks < 4; ++ks) S[kbi] = MFMA32(*(const LAS bf16x8*)(lds + AT_K + (32 * (qs + kbi) + r) * KRS + (16 * ks + 8 * h) * 2), qf[ks], S[kbi]); }
            float m = -1e30f;
#pragma unroll
            for (int kbi = 0; kbi < 5; ++kbi)
#pragma unroll
                for (int e = 0; e < 16; ++e) { const int keyb = 32 * (qs + kbi) + (e & 3) + 8 * (e >> 2) + 4 * h, dist = 128 + 32 * qs + r - keyb;
                    const bool valid = dist >= 0 && dist < 128 && (qblk > 0 || keyb >= 128);
                    const float sv = valid ? S[kbi][e] * 0.125f + biasT[wid * 128 + (dist & 127)] : -1e30f;
                    S[kbi][e] = sv; m = fmaxf(m, sv); }
            m = fmaxf(m, __shfl_xor(m, 32)); m = fmaxf(m, sink);
            float l = 0.f;
#pragma unroll
            for (int kbi = 0; kbi < 5; ++kbi)
#pragma unroll
                for (int e = 0; e < 16; ++e) { const float pv = __expf(S[kbi][e] - m); S[kbi][e] = pv; l += pv; }
            l += __shfl_xor(l, 32); l += __expf(sink - m);
            f32x16 O[2];
#pragma unroll
            for (int e = 0; e < 16; ++e) { O[0][e] = 0.f; O[1][e] = 0.f; }
            const int i16 = lane & 15, qq = i16 >> 2, pp = i16 & 3, gg = (lane >> 4) & 1;
#pragma unroll
            for (int kbi = 0; kbi < 5; ++kbi)
#pragma unroll
                for (int s2 = 0; s2 < 2; ++s2) {
                    u32x4 pk; pk.x = pg8::cvt_pk_bf16(S[kbi][8 * s2 + 0], S[kbi][8 * s2 + 1]); pk.y = pg8::cvt_pk_bf16(S[kbi][8 * s2 + 2], S[kbi][8 * s2 + 3]);
                    pk.z = pg8::cvt_pk_bf16(S[kbi][8 * s2 + 4], S[kbi][8 * s2 + 5]); pk.w = pg8::cvt_pk_bf16(S[kbi][8 * s2 + 6], S[kbi][8 * s2 + 7]);
                    const bf16x8 pf = __builtin_bit_cast(bf16x8, pk);
#pragma unroll
                    for (int db = 0; db < 2; ++db) { const LAS unsigned char* va = lds + AT_V + (32 * (qs + kbi) + 16 * s2 + 4 * h + qq) * KRS + (32 * db + 16 * gg + 4 * pp) * 2;
                        const s16x4 lo = __builtin_amdgcn_ds_read_tr16_b64_v4i16((lds_s16x4*)va), hi = __builtin_amdgcn_ds_read_tr16_b64_v4i16((lds_s16x4*)(va + 8 * KRS));
                        const bf16x8 vf = {lo[0], lo[1], lo[2], lo[3], hi[0], hi[1], hi[2], hi[3]};
                        O[db] = MFMA32(vf, pf, O[db]); } }
            const float inv = 1.0f / l;
            bf16_t* op = Og + (size_t)(row0 + 32 * qs + r) * D + hq * 64 + 4 * h;
#pragma unroll
            for (int db = 0; db < 2; ++db)
#pragma unroll
                for (int g4 = 0; g4 < 4; ++g4) { f32x4 v; v[0] = O[db][4 * g4] * inv; v[1] = O[db][4 * g4 + 1] * inv; v[2] = O[db][4 * g4 + 2] * inv; v[3] = O[db][4 * g4 + 3] * inv;
                    *(u32x2*)(op + 32 * db + 8 * g4) = pack4(v); }
        }
        __syncthreads();
    }
}

constexpr int LDS_STAGE = 0;
constexpr int LDS_MOETAB = pg8::STAGE_BYTES;
constexpr int LDS_MISC = LDS_MOETAB + pg8::MOE_TAB_INTS * 4;
constexpr int LDS_BYTES = 147456;
static_assert(LDS_MISC + 256 <= LDS_BYTES && H1_BYTES <= pg8::STAGE_BYTES && 8 * 8448 <= pg8::STAGE_BYTES && AT_BYTES <= pg8::STAGE_BYTES, "LDS map");
constexpr int CW_BAR = 4096;
constexpr int N_PHASES = 1 + NA * 9 + (DEPTH - NA) * 7;

struct MegaArgs { const float* in[19]; float* out; unsigned char* ws; int ph_lo, ph_hi; };

__global__ void __launch_bounds__(512, 2) mega_fwd(MegaArgs args) {
    extern __shared__ __attribute__((aligned(16))) unsigned char lds_raw[];
    LAS unsigned char* lds = (LAS unsigned char*)lds_raw;
    volatile LAS unsigned* MISC = (volatile LAS unsigned*)(lds + LDS_MISC);
    const int tid = threadIdx.x, G = gridDim.x, bx = blockIdx.x, vcu = (G % 8 == 0) ? (bx % 8) * (G / 8) + bx / 8 : bx;
    unsigned char* const ws = args.ws;
    if (tid < 64) MISC[tid] = 0u;
    __syncthreads();
    const int lo = args.ph_lo, hi = args.ph_hi;
    XcdBarrier bar; bar.bar = (unsigned*)(ws + WS_CTL) + CW_BAR; bar.x = 0; bar.st = nullptr;
    if (hi - lo > 1) bar = xcd_barrier_post((unsigned*)(ws + WS_CTL) + CW_BAR, MISC + 8);
#define WSP(type, off) ((type*)(args.ws + (off)))
    int ph = 0;
#ifndef PROBE_DUP
#define PROBE_DUP 0
#endif
#define PHASE_T(dupbit, trash_body, ...) if (lo <= ph && ph < hi) { if ((PROBE_DUP >> (dupbit)) & 1) { trash_body; xcd_barrier(bar); } __VA_ARGS__; if (ph + 1 < hi) xcd_barrier(bar); } ++ph;
#define PHASE(dupbit, ...) if (lo <= ph && ph < hi) { __VA_ARGS__; if ((PROBE_DUP >> (dupbit)) & 1) { xcd_barrier(bar); __VA_ARGS__; } if (ph + 1 < hi) xcd_barrier(bar); } ++ph;

    PHASE(0, { Ptrs p; p.x = args.in[0]; p.a_w_in = args.in[1]; p.a_w_out = args.in[4]; p.b_w_kv = args.in[5]; p.b_w_q = args.in[6]; p.b_w_out = args.in[8]; p.w_gate = args.in[14]; p.w_up = args.in[15]; p.w_down = args.in[16]; p.w_rg = args.in[10]; p.w_re = args.in[12]; p.ws = args.ws;
               prologue_phase(lds, p, vcu, G); })

    for (int L = 0; L < DEPTH; ++L) {
        if (L < NA) {
            PHASE(1, { pg8::DenseSched S; S.init(T, 4 * D, D, G, bx); pg8::EpiHgrn E{WSP(bf16_t, WS_QB), WSP(bf16_t, WS_KB), WSP(bf16_t, WS_VB), WSP(bf16_t, WS_GT), WSP(float, WS_GL), args.in[2], L, 0};
                       pg8::gemm_phase<pg8::EpiHgrn, pg8::DenseSched>(lds, WSP(bf16_t, WS_XB), WSP(bf16_t, WS_WIN) + (size_t)L * 4 * D * D, D, 0, S, E); })
#define HGARGS HgArgs{WSP(bf16_t, WS_QB), WSP(bf16_t, WS_KB), WSP(bf16_t, WS_VB), WSP(bf16_t, WS_GT), WSP(bf16_t, WS_OF), WSP(bf16_t, WS_UT), WSP(bf16_t, WS_SST), WSP(bf16_t, WS_OG), WSP(float, WS_GL), WSP(float, WS_DG), args.in[3] + (size_t)L * D, WSP(bf16_t, WS_QB)}
            PHASE_T(6, { HgArgs ha = HGARGS; ha.Qt = WSP(bf16_t, WS_TRASH); ha.OI = WSP(bf16_t, WS_TRASH + 32 * MiB); ha.UT = WSP(bf16_t, WS_TRASH + 64 * MiB); ha.Dg = WSP(float, WS_TRASH + 128 * MiB); h1_phase(lds, ha, vcu, G); },
                    { const HgArgs ha = HGARGS; h1_phase(lds, ha, vcu, G); })
            PHASE(3, { const HgArgs ha = HGARGS; h2_phase(ha, vcu, G); })
            PHASE(3, { const HgArgs ha = HGARGS; h3_phase(ha, vcu, G); })
            PHASE(1, { pg8::DenseSched S; S.init(T, D, D, G, bx); pg8::EpiStore E{WSP(bf16_t, WS_HM), WSP(bf16_t, WS_HM), D, 1 << 30, 1.0f, 0};
                       pg8::gemm_phase<pg8::EpiStore, pg8::DenseSched>(lds, WSP(bf16_t, WS_OG), WSP(bf16_t, WS_WOUT) + (size_t)L * D * D, D, 0, S, E); })
        } else {
            const int j = L - NA;
            PHASE(1, { if (j == 0) { pg8::DenseSched S; S.init(T, 2 * KVW, D, G, bx); pg8::EpiStore E{WSP(bf16_t, WS_KC), WSP(bf16_t, WS_VC), KVW, 1, 1.0f, 0};
                                     pg8::gemm_phase<pg8::EpiStore, pg8::DenseSched>(lds, WSP(bf16_t, WS_XB), WSP(bf16_t, WS_WKV), D, 0, S, E); }
                       pg8::DenseSched S; S.init(T, D, D, G, bx); pg8::EpiStore E{WSP(bf16_t, WS_QB), WSP(bf16_t, WS_QB), D, 1 << 30, 1.0f, 0};
                       pg8::gemm_phase<pg8::EpiStore, pg8::DenseSched>(lds, WSP(bf16_t, WS_XB), WSP(bf16_t, WS_WQ) + (size_t)j * D * D, D, 0, S, E); })
            PHASE(3, attn_phase(lds, WSP(bf16_t, WS_QB), WSP(bf16_t, WS_KC), WSP(bf16_t, WS_VC), args.in[7] + j * AT_HQ, args.in[9], WSP(bf16_t, WS_OG), vcu, G))
            PHASE(1, { pg8::DenseSched S; S.init(T, D, D, G, bx); pg8::EpiStore E{WSP(bf16_t, WS_HM), WSP(bf16_t, WS_HM), D, 1 << 30, 1.0f, 0};
                       pg8::gemm_phase<pg8::EpiStore, pg8::DenseSched>(lds, WSP(bf16_t, WS_OG), WSP(bf16_t, WS_WO) + (size_t)j * D * D, D, 0, S, E); })
        }
        PHASE_T(4, ln_router_phase(L == 0 ? args.in[0] : WSP(float, WS_XF), WSP(bf16_t, WS_HM), args.in[17] + (size_t)(2 * L) * D, args.in[18] + (size_t)(2 * L) * D, WSP(float, WS_TRASH), WSP(bf16_t, WS_TRASH + 64 * MiB), WSP(float, WS_WR) + (size_t)L * 36 * D, args.in[11] + L * NGRP, args.in[13] + L * NEXP, (LAS int*)lds, WSP(int, WS_TRASH + 100 * MiB), WSP(int, WS_TRASH + 96 * MiB), WSP(float, WS_TRASH + 98 * MiB), vcu, G),
                ln_router_phase(L == 0 ? args.in[0] : WSP(float, WS_XF), WSP(bf16_t, WS_HM), args.in[17] + (size_t)(2 * L) * D, args.in[18] + (size_t)(2 * L) * D, WSP(float, WS_XF), WSP(bf16_t, WS_XB), WSP(float, WS_WR) + (size_t)L * 36 * D, args.in[11] + L * NGRP, args.in[13] + L * NEXP, (LAS int*)lds, WSP(int, WS_HIST), WSP(int, WS_LIST), WSP(float, WS_TG), vcu, G))
        PHASE(2, { LAS int* tab = (LAS int*)(lds + LDS_MOETAB); pg8::MoeSched S{tab, 4, G, vcu, D, 1}; S.build(tab, (LAS int*)lds, WSP(int, WS_HIST), WSP(int, WS_LIST));
                   pg8::gemm_phase<pg8::EpiMoeH, pg8::MoeSched>(lds, WSP(bf16_t, WS_XB), WSP(bf16_t, WS_WGU) + (size_t)L * NEXP * 2 * DEXP * D, D, (size_t)2 * DEXP * D * 2, S, pg8::EpiMoeH{WSP(bf16_t, WS_HS)}); })
        PHASE(2, { LAS int* tab = (LAS int*)(lds + LDS_MOETAB); pg8::MoeSched S{tab, 8, G, vcu, DEXP, 0}; S.build(tab, (LAS int*)lds, WSP(int, WS_HIST), WSP(int, WS_LIST));
                   pg8::gemm_phase<pg8::EpiMoeY, pg8::MoeSched>(lds, WSP(bf16_t, WS_HS), WSP(bf16_t, WS_WD) + (size_t)L * NEXP * D * DEXP, DEXP, (size_t)D * DEXP * 2, S, pg8::EpiMoeY{WSP(bf16_t, WS_Y), WSP(float, WS_TG), S}); })
        PHASE_T(5, ln_phase<1>(WSP(float, WS_XF), nullptr, WSP(bf16_t, WS_Y), args.in[17] + (size_t)(2 * L + 1) * D, args.in[18] + (size_t)(2 * L + 1) * D, WSP(float, WS_TRASH), WSP(bf16_t, WS_TRASH + 64 * MiB),
                             nullptr, nullptr, nullptr, nullptr, nullptr, nullptr, nullptr, vcu, G),
                ln_phase<1>(WSP(float, WS_XF), nullptr, WSP(bf16_t, WS_Y), args.in[17] + (size_t)(2 * L + 1) * D, args.in[18] + (size_t)(2 * L + 1) * D, L == DEPTH - 1 ? args.out : WSP(float, WS_XF), L == DEPTH - 1 ? nullptr : WSP(bf16_t, WS_XB),
                             nullptr, nullptr, nullptr, nullptr, nullptr, nullptr, nullptr, vcu, G))
    }
#undef HGARGS
#undef WSP
#undef PHASE
#undef PHASE_T
}

#ifndef MK_PER_PHASE
#define MK_PER_PHASE 0
#endif
extern "C" void kernel_launch(void* const* d_in, const int* in_sizes, int n_in, void* d_out, int out_size, void* d_ws, size_t ws_size, hipStream_t stream) {
    static int grid = 0;
    if (grid == 0) {
        if (n_in != 19 || out_size != T * D || ws_size < WS_END) { fprintf(stderr, "kernel_launch: unexpected arguments (n_in %d, out %d, ws %zu < %zu)\n", n_in, out_size, ws_size, (size_t)WS_END); grid = -1; return; }
        int dev = 0, cus = 0, per_cu = 0;
        if (hipGetDevice(&dev) != hipSuccess || hipDeviceGetAttribute(&cus, hipDeviceAttributeMultiprocessorCount, dev) != hipSuccess) { grid = -1; return; }
        if (hipFuncSetAttribute((const void*)mega_fwd, hipFuncAttributeMaxDynamicSharedMemorySize, LDS_BYTES) != hipSuccess) { fprintf(stderr, "kernel_launch: hipFuncSetAttribute failed\n"); grid = -1; return; }
        if (hipOccupancyMaxActiveBlocksPerMultiprocessor(&per_cu, (const void*)mega_fwd, 512, LDS_BYTES) != hipSuccess || per_cu < 1) { fprintf(stderr, "kernel_launch: occupancy query reports %d\n", per_cu); }
        (void)hipGetLastError();
        grid = cus;
        if (grid != 256) { fprintf(stderr, "kernel_launch: built for 256 CUs (the routing tables assume 256 workgroups of 32 token rows); this device reports %d\n", cus); grid = -1; return; }
    }
    if (grid < 0) return;
    (void)hipMemsetAsync((char*)d_ws + WS_CTL, 0, CTL_BYTES, stream);
    MegaArgs a{};
    for (int i = 0; i < 19; ++i) a.in[i] = (const float*)d_in[i];
    a.out = (float*)d_out; a.ws = (unsigned char*)d_ws;
#if MK_PER_PHASE
    for (int ph = 0; ph < N_PHASES; ++ph) { a.ph_lo = ph; a.ph_hi = ph + 1; hipLaunchKernelGGL(mega_fwd, dim3(grid), dim3(512), LDS_BYTES, stream, a); }
#else
    a.ph_lo = 0; a.ph_hi = N_PHASES;
    hipLaunchKernelGGL(mega_fwd, dim3(grid), dim3(512), LDS_BYTES, stream, a);
#endif
}
```

```cpp
#include <hip/hip_runtime.h>
#include <cstdio>
#include <cstdint>

typedef unsigned short bf16_t;
typedef short bf16x8 __attribute__((ext_vector_type(8)));
typedef float f32x4 __attribute__((ext_vector_type(4)));

constexpr int BATCH = 4, SEQ = 2048, D = 2048, T = BATCH * SEQ, DEPTH = 4, NA = 2;
constexpr int HG_H = 16, HG_DK = 128;
constexpr int AT_HD = 64, AT_HQ = 32, AT_HKV = 4, AT_G = 8, KVW = AT_HKV * AT_HD;
constexpr int NGRP = 4, EPG = 8, NEXP = 32, DEXP = 512;
constexpr float ALPHA = 1.6817928305074290f;
constexpr float LN_EPS = 1e-5f, RMS_EPS = 1e-6f;

constexpr size_t MiB = 1u << 20;
constexpr size_t WS_CTL = 0, CTL_BYTES = 1 * MiB;
constexpr size_t WS_XF = 1 * MiB;
constexpr size_t WS_XB = WS_XF + 64 * MiB;
constexpr size_t WS_QB = WS_XB + 32 * MiB;
constexpr size_t WS_KB = WS_QB + 32 * MiB;
constexpr size_t WS_VB = WS_KB + 32 * MiB;
constexpr size_t WS_GT = WS_VB + 32 * MiB;
constexpr size_t WS_GL = WS_GT + 32 * MiB;
constexpr size_t WS_OF = WS_GL + 64 * MiB;
constexpr size_t WS_OG = WS_OF + 64 * MiB;
constexpr size_t WS_HM = WS_OG + 32 * MiB;
constexpr size_t WS_KC = WS_HM + 32 * MiB;
constexpr size_t WS_VC = WS_KC + 4 * MiB;
constexpr size_t WS_LIST = WS_VC + 4 * MiB;
constexpr size_t WS_TG = WS_LIST + 1 * MiB;
constexpr size_t WS_HS = WS_TG + 1 * MiB;
constexpr size_t WS_Y = WS_HS + 24 * MiB;
constexpr size_t WS_WIN = WS_Y + 64 * MiB;
constexpr size_t WS_WOUT = WS_WIN + 64 * MiB;
constexpr size_t WS_WKV = WS_WOUT + 16 * MiB;
constexpr size_t WS_WQ = WS_WKV + 2 * MiB;
constexpr size_t WS_WO = WS_WQ + 16 * MiB;
constexpr size_t WS_WGU = WS_WO + 16 * MiB;
constexpr size_t WS_WD = WS_WGU + 512 * MiB;
constexpr size_t WS_UT = WS_WD + 256 * MiB;
constexpr size_t WS_SST = WS_UT + 64 * MiB;
constexpr size_t WS_DG = WS_SST + 64 * MiB;
constexpr size_t WS_WR = WS_DG + 1 * MiB;
constexpr size_t WS_XF2 = WS_WR + 2 * MiB;
constexpr size_t WS_HIST = WS_XF2 + 64 * MiB;
constexpr size_t WS_TRASH = WS_HIST + 1 * MiB;
constexpr size_t WS_END = WS_TRASH + 256 * MiB;
constexpr int CW_CNT = 1024;

__device__ __forceinline__ unsigned f2bf(float f) { unsigned u = __builtin_bit_cast(unsigned, f); return (u + 0x7fffu + ((u >> 16) & 1u)) >> 16; }
__device__ __forceinline__ float bf2f(bf16_t b) { return __builtin_bit_cast(float, ((unsigned)b) << 16); }
__device__ __forceinline__ float wave_sum(float v) {
#pragma unroll
    for (int o = 1; o < 64; o <<= 1) v += __shfl_xor(v, o);
    return v;
}
__device__ __forceinline__ float wave_max(float v) {
#pragma unroll
    for (int o = 1; o < 64; o <<= 1) v = fmaxf(v, __shfl_xor(v, o));
    return v;
}
__device__ __forceinline__ float sigmoidf_(float x) { return 1.0f / (1.0f + __expf(-x)); }
__device__ __forceinline__ int opaque_tid() { int t = threadIdx.x; asm volatile("" : "+v"(t)); return t; }

#define LAS __attribute__((address_space(3)))
typedef unsigned u32x4 __attribute__((ext_vector_type(4)));
namespace pg8 {
constexpr int BM = 256, BK = 64, HALF = 128, HTB = HALF * BK * 2, STAGE_BYTES = 8 * HTB;
__host__ __device__ __forceinline__ int lds_byte(int r, int c) { const int st = (r >> 4) * 2 + (c >> 5), rr = r & 15, cc = c & 31, ob = rr * 64 + cc * 2; return st * 1024 + (ob ^ (((ob >> 9) & 1) << 5)); }
__host__ __device__ __forceinline__ void stage_rc(int b, int& R, int& C) { const int st = b / 1024, sb = b % 1024, swz = sb ^ (((sb >> 9) & 1) << 5); R = (st >> 1) * 16 + swz / 64; C = (st & 1) * 32 + (swz % 64) / 2; }
__host__ __device__ __forceinline__ int perm32(int rho) { const int n = rho >> 4, i = rho & 15; return 8 * (i >> 2) + 4 * n + (i & 3); }
struct Unit { int pm, pn, e, rows, tm, ui; };
typedef float f32x2_ __attribute__((ext_vector_type(2)));
typedef __bf16 bf16x2_ __attribute__((ext_vector_type(2)));
__device__ __forceinline__ unsigned cvt_pk_bf16(float lo, float hi) { const f32x2_ v = {lo, hi}; return __builtin_bit_cast(unsigned, __builtin_convertvector(v, bf16x2_)); }

struct DenseSched {
    int nM, nN, nwg, G, c, K;
    __device__ __forceinline__ void init(int M, int N, int K_, int G_, int c_) { nM = M / BM; nN = N / BM; nwg = nM * nN; G = G_; c = c_; K = K_; }
    __device__ __forceinline__ bool next(int i, Unit& u) const {
        const long L = (long)i * G + c; if (L >= nwg) return false;
        int wgid = (int)L; { const int q = nwg / 8, r = nwg % 8, xcd = wgid % 8, off = wgid / 8; wgid = (xcd < r ? xcd * (q + 1) : r * (q + 1) + (xcd - r) * q) + off; }
        const int nig = 8 * nN, gid = wgid / nig, fm = gid * 8, gsz = (nM - fm) < 8 ? (nM - fm) : 8;
        u.pm = fm + ((wgid % nig) % gsz); u.pn = (wgid % nig) / gsz; u.e = 0; u.rows = 256; u.tm = 0; u.ui = i; return true;
    }
    __device__ __forceinline__ unsigned a_off(const Unit& u, int half, int R) const { return (unsigned)((u.pm * 256 + half * 128 + R) * K) * 2u; }
};

template <class Epi, class Sched>
__device__ __forceinline__ void gemm_phase(LAS unsigned char* lds, const bf16_t* A, const bf16_t* Bt, int K, size_t bstride, const Sched& S, const Epi& E) {
    const int tid = opaque_tid(), wid = __builtin_amdgcn_readfirstlane(tid >> 6), lane = tid & 63, wr = wid >> 2, wc = wid & 3, fr = lane & 15, fq = lane >> 4;
    const int nt = K / BK;
    int sR[2], sC2[2]; unsigned voffB[2];
#pragma unroll
    for (int i = 0; i < 2; ++i) { int R, C; stage_rc(tid * 16 + i * 8192, R, C); const int Rb = (R & ~31) + perm32(R & 31); sR[i] = R; sC2[i] = C * 2; voffB[i] = (unsigned)(Rb * K + C) * 2u; }
    const size_t kstep = (size_t)(BK * 2);
    const size_t hstep = (size_t)HALF * K * 2;
    const size_t tstep = 2 * hstep;
    const unsigned ldsw = (unsigned)wid * 1024u;
    const int aoff = lds_byte(wr * 64 + fr, fq * 8), boff = lds_byte(wc * 32 + fr, fq * 8);
#define PG8_SA(b, h) (((b) * 2 + (h)) * HTB)
#define PG8_SB(b, h) ((4 + (b) * 2 + (h)) * HTB)
#define PG8_STAGE(bufoff, gbase, voff) do { _Pragma("unroll") for (int _i = 0; _i < 2; ++_i) \
        __builtin_amdgcn_global_load_lds((const unsigned*)((const char*)(gbase) + (voff)[_i]), (LAS unsigned*)(lds + (bufoff) + ldsw + _i * 8192), 16, 0, 0); } while (0)
#define PG8_LDA(dst, b, h) do { _Pragma("unroll") for (int m = 0; m < 4; ++m) _Pragma("unroll") for (int k = 0; k < 2; ++k) dst[m][k] = *(const LAS bf16x8*)(lds + PG8_SA(b, h) + aoff + m * 2048 + k * 1024); } while (0)
#define PG8_LDB(dst, b, h) do { _Pragma("unroll") for (int n = 0; n < 2; ++n) _Pragma("unroll") for (int k = 0; k < 2; ++k) dst[n][k] = *(const LAS bf16x8*)(lds + PG8_SB(b, h) + boff + n * 2048 + k * 1024); } while (0)
#define PG8_MMA(ai, bj, At, Bt_) do { __builtin_amdgcn_s_setprio(1); _Pragma("unroll") for (int m = 0; m < 4; ++m) _Pragma("unroll") for (int n = 0; n < 2; ++n) _Pragma("unroll") for (int k = 0; k < 2; ++k) \
        acc[ai][bj][m][n] = __builtin_amdgcn_mfma_f32_16x16x32_bf16(Bt_[n][k], At[m][k], acc[ai][bj][m][n], 0, 0, 0); __builtin_amdgcn_s_setprio(0); } while (0)
#define PG8_WAIT_V(n) asm volatile("s_waitcnt vmcnt(" #n ")" ::: "memory")
#define PG8_WAIT_L(n) asm volatile("s_waitcnt lgkmcnt(" #n ")" ::: "memory")
#define PG8_BAR __builtin_amdgcn_s_barrier()
#define PG8_SCHED __builtin_amdgcn_sched_barrier(0)
    Unit cur, nxt; int ui = 0;
    if (!S.next(0, cur)) return;
    f32x4 acc[2][2][4][2];
#pragma unroll
    for (int a = 0; a < 2; ++a)
#pragma unroll
        for (int b = 0; b < 2; ++b)
#pragma unroll
            for (int m = 0; m < 4; ++m)
#pragma unroll
                for (int n = 0; n < 2; ++n) acc[a][b][m][n] = (f32x4){0.f, 0.f, 0.f, 0.f};
    bf16x8 At[4][2], B0[2][2], B1[2][2];
    unsigned voffA0[2], voffA1[2];
#pragma unroll
    for (int i = 0; i < 2; ++i) { voffA0[i] = S.a_off(cur, 0, sR[i]) + sC2[i]; voffA1[i] = S.a_off(cur, 1, sR[i]) + sC2[i]; }
    const char* const Ab = (const char*)A;
    const char* cB = (const char*)Bt + (size_t)cur.e * bstride + (size_t)cur.pn * tstep;
    PG8_STAGE(PG8_SB(0, 0), cB, voffB); PG8_STAGE(PG8_SB(0, 1), cB + hstep, voffB); PG8_STAGE(PG8_SA(0, 0), Ab, voffA0); PG8_STAGE(PG8_SA(0, 1), Ab, voffA1);
    if (wr == 1) PG8_BAR;
    PG8_WAIT_V(2); PG8_BAR;
    PG8_STAGE(PG8_SB(1, 0), cB + kstep, voffB); PG8_STAGE(PG8_SA(1, 0), Ab + kstep, voffA0); PG8_STAGE(PG8_SB(1, 1), cB + hstep + kstep, voffB);
    PG8_WAIT_V(6); PG8_BAR;
    for (;;) {
        const bool has_next = S.next(ui + 1, nxt);
        const char* nB = has_next ? (const char*)Bt + (size_t)nxt.e * bstride + (size_t)nxt.pn * tstep : cB;
        for (int t = 0; t < nt; t += 2) {
            const bool last = (t == nt - 2);
            const char* a1 = Ab + (size_t)(t + 1) * kstep;
            const char* a2 = last ? Ab : Ab + (size_t)(t + 2) * kstep; const char* b2 = last ? nB : cB + (size_t)(t + 2) * kstep;
            const char* a3 = a2 + kstep; const char* b3 = b2 + kstep;
            PG8_LDB(B0, 0, 0); PG8_LDB(B1, 0, 1); PG8_SCHED; PG8_LDA(At, 0, 0); PG8_STAGE(PG8_SA(1, 1), a1, voffA1);
            if (last && has_next) {
#pragma unroll
                for (int i = 0; i < 2; ++i) { voffA0[i] = S.a_off(nxt, 0, sR[i]) + sC2[i]; voffA1[i] = S.a_off(nxt, 1, sR[i]) + sC2[i]; }
            }
            PG8_WAIT_V(8); PG8_WAIT_L(0); PG8_BAR; PG8_MMA(0, 0, At, B0); PG8_MMA(0, 1, At, B1); PG8_BAR; PG8_SCHED;
            PG8_LDA(At, 0, 1); PG8_STAGE(PG8_SB(0, 0), b2, voffB); PG8_STAGE(PG8_SB(0, 1), b2 + hstep, voffB); PG8_STAGE(PG8_SA(0, 0), a2, voffA0);
            PG8_WAIT_V(8); PG8_WAIT_L(0); PG8_BAR; PG8_MMA(1, 0, At, B0); PG8_MMA(1, 1, At, B1); PG8_BAR; PG8_SCHED;
            PG8_LDB(B0, 1, 0); PG8_LDB(B1, 1, 1); PG8_SCHED; PG8_LDA(At, 1, 0); PG8_STAGE(PG8_SA(0, 1), a2, voffA1);
            PG8_WAIT_V(8); PG8_WAIT_L(0); PG8_BAR; PG8_MMA(0, 0, At, B0); PG8_MMA(0, 1, At, B1); PG8_BAR; PG8_SCHED;
            PG8_LDA(At, 1, 1); PG8_STAGE(PG8_SB(1, 0), b3, voffB); PG8_STAGE(PG8_SB(1, 1), b3 + hstep, voffB); PG8_STAGE(PG8_SA(1, 0), a3, voffA0);
            PG8_WAIT_V(8); PG8_WAIT_L(0); PG8_BAR; PG8_MMA(1, 0, At, B0); PG8_MMA(1, 1, At, B1); PG8_BAR; PG8_SCHED;
        }
        if (wr == 0) PG8_BAR;
        E(acc, cur, wr, wc, fr, fq);
        if (!has_next) break;
#pragma unroll
        for (int a = 0; a < 2; ++a)
#pragma unroll
            for (int b = 0; b < 2; ++b)
#pragma unroll
                for (int m = 0; m < 4; ++m)
#pragma unroll
                    for (int n = 0; n < 2; ++n) acc[a][b][m][n] = (f32x4){0.f, 0.f, 0.f, 0.f};
        cur = nxt; cB = nB; ++ui;
        if (wr == 1) PG8_BAR;
    }
    PG8_WAIT_V(0);
    PG8_BAR;
#undef PG8_SA
#undef PG8_SB
#undef PG8_STAGE
#undef PG8_LDA
#undef PG8_LDB
#undef PG8_MMA
#undef PG8_WAIT_V
#undef PG8_WAIT_L
#undef PG8_BAR
#undef PG8_SCHED
}

#define PG8_ROWS_COLS const int row0 = u.pm * BM + wr * 64 + fr; const int col0 = wc * 32 + 8 * fq
__device__ __forceinline__ u32x4 pack8(const f32x4 v0, const f32x4 v1) { u32x4 w; w.x = cvt_pk_bf16(v0[0], v0[1]); w.y = cvt_pk_bf16(v0[2], v0[3]); w.z = cvt_pk_bf16(v1[0], v1[1]); w.w = cvt_pk_bf16(v1[2], v1[3]); return w; }
struct EpiStore {
    bf16_t* O; bf16_t* O2; int ldc, split; float scale; int pad;
    __device__ __forceinline__ void operator()(const f32x4 (&acc)[2][2][4][2], const Unit& u, int wr, int wc, int fr, int fq) const {
        PG8_ROWS_COLS; bf16_t* base = u.pn >= split ? O2 + (size_t)(u.pn - split) * BM : O + (size_t)u.pn * BM;
#pragma unroll
        for (int ai = 0; ai < 2; ++ai)
#pragma unroll
            for (int m = 0; m < 4; ++m) { bf16_t* rowp = base + (size_t)(row0 + ai * HALF + m * 16) * ldc + col0;
#pragma unroll
                for (int bj = 0; bj < 2; ++bj) *(u32x4*)(rowp + bj * HALF) = pack8(acc[ai][bj][m][0] * scale, acc[ai][bj][m][1] * scale); }
    }
};
struct EpiHgrn {
    bf16_t *Qb, *Kb, *Vb, *Gt; float* Gl; const float* lbraw; int layer, pad;
    __device__ __forceinline__ void operator()(const f32x4 (&acc)[2][2][4][2], const Unit& u, int wr, int wc, int fr, int fq) const {
        PG8_ROWS_COLS; const int seg = u.pn >> 3, ct = (u.pn & 7) * BM + col0;
        if (seg == 0 || seg == 2) { bf16_t* base = (seg == 0 ? Qb : Vb) + ct;
#pragma unroll
            for (int ai = 0; ai < 2; ++ai)
#pragma unroll
                for (int m = 0; m < 4; ++m) { bf16_t* rowp = base + (size_t)(row0 + ai * HALF + m * 16) * D;
#pragma unroll
                    for (int bj = 0; bj < 2; ++bj) *(u32x4*)(rowp + bj * HALF) = pack8(acc[ai][bj][m][0], acc[ai][bj][m][1]); }
        } else if (seg == 3) {
#pragma unroll
            for (int ai = 0; ai < 2; ++ai)
#pragma unroll
                for (int m = 0; m < 4; ++m) { bf16_t* rowp = Gt + ct + (size_t)(row0 + ai * HALF + m * 16) * D;
#pragma unroll
                    for (int bj = 0; bj < 2; ++bj) { f32x4 v[2];
#pragma unroll
                        for (int n = 0; n < 2; ++n)
#pragma unroll
                            for (int j = 0; j < 4; ++j) { const float x = acc[ai][bj][m][n][j]; v[n][j] = x * sigmoidf_(x); }
                        *(u32x4*)(rowp + bj * HALF) = pack8(v[0], v[1]); } }
        } else {
#pragma unroll
            for (int bj = 0; bj < 2; ++bj) { float lb[8];
#pragma unroll
                for (int j = 0; j < 8; ++j) { const int c = ct + bj * HALF + j; lb[j] = layer == 0 ? 0.f : sigmoidf_(lbraw[D + c] - lbraw[c]); }
#pragma unroll
                for (int ai = 0; ai < 2; ++ai)
#pragma unroll
                    for (int m = 0; m < 4; ++m) { const size_t o = (size_t)(row0 + ai * HALF + m * 16) * D + ct + bj * HALF; f32x4 kv[2], gv[2];
#pragma unroll
                        for (int n = 0; n < 2; ++n)
#pragma unroll
                            for (int j = 0; j < 4; ++j) { const float l = lb[4 * n + j], sg = sigmoidf_(acc[ai][bj][m][n][j]); gv[n][j] = __log2f(fmaxf(l + (1.f - l) * sg, 1e-30f));   kv[n][j] = (1.f - l) * (1.f - sg); }
                        *(u32x4*)(Kb + o) = pack8(kv[0], kv[1]); *(f32x4*)(Gl + o) = gv[0]; *(f32x4*)(Gl + o + 4) = gv[1]; } }
        }
    }
};


constexpr int MOE_MAXU = 4, MOE_TAB_INTS = 128 + 256 * MOE_MAXU;
struct MoeSched {
    const LAS int* tab; int NT, G, c, K, gather;
    __device__ __forceinline__ bool next(int i, Unit& u) const {
        const int L = i * G + c, TM = tab[32]; if (L >= TM * NT) return false;
        const int mt = L / NT; int e = 0; while (tab[e + 1] <= mt) ++e;
        u.pm = mt; u.pn = L - mt * NT; u.e = e; u.tm = mt - tab[e]; const int left = tab[64 + e] - 256 * u.tm; u.rows = left < 256 ? left : 256; u.ui = i; return true;
    }
    __device__ __forceinline__ int entry(const Unit& u, int r) const {
        const int a = tab[128 + 256 * u.ui + r]; return a >= 0 ? a : tab[128 + 256 * u.ui];
    }
    __device__ __forceinline__ unsigned a_off(const Unit& u, int half, int R) const {
        if (gather) return (unsigned)((entry(u, half * 128 + R) >> 1) * K) * 2u;
        return (unsigned)((u.pm * 256 + half * 128 + R) * K) * 2u;
    }
    __device__ __forceinline__ void build(LAS int* t, LAS int* scr, const int* hist, const int* inv) const {
        const int tid = opaque_tid(), lane = tid & 63, wv = tid >> 6;
        { const int e = tid & 31, part = tid >> 5; int sum = 0;
#pragma unroll 4
          for (int b = part * 16; b < part * 16 + 16; ++b) sum += hist[b * 32 + e];
          scr[tid] = sum; }
        __syncthreads();
        if (tid < 32) { int sum = 0; for (int part = 0; part < 16; ++part) sum += scr[part * 32 + tid]; t[64 + tid] = sum; }
        __syncthreads();
        if (tid == 0) { int p = 0; for (int e = 0; e < 32; ++e) { t[e] = p; p += (t[64 + e] + 255) >> 8; } t[32] = p; }
        __syncthreads();
        for (int i = 0; i < MOE_MAXU; ++i) { Unit u; if (!next(i, u)) break;
            int hv = 0, incl = 0;
            if (tid < 256) { hv = hist[tid * 32 + u.e]; incl = hv;
#pragma unroll
                for (int o = 1; o < 64; o <<= 1) { const int tv = __shfl_up(incl, o); if (lane >= o) incl += tv; }
                if (lane == 63) scr[wv] = incl; }
            __syncthreads();
            if (tid < 256) { int off = 0; for (int w2 = 0; w2 < wv; ++w2) off += scr[w2]; scr[512 + tid] = off + incl - hv; if (tid == 255) scr[512 + 256] = off + incl; }
            __syncthreads();
            if (tid < 256) { const int pos = 256 * u.tm + tid; int ent = -1;
                if (pos < t[64 + u.e]) { int lo = 0, hi = 256;
                    while (hi - lo > 1) { const int mid = (lo + hi) >> 1; if (scr[512 + mid] <= pos) lo = mid; else hi = mid; }
                    ent = inv[(lo * 32 + u.e) * 32 + (pos - scr[512 + lo])]; }
                t[128 + 256 * i + tid] = ent; }
            __syncthreads();
        }
    }
};
struct EpiMoeH {
    bf16_t* Hs;
    __device__ __forceinline__ void operator()(const f32x4 (&acc)[2][2][4][2], const Unit& u, int wr, int wc, int fr, int fq) const {
        const int col0 = u.pn * 128 + wc * 32 + 8 * fq;
#pragma unroll
        for (int ai = 0; ai < 2; ++ai)
#pragma unroll
            for (int m = 0; m < 4; ++m) { const int rl = ai * HALF + wr * 64 + m * 16 + fr; f32x4 v[2];
#pragma unroll
                for (int n = 0; n < 2; ++n)
#pragma unroll
                    for (int j = 0; j < 4; ++j) { const float g = acc[ai][0][m][n][j]; v[n][j] = g * sigmoidf_(g) * acc[ai][1][m][n][j]; }
                if (rl < u.rows) *(u32x4*)(Hs + (size_t)(u.pm * 256 + rl) * DEXP + col0) = pack8(v[0], v[1]); }
    }
};
struct EpiMoeY {
    bf16_t* Y; const float* tg; MoeSched S;
    __device__ __forceinline__ void operator()(const f32x4 (&acc)[2][2][4][2], const Unit& u, int wr, int wc, int fr, int fq) const {
        const int col0 = u.pn * BM + wc * 32 + 8 * fq;
#pragma unroll
        for (int ai = 0; ai < 2; ++ai)
#pragma unroll
            for (int m = 0; m < 4; ++m) { const int rl = ai * HALF + wr * 64 + m * 16 + fr;
                if (rl < u.rows) { const int a = S.entry(u, rl); const float g = tg[a]; bf16_t* rowp = Y + (size_t)a * D + col0;
#pragma unroll
                    for (int bj = 0; bj < 2; ++bj) *(u32x4*)(rowp + bj * HALF) = pack8(acc[ai][bj][m][0] * g, acc[ai][bj][m][1] * g); } }
    }
};

__device__ __forceinline__ void transpose_item(const float* W, int K, int N, bf16_t* WT, int dst_row0, LAS float* scr, int kb, int nb, int lane) {
    const int k0 = 64 * kb, n0 = 32 * nb;
    float tmp[32]; const float* src = W + (size_t)(k0 + (lane >> 5)) * N + n0 + (lane & 31);
#pragma unroll
    for (int i = 0; i < 32; ++i) tmp[i] = src[(size_t)(2 * i) * N];
#pragma unroll
    for (int i = 0; i < 32; ++i) scr[(2 * i + (lane >> 5)) * 33 + (lane & 31)] = tmp[i];
    asm volatile("s_waitcnt lgkmcnt(0)" ::: "memory");
    const int c = lane & 7;
#pragma unroll
    for (int j = 0; j < 4; ++j) { const int n = (lane >> 3) + 8 * j; const LAS float* sp = scr + (8 * c) * 33 + n;
        u32x4 o; o.x = cvt_pk_bf16(sp[0 * 33], sp[1 * 33]); o.y = cvt_pk_bf16(sp[2 * 33], sp[3 * 33]); o.z = cvt_pk_bf16(sp[4 * 33], sp[5 * 33]); o.w = cvt_pk_bf16(sp[6 * 33], sp[7 * 33]);
        *(u32x4*)(WT + (size_t)(dst_row0 + n) * K + k0 + 8 * c) = o; }
    asm volatile("s_waitcnt lgkmcnt(0)" ::: "memory");
}
}

typedef short s16x4 __attribute__((ext_vector_type(4)));
typedef LAS s16x4 lds_s16x4;
constexpr int HRS = 272, ARS = 144;
constexpr int H1_QH = 0, H1_KH0 = H1_QH + 64 * HRS, H1_KH1 = H1_KH0 + 16 * HRS, H1_KH2 = H1_KH1 + 32 * HRS, H1_KH3 = H1_KH2 + 48 * HRS, H1_KT = H1_KH3 + 64 * HRS,
              H1_VS = H1_KT + 64 * HRS, H1_AS = H1_VS + 64 * HRS, H1_TOT = H1_AS + 64 * ARS, H1_BYTES = H1_TOT + 4096;
constexpr int NUNIT = BATCH * HG_H * (SEQ / 64);
__device__ __forceinline__ bf16x8 tr_frag16(const LAS unsigned char* tile, int rs, int r0, int c0, int lane) {
    const int g = lane >> 4, i = lane & 15, q = i >> 2, p = i & 3;
    const LAS unsigned char* a = tile + (r0 + 8 * g + q) * rs + (c0 + 4 * p) * 2;
    const s16x4 lo = __builtin_amdgcn_ds_read_tr16_b64_v4i16((lds_s16x4*)a);
    const s16x4 hi = __builtin_amdgcn_ds_read_tr16_b64_v4i16((lds_s16x4*)(a + 4 * rs));
    return (bf16x8){lo[0], lo[1], lo[2], lo[3], hi[0], hi[1], hi[2], hi[3]};
}
__device__ __forceinline__ bf16x8 row_frag16(const LAS unsigned char* tile, int rs, int r0, int c0, int lane) {
    return *(const LAS bf16x8*)(tile + (r0 + (lane & 15)) * rs + (c0 + 8 * (lane >> 4)) * 2);
}
#define MFMA16(a, b, c) __builtin_amdgcn_mfma_f32_16x16x32_bf16((a), (b), (c), 0, 0, 0)
typedef unsigned u32x2 __attribute__((ext_vector_type(2)));
__device__ __forceinline__ u32x2 pack4(const f32x4 v) { u32x2 r; r.x = pg8::cvt_pk_bf16(v[0], v[1]); r.y = pg8::cvt_pk_bf16(v[2], v[3]); return r; }

struct HgArgs { bf16_t *Qb, *Kb, *Vb, *Gt, *OI, *UT, *Sst, *Og; float *Gl, *Dg; const float* ng; bf16_t* Qt; };

typedef float f32x2 __attribute__((ext_vector_type(2)));
__device__ __forceinline__ f32x2 exp2v(const f32x2 x) { f32x2 r; r.x = __builtin_amdgcn_exp2f(x.x); r.y = __builtin_amdgcn_exp2f(x.y); return r; }
__device__ __forceinline__ f32x2 bf2v(unsigned w) { f32x2 r; r.x = __builtin_bit_cast(float, w << 16); r.y = __builtin_bit_cast(float, w & 0xffff0000u); return r; }
__device__ __forceinline__ unsigned v2bf(const f32x2 v) { return pg8::cvt_pk_bf16(v.x, v.y); }
struct H1In { f32x2 g[8]; unsigned q[8], k[8]; u32x4 v[2]; };
__device__ __forceinline__ void h1_load(H1In& in, const HgArgs& a, int unit, int tid) {
    const int bh = unit >> 5, c = unit & 31, b = bh >> 4, h = bh & 15, cp = tid & 63, tq = tid >> 6;
    const size_t gbase = ((size_t)b * SEQ + c * 64) * D + h * 128;
#pragma unroll
    for (int i = 0; i < 8; ++i) { const size_t go = gbase + (size_t)(8 * tq + i) * D + 2 * cp; in.g[i] = *(const f32x2*)(a.Gl + go); in.q[i] = *(const unsigned*)(a.Qb + go); in.k[i] = *(const unsigned*)(a.Kb + go); }
#pragma unroll
    for (int i = 0; i < 2; ++i) { const int id = tid + 512 * i, r = id >> 4, ck = id & 15; in.v[i] = *(const u32x4*)(a.Vb + gbase + (size_t)r * D + ck * 8); }
}
__device__ __forceinline__ void h1_phase(LAS unsigned char* lds, const HgArgs& a, int vcu, int G) {
    const int tid = opaque_tid(), lane = tid & 63, wid = __builtin_amdgcn_readfirstlane(tid >> 6);
    const int cp = lane, tq = wid, J = wid >> 1, half = wid & 1;
    LAS f32x2* tot8 = (LAS f32x2*)(lds + H1_TOT);
    H1In in;
    if (vcu < NUNIT) h1_load(in, a, vcu, tid);
    for (int unit = vcu; unit < NUNIT; unit += G) {
        const int bh = unit >> 5, c = unit & 31, b = bh >> 4, h = bh & 15;
        const size_t gbase = ((size_t)b * SEQ + c * 64) * D + h * 128;
        f32x2 L[8]; { f32x2 l = {0.f, 0.f};
#pragma unroll
            for (int i = 0; i < 8; ++i) { l += in.g[i]; L[i] = l; } }
        tot8[tq * 64 + cp] = L[7];
#pragma unroll
        for (int i = 0; i < 2; ++i) { const int id = tid + 512 * i, r = id >> 4, ck = id & 15; *(LAS u32x4*)(lds + H1_VS + r * HRS + ck * 16) = in.v[i]; }
        for (int id = tid; id < 64 * ARS / 16; id += 512) *(LAS u32x4*)(lds + H1_AS + id * 16) = (u32x4){0u, 0u, 0u, 0u};
        __syncthreads();
        f32x2 tj[4];
#pragma unroll
        for (int M = 0; M < 4; ++M) tj[M] = tot8[(2 * M) * 64 + cp] + tot8[(2 * M + 1) * 64 + cp];
        f32x2 off = {0.f, 0.f}; if (half) off = tot8[(tq - 1) * 64 + cp];
        f32x2 aJ = {0.f, 0.f};
#pragma unroll
        for (int M = 0; M < 3; ++M) if (M < J) aJ += tj[M];
        const f32x2 PA = exp2v(aJ), L15 = tj[J == 0 ? 0 : J == 1 ? 1 : J == 2 ? 2 : 3];
        f32x2 cI[5];
#pragma unroll
        for (int I = 1; I <= 4; ++I) { f32x2 sx = {0.f, 0.f};
#pragma unroll
            for (int M = 1; M < 4; ++M) if (M > J && M < I) sx += tj[M];
            cI[I] = exp2v(sx); }
        const int khJ = J == 0 ? H1_KH0 : J == 1 ? H1_KH1 : J == 2 ? H1_KH2 : H1_KH3;
#pragma unroll
        for (int i = 0; i < 8; ++i) {
            const int t = 8 * tq + i; const int lo = t * HRS + cp * 4;
            const f32x2 q = bf2v(in.q[i]), k = bf2v(in.k[i]), Li = L[i] + off;
            const f32x2 ep = exp2v(Li), nl = -Li, en = exp2v((f32x2){fminf(nl.x, 80.f), fminf(nl.y, 80.f)}), rem = exp2v(L15 - Li);
            const f32x2 qh = q * ep, kr = k * rem;
            *(LAS unsigned*)(lds + H1_QH + lo) = v2bf(qh);
            *(unsigned*)(a.Qt + gbase + (size_t)t * D + 2 * cp) = v2bf(qh * PA);
            *(LAS unsigned*)(lds + khJ + lo) = v2bf(k * en);
#pragma unroll
            for (int I = 1; I <= 4; ++I) if (I > J) { constexpr int offs[5] = {H1_KH0, H1_KH1, H1_KH2, H1_KH3, H1_KT}; *(LAS unsigned*)(lds + offs[I] + lo) = v2bf(kr * cI[I]); }
        }
        if (J == 0 && half == 0) *(f32x2*)(a.Dg + (size_t)unit * 128 + 2 * cp) = exp2v((tj[0] + tj[1]) + (tj[2] + tj[3]));
        __syncthreads();
        if (unit + G < NUNIT) h1_load(in, a, unit + G, tid);
        for (int blk = wid; blk < 10; blk += 8) {
            const int I = blk < 1 ? 0 : blk < 3 ? 1 : blk < 6 ? 2 : 3, Jb = blk - (I * (I + 1)) / 2;
            const int khI = I == 0 ? H1_KH0 : I == 1 ? H1_KH1 : I == 2 ? H1_KH2 : H1_KH3;
            f32x4 acc = {0.f, 0.f, 0.f, 0.f};
#pragma unroll
            for (int ks = 0; ks < 4; ++ks) acc = MFMA16(row_frag16(lds + khI, HRS, 16 * Jb, 32 * ks, lane), row_frag16(lds + H1_QH, HRS, 16 * I, 32 * ks, lane), acc);
            const int tl = 16 * I + (lane & 15), s0 = 16 * Jb + 4 * (lane >> 4);
#pragma unroll
            for (int r = 0; r < 4; ++r) if (s0 + r > tl) acc[r] = 0.f;
            *(LAS u32x2*)(lds + H1_AS + tl * ARS + s0 * 2) = pack4(acc);
        }
        __syncthreads();
        {
            bf16x8 vtr[2];
#pragma unroll
            for (int ks = 0; ks < 2; ++ks) vtr[ks] = tr_frag16(lds + H1_VS, HRS, 32 * ks, 16 * wid, lane);
#pragma unroll
            for (int rb = 0; rb < 4; ++rb) { f32x4 acc = {0.f, 0.f, 0.f, 0.f};
#pragma unroll
                for (int ks = 0; ks < 2; ++ks) if (!(ks == 1 && rb < 2)) acc = MFMA16(vtr[ks], row_frag16(lds + H1_AS, ARS, 16 * rb, 32 * ks, lane), acc);
                *(u32x2*)(a.OI + gbase + (size_t)(16 * rb + (lane & 15)) * D + 16 * wid + 4 * (lane >> 4)) = pack4(acc); }
#pragma unroll
            for (int cb = 0; cb < 8; ++cb) { f32x4 acc = {0.f, 0.f, 0.f, 0.f};
#pragma unroll
                for (int ks = 0; ks < 2; ++ks) acc = MFMA16(tr_frag16(lds + H1_KT, HRS, 32 * ks, 16 * cb, lane), vtr[ks], acc);
                *(u32x2*)(a.UT + ((size_t)unit * 128 + 16 * wid + (lane & 15)) * 128 + 16 * cb + 4 * (lane >> 4)) = pack4(acc); }
        }
        __syncthreads();
    }
}
__device__ __forceinline__ void h2_phase(const HgArgs& a, int vcu, int G) {
    for (int item = vcu * 512 + opaque_tid(); item < BATCH * HG_H * 2048; item += G * 512) {
        const int bh = item >> 11, vec = item & 2047, ch0 = (vec & 15) * 8;
        float st[8];
#pragma unroll
        for (int j = 0; j < 8; ++j) st[j] = 0.f;
        for (int c = 0; c < 32; ++c) { const size_t u = (size_t)bh * 32 + c;
            *(u32x4*)(a.Sst + u * 16384 + vec * 8) = pg8::pack8((f32x4){st[0], st[1], st[2], st[3]}, (f32x4){st[4], st[5], st[6], st[7]});
            if (c < 31) { const uint4 uu = *(const uint4*)(a.UT + u * 16384 + vec * 8); const float4 d0 = *(const float4*)(a.Dg + u * 128 + ch0), d1 = *(const float4*)(a.Dg + u * 128 + ch0 + 4);
                const unsigned w[4] = {uu.x, uu.y, uu.z, uu.w}; const float dd[8] = {d0.x, d0.y, d0.z, d0.w, d1.x, d1.y, d1.z, d1.w};
#pragma unroll
                for (int j = 0; j < 4; ++j) { st[2 * j] = dd[2 * j] * st[2 * j] + bf2f((bf16_t)(w[j] & 0xffff)); st[2 * j + 1] = dd[2 * j + 1] * st[2 * j + 1] + bf2f((bf16_t)(w[j] >> 16)); } }
        }
    }
}
__device__ __forceinline__ void h3_phase(const HgArgs& a, int vcu, int G) {
    const int tid = opaque_tid(), lane = tid & 63, wid = __builtin_amdgcn_readfirstlane(tid >> 6);
    for (int pair = vcu; pair < NUNIT / 2; pair += G) {
        const int unit = pair * 2 + (wid >> 2), rb = wid & 3;
        const int bh = unit >> 5, c = unit & 31, b = bh >> 4, h = bh & 15;
        const size_t ro = ((size_t)b * SEQ + c * 64 + 16 * rb + (lane & 15)) * D + h * 128;
        bf16x8 qf[4];
#pragma unroll
        for (int ks = 0; ks < 4; ++ks) qf[ks] = *(const bf16x8*)(a.Qt + ro + 32 * ks + 8 * (lane >> 4));
        f32x4 o[8]; float ss = 0.f;
#pragma unroll
        for (int cb = 0; cb < 8; ++cb) { f32x4 acc = {0.f, 0.f, 0.f, 0.f};
            const bf16_t* sp = a.Sst + ((size_t)unit * 128 + 16 * cb + (lane & 15)) * 128 + 8 * (lane >> 4);
#pragma unroll
            for (int ks = 0; ks < 4; ++ks) acc = MFMA16(*(const bf16x8*)(sp + 32 * ks), qf[ks], acc);
            const uint2 oi = *(const uint2*)(a.OI + ro + 16 * cb + 4 * (lane >> 4));
            acc[0] += bf2f((bf16_t)(oi.x & 0xffff)); acc[1] += bf2f((bf16_t)(oi.x >> 16)); acc[2] += bf2f((bf16_t)(oi.y & 0xffff)); acc[3] += bf2f((bf16_t)(oi.y >> 16));
            o[cb] = acc; ss += (acc[0] * acc[0] + acc[1] * acc[1]) + (acc[2] * acc[2] + acc[3] * acc[3]); }
        ss += __shfl_xor(ss, 16); ss += __shfl_xor(ss, 32);
        const float r = 1.0f / sqrtf(ss * (1.f / 128.f) + RMS_EPS);
#pragma unroll
        for (int cb = 0; cb < 8; ++cb) { const int vc = 16 * cb + 4 * (lane >> 4); const float4 g = *(const float4*)(a.ng + h * 128 + vc); const uint2 gt = *(const uint2*)(a.Gt + ro + vc);
            f32x4 v; v[0] = o[cb][0] * r * g.x * bf2f((bf16_t)(gt.x & 0xffff)); v[1] = o[cb][1] * r * g.y * bf2f((bf16_t)(gt.x >> 16)); v[2] = o[cb][2] * r * g.z * bf2f((bf16_t)(gt.y & 0xffff)); v[3] = o[cb][3] * r * g.w * bf2f((bf16_t)(gt.y >> 16));
            *(u32x2*)(a.Og + ro + vc) = pack4(v); }
    }
}

#define XB_TMO      128
#define XB_XCNT(j)  (256  + 64 * (j))
#define XB_XSUB(j)  (1280 + 64 * (j))
#define XB_XGEN(j)  (2304 + 64 * (j))
#define XB_TOP      3328
#define XB_TOPGEN   3392
#define XCD_BAR_WORDS 3456
#define XB_SPIN_CAP (1u << 18)
__device__ __forceinline__ unsigned xb_ld(unsigned* p)              { return __hip_atomic_load(p, __ATOMIC_RELAXED, __HIP_MEMORY_SCOPE_AGENT); }
__device__ __forceinline__ unsigned xb_add(unsigned* p, unsigned v) { return __hip_atomic_fetch_add(p, v, __ATOMIC_RELAXED, __HIP_MEMORY_SCOPE_AGENT); }
__device__ __forceinline__ unsigned xb_xcc_id() { return (unsigned)__builtin_amdgcn_s_getreg((3 << 11) | 20) & 0xFu; }
#define XB_SPIN(cond, bar) do { unsigned _sp = 0; while (cond) { __builtin_amdgcn_s_sleep(1); \
    if ((++_sp & 255u) == 0u) { if (xb_ld(&(bar)[XB_TMO])) break; if (_sp > XB_SPIN_CAP) { atomicAdd(&(bar)[XB_TMO], 1u); break; } } } } while (0)
struct XcdBarrier { unsigned* bar; unsigned x; volatile LAS unsigned* st; };
__device__ __forceinline__ XcdBarrier xcd_barrier_post(unsigned* bar, volatile LAS unsigned* st) {
    XcdBarrier b; b.bar = bar; b.x = xb_xcc_id(); b.st = st;
    if (threadIdx.x == 0) (void)xb_add(&bar[XB_XCNT(b.x)], 1u);
    return b;
}
__device__ __forceinline__ void xcd_barrier_complete(unsigned* bar, unsigned x, unsigned& nloc, unsigned& nx) {
    const unsigned G = gridDim.x * gridDim.y * gridDim.z;
    unsigned sum, cnt, mine, sp = 0u;
    for (;;) {
        sum = 0u; cnt = 0u; mine = 0u;
#pragma unroll
        for (unsigned j = 0; j < 16; ++j) { const unsigned c = xb_ld(&bar[XB_XCNT(j)]); sum += c; cnt += (c > 0u) ? 1u : 0u; mine = (j == x) ? c : mine; }
        if (sum == G) break;
        __builtin_amdgcn_s_sleep(1);
        if ((++sp & 255u) == 0u) { if (xb_ld(&bar[XB_TMO])) break; if (sp > XB_SPIN_CAP) { atomicAdd(&bar[XB_TMO], 1u); break; } }
    }
    nloc = mine > 0u ? mine : 1u; nx = cnt > 0u ? cnt : 1u;
}
__device__ __forceinline__ void xcd_barrier(const XcdBarrier& b) {
    asm volatile("s_waitcnt vmcnt(0)" ::: "memory");
    __syncthreads();
    if (threadIdx.x == 0) {
        unsigned* bar = b.bar;
        __builtin_amdgcn_s_waitcnt(0);
        unsigned nloc = b.st[0], nx = b.st[1];
        if (nloc == 0u) { xcd_barrier_complete(bar, b.x, nloc, nx); b.st[0] = nloc; b.st[1] = nx; }
        const unsigned old = xb_add(&bar[XB_XSUB(b.x)], 1u);
        const unsigned gen = old / nloc;
        if (old + 1u == (gen + 1u) * nloc) {
            __builtin_amdgcn_fence(__ATOMIC_RELEASE, "agent");
            asm volatile("s_waitcnt vmcnt(0)" ::: "memory");
            const unsigned og = xb_add(&bar[XB_TOP], 1u);
            const unsigned tg = og / nx;
            if (og + 1u == (tg + 1u) * nx) xb_add(&bar[XB_TOPGEN], 1u);
            else XB_SPIN(xb_ld(&bar[XB_TOPGEN]) == tg, bar);
            __builtin_amdgcn_fence(__ATOMIC_ACQUIRE, "agent");
            xb_add(&bar[XB_XGEN(b.x)], 1u);
            asm volatile("s_waitcnt vmcnt(0)" ::: "memory");
        } else {
            XB_SPIN(xb_ld(&bar[XB_XGEN(b.x)]) == gen, bar);
            __builtin_amdgcn_fence(__ATOMIC_ACQUIRE, "agent");
            asm volatile("s_waitcnt vmcnt(0)" ::: "memory");
        }
    }
    __syncthreads();
}

struct Ptrs {
    const float *x, *a_w_in, *a_lb, *a_ng, *a_w_out, *b_w_kv, *b_w_q, *b_sinks, *b_w_out, *rel_bias, *w_rg, *b_rg, *w_re, *b_re, *w_gate, *w_up, *w_down, *ln_g, *ln_b;
    float* out; unsigned char* ws;
};
__device__ __forceinline__ void prologue_phase(LAS unsigned char* lds, const Ptrs& p, int vcu, int G) {
    const int tid = opaque_tid(), lane = tid & 63, wave = __builtin_amdgcn_readfirstlane(tid >> 6);
    LAS float* scr = (LAS float*)(lds + wave * 8448);
    const int gw = vcu * 8 + wave, NGW = G * 8;
    bf16_t* Win_t = (bf16_t*)(p.ws + WS_WIN); bf16_t* Wout_t = (bf16_t*)(p.ws + WS_WOUT); bf16_t* Wkv_t = (bf16_t*)(p.ws + WS_WKV); bf16_t* Wq_t = (bf16_t*)(p.ws + WS_WQ); bf16_t* Wo_t = (bf16_t*)(p.ws + WS_WO);
    bf16_t* Wgu_t = (bf16_t*)(p.ws + WS_WGU); bf16_t* Wd_t = (bf16_t*)(p.ws + WS_WD);
    constexpr int I_IN = 2 * 32 * 256, I_AO = 2 * 32 * 64, I_KV = 32 * 16, I_Q = 2 * 32 * 64, I_O = 2 * 32 * 64, I_G = 128 * 32 * 16, I_U = I_G, I_D = 128 * 8 * 64;
    constexpr int NITEMS = I_IN + I_AO + I_KV + I_Q + I_O + I_G + I_U + I_D;
    for (int it = gw; it < NITEMS; it += NGW) {
        int r = it;
        if (r < I_IN) { const int mat = r / (32 * 256), q = r % (32 * 256), kb = q / 256, nb = q % 256; pg8::transpose_item(p.a_w_in + (size_t)mat * D * 4 * D, D, 4 * D, Win_t + (size_t)mat * 4 * D * D, 32 * nb, scr, kb, nb, lane); continue; } r -= I_IN;
        if (r < I_AO) { const int mat = r / (32 * 64), q = r % (32 * 64), kb = q / 64, nb = q % 64; pg8::transpose_item(p.a_w_out + (size_t)mat * D * D, D, D, Wout_t + (size_t)mat * D * D, 32 * nb, scr, kb, nb, lane); continue; } r -= I_AO;
        if (r < I_KV) { const int kb = r / 16, nb = r % 16; pg8::transpose_item(p.b_w_kv, D, 2 * KVW, Wkv_t, 32 * nb, scr, kb, nb, lane); continue; } r -= I_KV;
        if (r < I_Q) { const int mat = r / (32 * 64), q = r % (32 * 64), kb = q / 64, nb = q % 64; pg8::transpose_item(p.b_w_q + (size_t)mat * D * D, D, D, Wq_t + (size_t)mat * D * D, 32 * nb, scr, kb, nb, lane); continue; } r -= I_Q;
        if (r < I_O) { const int mat = r / (32 * 64), q = r % (32 * 64), kb = q / 64, nb = q % 64; pg8::transpose_item(p.b_w_out + (size_t)mat * D * D, D, D, Wo_t + (size_t)mat * D * D, 32 * nb, scr, kb, nb, lane); continue; } r -= I_O;
        if (r < I_G + I_U) { const int up = r >= I_G; if (up) r -= I_G; const int mat = r / (32 * 16), q = r % (32 * 16), kb = q / 16, nb = q % 16;
            const int n0 = 32 * nb, drow = (n0 >> 7) * 256 + (n0 & 127) + (up ? 128 : 0);
            pg8::transpose_item((up ? p.w_up : p.w_gate) + (size_t)mat * D * DEXP, D, DEXP, Wgu_t + (size_t)mat * 2 * DEXP * D, drow, scr, kb, nb, lane); continue; } r -= I_G + I_U;
        { const int mat = r / (8 * 64), q = r % (8 * 64), kb = q / 64, nb = q % 64; pg8::transpose_item(p.w_down + (size_t)mat * DEXP * D, DEXP, D, Wd_t + (size_t)mat * D * DEXP, 32 * nb, scr, kb, nb, lane); }
    }
    { bf16_t* WRhi = (bf16_t*)(p.ws + WS_WR); bf16_t* WRlo = WRhi + (size_t)DEPTH * 64 * D;
      for (int i = vcu * 512 + tid; i < DEPTH * 64 * D; i += G * 512) { const int L = i / (64 * D), o = (i / D) % 64, d = i % D;
          const float w = o < 4 ? p.w_rg[((size_t)L * D + d) * NGRP + o] : o < 36 ? p.w_re[((size_t)L * D + d) * NEXP + (o - 4)] : 0.f;
          const unsigned hb = f2bf(w); WRhi[i] = (bf16_t)hb; WRlo[i] = (bf16_t)f2bf(w - bf2f((bf16_t)hb)); } }
    bf16_t* xb = (bf16_t*)(p.ws + WS_XB);
    for (size_t i = (size_t)vcu * 512 + tid; i < (size_t)T * D / 4; i += (size_t)G * 512) { const float4 v = ((const float4*)p.x)[i];
        u32x2 o; o.x = pg8::cvt_pk_bf16(v.x, v.y); o.y = pg8::cvt_pk_bf16(v.z, v.w); ((u32x2*)xb)[i] = o; }
}

template <int MODE>
__device__ __forceinline__ void ln_phase(const float* xin, const bf16_t* hm, const bf16_t* Y, const float* lng, const float* lnb, float* xf, bf16_t* xb,
                                         const float* wrg, const float* brg, const float* wre, const float* bre, int* cnt, int* list, float* tg, int vcu, int G) {
    const int tid = opaque_tid();
    for (int row = vcu * 8 + (tid >> 6); row < T; row += G * 8) {
        const int lane = opaque_tid() & 63;
        float v[32];
        float s = 0.f;
#pragma unroll
        for (int j = 0; j < 8; ++j) { const int c = 4 * lane + 256 * j; const float4 a = *(const float4*)(xin + (size_t)row * D + c);
            float4 h;
            if (MODE == 0) { const uint2 y0 = *(const uint2*)(hm + (size_t)row * D + c); h.x = bf2f((bf16_t)(y0.x & 0xffff)); h.y = bf2f((bf16_t)(y0.x >> 16)); h.z = bf2f((bf16_t)(y0.y & 0xffff)); h.w = bf2f((bf16_t)(y0.y >> 16)); }
            else { const uint2 y0 = *(const uint2*)(Y + (size_t)(row * 2) * D + c), y1 = *(const uint2*)(Y + (size_t)(row * 2 + 1) * D + c);
                h.x = bf2f((bf16_t)(y0.x & 0xffff)) + bf2f((bf16_t)(y1.x & 0xffff)); h.y = bf2f((bf16_t)(y0.x >> 16)) + bf2f((bf16_t)(y1.x >> 16));
                h.z = bf2f((bf16_t)(y0.y & 0xffff)) + bf2f((bf16_t)(y1.y & 0xffff)); h.w = bf2f((bf16_t)(y0.y >> 16)) + bf2f((bf16_t)(y1.y >> 16)); }
            v[4 * j + 0] = ALPHA * a.x + h.x; v[4 * j + 1] = ALPHA * a.y + h.y; v[4 * j + 2] = ALPHA * a.z + h.z; v[4 * j + 3] = ALPHA * a.w + h.w;
            s += (v[4 * j] + v[4 * j + 1]) + (v[4 * j + 2] + v[4 * j + 3]); }
        const float mean = wave_sum(s) * (1.f / D);
        float q = 0.f;
#pragma unroll
        for (int j = 0; j < 32; ++j) { v[j] -= mean; q += v[j] * v[j]; }
        const float rstd = 1.0f / sqrtf(wave_sum(q) * (1.f / D) + LN_EPS);
#pragma unroll
        for (int j = 0; j < 8; ++j) { const int c = 4 * lane + 256 * j; const float4 g = *(const float4*)(lng + c), b = *(const float4*)(lnb + c);
            v[4 * j + 0] = v[4 * j + 0] * rstd * g.x + b.x; v[4 * j + 1] = v[4 * j + 1] * rstd * g.y + b.y; v[4 * j + 2] = v[4 * j + 2] * rstd * g.z + b.z; v[4 * j + 3] = v[4 * j + 3] * rstd * g.w + b.w;
            *(float4*)(xf + (size_t)row * D + c) = make_float4(v[4 * j], v[4 * j + 1], v[4 * j + 2], v[4 * j + 3]);
            if (xb) { u32x2 o; o.x = pg8::cvt_pk_bf16(v[4 * j], v[4 * j + 1]); o.y = pg8::cvt_pk_bf16(v[4 * j + 2], v[4 * j + 3]); *(u32x2*)(xb + (size_t)row * D + c) = o; } }
        if (MODE == 0) {
            float gl[4] = {0.f, 0.f, 0.f, 0.f};
#pragma unroll
            for (int j = 0; j < 8; ++j)
#pragma unroll
                for (int i = 0; i < 4; ++i) { const int c = 4 * lane + 256 * j + i; const float4 w = *(const float4*)(wrg + (size_t)c * NGRP); const float x = v[4 * j + i];
                    gl[0] += x * w.x; gl[1] += x * w.y; gl[2] += x * w.z; gl[3] += x * w.w; }
#pragma unroll
            for (int g = 0; g < 4; ++g) gl[g] = wave_sum(gl[g]) + brg[g];
            int grp = 0; float gmax = gl[0];
#pragma unroll
            for (int g = 1; g < 4; ++g) if (gl[g] > gmax) { gmax = gl[g]; grp = g; }
            float gden = 0.f;
#pragma unroll
            for (int g = 0; g < 4; ++g) gden += __expf(gl[g] - gmax);
            const float pgrp = 1.0f / gden;
            float el[8] = {0.f, 0.f, 0.f, 0.f, 0.f, 0.f, 0.f, 0.f};
#pragma unroll
            for (int j = 0; j < 8; ++j)
#pragma unroll
                for (int i = 0; i < 4; ++i) { const int c = 4 * lane + 256 * j + i; const float4 w0 = *(const float4*)(wre + (size_t)c * NEXP + grp * 8), w1 = *(const float4*)(wre + (size_t)c * NEXP + grp * 8 + 4); const float x = v[4 * j + i];
                    el[0] += x * w0.x; el[1] += x * w0.y; el[2] += x * w0.z; el[3] += x * w0.w; el[4] += x * w1.x; el[5] += x * w1.y; el[6] += x * w1.z; el[7] += x * w1.w; }
#pragma unroll
            for (int e = 0; e < 8; ++e) el[e] = wave_sum(el[e]) + bre[grp * 8 + e];
            int i0 = 0; float v0 = el[0];
#pragma unroll
            for (int e = 1; e < 8; ++e) if (el[e] > v0) { v0 = el[e]; i0 = e; }
            int i1 = -1; float v1 = -3.0e38f;
#pragma unroll
            for (int e = 0; e < 8; ++e) if (e != i0 && el[e] > v1) { v1 = el[e]; i1 = e; }
            const float e1 = __expf(v1 - v0), den = 1.f + e1;
            const float g0 = pgrp / den, g1 = pgrp * e1 / den;
            if (lane == 0) {
                const int ea = grp * 8 + i0, eb = grp * 8 + i1;
                const int pa = atomicAdd(&cnt[ea], 1); list[ea * T + pa] = row * 2; tg[row * 2] = g0;
                const int pb = atomicAdd(&cnt[eb], 1); list[eb * T + pb] = row * 2 + 1; tg[row * 2 + 1] = g1;
            }
        }
    }
}


typedef float f32x16 __attribute__((ext_vector_type(16)));
#define MFMA32(a, b, c) __builtin_amdgcn_mfma_f32_32x32x16_bf16((a), (b), (c), 0, 0, 0)
constexpr int RT_RED = 0, RT_LOG = 8 * 64 * 32 * 4, RT_HIST = RT_LOG + 32 * 64 * 4, RT_BYTES = RT_HIST + 128;
__device__ __forceinline__ void ln_router_phase(LAS unsigned char* lds, const float* xin, const bf16_t* hm, const float* lng, const float* lnb, float* xf, bf16_t* xb,
                                                const bf16_t* WRhi, const bf16_t* WRlo, const float* brg, const float* bre, int* hist, int* inv, float* tg, int vcu, int G) {
    const int tid = opaque_tid(), lane = tid & 63, wid = __builtin_amdgcn_readfirstlane(tid >> 6);
    LAS int* lhist = (LAS int*)(lds + RT_HIST);
    if (tid < 32) lhist[tid] = 0;
    {
        const int row0 = 32 * vcu + 4 * wid;
#pragma unroll 1
        for (int r = 0; r < 4; ++r) {
            f32x4 v[8]; float s = 0.f;
#pragma unroll
            for (int j = 0; j < 8; ++j) { const int c = 4 * lane + 256 * j; const f32x4 a = *(const f32x4*)(xin + (size_t)(row0 + r) * D + c); const u32x2 y0 = *(const u32x2*)(hm + (size_t)(row0 + r) * D + c);
                f32x4 hh; hh[0] = bf2f((bf16_t)(y0.x & 0xffff)); hh[1] = bf2f((bf16_t)(y0.x >> 16)); hh[2] = bf2f((bf16_t)(y0.y & 0xffff)); hh[3] = bf2f((bf16_t)(y0.y >> 16));
                v[j] = a * ALPHA + hh; s += (v[j][0] + v[j][1]) + (v[j][2] + v[j][3]); }
            const float mean = wave_sum(s) * (1.f / D);
            float q = 0.f;
#pragma unroll
            for (int j = 0; j < 8; ++j) { v[j] = v[j] - mean; q += (v[j][0] * v[j][0] + v[j][1] * v[j][1]) + (v[j][2] * v[j][2] + v[j][3] * v[j][3]); }
            const float rstd = 1.0f / sqrtf(wave_sum(q) * (1.f / D) + LN_EPS);
#pragma unroll
            for (int j = 0; j < 8; ++j) { const int c = 4 * lane + 256 * j; const f32x4 g = *(const f32x4*)(lng + c), bb = *(const f32x4*)(lnb + c);
                v[j] = v[j] * rstd * g + bb;
                *(f32x4*)(xf + (size_t)(row0 + r) * D + c) = v[j];
                u32x2 o; o.x = pg8::cvt_pk_bf16(v[j][0], v[j][1]); o.y = pg8::cvt_pk_bf16(v[j][2], v[j][3]); *(u32x2*)(xb + (size_t)(row0 + r) * D + c) = o; }
        }
    }
    asm volatile("s_waitcnt vmcnt(0)" ::: "memory");
    __syncthreads();
    {
        const int r = lane & 31, h = lane >> 5;
        f32x16 acc0, acc1;
#pragma unroll
        for (int e = 0; e < 16; ++e) { acc0[e] = 0.f; acc1[e] = 0.f; }
        const float* xp = xf + (size_t)(32 * vcu + r) * D + 256 * wid + 8 * h;
        const size_t wo = (size_t)r * D + 256 * wid + 8 * h;
#pragma unroll 4
        for (int sx = 0; sx < 16; ++sx) {
            const f32x4 x0 = *(const f32x4*)(xp + 16 * sx), x1 = *(const f32x4*)(xp + 16 * sx + 4);
            const u32x4 hp = pg8::pack8(x0, x1);
            f32x4 h0, h1; h0[0] = __builtin_bit_cast(float, hp.x << 16); h0[1] = __builtin_bit_cast(float, hp.x & 0xffff0000u); h0[2] = __builtin_bit_cast(float, hp.y << 16); h0[3] = __builtin_bit_cast(float, hp.y & 0xffff0000u);
            h1[0] = __builtin_bit_cast(float, hp.z << 16); h1[1] = __builtin_bit_cast(float, hp.z & 0xffff0000u); h1[2] = __builtin_bit_cast(float, hp.w << 16); h1[3] = __builtin_bit_cast(float, hp.w & 0xffff0000u);
            const bf16x8 xh = __builtin_bit_cast(bf16x8, hp), xl = __builtin_bit_cast(bf16x8, pg8::pack8(x0 - h0, x1 - h1));
            const bf16x8 w0h = *(const bf16x8*)(WRhi + wo + 16 * sx), w0l = *(const bf16x8*)(WRlo + wo + 16 * sx), w1h = *(const bf16x8*)(WRhi + wo + (size_t)32 * D + 16 * sx), w1l = *(const bf16x8*)(WRlo + wo + (size_t)32 * D + 16 * sx);
            acc0 = MFMA32(xh, w0h, acc0); acc0 = MFMA32(xh, w0l, acc0); acc0 = MFMA32(xl, w0h, acc0);
            acc1 = MFMA32(xh, w1h, acc1); acc1 = MFMA32(xh, w1l, acc1); acc1 = MFMA32(xl, w1h, acc1);
        }
        LAS float* red = (LAS float*)(lds + RT_RED);
#pragma unroll
        for (int g4 = 0; g4 < 4; ++g4) {
            *(LAS f32x4*)(red + ((wid * 64 + r) * 32 + 8 * g4 + 4 * h)) = (f32x4){acc0[4 * g4], acc0[4 * g4 + 1], acc0[4 * g4 + 2], acc0[4 * g4 + 3]};
            *(LAS f32x4*)(red + ((wid * 64 + 32 + r) * 32 + 8 * g4 + 4 * h)) = (f32x4){acc1[4 * g4], acc1[4 * g4 + 1], acc1[4 * g4 + 2], acc1[4 * g4 + 3]}; }
    }
    __syncthreads();
    {
        const LAS float* red = (const LAS float*)(lds + RT_RED); LAS float* lg = (LAS float*)(lds + RT_LOG);
#pragma unroll
        for (int i = 0; i < 4; ++i) { const int idx = tid + 512 * i, o = idx >> 5, row = idx & 31; float sum = 0.f;
#pragma unroll
            for (int w2 = 0; w2 < 8; ++w2) sum += red[(w2 * 64 + o) * 32 + row];
            lg[row * 64 + o] = sum; }
    }
    __syncthreads();
    if (tid < 32) {
        const LAS float* lg = (const LAS float*)(lds + RT_LOG) + tid * 64;
        int grp = 0; float gmax = lg[0] + brg[0]; float glv[4]; glv[0] = gmax;
#pragma unroll
        for (int g = 1; g < 4; ++g) { glv[g] = lg[g] + brg[g]; if (glv[g] > gmax) { gmax = glv[g]; grp = g; } }
        float gden = 0.f;
#pragma unroll
        for (int g = 0; g < 4; ++g) gden += __expf(glv[g] - gmax);
        float v0 = -3.0e38f, v1 = -3.0e38f; int i0 = 0, i1 = 0;
#pragma unroll
        for (int e = 0; e < 8; ++e) { const float val = lg[4 + grp * 8 + e] + bre[grp * 8 + e];
            if (val > v0) { v1 = v0; i1 = i0; v0 = val; i0 = e; } else if (val > v1) { v1 = val; i1 = e; } }
        const float e1 = __expf(v1 - v0), den = 1.f + e1, pg = 1.0f / gden;
        const int row = 32 * vcu + tid, ea = grp * 8 + i0, eb = grp * 8 + i1;
        const int pa = __hip_atomic_fetch_add(lhist + ea, 1, __ATOMIC_RELAXED, __HIP_MEMORY_SCOPE_WORKGROUP); inv[(vcu * 32 + ea) * 32 + pa] = row * 2; tg[row * 2] = pg / den;
        const int pb = __hip_atomic_fetch_add(lhist + eb, 1, __ATOMIC_RELAXED, __HIP_MEMORY_SCOPE_WORKGROUP); inv[(vcu * 32 + eb) * 32 + pb] = row * 2 + 1; tg[row * 2 + 1] = pg * e1 / den;
    }
    __syncthreads();
    if (tid < 32) hist[vcu * 32 + tid] = lhist[tid];
}

constexpr int KRS = 144, AT_K = 0, AT_V = 256 * KRS, AT_BIAS = 2 * 256 * KRS, AT_BYTES = AT_BIAS + 8 * 128 * 4;
__device__ __forceinline__ int t5_bucket(int n) { if (n < 16) return n; int l = 16 + (int)(__logf((float)n * (1.f / 16.f)) / 2.0794415416798357f * 16.f); return l < 31 ? l : 31; }
__device__ __forceinline__ void attn_phase(LAS unsigned char* lds, const bf16_t* Qb, const bf16_t* Kc, const bf16_t* Vc, const float* sinks, const float* relb, bf16_t* Og, int vcu, int G) {
    const int tid = opaque_tid(), lane = tid & 63, wid = __builtin_amdgcn_readfirstlane(tid >> 6), r = lane & 31, h = lane >> 5;
    LAS float* biasT = (LAS float*)(lds + AT_BIAS);
    for (int unit = vcu; unit < BATCH * AT_HKV * (SEQ / 128); unit += G) {
        const int b = unit >> 6, kvh = (unit >> 4) & 3, qblk = unit & 15, hq = kvh * 8 + wid;
        const int row0 = b * SEQ + qblk * 128;
#pragma unroll
        for (int it = 0; it < 4; ++it) { const int id = tid + 512 * it, i = id >> 3, ck = id & 7;
            u32x4 kv = {0u, 0u, 0u, 0u}, vv = {0u, 0u, 0u, 0u};
            if (qblk > 0 || i >= 128) { const size_t go = (size_t)(row0 - 128 + i) * KVW + kvh * 64 + ck * 8; kv = *(const u32x4*)(Kc + go); vv = *(const u32x4*)(Vc + go); }
            *(LAS u32x4*)(lds + AT_K + i * KRS + ck * 16) = kv; *(LAS u32x4*)(lds + AT_V + i * KRS + ck * 16) = vv; }
        for (int id = tid; id < 1024; id += 512) biasT[id] = relb[t5_bucket(id & 127) * AT_HQ + kvh * 8 + (id >> 7)];
        __syncthreads();
        const float sink = sinks[hq];
        for (int qs = 0; qs < 4; ++qs) {
            bf16x8 qf[4]; { const bf16_t* qp = Qb + (size_t)(row0 + 32 * qs + r) * D + hq * 64 + 8 * h;
#pragma unroll
                for (int ks = 0; ks < 4; ++ks) qf[ks] = *(const bf16x8*)(qp + 16 * ks); }
            f32x16 S[5];
#pragma unroll
            for (int kbi = 0; kbi < 5; ++kbi) {
#pragma unroll
                for (int e = 0; e < 16; ++e) S[kbi][e] = 0.f;
#pragma unroll
                for (int ks = 0; ks < 4; ++ks) S[kbi] = MFMA32(*(const LAS bf16x8*)(lds + AT_K + (32 * (qs + kbi) + r) * KRS + (16 * ks + 8 * h) * 2), qf[ks], S[kbi]); }
            float m = -1e30f;
#pragma unroll
            for (int kbi = 0; kbi < 5; ++kbi)
#pragma unroll
                for (int e = 0; e < 16; ++e) { const int keyb = 32 * (qs + kbi) + (e & 3) + 8 * (e >> 2) + 4 * h, dist = 128 + 32 * qs + r - keyb;
                    const bool valid = dist >= 0 && dist < 128 && (qblk > 0 || keyb >= 128);
                    const float sv = valid ? S[kbi][e] * 0.125f + biasT[wid * 128 + (dist & 127)] : -1e30f;
                    S[kbi][e] = sv; m = fmaxf(m, sv); }
            m = fmaxf(m, __shfl_xor(m, 32)); m = fmaxf(m, sink);
            float l = 0.f;
#pragma unroll
            for (int kbi = 0; kbi < 5; ++kbi)
#pragma unroll
                for (int e = 0; e < 16; ++e) { const float pv = __expf(S[kbi][e] - m); S[kbi][e] = pv; l += pv; }
            l += __shfl_xor(l, 32); l += __expf(sink - m);
            f32x16 O[2];
#pragma unroll
            for (int e = 0; e < 16; ++e) { O[0][e] = 0.f; O[1][e] = 0.f; }
            const int i16 = lane & 15, qq = i16 >> 2, pp = i16 & 3, gg = (lane >> 4) & 1;
#pragma unroll
            for (int kbi = 0; kbi < 5; ++kbi)
#pragma unroll
                for (int s2 = 0; s2 < 2; ++s2) {
                    u32x4 pk; pk.x = pg8::cvt_pk_bf16(S[kbi][8 * s2 + 0], S[kbi][8 * s2 + 1]); pk.y = pg8::cvt_pk_bf16(S[kbi][8 * s2 + 2], S[kbi][8 * s2 + 3]);
                    pk.z = pg8::cvt_pk_bf16(S[kbi][8 * s2 + 4], S[kbi][8 * s2 + 5]); pk.w = pg8::cvt_pk_bf16(S[kbi][8 * s2 + 6], S[kbi][8 * s2 + 7]);
                    const bf16x8 pf = __builtin_bit_cast(bf16x8, pk);
#pragma unroll
                    for (int db = 0; db < 2; ++db) { const LAS unsigned char* va = lds + AT_V + (32 * (qs + kbi) + 16 * s2 + 4 * h + qq) * KRS + (32 * db + 16 * gg + 4 * pp) * 2;
                        const s16x4 lo = __builtin_amdgcn_ds_read_tr16_b64_v4i16((lds_s16x4*)va), hi = __builtin_amdgcn_ds_read_tr16_b64_v4i16((lds_s16x4*)(va + 8 * KRS));
                        const bf16x8 vf = {lo[0], lo[1], lo[2], lo[3], hi[0], hi[1], hi[2], hi[3]};
                        O[db] = MFMA32(vf, pf, O[db]); } }
            const float inv = 1.0f / l;
            bf16_t* op = Og + (size_t)(row0 + 32 * qs + r) * D + hq * 64 + 4 * h;
#pragma unroll
            for (int db = 0; db < 2; ++db)
#pragma unroll
                for (int g4 = 0; g4 < 4; ++g4) { f32x4 v; v[0] = O[db][4 * g4] * inv; v[1] = O[db][4 * g4 + 1] * inv; v[2] = O[db][4 * g4 + 2] * inv; v[3] = O[db][4 * g4 + 3] * inv;
                    *(u32x2*)(op + 32 * db + 8 * g4) = pack4(v); }
        }
        __syncthreads();
    }
}

constexpr int LDS_STAGE = 0;
constexpr int LDS_MOETAB = pg8::STAGE_BYTES;
constexpr int LDS_MISC = LDS_MOETAB + pg8::MOE_TAB_INTS * 4;
constexpr int LDS_BYTES = 147456;
static_assert(RT_BYTES <= pg8::STAGE_BYTES && LDS_MISC + 256 <= LDS_BYTES && H1_BYTES <= pg8::STAGE_BYTES && 8 * 8448 <= pg8::STAGE_BYTES && AT_BYTES <= pg8::STAGE_BYTES, "LDS map");
constexpr int CW_BAR = 4096;
constexpr int N_PHASES = 1 + NA * 9 + (DEPTH - NA) * 7;

struct MegaArgs { const float* in[19]; float* out; unsigned char* ws; int ph_lo, ph_hi; };

__global__ void __launch_bounds__(512, 2) mega_fwd(MegaArgs args) {
    extern __shared__ __attribute__((aligned(16))) unsigned char lds_raw[];
    LAS unsigned char* lds = (LAS unsigned char*)lds_raw;
    volatile LAS unsigned* MISC = (volatile LAS unsigned*)(lds + LDS_MISC);
    const int tid = threadIdx.x, G = gridDim.x, bx = blockIdx.x, vcu = (G % 8 == 0) ? (bx % 8) * (G / 8) + bx / 8 : bx;
    unsigned char* const ws = args.ws;
    if (tid < 64) MISC[tid] = 0u;
    __syncthreads();
    const int lo = args.ph_lo, hi = args.ph_hi;
    XcdBarrier bar; bar.bar = (unsigned*)(ws + WS_CTL) + CW_BAR; bar.x = 0; bar.st = nullptr;
    if (hi - lo > 1) bar = xcd_barrier_post((unsigned*)(ws + WS_CTL) + CW_BAR, MISC + 8);
#define WSP(type, off) ((type*)(args.ws + (off)))
    int ph = 0;
#ifndef PROBE_DUP
#define PROBE_DUP 0
#endif
#define PHASE_T(dupbit, trash_body, ...) if (lo <= ph && ph < hi) { if ((PROBE_DUP >> (dupbit)) & 1) { trash_body; xcd_barrier(bar); } __VA_ARGS__; if (ph + 1 < hi) xcd_barrier(bar); } ++ph;
#define PHASE(dupbit, ...) if (lo <= ph && ph < hi) { __VA_ARGS__; if ((PROBE_DUP >> (dupbit)) & 1) { xcd_barrier(bar); __VA_ARGS__; } if (ph + 1 < hi) xcd_barrier(bar); } ++ph;

    PHASE(0, { Ptrs p; p.x = args.in[0]; p.a_w_in = args.in[1]; p.a_w_out = args.in[4]; p.b_w_kv = args.in[5]; p.b_w_q = args.in[6]; p.b_w_out = args.in[8]; p.w_gate = args.in[14]; p.w_up = args.in[15]; p.w_down = args.in[16]; p.w_rg = args.in[10]; p.w_re = args.in[12]; p.ws = args.ws;
               prologue_phase(lds, p, vcu, G); })

    for (int L = 0; L < DEPTH; ++L) {
        if (L < NA) {
            PHASE(1, { pg8::DenseSched S; S.init(T, 4 * D, D, G, bx); pg8::EpiHgrn E{WSP(bf16_t, WS_QB), WSP(bf16_t, WS_KB), WSP(bf16_t, WS_VB), WSP(bf16_t, WS_GT), WSP(float, WS_GL), args.in[2], L, 0};
                       pg8::gemm_phase<pg8::EpiHgrn, pg8::DenseSched>(lds, WSP(bf16_t, WS_XB), WSP(bf16_t, WS_WIN) + (size_t)L * 4 * D * D, D, 0, S, E); })
#define HGARGS HgArgs{WSP(bf16_t, WS_QB), WSP(bf16_t, WS_KB), WSP(bf16_t, WS_VB), WSP(bf16_t, WS_GT), WSP(bf16_t, WS_OF), WSP(bf16_t, WS_UT), WSP(bf16_t, WS_SST), WSP(bf16_t, WS_OG), WSP(float, WS_GL), WSP(float, WS_DG), args.in[3] + (size_t)L * D, WSP(bf16_t, WS_QB)}
            PHASE_T(6, { HgArgs ha = HGARGS; ha.Qt = WSP(bf16_t, WS_TRASH); ha.OI = WSP(bf16_t, WS_TRASH + 32 * MiB); ha.UT = WSP(bf16_t, WS_TRASH + 64 * MiB); ha.Dg = WSP(float, WS_TRASH + 128 * MiB); h1_phase(lds, ha, vcu, G); },
                    { const HgArgs ha = HGARGS; h1_phase(lds, ha, vcu, G); })
            PHASE(3, { const HgArgs ha = HGARGS; h2_phase(ha, vcu, G); })
            PHASE(3, { const HgArgs ha = HGARGS; h3_phase(ha, vcu, G); })
            PHASE(1, { pg8::DenseSched S; S.init(T, D, D, G, bx); pg8::EpiStore E{WSP(bf16_t, WS_HM), WSP(bf16_t, WS_HM), D, 1 << 30, 1.0f, 0};
                       pg8::gemm_phase<pg8::EpiStore, pg8::DenseSched>(lds, WSP(bf16_t, WS_OG), WSP(bf16_t, WS_WOUT) + (size_t)L * D * D, D, 0, S, E); })
        } else {
            const int j = L - NA;
            PHASE(1, { if (j == 0) { pg8::DenseSched S; S.init(T, 2 * KVW, D, G, bx); pg8::EpiStore E{WSP(bf16_t, WS_KC), WSP(bf16_t, WS_VC), KVW, 1, 1.0f, 0};
                                     pg8::gemm_phase<pg8::EpiStore, pg8::DenseSched>(lds, WSP(bf16_t, WS_XB), WSP(bf16_t, WS_WKV), D, 0, S, E); }
                       pg8::DenseSched S; S.init(T, D, D, G, bx); pg8::EpiStore E{WSP(bf16_t, WS_QB), WSP(bf16_t, WS_QB), D, 1 << 30, 1.0f, 0};
                       pg8::gemm_phase<pg8::EpiStore, pg8::DenseSched>(lds, WSP(bf16_t, WS_XB), WSP(bf16_t, WS_WQ) + (size_t)j * D * D, D, 0, S, E); })
            PHASE(3, attn_phase(lds, WSP(bf16_t, WS_QB), WSP(bf16_t, WS_KC), WSP(bf16_t, WS_VC), args.in[7] + j * AT_HQ, args.in[9], WSP(bf16_t, WS_OG), vcu, G))
            PHASE(1, { pg8::DenseSched S; S.init(T, D, D, G, bx); pg8::EpiStore E{WSP(bf16_t, WS_HM), WSP(bf16_t, WS_HM), D, 1 << 30, 1.0f, 0};
                       pg8::gemm_phase<pg8::EpiStore, pg8::DenseSched>(lds, WSP(bf16_t, WS_OG), WSP(bf16_t, WS_WO) + (size_t)j * D * D, D, 0, S, E); })
        }
#define LN0_ARGS(XF, XB, HIST, INV, TG) ln_router_phase(lds, L == 0 ? args.in[0] : WSP(float, WS_XF), WSP(bf16_t, WS_HM), args.in[17] + (size_t)(2 * L) * D, args.in[18] + (size_t)(2 * L) * D, XF, XB, \
            WSP(bf16_t, WS_WR) + (size_t)L * 64 * D, WSP(bf16_t, WS_WR) + (size_t)(DEPTH + L) * 64 * D, args.in[11] + L * NGRP, args.in[13] + L * NEXP, HIST, INV, TG, vcu, G)
        PHASE_T(4, LN0_ARGS(WSP(float, WS_TRASH), WSP(bf16_t, WS_TRASH + 64 * MiB), WSP(int, WS_TRASH + 100 * MiB), WSP(int, WS_TRASH + 96 * MiB), WSP(float, WS_TRASH + 98 * MiB)),
                LN0_ARGS(WSP(float, WS_XF2), WSP(bf16_t, WS_XB), WSP(int, WS_HIST), WSP(int, WS_LIST), WSP(float, WS_TG)))
#undef LN0_ARGS
        PHASE(2, { LAS int* tab = (LAS int*)(lds + LDS_MOETAB); pg8::MoeSched S{tab, 4, G, vcu, D, 1}; S.build(tab, (LAS int*)lds, WSP(int, WS_HIST), WSP(int, WS_LIST));
                   pg8::gemm_phase<pg8::EpiMoeH, pg8::MoeSched>(lds, WSP(bf16_t, WS_XB), WSP(bf16_t, WS_WGU) + (size_t)L * NEXP * 2 * DEXP * D, D, (size_t)2 * DEXP * D * 2, S, pg8::EpiMoeH{WSP(bf16_t, WS_HS)}); })
        PHASE(2, { LAS int* tab = (LAS int*)(lds + LDS_MOETAB); pg8::MoeSched S{tab, 8, G, vcu, DEXP, 0}; S.build(tab, (LAS int*)lds, WSP(int, WS_HIST), WSP(int, WS_LIST));
                   pg8::gemm_phase<pg8::EpiMoeY, pg8::MoeSched>(lds, WSP(bf16_t, WS_HS), WSP(bf16_t, WS_WD) + (size_t)L * NEXP * D * DEXP, DEXP, (size_t)D * DEXP * 2, S, pg8::EpiMoeY{WSP(bf16_t, WS_Y), WSP(float, WS_TG), S}); })
        PHASE_T(5, ln_phase<1>(WSP(float, WS_XF2), nullptr, WSP(bf16_t, WS_Y), args.in[17] + (size_t)(2 * L + 1) * D, args.in[18] + (size_t)(2 * L + 1) * D, WSP(float, WS_TRASH), WSP(bf16_t, WS_TRASH + 64 * MiB),
                             nullptr, nullptr, nullptr, nullptr, nullptr, nullptr, nullptr, vcu, G),
                ln_phase<1>(WSP(float, WS_XF2), nullptr, WSP(bf16_t, WS_Y), args.in[17] + (size_t)(2 * L + 1) * D, args.in[18] + (size_t)(2 * L + 1) * D, L == DEPTH - 1 ? args.out : WSP(float, WS_XF), L == DEPTH - 1 ? nullptr : WSP(bf16_t, WS_XB),
                             nullptr, nullptr, nullptr, nullptr, nullptr, nullptr, nullptr, vcu, G))
    }
#undef HGARGS
#undef WSP
#undef PHASE
#undef PHASE_T
}

#ifndef MK_PER_PHASE
#define MK_PER_PHASE 0
#endif
extern "C" void kernel_launch(void* const* d_in, const int* in_sizes, int n_in, void* d_out, int out_size, void* d_ws, size_t ws_size, hipStream_t stream) {
    static int grid = 0;
    if (grid == 0) {
        if (n_in != 19 || out_size != T * D || ws_size < WS_END) { fprintf(stderr, "kernel_launch: unexpected arguments (n_in %d, out %d, ws %zu < %zu)\n", n_in, out_size, ws_size, (size_t)WS_END); grid = -1; return; }
        int dev = 0, cus = 0, per_cu = 0;
        if (hipGetDevice(&dev) != hipSuccess || hipDeviceGetAttribute(&cus, hipDeviceAttributeMultiprocessorCount, dev) != hipSuccess) { grid = -1; return; }
        if (hipFuncSetAttribute((const void*)mega_fwd, hipFuncAttributeMaxDynamicSharedMemorySize, LDS_BYTES) != hipSuccess) { fprintf(stderr, "kernel_launch: hipFuncSetAttribute failed\n"); grid = -1; return; }
        if (hipOccupancyMaxActiveBlocksPerMultiprocessor(&per_cu, (const void*)mega_fwd, 512, LDS_BYTES) != hipSuccess || per_cu < 1) { fprintf(stderr, "kernel_launch: occupancy query reports %d\n", per_cu); }
        (void)hipGetLastError();
        grid = cus;
        if (grid != 256) { fprintf(stderr, "kernel_launch: built for 256 CUs (the routing tables assume 256 workgroups of 32 token rows); this device reports %d\n", cus); grid = -1; return; }
    }
    if (grid < 0) return;
    (void)hipMemsetAsync((char*)d_ws + WS_CTL, 0, CTL_BYTES, stream);
    MegaArgs a{};
    for (int i = 0; i < 19; ++i) a.in[i] = (const float*)d_in[i];
    a.out = (float*)d_out; a.ws = (unsigned char*)d_ws;
#if MK_PER_PHASE
    for (int ph = 0; ph < N_PHASES; ++ph) { a.ph_lo = ph; a.ph_hi = ph + 1; hipLaunchKernelGGL(mega_fwd, dim3(grid), dim3(512), LDS_BYTES, stream, a); }
#else
    a.ph_lo = 0; a.ph_hi = N_PHASES;
    hipLaunchKernelGGL(mega_fwd, dim3(grid), dim3(512), LDS_BYTES, stream, a);
#endif
}
```

```cpp
#include <hip/hip_runtime.h>
#include <cstdio>
#include <cstdint>

typedef unsigned short bf16_t;
typedef short bf16x8 __attribute__((ext_vector_type(8)));
typedef float f32x4 __attribute__((ext_vector_type(4)));

constexpr int BATCH = 4, SEQ = 2048, D = 2048, T = BATCH * SEQ, DEPTH = 4, NA = 2;
constexpr int HG_H = 16, HG_DK = 128;
constexpr int AT_HD = 64, AT_HQ = 32, AT_HKV = 4, AT_G = 8, KVW = AT_HKV * AT_HD;
constexpr int NGRP = 4, EPG = 8, NEXP = 32, DEXP = 512;
constexpr float ALPHA = 1.6817928305074290f;
constexpr float LN_EPS = 1e-5f, RMS_EPS = 1e-6f;

constexpr size_t MiB = 1u << 20;
constexpr size_t WS_CTL = 0, CTL_BYTES = 1 * MiB;
constexpr size_t WS_XF = 1 * MiB;
constexpr size_t WS_XB2 = WS_XF;
constexpr size_t WS_XB = WS_XF + 64 * MiB;
constexpr size_t WS_QB = WS_XB + 32 * MiB;
constexpr size_t WS_KB = WS_QB + 32 * MiB;
constexpr size_t WS_VB = WS_KB + 32 * MiB;
constexpr size_t WS_GT = WS_VB + 32 * MiB;
constexpr size_t WS_GL = WS_GT + 32 * MiB;
constexpr size_t WS_OF = WS_GL + 64 * MiB;
constexpr size_t WS_OG = WS_OF + 64 * MiB;
constexpr size_t WS_HM = WS_OG + 32 * MiB;
constexpr size_t WS_KC = WS_HM + 32 * MiB;
constexpr size_t WS_VC = WS_KC + 4 * MiB;
constexpr size_t WS_LIST = WS_VC + 4 * MiB;
constexpr size_t WS_TG = WS_LIST + 1 * MiB;
constexpr size_t WS_HS = WS_TG + 1 * MiB;
constexpr size_t WS_Y = WS_HS + 24 * MiB;
constexpr size_t WS_WIN = WS_Y + 64 * MiB;
constexpr size_t WS_WOUT = WS_WIN + 64 * MiB;
constexpr size_t WS_WKV = WS_WOUT + 16 * MiB;
constexpr size_t WS_WQ = WS_WKV + 2 * MiB;
constexpr size_t WS_WO = WS_WQ + 16 * MiB;
constexpr size_t WS_WGU = WS_WO + 16 * MiB;
constexpr size_t WS_WD = WS_WGU + 512 * MiB;
constexpr size_t WS_UT = WS_WD + 256 * MiB;
constexpr size_t WS_SST = WS_UT + 64 * MiB;
constexpr size_t WS_DG = WS_SST + 64 * MiB;
constexpr size_t WS_WR = WS_DG + 1 * MiB;
constexpr size_t WS_XF2 = WS_WR + 2 * MiB;
constexpr size_t WS_HIST = WS_XF2 + 64 * MiB;
constexpr size_t WS_TRASH = WS_HIST + 1 * MiB;
constexpr size_t WS_END = WS_TRASH + 256 * MiB;
constexpr int CW_CNT = 1024;

__device__ __forceinline__ unsigned f2bf(float f) { unsigned u = __builtin_bit_cast(unsigned, f); return (u + 0x7fffu + ((u >> 16) & 1u)) >> 16; }
__device__ __forceinline__ float bf2f(bf16_t b) { return __builtin_bit_cast(float, ((unsigned)b) << 16); }
__device__ __forceinline__ float wave_sum(float v) {
#pragma unroll
    for (int o = 1; o < 64; o <<= 1) v += __shfl_xor(v, o);
    return v;
}
__device__ __forceinline__ float wave_max(float v) {
#pragma unroll
    for (int o = 1; o < 64; o <<= 1) v = fmaxf(v, __shfl_xor(v, o));
    return v;
}
__device__ __forceinline__ float sigmoidf_(float x) { return 1.0f / (1.0f + __expf(-x)); }
__device__ __forceinline__ int opaque_tid() { int t = threadIdx.x; asm volatile("" : "+v"(t)); return t; }

#define LAS __attribute__((address_space(3)))
typedef unsigned u32x4 __attribute__((ext_vector_type(4)));
namespace pg8 {
constexpr int BM = 256, BK = 64, HALF = 128, HTB = HALF * BK * 2, STAGE_BYTES = 8 * HTB;
__host__ __device__ __forceinline__ int lds_byte(int r, int c) { const int st = (r >> 4) * 2 + (c >> 5), rr = r & 15, cc = c & 31, ob = rr * 64 + cc * 2; return st * 1024 + (ob ^ (((ob >> 9) & 1) << 5)); }
__host__ __device__ __forceinline__ void stage_rc(int b, int& R, int& C) { const int st = b / 1024, sb = b % 1024, swz = sb ^ (((sb >> 9) & 1) << 5); R = (st >> 1) * 16 + swz / 64; C = (st & 1) * 32 + (swz % 64) / 2; }
__host__ __device__ __forceinline__ int perm32(int rho) { const int n = rho >> 4, i = rho & 15; return 8 * (i >> 2) + 4 * n + (i & 3); }
struct Unit { int pm, pn, e, rows, tm, ui; };
typedef float f32x2_ __attribute__((ext_vector_type(2)));
typedef __bf16 bf16x2_ __attribute__((ext_vector_type(2)));
__device__ __forceinline__ unsigned cvt_pk_bf16(float lo, float hi) { const f32x2_ v = {lo, hi}; return __builtin_bit_cast(unsigned, __builtin_convertvector(v, bf16x2_)); }

struct DenseSched {
    int nM, nN, nwg, G, c, K;
    __device__ __forceinline__ void init(int M, int N, int K_, int G_, int c_) { nM = M / BM; nN = N / BM; nwg = nM * nN; G = G_; c = c_; K = K_; }
    __device__ __forceinline__ bool next(int i, Unit& u) const {
        const long L = (long)i * G + c; if (L >= nwg) return false;
        int wgid = (int)L; { const int q = nwg / 8, r = nwg % 8, xcd = wgid % 8, off = wgid / 8; wgid = (xcd < r ? xcd * (q + 1) : r * (q + 1) + (xcd - r) * q) + off; }
        const int nig = 8 * nN, gid = wgid / nig, fm = gid * 8, gsz = (nM - fm) < 8 ? (nM - fm) : 8;
        u.pm = fm + ((wgid % nig) % gsz); u.pn = (wgid % nig) / gsz; u.e = 0; u.rows = 256; u.tm = 0; u.ui = i; return true;
    }
    __device__ __forceinline__ unsigned a_off(const Unit& u, int half, int R) const { return (unsigned)((u.pm * 256 + half * 128 + R) * K) * 2u; }
};

template <class Epi, class Sched>
__device__ __forceinline__ void gemm_phase(LAS unsigned char* lds, const bf16_t* A, const bf16_t* Bt, int K, size_t bstride, const Sched& S, const Epi& E) {
    const int tid = opaque_tid(), wid = __builtin_amdgcn_readfirstlane(tid >> 6), lane = tid & 63, wr = wid >> 2, wc = wid & 3, fr = lane & 15, fq = lane >> 4;
    const int nt = K / BK;
    int sR[2], sC2[2]; unsigned voffB[2];
#pragma unroll
    for (int i = 0; i < 2; ++i) { int R, C; stage_rc(tid * 16 + i * 8192, R, C); const int Rb = (R & ~31) + perm32(R & 31); sR[i] = R; sC2[i] = C * 2; voffB[i] = (unsigned)(Rb * K + C) * 2u; }
    const size_t kstep = (size_t)(BK * 2);
    const size_t hstep = (size_t)HALF * K * 2;
    const size_t tstep = 2 * hstep;
    const unsigned ldsw = (unsigned)wid * 1024u;
    const int aoff = lds_byte(wr * 64 + fr, fq * 8), boff = lds_byte(wc * 32 + fr, fq * 8);
#define PG8_SA(b, h) (((b) * 2 + (h)) * HTB)
#define PG8_SB(b, h) ((4 + (b) * 2 + (h)) * HTB)
#define PG8_STAGE(bufoff, gbase, voff) do { _Pragma("unroll") for (int _i = 0; _i < 2; ++_i) \
        __builtin_amdgcn_global_load_lds((const unsigned*)((const char*)(gbase) + (voff)[_i]), (LAS unsigned*)(lds + (bufoff) + ldsw + _i * 8192), 16, 0, 0); } while (0)
#define PG8_LDA(dst, b, h) do { _Pragma("unroll") for (int m = 0; m < 4; ++m) _Pragma("unroll") for (int k = 0; k < 2; ++k) dst[m][k] = *(const LAS bf16x8*)(lds + PG8_SA(b, h) + aoff + m * 2048 + k * 1024); } while (0)
#define PG8_LDB(dst, b, h) do { _Pragma("unroll") for (int n = 0; n < 2; ++n) _Pragma("unroll") for (int k = 0; k < 2; ++k) dst[n][k] = *(const LAS bf16x8*)(lds + PG8_SB(b, h) + boff + n * 2048 + k * 1024); } while (0)
#define PG8_MMA(ai, bj, At, Bt_) do { __builtin_amdgcn_s_setprio(1); _Pragma("unroll") for (int m = 0; m < 4; ++m) _Pragma("unroll") for (int n = 0; n < 2; ++n) _Pragma("unroll") for (int k = 0; k < 2; ++k) \
        acc[ai][bj][m][n] = __builtin_amdgcn_mfma_f32_16x16x32_bf16(Bt_[n][k], At[m][k], acc[ai][bj][m][n], 0, 0, 0); __builtin_amdgcn_s_setprio(0); } while (0)
#define PG8_WAIT_V(n) asm volatile("s_waitcnt vmcnt(" #n ")" ::: "memory")
#define PG8_WAIT_L(n) asm volatile("s_waitcnt lgkmcnt(" #n ")" ::: "memory")
#define PG8_BAR __builtin_amdgcn_s_barrier()
#define PG8_SCHED __builtin_amdgcn_sched_barrier(0)
    Unit cur, nxt; int ui = 0;
    if (!S.next(0, cur)) return;
    f32x4 acc[2][2][4][2];
#pragma unroll
    for (int a = 0; a < 2; ++a)
#pragma unroll
        for (int b = 0; b < 2; ++b)
#pragma unroll
            for (int m = 0; m < 4; ++m)
#pragma unroll
                for (int n = 0; n < 2; ++n) acc[a][b][m][n] = (f32x4){0.f, 0.f, 0.f, 0.f};
    bf16x8 At[4][2], B0[2][2], B1[2][2];
    unsigned voffA0[2], voffA1[2];
#pragma unroll
    for (int i = 0; i < 2; ++i) { voffA0[i] = S.a_off(cur, 0, sR[i]) + sC2[i]; voffA1[i] = S.a_off(cur, 1, sR[i]) + sC2[i]; }
    const char* const Ab = (const char*)A;
    const char* cB = (const char*)Bt + (size_t)cur.e * bstride + (size_t)cur.pn * tstep;
    PG8_STAGE(PG8_SB(0, 0), cB, voffB); PG8_STAGE(PG8_SB(0, 1), cB + hstep, voffB); PG8_STAGE(PG8_SA(0, 0), Ab, voffA0); PG8_STAGE(PG8_SA(0, 1), Ab, voffA1);
    if (wr == 1) PG8_BAR;
    PG8_WAIT_V(2); PG8_BAR;
    PG8_STAGE(PG8_SB(1, 0), cB + kstep, voffB); PG8_STAGE(PG8_SA(1, 0), Ab + kstep, voffA0); PG8_STAGE(PG8_SB(1, 1), cB + hstep + kstep, voffB);
    PG8_WAIT_V(6); PG8_BAR;
    for (;;) {
        const bool has_next = S.next(ui + 1, nxt);
        const char* nB = has_next ? (const char*)Bt + (size_t)nxt.e * bstride + (size_t)nxt.pn * tstep : cB;
        for (int t = 0; t < nt; t += 2) {
            const bool last = (t == nt - 2);
            const char* a1 = Ab + (size_t)(t + 1) * kstep;
            const char* a2 = last ? Ab : Ab + (size_t)(t + 2) * kstep; const char* b2 = last ? nB : cB + (size_t)(t + 2) * kstep;
            const char* a3 = a2 + kstep; const char* b3 = b2 + kstep;
            PG8_LDB(B0, 0, 0); PG8_LDB(B1, 0, 1); PG8_SCHED; PG8_LDA(At, 0, 0); PG8_STAGE(PG8_SA(1, 1), a1, voffA1);
            if (last && has_next) {
#pragma unroll
                for (int i = 0; i < 2; ++i) { voffA0[i] = S.a_off(nxt, 0, sR[i]) + sC2[i]; voffA1[i] = S.a_off(nxt, 1, sR[i]) + sC2[i]; }
            }
            PG8_WAIT_V(8); PG8_WAIT_L(0); PG8_BAR; PG8_MMA(0, 0, At, B0); PG8_MMA(0, 1, At, B1); PG8_BAR; PG8_SCHED;
            PG8_LDA(At, 0, 1); PG8_STAGE(PG8_SB(0, 0), b2, voffB); PG8_STAGE(PG8_SB(0, 1), b2 + hstep, voffB); PG8_STAGE(PG8_SA(0, 0), a2, voffA0);
            PG8_WAIT_V(8); PG8_WAIT_L(0); PG8_BAR; PG8_MMA(1, 0, At, B0); PG8_MMA(1, 1, At, B1); PG8_BAR; PG8_SCHED;
            PG8_LDB(B0, 1, 0); PG8_LDB(B1, 1, 1); PG8_SCHED; PG8_LDA(At, 1, 0); PG8_STAGE(PG8_SA(0, 1), a2, voffA1);
            PG8_WAIT_V(8); PG8_WAIT_L(0); PG8_BAR; PG8_MMA(0, 0, At, B0); PG8_MMA(0, 1, At, B1); PG8_BAR; PG8_SCHED;
            PG8_LDA(At, 1, 1); PG8_STAGE(PG8_SB(1, 0), b3, voffB); PG8_STAGE(PG8_SB(1, 1), b3 + hstep, voffB); PG8_STAGE(PG8_SA(1, 0), a3, voffA0);
            PG8_WAIT_V(8); PG8_WAIT_L(0); PG8_BAR; PG8_MMA(1, 0, At, B0); PG8_MMA(1, 1, At, B1); PG8_BAR; PG8_SCHED;
        }
        if (wr == 0) PG8_BAR;
        E(acc, cur, wr, wc, fr, fq);
        if (!has_next) break;
#pragma unroll
        for (int a = 0; a < 2; ++a)
#pragma unroll
            for (int b = 0; b < 2; ++b)
#pragma unroll
                for (int m = 0; m < 4; ++m)
#pragma unroll
                    for (int n = 0; n < 2; ++n) acc[a][b][m][n] = (f32x4){0.f, 0.f, 0.f, 0.f};
        cur = nxt; cB = nB; ++ui;
        if (wr == 1) PG8_BAR;
    }
    PG8_WAIT_V(0);
    PG8_BAR;
#undef PG8_SA
#undef PG8_SB
#undef PG8_STAGE
#undef PG8_LDA
#undef PG8_LDB
#undef PG8_MMA
#undef PG8_WAIT_V
#undef PG8_WAIT_L
#undef PG8_BAR
#undef PG8_SCHED
}

#define PG8_ROWS_COLS const int row0 = u.pm * BM + wr * 64 + fr; const int col0 = wc * 32 + 8 * fq
__device__ __forceinline__ u32x4 pack8(const f32x4 v0, const f32x4 v1) { u32x4 w; w.x = cvt_pk_bf16(v0[0], v0[1]); w.y = cvt_pk_bf16(v0[2], v0[3]); w.z = cvt_pk_bf16(v1[0], v1[1]); w.w = cvt_pk_bf16(v1[2], v1[3]); return w; }
struct EpiStore {
    bf16_t* O; bf16_t* O2; int ldc, split; float scale; int pad;
    __device__ __forceinline__ void operator()(const f32x4 (&acc)[2][2][4][2], const Unit& u, int wr, int wc, int fr, int fq) const {
        PG8_ROWS_COLS; bf16_t* base = u.pn >= split ? O2 + (size_t)(u.pn - split) * BM : O + (size_t)u.pn * BM;
#pragma unroll
        for (int ai = 0; ai < 2; ++ai)
#pragma unroll
            for (int m = 0; m < 4; ++m) { bf16_t* rowp = base + (size_t)(row0 + ai * HALF + m * 16) * ldc + col0;
#pragma unroll
                for (int bj = 0; bj < 2; ++bj) *(u32x4*)(rowp + bj * HALF) = pack8(acc[ai][bj][m][0] * scale, acc[ai][bj][m][1] * scale); }
    }
};
struct EpiHgrn {
    bf16_t *Qb, *Kb, *Vb, *Gt; float* Gl; const float* lbraw; int layer, pad;
    __device__ __forceinline__ void operator()(const f32x4 (&acc)[2][2][4][2], const Unit& u, int wr, int wc, int fr, int fq) const {
        PG8_ROWS_COLS; const int seg = u.pn >> 3, ct = (u.pn & 7) * BM + col0;
        if (seg == 0 || seg == 2) { bf16_t* base = (seg == 0 ? Qb : Vb) + ct;
#pragma unroll
            for (int ai = 0; ai < 2; ++ai)
#pragma unroll
                for (int m = 0; m < 4; ++m) { bf16_t* rowp = base + (size_t)(row0 + ai * HALF + m * 16) * D;
#pragma unroll
                    for (int bj = 0; bj < 2; ++bj) *(u32x4*)(rowp + bj * HALF) = pack8(acc[ai][bj][m][0], acc[ai][bj][m][1]); }
        } else if (seg == 3) {
#pragma unroll
            for (int ai = 0; ai < 2; ++ai)
#pragma unroll
                for (int m = 0; m < 4; ++m) { bf16_t* rowp = Gt + ct + (size_t)(row0 + ai * HALF + m * 16) * D;
#pragma unroll
                    for (int bj = 0; bj < 2; ++bj) { f32x4 v[2];
#pragma unroll
                        for (int n = 0; n < 2; ++n)
#pragma unroll
                            for (int j = 0; j < 4; ++j) { const float x = acc[ai][bj][m][n][j]; v[n][j] = x * sigmoidf_(x); }
                        *(u32x4*)(rowp + bj * HALF) = pack8(v[0], v[1]); } }
        } else {
#pragma unroll
            for (int bj = 0; bj < 2; ++bj) { float lb[8];
#pragma unroll
                for (int j = 0; j < 8; ++j) { const int c = ct + bj * HALF + j; lb[j] = layer == 0 ? 0.f : sigmoidf_(lbraw[D + c] - lbraw[c]); }
#pragma unroll
                for (int ai = 0; ai < 2; ++ai)
#pragma unroll
                    for (int m = 0; m < 4; ++m) { const size_t o = (size_t)(row0 + ai * HALF + m * 16) * D + ct + bj * HALF; f32x4 kv[2], gv[2];
#pragma unroll
                        for (int n = 0; n < 2; ++n)
#pragma unroll
                            for (int j = 0; j < 4; ++j) { const float l = lb[4 * n + j], sg = sigmoidf_(acc[ai][bj][m][n][j]); gv[n][j] = __log2f(fmaxf(l + (1.f - l) * sg, 1e-30f));   kv[n][j] = (1.f - l) * (1.f - sg); }
                        *(u32x4*)(Kb + o) = pack8(kv[0], kv[1]); *(f32x4*)(Gl + o) = gv[0]; *(f32x4*)(Gl + o + 4) = gv[1]; } }
        }
    }
};


constexpr int MOE_MAXU = 4, MOE_TAB_INTS = 128 + 256 * MOE_MAXU;
struct MoeSched {
    const LAS int* tab; int NT, G, c, K, gather;
    __device__ __forceinline__ bool next(int i, Unit& u) const {
        const int L = i * G + c, TM = tab[32]; if (L >= TM * NT) return false;
        const int mt = L / NT; int e = 0; while (tab[e + 1] <= mt) ++e;
        u.pm = mt; u.pn = L - mt * NT; u.e = e; u.tm = mt - tab[e]; const int left = tab[64 + e] - 256 * u.tm; u.rows = left < 256 ? left : 256; u.ui = i; return true;
    }
    __device__ __forceinline__ int entry(const Unit& u, int r) const {
        const int a = tab[128 + 256 * u.ui + r]; return a >= 0 ? a : tab[128 + 256 * u.ui];
    }
    __device__ __forceinline__ unsigned a_off(const Unit& u, int half, int R) const {
        if (gather) return (unsigned)((entry(u, half * 128 + R) >> 1) * K) * 2u;
        return (unsigned)((u.pm * 256 + half * 128 + R) * K) * 2u;
    }
    __device__ __forceinline__ void build(LAS int* t, LAS int* scr, const int* hist, const int* inv) const {
        const int tid = opaque_tid(), lane = tid & 63, wv = tid >> 6;
        { const int e = tid & 31, part = tid >> 5; int sum = 0;
#pragma unroll 4
          for (int b = part * 16; b < part * 16 + 16; ++b) sum += hist[b * 32 + e];
          scr[tid] = sum; }
        __syncthreads();
        if (tid < 32) { int sum = 0; for (int part = 0; part < 16; ++part) sum += scr[part * 32 + tid]; t[64 + tid] = sum; }
        __syncthreads();
        if (tid == 0) { int p = 0; for (int e = 0; e < 32; ++e) { t[e] = p; p += (t[64 + e] + 255) >> 8; } t[32] = p; }
        __syncthreads();
        for (int i = 0; i < MOE_MAXU; ++i) { Unit u; if (!next(i, u)) break;
            int hv = 0, incl = 0;
            if (tid < 256) { hv = hist[tid * 32 + u.e]; incl = hv;
#pragma unroll
                for (int o = 1; o < 64; o <<= 1) { const int tv = __shfl_up(incl, o); if (lane >= o) incl += tv; }
                if (lane == 63) scr[wv] = incl; }
            __syncthreads();
            if (tid < 256) { int off = 0; for (int w2 = 0; w2 < wv; ++w2) off += scr[w2]; scr[512 + tid] = off + incl - hv; if (tid == 255) scr[512 + 256] = off + incl; }
            __syncthreads();
            if (tid < 256) { const int pos = 256 * u.tm + tid; int ent = -1;
                if (pos < t[64 + u.e]) { int lo = 0, hi = 256;
                    while (hi - lo > 1) { const int mid = (lo + hi) >> 1; if (scr[512 + mid] <= pos) lo = mid; else hi = mid; }
                    ent = inv[(lo * 32 + u.e) * 32 + (pos - scr[512 + lo])]; }
                t[128 + 256 * i + tid] = ent; }
            __syncthreads();
        }
    }
};
struct EpiMoeH {
    bf16_t* Hs;
    __device__ __forceinline__ void operator()(const f32x4 (&acc)[2][2][4][2], const Unit& u, int wr, int wc, int fr, int fq) const {
        const int col0 = u.pn * 128 + wc * 32 + 8 * fq;
#pragma unroll
        for (int ai = 0; ai < 2; ++ai)
#pragma unroll
            for (int m = 0; m < 4; ++m) { const int rl = ai * HALF + wr * 64 + m * 16 + fr; f32x4 v[2];
#pragma unroll
                for (int n = 0; n < 2; ++n)
#pragma unroll
                    for (int j = 0; j < 4; ++j) { const float g = acc[ai][0][m][n][j]; v[n][j] = g * sigmoidf_(g) * acc[ai][1][m][n][j]; }
                if (rl < u.rows) *(u32x4*)(Hs + (size_t)(u.pm * 256 + rl) * DEXP + col0) = pack8(v[0], v[1]); }
    }
};
struct EpiMoeY {
    bf16_t* Y; const float* tg; MoeSched S;
    __device__ __forceinline__ void operator()(const f32x4 (&acc)[2][2][4][2], const Unit& u, int wr, int wc, int fr, int fq) const {
        const int col0 = u.pn * BM + wc * 32 + 8 * fq;
#pragma unroll
        for (int ai = 0; ai < 2; ++ai)
#pragma unroll
            for (int m = 0; m < 4; ++m) { const int rl = ai * HALF + wr * 64 + m * 16 + fr;
                if (rl < u.rows) { const int a = S.entry(u, rl); const float g = tg[a]; bf16_t* rowp = Y + (size_t)a * D + col0;
#pragma unroll
                    for (int bj = 0; bj < 2; ++bj) *(u32x4*)(rowp + bj * HALF) = pack8(acc[ai][bj][m][0] * g, acc[ai][bj][m][1] * g); } }
    }
};

__device__ __forceinline__ void transpose_item(const float* W, int K, int N, bf16_t* WT, int dst_row0, LAS float* scr, int kb, int nb, int lane) {
    const int k0 = 64 * kb, n0 = 32 * nb;
    float tmp[32]; const float* src = W + (size_t)(k0 + (lane >> 5)) * N + n0 + (lane & 31);
#pragma unroll
    for (int i = 0; i < 32; ++i) tmp[i] = src[(size_t)(2 * i) * N];
#pragma unroll
    for (int i = 0; i < 32; ++i) scr[(2 * i + (lane >> 5)) * 33 + (lane & 31)] = tmp[i];
    asm volatile("s_waitcnt lgkmcnt(0)" ::: "memory");
    const int c = lane & 7;
#pragma unroll
    for (int j = 0; j < 4; ++j) { const int n = (lane >> 3) + 8 * j; const LAS float* sp = scr + (8 * c) * 33 + n;
        u32x4 o; o.x = cvt_pk_bf16(sp[0 * 33], sp[1 * 33]); o.y = cvt_pk_bf16(sp[2 * 33], sp[3 * 33]); o.z = cvt_pk_bf16(sp[4 * 33], sp[5 * 33]); o.w = cvt_pk_bf16(sp[6 * 33], sp[7 * 33]);
        *(u32x4*)(WT + (size_t)(dst_row0 + n) * K + k0 + 8 * c) = o; }
    asm volatile("s_waitcnt lgkmcnt(0)" ::: "memory");
}
}

typedef short s16x4 __attribute__((ext_vector_type(4)));
typedef LAS s16x4 lds_s16x4;
constexpr int HRS = 272, ARS = 144;
constexpr int H1_QH = 0, H1_KH0 = H1_QH + 64 * HRS, H1_KH1 = H1_KH0 + 16 * HRS, H1_KH2 = H1_KH1 + 32 * HRS, H1_KH3 = H1_KH2 + 48 * HRS, H1_KT = H1_KH3 + 64 * HRS,
              H1_VS = H1_KT + 64 * HRS, H1_AS = H1_VS + 64 * HRS, H1_TOT = H1_AS + 64 * ARS, H1_BYTES = H1_TOT + 4096;
constexpr int NUNIT = BATCH * HG_H * (SEQ / 64);
__device__ __forceinline__ bf16x8 tr_frag16(const LAS unsigned char* tile, int rs, int r0, int c0, int lane) {
    const int g = lane >> 4, i = lane & 15, q = i >> 2, p = i & 3;
    const LAS unsigned char* a = tile + (r0 + 8 * g + q) * rs + (c0 + 4 * p) * 2;
    const s16x4 lo = __builtin_amdgcn_ds_read_tr16_b64_v4i16((lds_s16x4*)a);
    const s16x4 hi = __builtin_amdgcn_ds_read_tr16_b64_v4i16((lds_s16x4*)(a + 4 * rs));
    return (bf16x8){lo[0], lo[1], lo[2], lo[3], hi[0], hi[1], hi[2], hi[3]};
}
__device__ __forceinline__ bf16x8 row_frag16(const LAS unsigned char* tile, int rs, int r0, int c0, int lane) {
    return *(const LAS bf16x8*)(tile + (r0 + (lane & 15)) * rs + (c0 + 8 * (lane >> 4)) * 2);
}
#define MFMA16(a, b, c) __builtin_amdgcn_mfma_f32_16x16x32_bf16((a), (b), (c), 0, 0, 0)
typedef unsigned u32x2 __attribute__((ext_vector_type(2)));
__device__ __forceinline__ u32x2 pack4(const f32x4 v) { u32x2 r; r.x = pg8::cvt_pk_bf16(v[0], v[1]); r.y = pg8::cvt_pk_bf16(v[2], v[3]); return r; }

struct HgArgs { bf16_t *Qb, *Kb, *Vb, *Gt, *OI, *UT, *Sst, *Og; float *Gl, *Dg; const float* ng; bf16_t* Qt; };

typedef float f32x2 __attribute__((ext_vector_type(2)));
__device__ __forceinline__ f32x2 exp2v(const f32x2 x) { f32x2 r; r.x = __builtin_amdgcn_exp2f(x.x); r.y = __builtin_amdgcn_exp2f(x.y); return r; }
__device__ __forceinline__ f32x2 bf2v(unsigned w) { f32x2 r; r.x = __builtin_bit_cast(float, w << 16); r.y = __builtin_bit_cast(float, w & 0xffff0000u); return r; }
__device__ __forceinline__ unsigned v2bf(const f32x2 v) { return pg8::cvt_pk_bf16(v.x, v.y); }
struct H1In { f32x2 g[8]; unsigned q[8], k[8]; u32x4 v[2]; };
__device__ __forceinline__ void h1_load(H1In& in, const HgArgs& a, int unit, int tid) {
    const int bh = unit >> 5, c = unit & 31, b = bh >> 4, h = bh & 15, cp = tid & 63, tq = tid >> 6;
    const size_t gbase = ((size_t)b * SEQ + c * 64) * D + h * 128;
#pragma unroll
    for (int i = 0; i < 8; ++i) { const size_t go = gbase + (size_t)(8 * tq + i) * D + 2 * cp; in.g[i] = *(const f32x2*)(a.Gl + go); in.q[i] = *(const unsigned*)(a.Qb + go); in.k[i] = *(const unsigned*)(a.Kb + go); }
#pragma unroll
    for (int i = 0; i < 2; ++i) { const int id = tid + 512 * i, r = id >> 4, ck = id & 15; in.v[i] = *(const u32x4*)(a.Vb + gbase + (size_t)r * D + ck * 8); }
}
__device__ __forceinline__ void h1_phase(LAS unsigned char* lds, const HgArgs& a, int vcu, int G) {
    const int tid = opaque_tid(), lane = tid & 63, wid = __builtin_amdgcn_readfirstlane(tid >> 6);
    const int cp = lane, tq = wid, J = wid >> 1, half = wid & 1;
    LAS f32x2* tot8 = (LAS f32x2*)(lds + H1_TOT);
    H1In in;
    if (vcu < NUNIT) h1_load(in, a, vcu, tid);
    for (int unit = vcu; unit < NUNIT; unit += G) {
        const int bh = unit >> 5, c = unit & 31, b = bh >> 4, h = bh & 15;
        const size_t gbase = ((size_t)b * SEQ + c * 64) * D + h * 128;
        f32x2 L[8]; { f32x2 l = {0.f, 0.f};
#pragma unroll
            for (int i = 0; i < 8; ++i) { l += in.g[i]; L[i] = l; } }
        tot8[tq * 64 + cp] = L[7];
#pragma unroll
        for (int i = 0; i < 2; ++i) { const int id = tid + 512 * i, r = id >> 4, ck = id & 15; *(LAS u32x4*)(lds + H1_VS + r * HRS + ck * 16) = in.v[i]; }
        for (int id = tid; id < 64 * ARS / 16; id += 512) *(LAS u32x4*)(lds + H1_AS + id * 16) = (u32x4){0u, 0u, 0u, 0u};
        __syncthreads();
        f32x2 tj[4];
#pragma unroll
        for (int M = 0; M < 4; ++M) tj[M] = tot8[(2 * M) * 64 + cp] + tot8[(2 * M + 1) * 64 + cp];
        f32x2 off = {0.f, 0.f}; if (half) off = tot8[(tq - 1) * 64 + cp];
        f32x2 aJ = {0.f, 0.f};
#pragma unroll
        for (int M = 0; M < 3; ++M) if (M < J) aJ += tj[M];
        const f32x2 PA = exp2v(aJ), L15 = tj[J == 0 ? 0 : J == 1 ? 1 : J == 2 ? 2 : 3];
        f32x2 cI[5];
#pragma unroll
        for (int I = 1; I <= 4; ++I) { f32x2 sx = {0.f, 0.f};
#pragma unroll
            for (int M = 1; M < 4; ++M) if (M > J && M < I) sx += tj[M];
            cI[I] = exp2v(sx); }
        const int khJ = J == 0 ? H1_KH0 : J == 1 ? H1_KH1 : J == 2 ? H1_KH2 : H1_KH3;
#pragma unroll
        for (int i = 0; i < 8; ++i) {
            const int t = 8 * tq + i; const int lo = t * HRS + cp * 4;
            const f32x2 q = bf2v(in.q[i]), k = bf2v(in.k[i]), Li = L[i] + off;
            const f32x2 ep = exp2v(Li), nl = -Li, en = exp2v((f32x2){fminf(nl.x, 80.f), fminf(nl.y, 80.f)}), rem = exp2v(L15 - Li);
            const f32x2 qh = q * ep, kr = k * rem;
            *(LAS unsigned*)(lds + H1_QH + lo) = v2bf(qh);
            *(unsigned*)(a.Qt + gbase + (size_t)t * D + 2 * cp) = v2bf(qh * PA);
            *(LAS unsigned*)(lds + khJ + lo) = v2bf(k * en);
#pragma unroll
            for (int I = 1; I <= 4; ++I) if (I > J) { constexpr int offs[5] = {H1_KH0, H1_KH1, H1_KH2, H1_KH3, H1_KT}; *(LAS unsigned*)(lds + offs[I] + lo) = v2bf(kr * cI[I]); }
        }
        if (J == 0 && half == 0) *(f32x2*)(a.Dg + (size_t)unit * 128 + 2 * cp) = exp2v((tj[0] + tj[1]) + (tj[2] + tj[3]));
        __syncthreads();
        if (unit + G < NUNIT) h1_load(in, a, unit + G, tid);
        for (int blk = wid; blk < 10; blk += 8) {
            const int I = blk < 1 ? 0 : blk < 3 ? 1 : blk < 6 ? 2 : 3, Jb = blk - (I * (I + 1)) / 2;
            const int khI = I == 0 ? H1_KH0 : I == 1 ? H1_KH1 : I == 2 ? H1_KH2 : H1_KH3;
            f32x4 acc = {0.f, 0.f, 0.f, 0.f};
#pragma unroll
            for (int ks = 0; ks < 4; ++ks) acc = MFMA16(row_frag16(lds + khI, HRS, 16 * Jb, 32 * ks, lane), row_frag16(lds + H1_QH, HRS, 16 * I, 32 * ks, lane), acc);
            const int tl = 16 * I + (lane & 15), s0 = 16 * Jb + 4 * (lane >> 4);
#pragma unroll
            for (int r = 0; r < 4; ++r) if (s0 + r > tl) acc[r] = 0.f;
            *(LAS u32x2*)(lds + H1_AS + tl * ARS + s0 * 2) = pack4(acc);
        }
        __syncthreads();
        {
            bf16x8 vtr[2];
#pragma unroll
            for (int ks = 0; ks < 2; ++ks) vtr[ks] = tr_frag16(lds + H1_VS, HRS, 32 * ks, 16 * wid, lane);
#pragma unroll
            for (int rb = 0; rb < 4; ++rb) { f32x4 acc = {0.f, 0.f, 0.f, 0.f};
#pragma unroll
                for (int ks = 0; ks < 2; ++ks) if (!(ks == 1 && rb < 2)) acc = MFMA16(vtr[ks], row_frag16(lds + H1_AS, ARS, 16 * rb, 32 * ks, lane), acc);
                *(u32x2*)(a.OI + gbase + (size_t)(16 * rb + (lane & 15)) * D + 16 * wid + 4 * (lane >> 4)) = pack4(acc); }
#pragma unroll
            for (int cb = 0; cb < 8; ++cb) { f32x4 acc = {0.f, 0.f, 0.f, 0.f};
#pragma unroll
                for (int ks = 0; ks < 2; ++ks) acc = MFMA16(tr_frag16(lds + H1_KT, HRS, 32 * ks, 16 * cb, lane), vtr[ks], acc);
                *(u32x2*)(a.UT + ((size_t)unit * 128 + 16 * wid + (lane & 15)) * 128 + 16 * cb + 4 * (lane >> 4)) = pack4(acc); }
        }
        __syncthreads();
    }
}
__device__ __forceinline__ void h2_phase(const HgArgs& a, int vcu, int G) {
    for (int item = vcu * 512 + opaque_tid(); item < BATCH * HG_H * 2048; item += G * 512) {
        const int bh = item >> 11, vec = item & 2047, ch0 = (vec & 15) * 8;
        float st[8];
#pragma unroll
        for (int j = 0; j < 8; ++j) st[j] = 0.f;
        for (int c = 0; c < 32; ++c) { const size_t u = (size_t)bh * 32 + c;
            *(u32x4*)(a.Sst + u * 16384 + vec * 8) = pg8::pack8((f32x4){st[0], st[1], st[2], st[3]}, (f32x4){st[4], st[5], st[6], st[7]});
            if (c < 31) { const uint4 uu = *(const uint4*)(a.UT + u * 16384 + vec * 8); const float4 d0 = *(const float4*)(a.Dg + u * 128 + ch0), d1 = *(const float4*)(a.Dg + u * 128 + ch0 + 4);
                const unsigned w[4] = {uu.x, uu.y, uu.z, uu.w}; const float dd[8] = {d0.x, d0.y, d0.z, d0.w, d1.x, d1.y, d1.z, d1.w};
#pragma unroll
                for (int j = 0; j < 4; ++j) { st[2 * j] = dd[2 * j] * st[2 * j] + bf2f((bf16_t)(w[j] & 0xffff)); st[2 * j + 1] = dd[2 * j + 1] * st[2 * j + 1] + bf2f((bf16_t)(w[j] >> 16)); } }
        }
    }
}
__device__ __forceinline__ void h3_phase(const HgArgs& a, int vcu, int G) {
    const int tid = opaque_tid(), lane = tid & 63, wid = __builtin_amdgcn_readfirstlane(tid >> 6);
    for (int pair = vcu; pair < NUNIT / 2; pair += G) {
        const int unit = pair * 2 + (wid >> 2), rb = wid & 3;
        const int bh = unit >> 5, c = unit & 31, b = bh >> 4, h = bh & 15;
        const size_t ro = ((size_t)b * SEQ + c * 64 + 16 * rb + (lane & 15)) * D + h * 128;
        bf16x8 qf[4];
#pragma unroll
        for (int ks = 0; ks < 4; ++ks) qf[ks] = *(const bf16x8*)(a.Qt + ro + 32 * ks + 8 * (lane >> 4));
        f32x4 o[8]; float ss = 0.f;
#pragma unroll
        for (int cb = 0; cb < 8; ++cb) { f32x4 acc = {0.f, 0.f, 0.f, 0.f};
            const bf16_t* sp = a.Sst + ((size_t)unit * 128 + 16 * cb + (lane & 15)) * 128 + 8 * (lane >> 4);
#pragma unroll
            for (int ks = 0; ks < 4; ++ks) acc = MFMA16(*(const bf16x8*)(sp + 32 * ks), qf[ks], acc);
            const uint2 oi = *(const uint2*)(a.OI + ro + 16 * cb + 4 * (lane >> 4));
            acc[0] += bf2f((bf16_t)(oi.x & 0xffff)); acc[1] += bf2f((bf16_t)(oi.x >> 16)); acc[2] += bf2f((bf16_t)(oi.y & 0xffff)); acc[3] += bf2f((bf16_t)(oi.y >> 16));
            o[cb] = acc; ss += (acc[0] * acc[0] + acc[1] * acc[1]) + (acc[2] * acc[2] + acc[3] * acc[3]); }
        ss += __shfl_xor(ss, 16); ss += __shfl_xor(ss, 32);
        const float r = 1.0f / sqrtf(ss * (1.f / 128.f) + RMS_EPS);
#pragma unroll
        for (int cb = 0; cb < 8; ++cb) { const int vc = 16 * cb + 4 * (lane >> 4); const float4 g = *(const float4*)(a.ng + h * 128 + vc); const uint2 gt = *(const uint2*)(a.Gt + ro + vc);
            f32x4 v; v[0] = o[cb][0] * r * g.x * bf2f((bf16_t)(gt.x & 0xffff)); v[1] = o[cb][1] * r * g.y * bf2f((bf16_t)(gt.x >> 16)); v[2] = o[cb][2] * r * g.z * bf2f((bf16_t)(gt.y & 0xffff)); v[3] = o[cb][3] * r * g.w * bf2f((bf16_t)(gt.y >> 16));
            *(u32x2*)(a.Og + ro + vc) = pack4(v); }
    }
}

#define XB_TMO      128
#define XB_XCNT(j)  (256  + 64 * (j))
#define XB_XSUB(j)  (1280 + 64 * (j))
#define XB_XGEN(j)  (2304 + 64 * (j))
#define XB_TOP      3328
#define XB_TOPGEN   3392
#define XCD_BAR_WORDS 3456
#define XB_SPIN_CAP (1u << 18)
__device__ __forceinline__ unsigned xb_ld(unsigned* p)              { return __hip_atomic_load(p, __ATOMIC_RELAXED, __HIP_MEMORY_SCOPE_AGENT); }
__device__ __forceinline__ unsigned xb_add(unsigned* p, unsigned v) { return __hip_atomic_fetch_add(p, v, __ATOMIC_RELAXED, __HIP_MEMORY_SCOPE_AGENT); }
__device__ __forceinline__ unsigned xb_xcc_id() { return (unsigned)__builtin_amdgcn_s_getreg((3 << 11) | 20) & 0xFu; }
#define XB_SPIN(cond, bar) do { unsigned _sp = 0; while (cond) { __builtin_amdgcn_s_sleep(1); \
    if ((++_sp & 255u) == 0u) { if (xb_ld(&(bar)[XB_TMO])) break; if (_sp > XB_SPIN_CAP) { atomicAdd(&(bar)[XB_TMO], 1u); break; } } } } while (0)
struct XcdBarrier { unsigned* bar; unsigned x; volatile LAS unsigned* st; };
__device__ __forceinline__ XcdBarrier xcd_barrier_post(unsigned* bar, volatile LAS unsigned* st) {
    XcdBarrier b; b.bar = bar; b.x = xb_xcc_id(); b.st = st;
    if (threadIdx.x == 0) (void)xb_add(&bar[XB_XCNT(b.x)], 1u);
    return b;
}
__device__ __forceinline__ void xcd_barrier_complete(unsigned* bar, unsigned x, unsigned& nloc, unsigned& nx) {
    const unsigned G = gridDim.x * gridDim.y * gridDim.z;
    unsigned sum, cnt, mine, sp = 0u;
    for (;;) {
        sum = 0u; cnt = 0u; mine = 0u;
#pragma unroll
        for (unsigned j = 0; j < 16; ++j) { const unsigned c = xb_ld(&bar[XB_XCNT(j)]); sum += c; cnt += (c > 0u) ? 1u : 0u; mine = (j == x) ? c : mine; }
        if (sum == G) break;
        __builtin_amdgcn_s_sleep(1);
        if ((++sp & 255u) == 0u) { if (xb_ld(&bar[XB_TMO])) break; if (sp > XB_SPIN_CAP) { atomicAdd(&bar[XB_TMO], 1u); break; } }
    }
    nloc = mine > 0u ? mine : 1u; nx = cnt > 0u ? cnt : 1u;
}
__device__ __forceinline__ void xcd_barrier(const XcdBarrier& b) {
    asm volatile("s_waitcnt vmcnt(0)" ::: "memory");
    __syncthreads();
    if (threadIdx.x == 0) {
        unsigned* bar = b.bar;
        __builtin_amdgcn_s_waitcnt(0);
        unsigned nloc = b.st[0], nx = b.st[1];
        if (nloc == 0u) { xcd_barrier_complete(bar, b.x, nloc, nx); b.st[0] = nloc; b.st[1] = nx; }
        const unsigned old = xb_add(&bar[XB_XSUB(b.x)], 1u);
        const unsigned gen = old / nloc;
        if (old + 1u == (gen + 1u) * nloc) {
            __builtin_amdgcn_fence(__ATOMIC_RELEASE, "agent");
            asm volatile("s_waitcnt vmcnt(0)" ::: "memory");
            const unsigned og = xb_add(&bar[XB_TOP], 1u);
            const unsigned tg = og / nx;
            if (og + 1u == (tg + 1u) * nx) xb_add(&bar[XB_TOPGEN], 1u);
            else XB_SPIN(xb_ld(&bar[XB_TOPGEN]) == tg, bar);
            __builtin_amdgcn_fence(__ATOMIC_ACQUIRE, "agent");
            xb_add(&bar[XB_XGEN(b.x)], 1u);
            asm volatile("s_waitcnt vmcnt(0)" ::: "memory");
        } else {
            XB_SPIN(xb_ld(&bar[XB_XGEN(b.x)]) == gen, bar);
            __builtin_amdgcn_fence(__ATOMIC_ACQUIRE, "agent");
            asm volatile("s_waitcnt vmcnt(0)" ::: "memory");
        }
    }
    __syncthreads();
}

struct Ptrs {
    const float *x, *a_w_in, *a_lb, *a_ng, *a_w_out, *b_w_kv, *b_w_q, *b_sinks, *b_w_out, *rel_bias, *w_rg, *b_rg, *w_re, *b_re, *w_gate, *w_up, *w_down, *ln_g, *ln_b;
    float* out; unsigned char* ws;
};
__device__ __forceinline__ void prologue_phase(LAS unsigned char* lds, const Ptrs& p, int vcu, int G) {
    const int tid = opaque_tid(), lane = tid & 63, wave = __builtin_amdgcn_readfirstlane(tid >> 6);
    LAS float* scr = (LAS float*)(lds + wave * 8448);
    const int gw = vcu * 8 + wave, NGW = G * 8;
    bf16_t* Win_t = (bf16_t*)(p.ws + WS_WIN); bf16_t* Wout_t = (bf16_t*)(p.ws + WS_WOUT); bf16_t* Wkv_t = (bf16_t*)(p.ws + WS_WKV); bf16_t* Wq_t = (bf16_t*)(p.ws + WS_WQ); bf16_t* Wo_t = (bf16_t*)(p.ws + WS_WO);
    bf16_t* Wgu_t = (bf16_t*)(p.ws + WS_WGU); bf16_t* Wd_t = (bf16_t*)(p.ws + WS_WD);
    constexpr int I_IN = 2 * 32 * 256, I_AO = 2 * 32 * 64, I_KV = 32 * 16, I_Q = 2 * 32 * 64, I_O = 2 * 32 * 64, I_G = 128 * 32 * 16, I_U = I_G, I_D = 128 * 8 * 64;
    constexpr int NITEMS = I_IN + I_AO + I_KV + I_Q + I_O + I_G + I_U + I_D;
    for (int it = gw; it < NITEMS; it += NGW) {
        int r = it;
        if (r < I_IN) { const int mat = r / (32 * 256), q = r % (32 * 256), kb = q / 256, nb = q % 256; pg8::transpose_item(p.a_w_in + (size_t)mat * D * 4 * D, D, 4 * D, Win_t + (size_t)mat * 4 * D * D, 32 * nb, scr, kb, nb, lane); continue; } r -= I_IN;
        if (r < I_AO) { const int mat = r / (32 * 64), q = r % (32 * 64), kb = q / 64, nb = q % 64; pg8::transpose_item(p.a_w_out + (size_t)mat * D * D, D, D, Wout_t + (size_t)mat * D * D, 32 * nb, scr, kb, nb, lane); continue; } r -= I_AO;
        if (r < I_KV) { const int kb = r / 16, nb = r % 16; pg8::transpose_item(p.b_w_kv, D, 2 * KVW, Wkv_t, 32 * nb, scr, kb, nb, lane); continue; } r -= I_KV;
        if (r < I_Q) { const int mat = r / (32 * 64), q = r % (32 * 64), kb = q / 64, nb = q % 64; pg8::transpose_item(p.b_w_q + (size_t)mat * D * D, D, D, Wq_t + (size_t)mat * D * D, 32 * nb, scr, kb, nb, lane); continue; } r -= I_Q;
        if (r < I_O) { const int mat = r / (32 * 64), q = r % (32 * 64), kb = q / 64, nb = q % 64; pg8::transpose_item(p.b_w_out + (size_t)mat * D * D, D, D, Wo_t + (size_t)mat * D * D, 32 * nb, scr, kb, nb, lane); continue; } r -= I_O;
        if (r < I_G + I_U) { const int up = r >= I_G; if (up) r -= I_G; const int mat = r / (32 * 16), q = r % (32 * 16), kb = q / 16, nb = q % 16;
            const int n0 = 32 * nb, drow = (n0 >> 7) * 256 + (n0 & 127) + (up ? 128 : 0);
            pg8::transpose_item((up ? p.w_up : p.w_gate) + (size_t)mat * D * DEXP, D, DEXP, Wgu_t + (size_t)mat * 2 * DEXP * D, drow, scr, kb, nb, lane); continue; } r -= I_G + I_U;
        { const int mat = r / (8 * 64), q = r % (8 * 64), kb = q / 64, nb = q % 64; pg8::transpose_item(p.w_down + (size_t)mat * DEXP * D, DEXP, D, Wd_t + (size_t)mat * D * DEXP, 32 * nb, scr, kb, nb, lane); }
    }
    { bf16_t* WRhi = (bf16_t*)(p.ws + WS_WR); bf16_t* WRlo = WRhi + (size_t)DEPTH * 64 * D;
      for (int i = vcu * 512 + tid; i < DEPTH * 64 * D; i += G * 512) { const int L = i / (64 * D), o = (i / D) % 64, d = i % D;
          const float w = o < 4 ? p.w_rg[((size_t)L * D + d) * NGRP + o] : o < 36 ? p.w_re[((size_t)L * D + d) * NEXP + (o - 4)] : 0.f;
          const unsigned hb = f2bf(w); WRhi[i] = (bf16_t)hb; WRlo[i] = (bf16_t)f2bf(w - bf2f((bf16_t)hb)); } }
    bf16_t* xb = (bf16_t*)(p.ws + WS_XB2);
    for (size_t i = (size_t)vcu * 512 + tid; i < (size_t)T * D / 4; i += (size_t)G * 512) { const float4 v = ((const float4*)p.x)[i];
        u32x2 o; o.x = pg8::cvt_pk_bf16(v.x, v.y); o.y = pg8::cvt_pk_bf16(v.z, v.w); ((u32x2*)xb)[i] = o; }
}

__device__ __forceinline__ f32x4 bf4(const u32x2 w) { f32x4 r; r[0] = __builtin_bit_cast(float, w.x << 16); r[1] = __builtin_bit_cast(float, w.x & 0xffff0000u); r[2] = __builtin_bit_cast(float, w.y << 16); r[3] = __builtin_bit_cast(float, w.y & 0xffff0000u); return r; }
__device__ __forceinline__ void ln2_phase(const bf16_t* x, const bf16_t* Y, const float* lng, const float* lnb, bf16_t* xb, float* out, int vcu, int G) {
    const int tid = opaque_tid();
    for (int row = vcu * 8 + (tid >> 6); row < T; row += G * 8) {
        const int lane = opaque_tid() & 63;
        f32x4 v[8]; float s = 0.f;
#pragma unroll
        for (int j = 0; j < 8; ++j) { const int c = 4 * lane + 256 * j;
            v[j] = bf4(*(const u32x2*)(x + (size_t)row * D + c)) * ALPHA + (bf4(*(const u32x2*)(Y + (size_t)(row * 2) * D + c)) + bf4(*(const u32x2*)(Y + (size_t)(row * 2 + 1) * D + c)));
            s += (v[j][0] + v[j][1]) + (v[j][2] + v[j][3]); }
        const float mean = wave_sum(s) * (1.f / D);
        float q = 0.f;
#pragma unroll
        for (int j = 0; j < 8; ++j) { v[j] = v[j] - mean; q += (v[j][0] * v[j][0] + v[j][1] * v[j][1]) + (v[j][2] * v[j][2] + v[j][3] * v[j][3]); }
        const float rstd = 1.0f / sqrtf(wave_sum(q) * (1.f / D) + LN_EPS);
#pragma unroll
        for (int j = 0; j < 8; ++j) { const int c = 4 * lane + 256 * j; const f32x4 g = *(const f32x4*)(lng + c), bb = *(const f32x4*)(lnb + c);
            v[j] = v[j] * rstd * g + bb;
            if (out) *(f32x4*)(out + (size_t)row * D + c) = v[j];
            else { u32x2 o; o.x = pg8::cvt_pk_bf16(v[j][0], v[j][1]); o.y = pg8::cvt_pk_bf16(v[j][2], v[j][3]); *(u32x2*)(xb + (size_t)row * D + c) = o; } }
    }
}

typedef float f32x16 __attribute__((ext_vector_type(16)));
#define MFMA32(a, b, c) __builtin_amdgcn_mfma_f32_32x32x16_bf16((a), (b), (c), 0, 0, 0)
constexpr int RT_RED = 0, RT_LOG = 8 * 64 * 32 * 4, RT_HIST = RT_LOG + 32 * 64 * 4, RT_BYTES = RT_HIST + 128;
__device__ __forceinline__ void ln_router_phase(LAS unsigned char* lds, const float* xin32, const bf16_t* xin16, const bf16_t* hm, const float* lng, const float* lnb, bf16_t* xlo, bf16_t* xb,
                                                const bf16_t* WRhi, const bf16_t* WRlo, const float* brg, const float* bre, int* hist, int* inv, float* tg, int vcu, int G) {
    const int tid = opaque_tid(), lane = tid & 63, wid = __builtin_amdgcn_readfirstlane(tid >> 6);
    LAS int* lhist = (LAS int*)(lds + RT_HIST);
    if (tid < 32) lhist[tid] = 0;
    {
        const int row0 = 32 * vcu + 4 * wid;
#pragma unroll 1
        for (int r = 0; r < 4; ++r) {
            f32x4 v[8]; float s = 0.f;
#pragma unroll
            for (int j = 0; j < 8; ++j) { const int c = 4 * lane + 256 * j; const size_t go = (size_t)(row0 + r) * D + c;
                const f32x4 a = xin32 ? *(const f32x4*)(xin32 + go) : bf4(*(const u32x2*)(xin16 + go)); const f32x4 hh = bf4(*(const u32x2*)(hm + go));
                v[j] = a * ALPHA + hh; s += (v[j][0] + v[j][1]) + (v[j][2] + v[j][3]); }
            const float mean = wave_sum(s) * (1.f / D);
            float q = 0.f;
#pragma unroll
            for (int j = 0; j < 8; ++j) { v[j] = v[j] - mean; q += (v[j][0] * v[j][0] + v[j][1] * v[j][1]) + (v[j][2] * v[j][2] + v[j][3] * v[j][3]); }
            const float rstd = 1.0f / sqrtf(wave_sum(q) * (1.f / D) + LN_EPS);
#pragma unroll
            for (int j = 0; j < 8; ++j) { const int c = 4 * lane + 256 * j; const f32x4 g = *(const f32x4*)(lng + c), bb = *(const f32x4*)(lnb + c);
                v[j] = v[j] * rstd * g + bb;
                u32x2 o; o.x = pg8::cvt_pk_bf16(v[j][0], v[j][1]); o.y = pg8::cvt_pk_bf16(v[j][2], v[j][3]); *(u32x2*)(xb + (size_t)(row0 + r) * D + c) = o;
                const f32x4 lo = v[j] - bf4(o); u32x2 ol; ol.x = pg8::cvt_pk_bf16(lo[0], lo[1]); ol.y = pg8::cvt_pk_bf16(lo[2], lo[3]); *(u32x2*)(xlo + (size_t)(row0 + r) * D + c) = ol; }
        }
    }
    asm volatile("s_waitcnt vmcnt(0)" ::: "memory");
    __syncthreads();
    {
        const int r = lane & 31, h = lane >> 5;
        f32x16 acc0, acc1;
#pragma unroll
        for (int e = 0; e < 16; ++e) { acc0[e] = 0.f; acc1[e] = 0.f; }
        const size_t xo = (size_t)(32 * vcu + r) * D + 256 * wid + 8 * h;
        const size_t wo = (size_t)r * D + 256 * wid + 8 * h;
#pragma unroll 4
        for (int sx = 0; sx < 16; ++sx) {
            const bf16x8 xh = *(const bf16x8*)(xb + xo + 16 * sx), xl = *(const bf16x8*)(xlo + xo + 16 * sx);
            const bf16x8 w0h = *(const bf16x8*)(WRhi + wo + 16 * sx), w0l = *(const bf16x8*)(WRlo + wo + 16 * sx), w1h = *(const bf16x8*)(WRhi + wo + (size_t)32 * D + 16 * sx), w1l = *(const bf16x8*)(WRlo + wo + (size_t)32 * D + 16 * sx);
            acc0 = MFMA32(xh, w0h, acc0); acc0 = MFMA32(xh, w0l, acc0); acc0 = MFMA32(xl, w0h, acc0);
            acc1 = MFMA32(xh, w1h, acc1); acc1 = MFMA32(xh, w1l, acc1); acc1 = MFMA32(xl, w1h, acc1);
        }
        LAS float* red = (LAS float*)(lds + RT_RED);
#pragma unroll
        for (int g4 = 0; g4 < 4; ++g4) {
            *(LAS f32x4*)(red + ((wid * 64 + r) * 32 + 8 * g4 + 4 * h)) = (f32x4){acc0[4 * g4], acc0[4 * g4 + 1], acc0[4 * g4 + 2], acc0[4 * g4 + 3]};
            *(LAS f32x4*)(red + ((wid * 64 + 32 + r) * 32 + 8 * g4 + 4 * h)) = (f32x4){acc1[4 * g4], acc1[4 * g4 + 1], acc1[4 * g4 + 2], acc1[4 * g4 + 3]}; }
    }
    __syncthreads();
    {
        const LAS float* red = (const LAS float*)(lds + RT_RED); LAS float* lg = (LAS float*)(lds + RT_LOG);
#pragma unroll
        for (int i = 0; i < 4; ++i) { const int idx = tid + 512 * i, o = idx >> 5, row = idx & 31; float sum = 0.f;
#pragma unroll
            for (int w2 = 0; w2 < 8; ++w2) sum += red[(w2 * 64 + o) * 32 + row];
            lg[row * 64 + o] = sum; }
    }
    __syncthreads();
    if (tid < 32) {
        const LAS float* lg = (const LAS float*)(lds + RT_LOG) + tid * 64;
        int grp = 0; float gmax = lg[0] + brg[0]; float glv[4]; glv[0] = gmax;
#pragma unroll
        for (int g = 1; g < 4; ++g) { glv[g] = lg[g] + brg[g]; if (glv[g] > gmax) { gmax = glv[g]; grp = g; } }
        float gden = 0.f;
#pragma unroll
        for (int g = 0; g < 4; ++g) gden += __expf(glv[g] - gmax);
        float v0 = -3.0e38f, v1 = -3.0e38f; int i0 = 0, i1 = 0;
#pragma unroll
        for (int e = 0; e < 8; ++e) { const float val = lg[4 + grp * 8 + e] + bre[grp * 8 + e];
            if (val > v0) { v1 = v0; i1 = i0; v0 = val; i0 = e; } else if (val > v1) { v1 = val; i1 = e; } }
        const float e1 = __expf(v1 - v0), den = 1.f + e1, pg = 1.0f / gden;
        const int row = 32 * vcu + tid, ea = grp * 8 + i0, eb = grp * 8 + i1;
        const int pa = __hip_atomic_fetch_add(lhist + ea, 1, __ATOMIC_RELAXED, __HIP_MEMORY_SCOPE_WORKGROUP); inv[(vcu * 32 + ea) * 32 + pa] = row * 2; tg[row * 2] = pg / den;
        const int pb = __hip_atomic_fetch_add(lhist + eb, 1, __ATOMIC_RELAXED, __HIP_MEMORY_SCOPE_WORKGROUP); inv[(vcu * 32 + eb) * 32 + pb] = row * 2 + 1; tg[row * 2 + 1] = pg * e1 / den;
    }
    __syncthreads();
    if (tid < 32) hist[vcu * 32 + tid] = lhist[tid];
}

constexpr int KRS = 144, AT_K = 0, AT_V = 256 * KRS, AT_BIAS = 2 * 256 * KRS, AT_BYTES = AT_BIAS + 8 * 128 * 4;
__device__ __forceinline__ int t5_bucket(int n) { if (n < 16) return n; int l = 16 + (int)(__logf((float)n * (1.f / 16.f)) / 2.0794415416798357f * 16.f); return l < 31 ? l : 31; }
__device__ __forceinline__ void attn_phase(LAS unsigned char* lds, const bf16_t* Qb, const bf16_t* Kc, const bf16_t* Vc, const float* sinks, const float* relb, bf16_t* Og, int vcu, int G) {
    const int tid = opaque_tid(), lane = tid & 63, wid = __builtin_amdgcn_readfirstlane(tid >> 6), r = lane & 31, h = lane >> 5;
    LAS float* biasT = (LAS float*)(lds + AT_BIAS);
    for (int unit = vcu; unit < BATCH * AT_HKV * (SEQ / 128); unit += G) {
        const int b = unit >> 6, kvh = (unit >> 4) & 3, qblk = unit & 15, hq = kvh * 8 + wid;
        const int row0 = b * SEQ + qblk * 128;
#pragma unroll
        for (int it = 0; it < 4; ++it) { const int id = tid + 512 * it, i = id >> 3, ck = id & 7;
            u32x4 kv = {0u, 0u, 0u, 0u}, vv = {0u, 0u, 0u, 0u};
            if (qblk > 0 || i >= 128) { const size_t go = (size_t)(row0 - 128 + i) * KVW + kvh * 64 + ck * 8; kv = *(const u32x4*)(Kc + go); vv = *(const u32x4*)(Vc + go); }
            *(LAS u32x4*)(lds + AT_K + i * KRS + ck * 16) = kv; *(LAS u32x4*)(lds + AT_V + i * KRS + ck * 16) = vv; }
        for (int id = tid; id < 1024; id += 512) biasT[id] = relb[t5_bucket(id & 127) * AT_HQ + kvh * 8 + (id >> 7)];
        __syncthreads();
        const float sink = sinks[hq];
        for (int qs = 0; qs < 4; ++qs) {
            bf16x8 qf[4]; { const bf16_t* qp = Qb + (size_t)(row0 + 32 * qs + r) * D + hq * 64 + 8 * h;
#pragma unroll
                for (int ks = 0; ks < 4; ++ks) qf[ks] = *(const bf16x8*)(qp + 16 * ks); }
            f32x16 S[5];
#pragma unroll
            for (int kbi = 0; kbi < 5; ++kbi) {
#pragma unroll
                for (int e = 0; e < 16; ++e) S[kbi][e] = 0.f;
#pragma unroll
                for (int ks = 0; ks < 4; ++ks) S[kbi] = MFMA32(*(const LAS bf16x8*)(lds + AT_K + (32 * (qs + kbi) + r) * KRS + (16 * ks + 8 * h) * 2), qf[ks], S[kbi]); }
            float m = -1e30f;
#pragma unroll
            for (int kbi = 0; kbi < 5; ++kbi)
#pragma unroll
                for (int e = 0; e < 16; ++e) { const int keyb = 32 * (qs + kbi) + (e & 3) + 8 * (e >> 2) + 4 * h, dist = 128 + 32 * qs + r - keyb;
                    const bool valid = dist >= 0 && dist < 128 && (qblk > 0 || keyb >= 128);
                    const float sv = valid ? S[kbi][e] * 0.125f + biasT[wid * 128 + (dist & 127)] : -1e30f;
                    S[kbi][e] = sv; m = fmaxf(m, sv); }
            m = fmaxf(m, __shfl_xor(m, 32)); m = fmaxf(m, sink);
            float l = 0.f;
#pragma unroll
            for (int kbi = 0; kbi < 5; ++kbi)
#pragma unroll
                for (int e = 0; e < 16; ++e) { const float pv = __expf(S[kbi][e] - m); S[kbi][e] = pv; l += pv; }
            l += __shfl_xor(l, 32); l += __expf(sink - m);
            f32x16 O[2];
#pragma unroll
            for (int e = 0; e < 16; ++e) { O[0][e] = 0.f; O[1][e] = 0.f; }
            const int i16 = lane & 15, qq = i16 >> 2, pp = i16 & 3, gg = (lane >> 4) & 1;
#pragma unroll
            for (int kbi = 0; kbi < 5; ++kbi)
#pragma unroll
                for (int s2 = 0; s2 < 2; ++s2) {
                    u32x4 pk; pk.x = pg8::cvt_pk_bf16(S[kbi][8 * s2 + 0], S[kbi][8 * s2 + 1]); pk.y = pg8::cvt_pk_bf16(S[kbi][8 * s2 + 2], S[kbi][8 * s2 + 3]);
                    pk.z = pg8::cvt_pk_bf16(S[kbi][8 * s2 + 4], S[kbi][8 * s2 + 5]); pk.w = pg8::cvt_pk_bf16(S[kbi][8 * s2 + 6], S[kbi][8 * s2 + 7]);
                    const bf16x8 pf = __builtin_bit_cast(bf16x8, pk);
#pragma unroll
                    for (int db = 0; db < 2; ++db) { const LAS unsigned char* va = lds + AT_V + (32 * (qs + kbi) + 16 * s2 + 4 * h + qq) * KRS + (32 * db + 16 * gg + 4 * pp) * 2;
                        const s16x4 lo = __builtin_amdgcn_ds_read_tr16_b64_v4i16((lds_s16x4*)va), hi = __builtin_amdgcn_ds_read_tr16_b64_v4i16((lds_s16x4*)(va + 8 * KRS));
                        const bf16x8 vf = {lo[0], lo[1], lo[2], lo[3], hi[0], hi[1], hi[2], hi[3]};
                        O[db] = MFMA32(vf, pf, O[db]); } }
            const float inv = 1.0f / l;
            bf16_t* op = Og + (size_t)(row0 + 32 * qs + r) * D + hq * 64 + 4 * h;
#pragma unroll
            for (int db = 0; db < 2; ++db)
#pragma unroll
                for (int g4 = 0; g4 < 4; ++g4) { f32x4 v; v[0] = O[db][4 * g4] * inv; v[1] = O[db][4 * g4 + 1] * inv; v[2] = O[db][4 * g4 + 2] * inv; v[3] = O[db][4 * g4 + 3] * inv;
                    *(u32x2*)(op + 32 * db + 8 * g4) = pack4(v); }
        }
        __syncthreads();
    }
}

constexpr int LDS_STAGE = 0;
constexpr int LDS_MOETAB = pg8::STAGE_BYTES;
constexpr int LDS_MISC = LDS_MOETAB + pg8::MOE_TAB_INTS * 4;
constexpr int LDS_BYTES = 147456;
static_assert(RT_BYTES <= pg8::STAGE_BYTES && LDS_MISC + 256 <= LDS_BYTES && H1_BYTES <= pg8::STAGE_BYTES && 8 * 8448 <= pg8::STAGE_BYTES && AT_BYTES <= pg8::STAGE_BYTES, "LDS map");
constexpr int CW_BAR = 4096;
constexpr int N_PHASES = 1 + NA * 9 + (DEPTH - NA) * 7;

struct MegaArgs { const float* in[19]; float* out; unsigned char* ws; int ph_lo, ph_hi; };

__global__ void __launch_bounds__(512, 2) mega_fwd(MegaArgs args) {
    extern __shared__ __attribute__((aligned(16))) unsigned char lds_raw[];
    LAS unsigned char* lds = (LAS unsigned char*)lds_raw;
    volatile LAS unsigned* MISC = (volatile LAS unsigned*)(lds + LDS_MISC);
    const int tid = threadIdx.x, G = gridDim.x, bx = blockIdx.x, vcu = (G % 8 == 0) ? (bx % 8) * (G / 8) + bx / 8 : bx;
    unsigned char* const ws = args.ws;
    if (tid < 64) MISC[tid] = 0u;
    __syncthreads();
    const int lo = args.ph_lo, hi = args.ph_hi;
    XcdBarrier bar; bar.bar = (unsigned*)(ws + WS_CTL) + CW_BAR; bar.x = 0; bar.st = nullptr;
    if (hi - lo > 1) bar = xcd_barrier_post((unsigned*)(ws + WS_CTL) + CW_BAR, MISC + 8);
#define WSP(type, off) ((type*)(args.ws + (off)))
    int ph = 0;
#ifndef PROBE_DUP
#define PROBE_DUP 0
#endif
#define PHASE_T(dupbit, trash_body, ...) if (lo <= ph && ph < hi) { if ((PROBE_DUP >> (dupbit)) & 1) { trash_body; xcd_barrier(bar); } __VA_ARGS__; if (ph + 1 < hi) xcd_barrier(bar); } ++ph;
#define PHASE(dupbit, ...) if (lo <= ph && ph < hi) { __VA_ARGS__; if ((PROBE_DUP >> (dupbit)) & 1) { xcd_barrier(bar); __VA_ARGS__; } if (ph + 1 < hi) xcd_barrier(bar); } ++ph;

    PHASE(0, { Ptrs p; p.x = args.in[0]; p.a_w_in = args.in[1]; p.a_w_out = args.in[4]; p.b_w_kv = args.in[5]; p.b_w_q = args.in[6]; p.b_w_out = args.in[8]; p.w_gate = args.in[14]; p.w_up = args.in[15]; p.w_down = args.in[16]; p.w_rg = args.in[10]; p.w_re = args.in[12]; p.ws = args.ws;
               prologue_phase(lds, p, vcu, G); })

    for (int L = 0; L < DEPTH; ++L) {
        if (L < NA) {
            PHASE(1, { pg8::DenseSched S; S.init(T, 4 * D, D, G, bx); pg8::EpiHgrn E{WSP(bf16_t, WS_QB), WSP(bf16_t, WS_KB), WSP(bf16_t, WS_VB), WSP(bf16_t, WS_GT), WSP(float, WS_GL), args.in[2], L, 0};
                       pg8::gemm_phase<pg8::EpiHgrn, pg8::DenseSched>(lds, WSP(bf16_t, WS_XB2), WSP(bf16_t, WS_WIN) + (size_t)L * 4 * D * D, D, 0, S, E); })
#define HGARGS HgArgs{WSP(bf16_t, WS_QB), WSP(bf16_t, WS_KB), WSP(bf16_t, WS_VB), WSP(bf16_t, WS_GT), WSP(bf16_t, WS_OF), WSP(bf16_t, WS_UT), WSP(bf16_t, WS_SST), WSP(bf16_t, WS_OG), WSP(float, WS_GL), WSP(float, WS_DG), args.in[3] + (size_t)L * D, WSP(bf16_t, WS_QB)}
            PHASE_T(6, { HgArgs ha = HGARGS; ha.Qt = WSP(bf16_t, WS_TRASH); ha.OI = WSP(bf16_t, WS_TRASH + 32 * MiB); ha.UT = WSP(bf16_t, WS_TRASH + 64 * MiB); ha.Dg = WSP(float, WS_TRASH + 128 * MiB); h1_phase(lds, ha, vcu, G); },
                    { const HgArgs ha = HGARGS; h1_phase(lds, ha, vcu, G); })
            PHASE(3, { const HgArgs ha = HGARGS; h2_phase(ha, vcu, G); })
            PHASE(3, { const HgArgs ha = HGARGS; h3_phase(ha, vcu, G); })
            PHASE(1, { pg8::DenseSched S; S.init(T, D, D, G, bx); pg8::EpiStore E{WSP(bf16_t, WS_HM), WSP(bf16_t, WS_HM), D, 1 << 30, 1.0f, 0};
                       pg8::gemm_phase<pg8::EpiStore, pg8::DenseSched>(lds, WSP(bf16_t, WS_OG), WSP(bf16_t, WS_WOUT) + (size_t)L * D * D, D, 0, S, E); })
        } else {
            const int j = L - NA;
            PHASE(1, { if (j == 0) { pg8::DenseSched S; S.init(T, 2 * KVW, D, G, bx); pg8::EpiStore E{WSP(bf16_t, WS_KC), WSP(bf16_t, WS_VC), KVW, 1, 1.0f, 0};
                                     pg8::gemm_phase<pg8::EpiStore, pg8::DenseSched>(lds, WSP(bf16_t, WS_XB2), WSP(bf16_t, WS_WKV), D, 0, S, E); }
                       pg8::DenseSched S; S.init(T, D, D, G, bx); pg8::EpiStore E{WSP(bf16_t, WS_QB), WSP(bf16_t, WS_QB), D, 1 << 30, 1.0f, 0};
                       pg8::gemm_phase<pg8::EpiStore, pg8::DenseSched>(lds, WSP(bf16_t, WS_XB2), WSP(bf16_t, WS_WQ) + (size_t)j * D * D, D, 0, S, E); })
            PHASE(3, attn_phase(lds, WSP(bf16_t, WS_QB), WSP(bf16_t, WS_KC), WSP(bf16_t, WS_VC), args.in[7] + j * AT_HQ, args.in[9], WSP(bf16_t, WS_OG), vcu, G))
            PHASE(1, { pg8::DenseSched S; S.init(T, D, D, G, bx); pg8::EpiStore E{WSP(bf16_t, WS_HM), WSP(bf16_t, WS_HM), D, 1 << 30, 1.0f, 0};
                       pg8::gemm_phase<pg8::EpiStore, pg8::DenseSched>(lds, WSP(bf16_t, WS_OG), WSP(bf16_t, WS_WO) + (size_t)j * D * D, D, 0, S, E); })
        }
#define LN0_ARGS(XLO, XB, HIST, INV, TG) ln_router_phase(lds, L == 0 ? args.in[0] : nullptr, WSP(bf16_t, WS_XB2), WSP(bf16_t, WS_HM), args.in[17] + (size_t)(2 * L) * D, args.in[18] + (size_t)(2 * L) * D, XLO, XB, \
            WSP(bf16_t, WS_WR) + (size_t)L * 64 * D, WSP(bf16_t, WS_WR) + (size_t)(DEPTH + L) * 64 * D, args.in[11] + L * NGRP, args.in[13] + L * NEXP, HIST, INV, TG, vcu, G)
        PHASE_T(4, LN0_ARGS(WSP(bf16_t, WS_TRASH), WSP(bf16_t, WS_TRASH + 64 * MiB), WSP(int, WS_TRASH + 100 * MiB), WSP(int, WS_TRASH + 96 * MiB), WSP(float, WS_TRASH + 98 * MiB)),
                LN0_ARGS(WSP(bf16_t, WS_XF2), WSP(bf16_t, WS_XB), WSP(int, WS_HIST), WSP(int, WS_LIST), WSP(float, WS_TG)))
#undef LN0_ARGS
        PHASE(2, { LAS int* tab = (LAS int*)(lds + LDS_MOETAB); pg8::MoeSched S{tab, 4, G, vcu, D, 1}; S.build(tab, (LAS int*)lds, WSP(int, WS_HIST), WSP(int, WS_LIST));
                   pg8::gemm_phase<pg8::EpiMoeH, pg8::MoeSched>(lds, WSP(bf16_t, WS_XB), WSP(bf16_t, WS_WGU) + (size_t)L * NEXP * 2 * DEXP * D, D, (size_t)2 * DEXP * D * 2, S, pg8::EpiMoeH{WSP(bf16_t, WS_HS)}); })
        PHASE(2, { LAS int* tab = (LAS int*)(lds + LDS_MOETAB); pg8::MoeSched S{tab, 8, G, vcu, DEXP, 0}; S.build(tab, (LAS int*)lds, WSP(int, WS_HIST), WSP(int, WS_LIST));
                   pg8::gemm_phase<pg8::EpiMoeY, pg8::MoeSched>(lds, WSP(bf16_t, WS_HS), WSP(bf16_t, WS_WD) + (size_t)L * NEXP * D * DEXP, DEXP, (size_t)D * DEXP * 2, S, pg8::EpiMoeY{WSP(bf16_t, WS_Y), WSP(float, WS_TG), S}); })
        PHASE_T(5, ln2_phase(WSP(bf16_t, WS_XB), WSP(bf16_t, WS_Y), args.in[17] + (size_t)(2 * L + 1) * D, args.in[18] + (size_t)(2 * L + 1) * D, WSP(bf16_t, WS_TRASH), nullptr, vcu, G),
                ln2_phase(WSP(bf16_t, WS_XB), WSP(bf16_t, WS_Y), args.in[17] + (size_t)(2 * L + 1) * D, args.in[18] + (size_t)(2 * L + 1) * D, WSP(bf16_t, WS_XB2), L == DEPTH - 1 ? args.out : nullptr, vcu, G))
    }
#undef HGARGS
#undef WSP
#undef PHASE
#undef PHASE_T
}

#ifndef MK_PER_PHASE
#define MK_PER_PHASE 0
#endif
extern "C" void kernel_launch(void* const* d_in, const int* in_sizes, int n_in, void* d_out, int out_size, void* d_ws, size_t ws_size, hipStream_t stream) {
    static int grid = 0;
    if (grid == 0) {
        if (n_in != 19 || out_size != T * D || ws_size < WS_END) { fprintf(stderr, "kernel_launch: unexpected arguments (n_in %d, out %d, ws %zu < %zu)\n", n_in, out_size, ws_size, (size_t)WS_END); grid = -1; return; }
        int dev = 0, cus = 0, per_cu = 0;
        if (hipGetDevice(&dev) != hipSuccess || hipDeviceGetAttribute(&cus, hipDeviceAttributeMultiprocessorCount, dev) != hipSuccess) { grid = -1; return; }
        if (hipFuncSetAttribute((const void*)mega_fwd, hipFuncAttributeMaxDynamicSharedMemorySize, LDS_BYTES) != hipSuccess) { fprintf(stderr, "kernel_launch: hipFuncSetAttribute failed\n"); grid = -1; return; }
        if (hipOccupancyMaxActiveBlocksPerMultiprocessor(&per_cu, (const void*)mega_fwd, 512, LDS_BYTES) != hipSuccess || per_cu < 1) { fprintf(stderr, "kernel_launch: occupancy query reports %d\n", per_cu); }
        (void)hipGetLastError();
        grid = cus;
        if (grid != 256) { fprintf(stderr, "kernel_launch: built for 256 CUs (the routing tables assume 256 workgroups of 32 token rows); this device reports %d\n", cus); grid = -1; return; }
    }
    if (grid < 0) return;
    (void)hipMemsetAsync((char*)d_ws + WS_CTL, 0, CTL_BYTES, stream);
    MegaArgs a{};
    for (int i = 0; i < 19; ++i) a.in[i] = (const float*)d_in[i];
    a.out = (float*)d_out; a.ws = (unsigned char*)d_ws;
#if MK_PER_PHASE
    for (int ph = 0; ph < N_PHASES; ++ph) { a.ph_lo = ph; a.ph_hi = ph + 1; hipLaunchKernelGGL(mega_fwd, dim3(grid), dim3(512), LDS_BYTES, stream, a); }
#else
    a.ph_lo = 0; a.ph_hi = N_PHASES;
    hipLaunchKernelGGL(mega_fwd, dim3(grid), dim3(512), LDS_BYTES, stream, a);
#endif
}
```

```cpp
#include <hip/hip_runtime.h>
#include <cstdio>
#include <cstdint>

typedef unsigned short bf16_t;
typedef short bf16x8 __attribute__((ext_vector_type(8)));
typedef float f32x4 __attribute__((ext_vector_type(4)));

constexpr int BATCH = 4, SEQ = 2048, D = 2048, T = BATCH * SEQ, DEPTH = 4, NA = 2;
constexpr int HG_H = 16, HG_DK = 128;
constexpr int AT_HD = 64, AT_HQ = 32, AT_HKV = 4, AT_G = 8, KVW = AT_HKV * AT_HD;
constexpr int NGRP = 4, EPG = 8, NEXP = 32, DEXP = 512;
constexpr float ALPHA = 1.6817928305074290f;
constexpr float LN_EPS = 1e-5f, RMS_EPS = 1e-6f;

constexpr size_t MiB = 1u << 20;
constexpr size_t WS_CTL = 0, CTL_BYTES = 1 * MiB;
constexpr size_t WS_XF = 1 * MiB;
constexpr size_t WS_XB2 = WS_XF;
constexpr size_t WS_XB = WS_XF + 64 * MiB;
constexpr size_t WS_QB = WS_XB + 32 * MiB;
constexpr size_t WS_KB = WS_QB + 32 * MiB;
constexpr size_t WS_VB = WS_KB + 32 * MiB;
constexpr size_t WS_GT = WS_VB + 32 * MiB;
constexpr size_t WS_GL = WS_GT + 32 * MiB;
constexpr size_t WS_OF = WS_GL + 64 * MiB;
constexpr size_t WS_OG = WS_OF + 64 * MiB;
constexpr size_t WS_HM = WS_OG + 32 * MiB;
constexpr size_t WS_KC = WS_HM + 32 * MiB;
constexpr size_t WS_VC = WS_KC + 4 * MiB;
constexpr size_t WS_LIST = WS_VC + 4 * MiB;
constexpr size_t WS_TG = WS_LIST + 1 * MiB;
constexpr size_t WS_HS = WS_TG + 1 * MiB;
constexpr size_t WS_Y = WS_HS + 24 * MiB;
constexpr size_t WS_WIN = WS_Y + 64 * MiB;
constexpr size_t WS_WOUT = WS_WIN + 64 * MiB;
constexpr size_t WS_WKV = WS_WOUT + 16 * MiB;
constexpr size_t WS_WQ = WS_WKV + 2 * MiB;
constexpr size_t WS_WO = WS_WQ + 16 * MiB;
constexpr size_t WS_WGU = WS_WO + 16 * MiB;
constexpr size_t WS_WD = WS_WGU + 512 * MiB;
constexpr size_t WS_UT = WS_WD + 256 * MiB;
constexpr size_t WS_SST = WS_UT + 64 * MiB;
constexpr size_t WS_DG = WS_SST + 64 * MiB;
constexpr size_t WS_WR = WS_DG + 1 * MiB;
constexpr size_t WS_XF2 = WS_WR + 2 * MiB;
constexpr size_t WS_HIST = WS_XF2 + 64 * MiB;
constexpr size_t WS_TRASH = WS_HIST + 1 * MiB;
constexpr size_t WS_END = WS_TRASH + 256 * MiB;
constexpr int CW_CNT = 1024;

__device__ __forceinline__ unsigned f2bf(float f) { unsigned u = __builtin_bit_cast(unsigned, f); return (u + 0x7fffu + ((u >> 16) & 1u)) >> 16; }
__device__ __forceinline__ float bf2f(bf16_t b) { return __builtin_bit_cast(float, ((unsigned)b) << 16); }
__device__ __forceinline__ float wave_sum(float v) {
#pragma unroll
    for (int o = 1; o < 64; o <<= 1) v += __shfl_xor(v, o);
    return v;
}
__device__ __forceinline__ float wave_max(float v) {
#pragma unroll
    for (int o = 1; o < 64; o <<= 1) v = fmaxf(v, __shfl_xor(v, o));
    return v;
}
__device__ __forceinline__ float sigmoidf_(float x) { return 1.0f / (1.0f + __expf(-x)); }
__device__ __forceinline__ int opaque_tid() { int t = threadIdx.x; asm volatile("" : "+v"(t)); return t; }

#define LAS __attribute__((address_space(3)))
typedef unsigned u32x4 __attribute__((ext_vector_type(4)));
namespace pg8 {
constexpr int BM = 256, BK = 64, HALF = 128, HTB = HALF * BK * 2, STAGE_BYTES = 8 * HTB;
__host__ __device__ __forceinline__ int lds_byte(int r, int c) { const int st = (r >> 4) * 2 + (c >> 5), rr = r & 15, cc = c & 31, ob = rr * 64 + cc * 2; return st * 1024 + (ob ^ (((ob >> 9) & 1) << 5)); }
__host__ __device__ __forceinline__ void stage_rc(int b, int& R, int& C) { const int st = b / 1024, sb = b % 1024, swz = sb ^ (((sb >> 9) & 1) << 5); R = (st >> 1) * 16 + swz / 64; C = (st & 1) * 32 + (swz % 64) / 2; }
__host__ __device__ __forceinline__ int perm32(int rho) { const int n = rho >> 4, i = rho & 15; return 8 * (i >> 2) + 4 * n + (i & 3); }
struct Unit { int r0, pn, e, rows, tm, ui; };
typedef float f32x2_ __attribute__((ext_vector_type(2)));
typedef __bf16 bf16x2_ __attribute__((ext_vector_type(2)));
__device__ __forceinline__ unsigned cvt_pk_bf16(float lo, float hi) { const f32x2_ v = {lo, hi}; return __builtin_bit_cast(unsigned, __builtin_convertvector(v, bf16x2_)); }

struct DenseSched {
    int nM, nN, nwg, G, c, K;
    __device__ __forceinline__ void init(int M, int N, int K_, int G_, int c_) { nM = M / BM; nN = N / BM; nwg = nM * nN; G = G_; c = c_; K = K_; }
    __device__ __forceinline__ bool next(int i, Unit& u) const {
        const long L = (long)i * G + c; if (L >= nwg) return false;
        int wgid = (int)L; { const int q = nwg / 8, r = nwg % 8, xcd = wgid % 8, off = wgid / 8; wgid = (xcd < r ? xcd * (q + 1) : r * (q + 1) + (xcd - r) * q) + off; }
        const int nig = 8 * nN, gid = wgid / nig, fm = gid * 8, gsz = (nM - fm) < 8 ? (nM - fm) : 8;
        u.r0 = (fm + ((wgid % nig) % gsz)) * BM; u.pn = (wgid % nig) / gsz; u.e = 0; u.rows = 256; u.tm = 0; u.ui = i; return true;
    }
    __device__ __forceinline__ unsigned a_off(const Unit& u, int half, int R) const { return (unsigned)((u.r0 + half * 128 + R) * K) * 2u; }
};
struct DenseHalfSched {
    int nN, nwg, G, c, K;
    __device__ __forceinline__ void init(int M, int N, int K_, int G_, int c_) { nN = N / BM; nwg = (M / HALF) * nN; G = G_; c = c_; K = K_; }
    __device__ __forceinline__ bool next(int i, Unit& u) const { const int L = i * G + c; if (L >= nwg) return false; u.r0 = (L / nN) * HALF; u.pn = L % nN; u.e = 0; u.rows = HALF; u.tm = 0; u.ui = i; return true; }
    __device__ __forceinline__ unsigned a_off(const Unit& u, int half, int R) const { return (unsigned)((u.r0 + half * 128 + R) * K) * 2u; }
};

template <class Epi, class Sched>
__device__ __forceinline__ void gemm_phase(LAS unsigned char* lds, const bf16_t* A, const bf16_t* Bt, int K, size_t bstride, const Sched& S, const Epi& E) {
    const int tid = opaque_tid(), wid = __builtin_amdgcn_readfirstlane(tid >> 6), lane = tid & 63, wr = wid >> 2, wc = wid & 3, fr = lane & 15, fq = lane >> 4;
    const int nt = K / BK;
    int sR[2], sC2[2]; unsigned voffB[2];
#pragma unroll
    for (int i = 0; i < 2; ++i) { int R, C; stage_rc(tid * 16 + i * 8192, R, C); const int Rb = (R & ~31) + perm32(R & 31); sR[i] = R; sC2[i] = C * 2; voffB[i] = (unsigned)(Rb * K + C) * 2u; }
    const size_t kstep = (size_t)(BK * 2);
    const size_t hstep = (size_t)HALF * K * 2;
    const size_t tstep = 2 * hstep;
    const unsigned ldsw = (unsigned)wid * 1024u;
    const int aoff = lds_byte(wr * 64 + fr, fq * 8), boff = lds_byte(wc * 32 + fr, fq * 8);
#define PG8_SA(b, h) (((b) * 2 + (h)) * HTB)
#define PG8_SB(b, h) ((4 + (b) * 2 + (h)) * HTB)
#define PG8_STAGE(bufoff, gbase, voff) do { _Pragma("unroll") for (int _i = 0; _i < 2; ++_i) \
        __builtin_amdgcn_global_load_lds((const unsigned*)((const char*)(gbase) + (voff)[_i]), (LAS unsigned*)(lds + (bufoff) + ldsw + _i * 8192), 16, 0, 0); } while (0)
#define PG8_LDA(dst, b, h) do { _Pragma("unroll") for (int m = 0; m < 4; ++m) _Pragma("unroll") for (int k = 0; k < 2; ++k) dst[m][k] = *(const LAS bf16x8*)(lds + PG8_SA(b, h) + aoff + m * 2048 + k * 1024); } while (0)
#define PG8_LDB(dst, b, h) do { _Pragma("unroll") for (int n = 0; n < 2; ++n) _Pragma("unroll") for (int k = 0; k < 2; ++k) dst[n][k] = *(const LAS bf16x8*)(lds + PG8_SB(b, h) + boff + n * 2048 + k * 1024); } while (0)
#define PG8_MMA(ai, bj, At, Bt_) do { __builtin_amdgcn_s_setprio(1); _Pragma("unroll") for (int m = 0; m < 4; ++m) _Pragma("unroll") for (int n = 0; n < 2; ++n) _Pragma("unroll") for (int k = 0; k < 2; ++k) \
        acc[ai][bj][m][n] = __builtin_amdgcn_mfma_f32_16x16x32_bf16(Bt_[n][k], At[m][k], acc[ai][bj][m][n], 0, 0, 0); __builtin_amdgcn_s_setprio(0); } while (0)
#define PG8_WAIT_V(n) asm volatile("s_waitcnt vmcnt(" #n ")" ::: "memory")
#define PG8_WAIT_L(n) asm volatile("s_waitcnt lgkmcnt(" #n ")" ::: "memory")
#define PG8_BAR __builtin_amdgcn_s_barrier()
#define PG8_SCHED __builtin_amdgcn_sched_barrier(0)
    Unit cur, nxt; int ui = 0;
    if (!S.next(0, cur)) return;
    f32x4 acc[2][2][4][2];
#pragma unroll
    for (int a = 0; a < 2; ++a)
#pragma unroll
        for (int b = 0; b < 2; ++b)
#pragma unroll
            for (int m = 0; m < 4; ++m)
#pragma unroll
                for (int n = 0; n < 2; ++n) acc[a][b][m][n] = (f32x4){0.f, 0.f, 0.f, 0.f};
    bf16x8 At[4][2], B0[2][2], B1[2][2];
    unsigned voffA0[2], voffA1[2];
#pragma unroll
    for (int i = 0; i < 2; ++i) { voffA0[i] = S.a_off(cur, 0, sR[i]) + sC2[i]; voffA1[i] = S.a_off(cur, 1, sR[i]) + sC2[i]; }
    const char* const Ab = (const char*)A;
    const char* cB = (const char*)Bt + (size_t)cur.e * bstride + (size_t)cur.pn * tstep;
    PG8_STAGE(PG8_SB(0, 0), cB, voffB); PG8_STAGE(PG8_SB(0, 1), cB + hstep, voffB); PG8_STAGE(PG8_SA(0, 0), Ab, voffA0); PG8_STAGE(PG8_SA(0, 1), Ab, voffA1);
    if (wr == 1) PG8_BAR;
    PG8_WAIT_V(2); PG8_BAR;
    PG8_STAGE(PG8_SB(1, 0), cB + kstep, voffB); PG8_STAGE(PG8_SA(1, 0), Ab + kstep, voffA0); PG8_STAGE(PG8_SB(1, 1), cB + hstep + kstep, voffB);
    PG8_WAIT_V(6); PG8_BAR;
    for (;;) {
        const bool has_next = S.next(ui + 1, nxt);
        const bool full = cur.rows > HALF;
        const char* nB = has_next ? (const char*)Bt + (size_t)nxt.e * bstride + (size_t)nxt.pn * tstep : cB;
        for (int t = 0; t < nt; t += 2) {
            const bool last = (t == nt - 2);
            const char* a1 = Ab + (size_t)(t + 1) * kstep;
            const char* a2 = last ? Ab : Ab + (size_t)(t + 2) * kstep; const char* b2 = last ? nB : cB + (size_t)(t + 2) * kstep;
            const char* a3 = a2 + kstep; const char* b3 = b2 + kstep;
            PG8_LDB(B0, 0, 0); PG8_LDB(B1, 0, 1); PG8_SCHED; PG8_LDA(At, 0, 0); PG8_STAGE(PG8_SA(1, 1), a1, voffA1);
            if (last && has_next) {
#pragma unroll
                for (int i = 0; i < 2; ++i) { voffA0[i] = S.a_off(nxt, 0, sR[i]) + sC2[i]; voffA1[i] = S.a_off(nxt, 1, sR[i]) + sC2[i]; }
            }
            PG8_WAIT_V(8); PG8_WAIT_L(0); PG8_BAR; PG8_MMA(0, 0, At, B0); PG8_MMA(0, 1, At, B1); PG8_BAR; PG8_SCHED;
            if (full) PG8_LDA(At, 0, 1); PG8_STAGE(PG8_SB(0, 0), b2, voffB); PG8_STAGE(PG8_SB(0, 1), b2 + hstep, voffB); PG8_STAGE(PG8_SA(0, 0), a2, voffA0);
            PG8_WAIT_V(8); PG8_WAIT_L(0); PG8_BAR; if (full) { PG8_MMA(1, 0, At, B0); PG8_MMA(1, 1, At, B1); } PG8_BAR; PG8_SCHED;
            PG8_LDB(B0, 1, 0); PG8_LDB(B1, 1, 1); PG8_SCHED; PG8_LDA(At, 1, 0); PG8_STAGE(PG8_SA(0, 1), a2, voffA1);
            PG8_WAIT_V(8); PG8_WAIT_L(0); PG8_BAR; PG8_MMA(0, 0, At, B0); PG8_MMA(0, 1, At, B1); PG8_BAR; PG8_SCHED;
            if (full) PG8_LDA(At, 1, 1); PG8_STAGE(PG8_SB(1, 0), b3, voffB); PG8_STAGE(PG8_SB(1, 1), b3 + hstep, voffB); PG8_STAGE(PG8_SA(1, 0), a3, voffA0);
            PG8_WAIT_V(8); PG8_WAIT_L(0); PG8_BAR; if (full) { PG8_MMA(1, 0, At, B0); PG8_MMA(1, 1, At, B1); } PG8_BAR; PG8_SCHED;
        }
        if (wr == 0) PG8_BAR;
        E(acc, cur, wr, wc, fr, fq);
        if (!has_next) break;
#pragma unroll
        for (int a = 0; a < 2; ++a)
#pragma unroll
            for (int b = 0; b < 2; ++b)
#pragma unroll
                for (int m = 0; m < 4; ++m)
#pragma unroll
                    for (int n = 0; n < 2; ++n) acc[a][b][m][n] = (f32x4){0.f, 0.f, 0.f, 0.f};
        cur = nxt; cB = nB; ++ui;
        if (wr == 1) PG8_BAR;
    }
    PG8_WAIT_V(0);
    PG8_BAR;
#undef PG8_SA
#undef PG8_SB
#undef PG8_STAGE
#undef PG8_LDA
#undef PG8_LDB
#undef PG8_MMA
#undef PG8_WAIT_V
#undef PG8_WAIT_L
#undef PG8_BAR
#undef PG8_SCHED
}

#define PG8_ROWS_COLS const int row0 = u.r0 + wr * 64 + fr; const int col0 = wc * 32 + 8 * fq
__device__ __forceinline__ u32x4 pack8(const f32x4 v0, const f32x4 v1) { u32x4 w; w.x = cvt_pk_bf16(v0[0], v0[1]); w.y = cvt_pk_bf16(v0[2], v0[3]); w.z = cvt_pk_bf16(v1[0], v1[1]); w.w = cvt_pk_bf16(v1[2], v1[3]); return w; }
struct EpiStore {
    bf16_t* O; bf16_t* O2; int ldc, split; float scale; int pad;
    __device__ __forceinline__ void operator()(const f32x4 (&acc)[2][2][4][2], const Unit& u, int wr, int wc, int fr, int fq) const {
        PG8_ROWS_COLS; bf16_t* base = u.pn >= split ? O2 + (size_t)(u.pn - split) * BM : O + (size_t)u.pn * BM;
#pragma unroll
        for (int ai = 0; ai < 2; ++ai) if (ai * HALF < u.rows)
#pragma unroll
            for (int m = 0; m < 4; ++m) { bf16_t* rowp = base + (size_t)(row0 + ai * HALF + m * 16) * ldc + col0;
#pragma unroll
                for (int bj = 0; bj < 2; ++bj) *(u32x4*)(rowp + bj * HALF) = pack8(acc[ai][bj][m][0] * scale, acc[ai][bj][m][1] * scale); }
    }
};
struct EpiHgrn {
    bf16_t *Qb, *Kb, *Vb, *Gt; float* Gl; const float* lbraw; int layer, pad;
    __device__ __forceinline__ void operator()(const f32x4 (&acc)[2][2][4][2], const Unit& u, int wr, int wc, int fr, int fq) const {
        PG8_ROWS_COLS; const int seg = u.pn >> 3, ct = (u.pn & 7) * BM + col0;
        if (seg == 0 || seg == 2) { bf16_t* base = (seg == 0 ? Qb : Vb) + ct;
#pragma unroll
            for (int ai = 0; ai < 2; ++ai)
#pragma unroll
                for (int m = 0; m < 4; ++m) { bf16_t* rowp = base + (size_t)(row0 + ai * HALF + m * 16) * D;
#pragma unroll
                    for (int bj = 0; bj < 2; ++bj) *(u32x4*)(rowp + bj * HALF) = pack8(acc[ai][bj][m][0], acc[ai][bj][m][1]); }
        } else if (seg == 3) {
#pragma unroll
            for (int ai = 0; ai < 2; ++ai)
#pragma unroll
                for (int m = 0; m < 4; ++m) { bf16_t* rowp = Gt + ct + (size_t)(row0 + ai * HALF + m * 16) * D;
#pragma unroll
                    for (int bj = 0; bj < 2; ++bj) { f32x4 v[2];
#pragma unroll
                        for (int n = 0; n < 2; ++n)
#pragma unroll
                            for (int j = 0; j < 4; ++j) { const float x = acc[ai][bj][m][n][j]; v[n][j] = x * sigmoidf_(x); }
                        *(u32x4*)(rowp + bj * HALF) = pack8(v[0], v[1]); } }
        } else {
#pragma unroll
            for (int bj = 0; bj < 2; ++bj) { float lb[8];
#pragma unroll
                for (int j = 0; j < 8; ++j) { const int c = ct + bj * HALF + j; lb[j] = layer == 0 ? 0.f : sigmoidf_(lbraw[D + c] - lbraw[c]); }
#pragma unroll
                for (int ai = 0; ai < 2; ++ai)
#pragma unroll
                    for (int m = 0; m < 4; ++m) { const size_t o = (size_t)(row0 + ai * HALF + m * 16) * D + ct + bj * HALF; f32x4 kv[2], gv[2];
#pragma unroll
                        for (int n = 0; n < 2; ++n)
#pragma unroll
                            for (int j = 0; j < 4; ++j) { const float l = lb[4 * n + j], sg = sigmoidf_(acc[ai][bj][m][n][j]); gv[n][j] = __log2f(fmaxf(l + (1.f - l) * sg, 1e-30f));   kv[n][j] = (1.f - l) * (1.f - sg); }
                        *(u32x4*)(Kb + o) = pack8(kv[0], kv[1]); *(f32x4*)(Gl + o) = gv[0]; *(f32x4*)(Gl + o + 4) = gv[1]; } }
        }
    }
};


constexpr int MOE_MAXU = 4, MT_TILE = 0, MT_FULL = 40, MT_TAIL = 80, MT_CNT = 120, MT_ROWS = 160, MOE_TAB_INTS = MT_ROWS + 256 * MOE_MAXU;
struct MoeSched {
    const LAS int* tab; int NT, G, c, K, gather;
    __device__ __forceinline__ bool next(int i, Unit& u) const {
        int L = i * G + c; const int FT = tab[MT_FULL + 32] * NT; int e = 0, tm;
        if (L < FT) { const int k = L / NT; u.pn = L - k * NT; while (tab[MT_FULL + e + 1] <= k) ++e; tm = k - tab[MT_FULL + e]; }
        else { L -= FT; if (L >= tab[MT_TAIL + 32] * NT) return false; const int k = L / NT; u.pn = L - k * NT; while (tab[MT_TAIL + e + 1] <= k) ++e; tm = tab[MT_TILE + e + 1] - tab[MT_TILE + e] - 1; }
        u.r0 = (tab[MT_TILE + e] + tm) * 256; u.e = e; u.tm = tm; const int left = tab[MT_CNT + e] - 256 * tm; u.rows = left < 256 ? left : 256; u.ui = i; return true;
    }
    __device__ __forceinline__ int entry(const Unit& u, int r) const {
        const int a = tab[MT_ROWS + 256 * u.ui + r]; return a >= 0 ? a : tab[MT_ROWS + 256 * u.ui];
    }
    __device__ __forceinline__ unsigned a_off(const Unit& u, int half, int R) const {
        if (gather) return (unsigned)((entry(u, half * 128 + R) >> 1) * K) * 2u;
        return (unsigned)((u.r0 + half * 128 + R) * K) * 2u;
    }
    __device__ __forceinline__ void build(LAS int* t, LAS int* scr, const int* hist, const int* inv) const {
        const int tid = opaque_tid(), lane = tid & 63, wv = tid >> 6;
        { const int e = tid & 31, part = tid >> 5; int sum = 0;
#pragma unroll 4
          for (int b = part * 16; b < part * 16 + 16; ++b) sum += hist[b * 32 + e];
          scr[tid] = sum; }
        __syncthreads();
        if (tid < 32) { int sum = 0; for (int part = 0; part < 16; ++part) sum += scr[part * 32 + tid]; t[MT_CNT + tid] = sum; }
        __syncthreads();
        if (tid == 0) { int p = 0, pf = 0, pt = 0; for (int e = 0; e < 32; ++e) { const int cn = t[MT_CNT + e], nt = (cn + 255) >> 8, tail = (nt > 0 && cn - 256 * (nt - 1) <= 128) ? 1 : 0;
                t[MT_TILE + e] = p; t[MT_FULL + e] = pf; t[MT_TAIL + e] = pt; p += nt; pf += nt - tail; pt += tail; }
            t[MT_TILE + 32] = p; t[MT_FULL + 32] = pf; t[MT_TAIL + 32] = pt; }
        __syncthreads();
        for (int i = 0; i < MOE_MAXU; ++i) { Unit u; if (!next(i, u)) break;
            int hv = 0, incl = 0;
            if (tid < 256) { hv = hist[tid * 32 + u.e]; incl = hv;
#pragma unroll
                for (int o = 1; o < 64; o <<= 1) { const int tv = __shfl_up(incl, o); if (lane >= o) incl += tv; }
                if (lane == 63) scr[wv] = incl; }
            __syncthreads();
            if (tid < 256) { int off = 0; for (int w2 = 0; w2 < wv; ++w2) off += scr[w2]; scr[512 + tid] = off + incl - hv; if (tid == 255) scr[512 + 256] = off + incl; }
            __syncthreads();
            if (tid < 256) { const int pos = 256 * u.tm + tid; int ent = -1;
                if (pos < t[MT_CNT + u.e]) { int lo = 0, hi = 256;
                    while (hi - lo > 1) { const int mid = (lo + hi) >> 1; if (scr[512 + mid] <= pos) lo = mid; else hi = mid; }
                    ent = inv[(lo * 32 + u.e) * 32 + (pos - scr[512 + lo])]; }
                t[MT_ROWS + 256 * i + tid] = ent; }
            __syncthreads();
        }
    }
};
struct EpiMoeH {
    bf16_t* Hs;
    __device__ __forceinline__ void operator()(const f32x4 (&acc)[2][2][4][2], const Unit& u, int wr, int wc, int fr, int fq) const {
        const int col0 = u.pn * 128 + wc * 32 + 8 * fq;
#pragma unroll
        for (int ai = 0; ai < 2; ++ai)
#pragma unroll
            for (int m = 0; m < 4; ++m) { const int rl = ai * HALF + wr * 64 + m * 16 + fr; f32x4 v[2];
#pragma unroll
                for (int n = 0; n < 2; ++n)
#pragma unroll
                    for (int j = 0; j < 4; ++j) { const float g = acc[ai][0][m][n][j]; v[n][j] = g * sigmoidf_(g) * acc[ai][1][m][n][j]; }
                if (rl < u.rows) *(u32x4*)(Hs + (size_t)(u.r0 + rl) * DEXP + col0) = pack8(v[0], v[1]); }
    }
};
struct EpiMoeY {
    bf16_t* Y; const float* tg; MoeSched S;
    __device__ __forceinline__ void operator()(const f32x4 (&acc)[2][2][4][2], const Unit& u, int wr, int wc, int fr, int fq) const {
        const int col0 = u.pn * BM + wc * 32 + 8 * fq;
#pragma unroll
        for (int ai = 0; ai < 2; ++ai)
#pragma unroll
            for (int m = 0; m < 4; ++m) { const int rl = ai * HALF + wr * 64 + m * 16 + fr;
                if (rl < u.rows) { const int a = S.entry(u, rl); const float g = tg[a]; bf16_t* rowp = Y + (size_t)a * D + col0;
#pragma unroll
                    for (int bj = 0; bj < 2; ++bj) *(u32x4*)(rowp + bj * HALF) = pack8(acc[ai][bj][m][0] * g, acc[ai][bj][m][1] * g); } }
    }
};

__device__ __forceinline__ void transpose_item(const float* W, int K, int N, bf16_t* WT, int dst_row0, LAS float* scr, int kb, int nb, int lane) {
    const int k0 = 64 * kb, n0 = 32 * nb;
    float tmp[32]; const float* src = W + (size_t)(k0 + (lane >> 5)) * N + n0 + (lane & 31);
#pragma unroll
    for (int i = 0; i < 32; ++i) tmp[i] = src[(size_t)(2 * i) * N];
#pragma unroll
    for (int i = 0; i < 32; ++i) scr[(2 * i + (lane >> 5)) * 33 + (lane & 31)] = tmp[i];
    asm volatile("s_waitcnt lgkmcnt(0)" ::: "memory");
    const int c = lane & 7;
#pragma unroll
    for (int j = 0; j < 4; ++j) { const int n = (lane >> 3) + 8 * j; const LAS float* sp = scr + (8 * c) * 33 + n;
        u32x4 o; o.x = cvt_pk_bf16(sp[0 * 33], sp[1 * 33]); o.y = cvt_pk_bf16(sp[2 * 33], sp[3 * 33]); o.z = cvt_pk_bf16(sp[4 * 33], sp[5 * 33]); o.w = cvt_pk_bf16(sp[6 * 33], sp[7 * 33]);
        *(u32x4*)(WT + (size_t)(dst_row0 + n) * K + k0 + 8 * c) = o; }
    asm volatile("s_waitcnt lgkmcnt(0)" ::: "memory");
}
}

typedef short s16x4 __attribute__((ext_vector_type(4)));
typedef LAS s16x4 lds_s16x4;
constexpr int HRS = 272, ARS = 144;
constexpr int H1_QH = 0, H1_KH0 = H1_QH + 64 * HRS, H1_KH1 = H1_KH0 + 16 * HRS, H1_KH2 = H1_KH1 + 32 * HRS, H1_KH3 = H1_KH2 + 48 * HRS, H1_KT = H1_KH3 + 64 * HRS,
              H1_VS = H1_KT + 64 * HRS, H1_AS = H1_VS + 64 * HRS, H1_TOT = H1_AS + 64 * ARS, H1_BYTES = H1_TOT + 4096;
constexpr int NUNIT = BATCH * HG_H * (SEQ / 64);
__device__ __forceinline__ bf16x8 tr_frag16(const LAS unsigned char* tile, int rs, int r0, int c0, int lane) {
    const int g = lane >> 4, i = lane & 15, q = i >> 2, p = i & 3;
    const LAS unsigned char* a = tile + (r0 + 8 * g + q) * rs + (c0 + 4 * p) * 2;
    const s16x4 lo = __builtin_amdgcn_ds_read_tr16_b64_v4i16((lds_s16x4*)a);
    const s16x4 hi = __builtin_amdgcn_ds_read_tr16_b64_v4i16((lds_s16x4*)(a + 4 * rs));
    return (bf16x8){lo[0], lo[1], lo[2], lo[3], hi[0], hi[1], hi[2], hi[3]};
}
__device__ __forceinline__ bf16x8 row_frag16(const LAS unsigned char* tile, int rs, int r0, int c0, int lane) {
    return *(const LAS bf16x8*)(tile + (r0 + (lane & 15)) * rs + (c0 + 8 * (lane >> 4)) * 2);
}
#define MFMA16(a, b, c) __builtin_amdgcn_mfma_f32_16x16x32_bf16((a), (b), (c), 0, 0, 0)
typedef unsigned u32x2 __attribute__((ext_vector_type(2)));
__device__ __forceinline__ u32x2 pack4(const f32x4 v) { u32x2 r; r.x = pg8::cvt_pk_bf16(v[0], v[1]); r.y = pg8::cvt_pk_bf16(v[2], v[3]); return r; }

struct HgArgs { bf16_t *Qb, *Kb, *Vb, *Gt, *OI, *UT, *Sst, *Og; float *Gl, *Dg; const float* ng; bf16_t* Qt; };

typedef float f32x2 __attribute__((ext_vector_type(2)));
__device__ __forceinline__ f32x2 exp2v(const f32x2 x) { f32x2 r; r.x = __builtin_amdgcn_exp2f(x.x); r.y = __builtin_amdgcn_exp2f(x.y); return r; }
__device__ __forceinline__ f32x2 bf2v(unsigned w) { f32x2 r; r.x = __builtin_bit_cast(float, w << 16); r.y = __builtin_bit_cast(float, w & 0xffff0000u); return r; }
__device__ __forceinline__ unsigned v2bf(const f32x2 v) { return pg8::cvt_pk_bf16(v.x, v.y); }
struct H1In { f32x2 g[8]; unsigned q[8], k[8]; u32x4 v[2]; };
__device__ __forceinline__ void h1_load(H1In& in, const HgArgs& a, int unit, int tid) {
    const int bh = unit >> 5, c = unit & 31, b = bh >> 4, h = bh & 15, cp = tid & 63, tq = tid >> 6;
    const size_t gbase = ((size_t)b * SEQ + c * 64) * D + h * 128;
#pragma unroll
    for (int i = 0; i < 8; ++i) { const size_t go = gbase + (size_t)(8 * tq + i) * D + 2 * cp; in.g[i] = *(const f32x2*)(a.Gl + go); in.q[i] = *(const unsigned*)(a.Qb + go); in.k[i] = *(const unsigned*)(a.Kb + go); }
#pragma unroll
    for (int i = 0; i < 2; ++i) { const int id = tid + 512 * i, r = id >> 4, ck = id & 15; in.v[i] = *(const u32x4*)(a.Vb + gbase + (size_t)r * D + ck * 8); }
}
__device__ __forceinline__ void h1_phase(LAS unsigned char* lds, const HgArgs& a, int vcu, int G) {
    const int tid = opaque_tid(), lane = tid & 63, wid = __builtin_amdgcn_readfirstlane(tid >> 6);
    const int cp = lane, tq = wid, J = wid >> 1, half = wid & 1;
    LAS f32x2* tot8 = (LAS f32x2*)(lds + H1_TOT);
    H1In in;
    if (vcu < NUNIT) h1_load(in, a, vcu, tid);
    for (int unit = vcu; unit < NUNIT; unit += G) {
        const int bh = unit >> 5, c = unit & 31, b = bh >> 4, h = bh & 15;
        const size_t gbase = ((size_t)b * SEQ + c * 64) * D + h * 128;
        f32x2 L[8]; { f32x2 l = {0.f, 0.f};
#pragma unroll
            for (int i = 0; i < 8; ++i) { l += in.g[i]; L[i] = l; } }
        tot8[tq * 64 + cp] = L[7];
#pragma unroll
        for (int i = 0; i < 2; ++i) { const int id = tid + 512 * i, r = id >> 4, ck = id & 15; *(LAS u32x4*)(lds + H1_VS + r * HRS + ck * 16) = in.v[i]; }
        for (int id = tid; id < 64 * ARS / 16; id += 512) *(LAS u32x4*)(lds + H1_AS + id * 16) = (u32x4){0u, 0u, 0u, 0u};
        __syncthreads();
        f32x2 tj[4];
#pragma unroll
        for (int M = 0; M < 4; ++M) tj[M] = tot8[(2 * M) * 64 + cp] + tot8[(2 * M + 1) * 64 + cp];
        f32x2 off = {0.f, 0.f}; if (half) off = tot8[(tq - 1) * 64 + cp];
        f32x2 aJ = {0.f, 0.f};
#pragma unroll
        for (int M = 0; M < 3; ++M) if (M < J) aJ += tj[M];
        const f32x2 PA = exp2v(aJ), L15 = tj[J == 0 ? 0 : J == 1 ? 1 : J == 2 ? 2 : 3];
        f32x2 cI[5];
#pragma unroll
        for (int I = 1; I <= 4; ++I) { f32x2 sx = {0.f, 0.f};
#pragma unroll
            for (int M = 1; M < 4; ++M) if (M > J && M < I) sx += tj[M];
            cI[I] = exp2v(sx); }
        const int khJ = J == 0 ? H1_KH0 : J == 1 ? H1_KH1 : J == 2 ? H1_KH2 : H1_KH3;
#pragma unroll
        for (int i = 0; i < 8; ++i) {
            const int t = 8 * tq + i; const int lo = t * HRS + cp * 4;
            const f32x2 q = bf2v(in.q[i]), k = bf2v(in.k[i]), Li = L[i] + off;
            const f32x2 ep = exp2v(Li), nl = -Li, en = exp2v((f32x2){fminf(nl.x, 80.f), fminf(nl.y, 80.f)}), rem = exp2v(L15 - Li);
            const f32x2 qh = q * ep, kr = k * rem;
            *(LAS unsigned*)(lds + H1_QH + lo) = v2bf(qh);
            *(unsigned*)(a.Qt + gbase + (size_t)t * D + 2 * cp) = v2bf(qh * PA);
            *(LAS unsigned*)(lds + khJ + lo) = v2bf(k * en);
#pragma unroll
            for (int I = 1; I <= 4; ++I) if (I > J) { constexpr int offs[5] = {H1_KH0, H1_KH1, H1_KH2, H1_KH3, H1_KT}; *(LAS unsigned*)(lds + offs[I] + lo) = v2bf(kr * cI[I]); }
        }
        if (J == 0 && half == 0) *(f32x2*)(a.Dg + (size_t)unit * 128 + 2 * cp) = exp2v((tj[0] + tj[1]) + (tj[2] + tj[3]));
        __syncthreads();
        if (unit + G < NUNIT) h1_load(in, a, unit + G, tid);
        for (int blk = wid; blk < 10; blk += 8) {
            const int I = blk < 1 ? 0 : blk < 3 ? 1 : blk < 6 ? 2 : 3, Jb = blk - (I * (I + 1)) / 2;
            const int khI = I == 0 ? H1_KH0 : I == 1 ? H1_KH1 : I == 2 ? H1_KH2 : H1_KH3;
            f32x4 acc = {0.f, 0.f, 0.f, 0.f};
#pragma unroll
            for (int ks = 0; ks < 4; ++ks) acc = MFMA16(row_frag16(lds + khI, HRS, 16 * Jb, 32 * ks, lane), row_frag16(lds + H1_QH, HRS, 16 * I, 32 * ks, lane), acc);
            const int tl = 16 * I + (lane & 15), s0 = 16 * Jb + 4 * (lane >> 4);
#pragma unroll
            for (int r = 0; r < 4; ++r) if (s0 + r > tl) acc[r] = 0.f;
            *(LAS u32x2*)(lds + H1_AS + tl * ARS + s0 * 2) = pack4(acc);
        }
        __syncthreads();
        {
            bf16x8 vtr[2];
#pragma unroll
            for (int ks = 0; ks < 2; ++ks) vtr[ks] = tr_frag16(lds + H1_VS, HRS, 32 * ks, 16 * wid, lane);
#pragma unroll
            for (int rb = 0; rb < 4; ++rb) { f32x4 acc = {0.f, 0.f, 0.f, 0.f};
#pragma unroll
                for (int ks = 0; ks < 2; ++ks) if (!(ks == 1 && rb < 2)) acc = MFMA16(vtr[ks], row_frag16(lds + H1_AS, ARS, 16 * rb, 32 * ks, lane), acc);
                *(u32x2*)(a.OI + gbase + (size_t)(16 * rb + (lane & 15)) * D + 16 * wid + 4 * (lane >> 4)) = pack4(acc); }
#pragma unroll
            for (int cb = 0; cb < 8; ++cb) { f32x4 acc = {0.f, 0.f, 0.f, 0.f};
#pragma unroll
                for (int ks = 0; ks < 2; ++ks) acc = MFMA16(tr_frag16(lds + H1_KT, HRS, 32 * ks, 16 * cb, lane), vtr[ks], acc);
                *(u32x2*)(a.UT + ((size_t)unit * 128 + 16 * wid + (lane & 15)) * 128 + 16 * cb + 4 * (lane >> 4)) = pack4(acc); }
        }
        __syncthreads();
    }
}
__device__ __forceinline__ void h2_phase(const HgArgs& a, int vcu, int G) {
    for (int item = vcu * 512 + opaque_tid(); item < BATCH * HG_H * 2048; item += G * 512) {
        const int bh = item >> 11, vec = item & 2047, ch0 = (vec & 15) * 8;
        float st[8];
#pragma unroll
        for (int j = 0; j < 8; ++j) st[j] = 0.f;
        for (int c = 0; c < 32; ++c) { const size_t u = (size_t)bh * 32 + c;
            *(u32x4*)(a.Sst + u * 16384 + vec * 8) = pg8::pack8((f32x4){st[0], st[1], st[2], st[3]}, (f32x4){st[4], st[5], st[6], st[7]});
            if (c < 31) { const uint4 uu = *(const uint4*)(a.UT + u * 16384 + vec * 8); const float4 d0 = *(const float4*)(a.Dg + u * 128 + ch0), d1 = *(const float4*)(a.Dg + u * 128 + ch0 + 4);
                const unsigned w[4] = {uu.x, uu.y, uu.z, uu.w}; const float dd[8] = {d0.x, d0.y, d0.z, d0.w, d1.x, d1.y, d1.z, d1.w};
#pragma unroll
                for (int j = 0; j < 4; ++j) { st[2 * j] = dd[2 * j] * st[2 * j] + bf2f((bf16_t)(w[j] & 0xffff)); st[2 * j + 1] = dd[2 * j + 1] * st[2 * j + 1] + bf2f((bf16_t)(w[j] >> 16)); } }
        }
    }
}
__device__ __forceinline__ void h3_phase(const HgArgs& a, int vcu, int G) {
    const int tid = opaque_tid(), lane = tid & 63, wid = __builtin_amdgcn_readfirstlane(tid >> 6);
    for (int pair = vcu; pair < NUNIT / 2; pair += G) {
        const int unit = pair * 2 + (wid >> 2), rb = wid & 3;
        const int bh = unit >> 5, c = unit & 31, b = bh >> 4, h = bh & 15;
        const size_t ro = ((size_t)b * SEQ + c * 64 + 16 * rb + (lane & 15)) * D + h * 128;
        bf16x8 qf[4];
#pragma unroll
        for (int ks = 0; ks < 4; ++ks) qf[ks] = *(const bf16x8*)(a.Qt + ro + 32 * ks + 8 * (lane >> 4));
        f32x4 o[8]; float ss = 0.f;
#pragma unroll
        for (int cb = 0; cb < 8; ++cb) { f32x4 acc = {0.f, 0.f, 0.f, 0.f};
            const bf16_t* sp = a.Sst + ((size_t)unit * 128 + 16 * cb + (lane & 15)) * 128 + 8 * (lane >> 4);
#pragma unroll
            for (int ks = 0; ks < 4; ++ks) acc = MFMA16(*(const bf16x8*)(sp + 32 * ks), qf[ks], acc);
            const uint2 oi = *(const uint2*)(a.OI + ro + 16 * cb + 4 * (lane >> 4));
            acc[0] += bf2f((bf16_t)(oi.x & 0xffff)); acc[1] += bf2f((bf16_t)(oi.x >> 16)); acc[2] += bf2f((bf16_t)(oi.y & 0xffff)); acc[3] += bf2f((bf16_t)(oi.y >> 16));
            o[cb] = acc; ss += (acc[0] * acc[0] + acc[1] * acc[1]) + (acc[2] * acc[2] + acc[3] * acc[3]); }
        ss += __shfl_xor(ss, 16); ss += __shfl_xor(ss, 32);
        const float r = 1.0f / sqrtf(ss * (1.f / 128.f) + RMS_EPS);
#pragma unroll
        for (int cb = 0; cb < 8; ++cb) { const int vc = 16 * cb + 4 * (lane >> 4); const float4 g = *(const float4*)(a.ng + h * 128 + vc); const uint2 gt = *(const uint2*)(a.Gt + ro + vc);
            f32x4 v; v[0] = o[cb][0] * r * g.x * bf2f((bf16_t)(gt.x & 0xffff)); v[1] = o[cb][1] * r * g.y * bf2f((bf16_t)(gt.x >> 16)); v[2] = o[cb][2] * r * g.z * bf2f((bf16_t)(gt.y & 0xffff)); v[3] = o[cb][3] * r * g.w * bf2f((bf16_t)(gt.y >> 16));
            *(u32x2*)(a.Og + ro + vc) = pack4(v); }
    }
}

#define XB_TMO      128
#define XB_XCNT(j)  (256  + 64 * (j))
#define XB_XSUB(j)  (1280 + 64 * (j))
#define XB_XGEN(j)  (2304 + 64 * (j))
#define XB_TOP      3328
#define XB_TOPGEN   3392
#define XCD_BAR_WORDS 3456
#define XB_SPIN_CAP (1u << 18)
__device__ __forceinline__ unsigned xb_ld(unsigned* p)              { return __hip_atomic_load(p, __ATOMIC_RELAXED, __HIP_MEMORY_SCOPE_AGENT); }
__device__ __forceinline__ unsigned xb_add(unsigned* p, unsigned v) { return __hip_atomic_fetch_add(p, v, __ATOMIC_RELAXED, __HIP_MEMORY_SCOPE_AGENT); }
__device__ __forceinline__ unsigned xb_xcc_id() { return (unsigned)__builtin_amdgcn_s_getreg((3 << 11) | 20) & 0xFu; }
#define XB_SPIN(cond, bar) do { unsigned _sp = 0; while (cond) { __builtin_amdgcn_s_sleep(1); \
    if ((++_sp & 255u) == 0u) { if (xb_ld(&(bar)[XB_TMO])) break; if (_sp > XB_SPIN_CAP) { atomicAdd(&(bar)[XB_TMO], 1u); break; } } } } while (0)
struct XcdBarrier { unsigned* bar; unsigned x; volatile LAS unsigned* st; };
__device__ __forceinline__ XcdBarrier xcd_barrier_post(unsigned* bar, volatile LAS unsigned* st) {
    XcdBarrier b; b.bar = bar; b.x = xb_xcc_id(); b.st = st;
    if (threadIdx.x == 0) (void)xb_add(&bar[XB_XCNT(b.x)], 1u);
    return b;
}
__device__ __forceinline__ void xcd_barrier_complete(unsigned* bar, unsigned x, unsigned& nloc, unsigned& nx) {
    const unsigned G = gridDim.x * gridDim.y * gridDim.z;
    unsigned sum, cnt, mine, sp = 0u;
    for (;;) {
        sum = 0u; cnt = 0u; mine = 0u;
#pragma unroll
        for (unsigned j = 0; j < 16; ++j) { const unsigned c = xb_ld(&bar[XB_XCNT(j)]); sum += c; cnt += (c > 0u) ? 1u : 0u; mine = (j == x) ? c : mine; }
        if (sum == G) break;
        __builtin_amdgcn_s_sleep(1);
        if ((++sp & 255u) == 0u) { if (xb_ld(&bar[XB_TMO])) break; if (sp > XB_SPIN_CAP) { atomicAdd(&bar[XB_TMO], 1u); break; } }
    }
    nloc = mine > 0u ? mine : 1u; nx = cnt > 0u ? cnt : 1u;
}
__device__ __forceinline__ void xcd_barrier(const XcdBarrier& b) {
    asm volatile("s_waitcnt vmcnt(0)" ::: "memory");
    __syncthreads();
    if (threadIdx.x == 0) {
        unsigned* bar = b.bar;
        __builtin_amdgcn_s_waitcnt(0);
        unsigned nloc = b.st[0], nx = b.st[1];
        if (nloc == 0u) { xcd_barrier_complete(bar, b.x, nloc, nx); b.st[0] = nloc; b.st[1] = nx; }
        const unsigned old = xb_add(&bar[XB_XSUB(b.x)], 1u);
        const unsigned gen = old / nloc;
        if (old + 1u == (gen + 1u) * nloc) {
            __builtin_amdgcn_fence(__ATOMIC_RELEASE, "agent");
            asm volatile("s_waitcnt vmcnt(0)" ::: "memory");
            const unsigned og = xb_add(&bar[XB_TOP], 1u);
            const unsigned tg = og / nx;
            if (og + 1u == (tg + 1u) * nx) xb_add(&bar[XB_TOPGEN], 1u);
            else XB_SPIN(xb_ld(&bar[XB_TOPGEN]) == tg, bar);
            __builtin_amdgcn_fence(__ATOMIC_ACQUIRE, "agent");
            xb_add(&bar[XB_XGEN(b.x)], 1u);
            asm volatile("s_waitcnt vmcnt(0)" ::: "memory");
        } else {
            XB_SPIN(xb_ld(&bar[XB_XGEN(b.x)]) == gen, bar);
            __builtin_amdgcn_fence(__ATOMIC_ACQUIRE, "agent");
            asm volatile("s_waitcnt vmcnt(0)" ::: "memory");
        }
    }
    __syncthreads();
}

struct Ptrs {
    const float *x, *a_w_in, *a_lb, *a_ng, *a_w_out, *b_w_kv, *b_w_q, *b_sinks, *b_w_out, *rel_bias, *w_rg, *b_rg, *w_re, *b_re, *w_gate, *w_up, *w_down, *ln_g, *ln_b;
    float* out; unsigned char* ws;
};
__device__ __forceinline__ void prologue_phase(LAS unsigned char* lds, const Ptrs& p, int vcu, int G) {
    const int tid = opaque_tid(), lane = tid & 63, wave = __builtin_amdgcn_readfirstlane(tid >> 6);
    LAS float* scr = (LAS float*)(lds + wave * 8448);
    const int gw = vcu * 8 + wave, NGW = G * 8;
    bf16_t* Win_t = (bf16_t*)(p.ws + WS_WIN); bf16_t* Wout_t = (bf16_t*)(p.ws + WS_WOUT); bf16_t* Wkv_t = (bf16_t*)(p.ws + WS_WKV); bf16_t* Wq_t = (bf16_t*)(p.ws + WS_WQ); bf16_t* Wo_t = (bf16_t*)(p.ws + WS_WO);
    bf16_t* Wgu_t = (bf16_t*)(p.ws + WS_WGU); bf16_t* Wd_t = (bf16_t*)(p.ws + WS_WD);
    constexpr int I_IN = 2 * 32 * 256, I_AO = 2 * 32 * 64, I_KV = 32 * 16, I_Q = 2 * 32 * 64, I_O = 2 * 32 * 64, I_G = 128 * 32 * 16, I_U = I_G, I_D = 128 * 8 * 64;
    constexpr int NITEMS = I_IN + I_AO + I_KV + I_Q + I_O + I_G + I_U + I_D;
    for (int it = gw; it < NITEMS; it += NGW) {
        int r = it;
        if (r < I_IN) { const int mat = r / (32 * 256), q = r % (32 * 256), kb = q / 256, nb = q % 256; pg8::transpose_item(p.a_w_in + (size_t)mat * D * 4 * D, D, 4 * D, Win_t + (size_t)mat * 4 * D * D, 32 * nb, scr, kb, nb, lane); continue; } r -= I_IN;
        if (r < I_AO) { const int mat = r / (32 * 64), q = r % (32 * 64), kb = q / 64, nb = q % 64; pg8::transpose_item(p.a_w_out + (size_t)mat * D * D, D, D, Wout_t + (size_t)mat * D * D, 32 * nb, scr, kb, nb, lane); continue; } r -= I_AO;
        if (r < I_KV) { const int kb = r / 16, nb = r % 16; pg8::transpose_item(p.b_w_kv, D, 2 * KVW, Wkv_t, 32 * nb, scr, kb, nb, lane); continue; } r -= I_KV;
        if (r < I_Q) { const int mat = r / (32 * 64), q = r % (32 * 64), kb = q / 64, nb = q % 64; pg8::transpose_item(p.b_w_q + (size_t)mat * D * D, D, D, Wq_t + (size_t)mat * D * D, 32 * nb, scr, kb, nb, lane); continue; } r -= I_Q;
        if (r < I_O) { const int mat = r / (32 * 64), q = r % (32 * 64), kb = q / 64, nb = q % 64; pg8::transpose_item(p.b_w_out + (size_t)mat * D * D, D, D, Wo_t + (size_t)mat * D * D, 32 * nb, scr, kb, nb, lane); continue; } r -= I_O;
        if (r < I_G + I_U) { const int up = r >= I_G; if (up) r -= I_G; const int mat = r / (32 * 16), q = r % (32 * 16), kb = q / 16, nb = q % 16;
            const int n0 = 32 * nb, drow = (n0 >> 7) * 256 + (n0 & 127) + (up ? 128 : 0);
            pg8::transpose_item((up ? p.w_up : p.w_gate) + (size_t)mat * D * DEXP, D, DEXP, Wgu_t + (size_t)mat * 2 * DEXP * D, drow, scr, kb, nb, lane); continue; } r -= I_G + I_U;
        { const int mat = r / (8 * 64), q = r % (8 * 64), kb = q / 64, nb = q % 64; pg8::transpose_item(p.w_down + (size_t)mat * DEXP * D, DEXP, D, Wd_t + (size_t)mat * D * DEXP, 32 * nb, scr, kb, nb, lane); }
    }
    { bf16_t* WRhi = (bf16_t*)(p.ws + WS_WR); bf16_t* WRlo = WRhi + (size_t)DEPTH * 64 * D;
      for (int i = vcu * 512 + tid; i < DEPTH * 64 * D; i += G * 512) { const int L = i / (64 * D), o = (i / D) % 64, d = i % D;
          const float w = o < 4 ? p.w_rg[((size_t)L * D + d) * NGRP + o] : o < 36 ? p.w_re[((size_t)L * D + d) * NEXP + (o - 4)] : 0.f;
          const unsigned hb = f2bf(w); WRhi[i] = (bf16_t)hb; WRlo[i] = (bf16_t)f2bf(w - bf2f((bf16_t)hb)); } }
    bf16_t* xb = (bf16_t*)(p.ws + WS_XB2);
    for (size_t i = (size_t)vcu * 512 + tid; i < (size_t)T * D / 4; i += (size_t)G * 512) { const float4 v = ((const float4*)p.x)[i];
        u32x2 o; o.x = pg8::cvt_pk_bf16(v.x, v.y); o.y = pg8::cvt_pk_bf16(v.z, v.w); ((u32x2*)xb)[i] = o; }
}

__device__ __forceinline__ f32x4 bf4(const u32x2 w) { f32x4 r; r[0] = __builtin_bit_cast(float, w.x << 16); r[1] = __builtin_bit_cast(float, w.x & 0xffff0000u); r[2] = __builtin_bit_cast(float, w.y << 16); r[3] = __builtin_bit_cast(float, w.y & 0xffff0000u); return r; }
__device__ __forceinline__ void ln2_phase(const bf16_t* x, const bf16_t* Y, const float* lng, const float* lnb, bf16_t* xb, float* out, int vcu, int G) {
    const int tid = opaque_tid();
    for (int row = vcu * 8 + (tid >> 6); row < T; row += G * 8) {
        const int lane = opaque_tid() & 63;
        f32x4 v[8]; float s = 0.f;
#pragma unroll
        for (int j = 0; j < 8; ++j) { const int c = 4 * lane + 256 * j;
            v[j] = bf4(*(const u32x2*)(x + (size_t)row * D + c)) * ALPHA + (bf4(*(const u32x2*)(Y + (size_t)(row * 2) * D + c)) + bf4(*(const u32x2*)(Y + (size_t)(row * 2 + 1) * D + c)));
            s += (v[j][0] + v[j][1]) + (v[j][2] + v[j][3]); }
        const float mean = wave_sum(s) * (1.f / D);
        float q = 0.f;
#pragma unroll
        for (int j = 0; j < 8; ++j) { v[j] = v[j] - mean; q += (v[j][0] * v[j][0] + v[j][1] * v[j][1]) + (v[j][2] * v[j][2] + v[j][3] * v[j][3]); }
        const float rstd = 1.0f / sqrtf(wave_sum(q) * (1.f / D) + LN_EPS);
#pragma unroll
        for (int j = 0; j < 8; ++j) { const int c = 4 * lane + 256 * j; const f32x4 g = *(const f32x4*)(lng + c), bb = *(const f32x4*)(lnb + c);
            v[j] = v[j] * rstd * g + bb;
            if (out) *(f32x4*)(out + (size_t)row * D + c) = v[j];
            else { u32x2 o; o.x = pg8::cvt_pk_bf16(v[j][0], v[j][1]); o.y = pg8::cvt_pk_bf16(v[j][2], v[j][3]); *(u32x2*)(xb + (size_t)row * D + c) = o; } }
    }
}

typedef float f32x16 __attribute__((ext_vector_type(16)));
#define MFMA32(a, b, c) __builtin_amdgcn_mfma_f32_32x32x16_bf16((a), (b), (c), 0, 0, 0)
constexpr int RT_RED = 0, RT_LOG = 8 * 64 * 32 * 4, RT_HIST = RT_LOG + 32 * 64 * 4, RT_BYTES = RT_HIST + 128;
__device__ __forceinline__ void ln_router_phase(LAS unsigned char* lds, const float* xin32, const bf16_t* xin16, const bf16_t* hm, const float* lng, const float* lnb, bf16_t* xlo, bf16_t* xb,
                                                const bf16_t* WRhi, const bf16_t* WRlo, const float* brg, const float* bre, int* hist, int* inv, float* tg, int vcu, int G) {
    const int tid = opaque_tid(), lane = tid & 63, wid = __builtin_amdgcn_readfirstlane(tid >> 6);
    LAS int* lhist = (LAS int*)(lds + RT_HIST);
    if (tid < 32) lhist[tid] = 0;
    {
        const int row0 = 32 * vcu + 4 * wid;
#pragma unroll 1
        for (int r = 0; r < 4; ++r) {
            f32x4 v[8]; float s = 0.f;
#pragma unroll
            for (int j = 0; j < 8; ++j) { const int c = 4 * lane + 256 * j; const size_t go = (size_t)(row0 + r) * D + c;
                const f32x4 a = xin32 ? *(const f32x4*)(xin32 + go) : bf4(*(const u32x2*)(xin16 + go)); const f32x4 hh = bf4(*(const u32x2*)(hm + go));
                v[j] = a * ALPHA + hh; s += (v[j][0] + v[j][1]) + (v[j][2] + v[j][3]); }
            const float mean = wave_sum(s) * (1.f / D);
            float q = 0.f;
#pragma unroll
            for (int j = 0; j < 8; ++j) { v[j] = v[j] - mean; q += (v[j][0] * v[j][0] + v[j][1] * v[j][1]) + (v[j][2] * v[j][2] + v[j][3] * v[j][3]); }
            const float rstd = 1.0f / sqrtf(wave_sum(q) * (1.f / D) + LN_EPS);
#pragma unroll
            for (int j = 0; j < 8; ++j) { const int c = 4 * lane + 256 * j; const f32x4 g = *(const f32x4*)(lng + c), bb = *(const f32x4*)(lnb + c);
                v[j] = v[j] * rstd * g + bb;
                u32x2 o; o.x = pg8::cvt_pk_bf16(v[j][0], v[j][1]); o.y = pg8::cvt_pk_bf16(v[j][2], v[j][3]); *(u32x2*)(xb + (size_t)(row0 + r) * D + c) = o;
                const f32x4 lo = v[j] - bf4(o); u32x2 ol; ol.x = pg8::cvt_pk_bf16(lo[0], lo[1]); ol.y = pg8::cvt_pk_bf16(lo[2], lo[3]); *(u32x2*)(xlo + (size_t)(row0 + r) * D + c) = ol; }
        }
    }
    asm volatile("s_waitcnt vmcnt(0)" ::: "memory");
    __syncthreads();
    {
        const int r = lane & 31, h = lane >> 5;
        f32x16 acc0, acc1;
#pragma unroll
        for (int e = 0; e < 16; ++e) { acc0[e] = 0.f; acc1[e] = 0.f; }
        const size_t xo = (size_t)(32 * vcu + r) * D + 256 * wid + 8 * h;
        const size_t wo = (size_t)r * D + 256 * wid + 8 * h;
#pragma unroll 4
        for (int sx = 0; sx < 16; ++sx) {
            const bf16x8 xh = *(const bf16x8*)(xb + xo + 16 * sx), xl = *(const bf16x8*)(xlo + xo + 16 * sx);
            const bf16x8 w0h = *(const bf16x8*)(WRhi + wo + 16 * sx), w0l = *(const bf16x8*)(WRlo + wo + 16 * sx), w1h = *(const bf16x8*)(WRhi + wo + (size_t)32 * D + 16 * sx), w1l = *(const bf16x8*)(WRlo + wo + (size_t)32 * D + 16 * sx);
            acc0 = MFMA32(xh, w0h, acc0); acc0 = MFMA32(xh, w0l, acc0); acc0 = MFMA32(xl, w0h, acc0);
            acc1 = MFMA32(xh, w1h, acc1); acc1 = MFMA32(xh, w1l, acc1); acc1 = MFMA32(xl, w1h, acc1);
        }
        LAS float* red = (LAS float*)(lds + RT_RED);
#pragma unroll
        for (int g4 = 0; g4 < 4; ++g4) {
            *(LAS f32x4*)(red + ((wid * 64 + r) * 32 + 8 * g4 + 4 * h)) = (f32x4){acc0[4 * g4], acc0[4 * g4 + 1], acc0[4 * g4 + 2], acc0[4 * g4 + 3]};
            *(LAS f32x4*)(red + ((wid * 64 + 32 + r) * 32 + 8 * g4 + 4 * h)) = (f32x4){acc1[4 * g4], acc1[4 * g4 + 1], acc1[4 * g4 + 2], acc1[4 * g4 + 3]}; }
    }
    __syncthreads();
    {
        const LAS float* red = (const LAS float*)(lds + RT_RED); LAS float* lg = (LAS float*)(lds + RT_LOG);
#pragma unroll
        for (int i = 0; i < 4; ++i) { const int idx = tid + 512 * i, o = idx >> 5, row = idx & 31; float sum = 0.f;
#pragma unroll
            for (int w2 = 0; w2 < 8; ++w2) sum += red[(w2 * 64 + o) * 32 + row];
            lg[row * 64 + o] = sum; }
    }
    __syncthreads();
    if (tid < 32) {
        const LAS float* lg = (const LAS float*)(lds + RT_LOG) + tid * 64;
        int grp = 0; float gmax = lg[0] + brg[0]; float glv[4]; glv[0] = gmax;
#pragma unroll
        for (int g = 1; g < 4; ++g) { glv[g] = lg[g] + brg[g]; if (glv[g] > gmax) { gmax = glv[g]; grp = g; } }
        float gden = 0.f;
#pragma unroll
        for (int g = 0; g < 4; ++g) gden += __expf(glv[g] - gmax);
        float v0 = -3.0e38f, v1 = -3.0e38f; int i0 = 0, i1 = 0;
#pragma unroll
        for (int e = 0; e < 8; ++e) { const float val = lg[4 + grp * 8 + e] + bre[grp * 8 + e];
            if (val > v0) { v1 = v0; i1 = i0; v0 = val; i0 = e; } else if (val > v1) { v1 = val; i1 = e; } }
        const float e1 = __expf(v1 - v0), den = 1.f + e1, pg = 1.0f / gden;
        const int row = 32 * vcu + tid, ea = grp * 8 + i0, eb = grp * 8 + i1;
        const int pa = __hip_atomic_fetch_add(lhist + ea, 1, __ATOMIC_RELAXED, __HIP_MEMORY_SCOPE_WORKGROUP); inv[(vcu * 32 + ea) * 32 + pa] = row * 2; tg[row * 2] = pg / den;
        const int pb = __hip_atomic_fetch_add(lhist + eb, 1, __ATOMIC_RELAXED, __HIP_MEMORY_SCOPE_WORKGROUP); inv[(vcu * 32 + eb) * 32 + pb] = row * 2 + 1; tg[row * 2 + 1] = pg * e1 / den;
    }
    __syncthreads();
    if (tid < 32) hist[vcu * 32 + tid] = lhist[tid];
}

constexpr int KRS = 144, AT_K = 0, AT_V = 256 * KRS, AT_BIAS = 2 * 256 * KRS, AT_BYTES = AT_BIAS + 8 * 128 * 4;
__device__ __forceinline__ int t5_bucket(int n) { if (n < 16) return n; int l = 16 + (int)(__logf((float)n * (1.f / 16.f)) / 2.0794415416798357f * 16.f); return l < 31 ? l : 31; }
__device__ __forceinline__ void attn_phase(LAS unsigned char* lds, const bf16_t* Qb, const bf16_t* Kc, const bf16_t* Vc, const float* sinks, const float* relb, bf16_t* Og, int vcu, int G) {
    const int tid = opaque_tid(), lane = tid & 63, wid = __builtin_amdgcn_readfirstlane(tid >> 6), r = lane & 31, h = lane >> 5;
    LAS float* biasT = (LAS float*)(lds + AT_BIAS);
    for (int unit = vcu; unit < BATCH * AT_HKV * (SEQ / 128); unit += G) {
        const int b = unit >> 6, kvh = (unit >> 4) & 3, qblk = unit & 15, hq = kvh * 8 + wid;
        const int row0 = b * SEQ + qblk * 128;
#pragma unroll
        for (int it = 0; it < 4; ++it) { const int id = tid + 512 * it, i = id >> 3, ck = id & 7;
            u32x4 kv = {0u, 0u, 0u, 0u}, vv = {0u, 0u, 0u, 0u};
            if (qblk > 0 || i >= 128) { const size_t go = (size_t)(row0 - 128 + i) * KVW + kvh * 64 + ck * 8; kv = *(const u32x4*)(Kc + go); vv = *(const u32x4*)(Vc + go); }
            *(LAS u32x4*)(lds + AT_K + i * KRS + ck * 16) = kv; *(LAS u32x4*)(lds + AT_V + i * KRS + ck * 16) = vv; }
        for (int id = tid; id < 1024; id += 512) biasT[id] = relb[t5_bucket(id & 127) * AT_HQ + kvh * 8 + (id >> 7)];
        __syncthreads();
        const float sink = sinks[hq];
        for (int qs = 0; qs < 4; ++qs) {
            bf16x8 qf[4]; { const bf16_t* qp = Qb + (size_t)(row0 + 32 * qs + r) * D + hq * 64 + 8 * h;
#pragma unroll
                for (int ks = 0; ks < 4; ++ks) qf[ks] = *(const bf16x8*)(qp + 16 * ks); }
            f32x16 S[5];
#pragma unroll
            for (int kbi = 0; kbi < 5; ++kbi) {
#pragma unroll
                for (int e = 0; e < 16; ++e) S[kbi][e] = 0.f;
#pragma unroll
                for (int ks = 0; ks < 4; ++ks) S[kbi] = MFMA32(*(const LAS bf16x8*)(lds + AT_K + (32 * (qs + kbi) + r) * KRS + (16 * ks + 8 * h) * 2), qf[ks], S[kbi]); }
            float m = -1e30f;
#pragma unroll
            for (int kbi = 0; kbi < 5; ++kbi)
#pragma unroll
                for (int e = 0; e < 16; ++e) { const int keyb = 32 * (qs + kbi) + (e & 3) + 8 * (e >> 2) + 4 * h, dist = 128 + 32 * qs + r - keyb;
                    const bool valid = dist >= 0 && dist < 128 && (qblk > 0 || keyb >= 128);
                    const float sv = valid ? S[kbi][e] * 0.125f + biasT[wid * 128 + (dist & 127)] : -1e30f;
                    S[kbi][e] = sv; m = fmaxf(m, sv); }
            m = fmaxf(m, __shfl_xor(m, 32)); m = fmaxf(m, sink);
            float l = 0.f;
#pragma unroll
            for (int kbi = 0; kbi < 5; ++kbi)
#pragma unroll
                for (int e = 0; e < 16; ++e) { const float pv = __expf(S[kbi][e] - m); S[kbi][e] = pv; l += pv; }
            l += __shfl_xor(l, 32); l += __expf(sink - m);
            f32x16 O[2];
#pragma unroll
            for (int e = 0; e < 16; ++e) { O[0][e] = 0.f; O[1][e] = 0.f; }
            const int i16 = lane & 15, qq = i16 >> 2, pp = i16 & 3, gg = (lane >> 4) & 1;
#pragma unroll
            for (int kbi = 0; kbi < 5; ++kbi)
#pragma unroll
                for (int s2 = 0; s2 < 2; ++s2) {
                    u32x4 pk; pk.x = pg8::cvt_pk_bf16(S[kbi][8 * s2 + 0], S[kbi][8 * s2 + 1]); pk.y = pg8::cvt_pk_bf16(S[kbi][8 * s2 + 2], S[kbi][8 * s2 + 3]);
                    pk.z = pg8::cvt_pk_bf16(S[kbi][8 * s2 + 4], S[kbi][8 * s2 + 5]); pk.w = pg8::cvt_pk_bf16(S[kbi][8 * s2 + 6], S[kbi][8 * s2 + 7]);
                    const bf16x8 pf = __builtin_bit_cast(bf16x8, pk);
#pragma unroll
                    for (int db = 0; db < 2; ++db) { const LAS unsigned char* va = lds + AT_V + (32 * (qs + kbi) + 16 * s2 + 4 * h + qq) * KRS + (32 * db + 16 * gg + 4 * pp) * 2;
                        const s16x4 lo = __builtin_amdgcn_ds_read_tr16_b64_v4i16((lds_s16x4*)va), hi = __builtin_amdgcn_ds_read_tr16_b64_v4i16((lds_s16x4*)(va + 8 * KRS));
                        const bf16x8 vf = {lo[0], lo[1], lo[2], lo[3], hi[0], hi[1], hi[2], hi[3]};
                        O[db] = MFMA32(vf, pf, O[db]); } }
            const float inv = 1.0f / l;
            bf16_t* op = Og + (size_t)(row0 + 32 * qs + r) * D + hq * 64 + 4 * h;
#pragma unroll
            for (int db = 0; db < 2; ++db)
#pragma unroll
                for (int g4 = 0; g4 < 4; ++g4) { f32x4 v; v[0] = O[db][4 * g4] * inv; v[1] = O[db][4 * g4 + 1] * inv; v[2] = O[db][4 * g4 + 2] * inv; v[3] = O[db][4 * g4 + 3] * inv;
                    *(u32x2*)(op + 32 * db + 8 * g4) = pack4(v); }
        }
        __syncthreads();
    }
}

constexpr int LDS_STAGE = 0;
constexpr int LDS_MOETAB = pg8::STAGE_BYTES;
constexpr int LDS_MISC = LDS_MOETAB + pg8::MOE_TAB_INTS * 4;
constexpr int LDS_BYTES = 147456;
static_assert(RT_BYTES <= pg8::STAGE_BYTES && LDS_MISC + 256 <= LDS_BYTES && H1_BYTES <= pg8::STAGE_BYTES && 8 * 8448 <= pg8::STAGE_BYTES && AT_BYTES <= pg8::STAGE_BYTES, "LDS map");
constexpr int CW_BAR = 4096;
constexpr int N_PHASES = 1 + NA * 9 + (DEPTH - NA) * 7;

struct MegaArgs { const float* in[19]; float* out; unsigned char* ws; int ph_lo, ph_hi; };

__global__ void __launch_bounds__(512, 2) mega_fwd(MegaArgs args) {
    extern __shared__ __attribute__((aligned(16))) unsigned char lds_raw[];
    LAS unsigned char* lds = (LAS unsigned char*)lds_raw;
    volatile LAS unsigned* MISC = (volatile LAS unsigned*)(lds + LDS_MISC);
    const int tid = threadIdx.x, G = gridDim.x, bx = blockIdx.x, vcu = (G % 8 == 0) ? (bx % 8) * (G / 8) + bx / 8 : bx;
    unsigned char* const ws = args.ws;
    if (tid < 64) MISC[tid] = 0u;
    __syncthreads();
    const int lo = args.ph_lo, hi = args.ph_hi;
    XcdBarrier bar; bar.bar = (unsigned*)(ws + WS_CTL) + CW_BAR; bar.x = 0; bar.st = nullptr;
    if (hi - lo > 1) bar = xcd_barrier_post((unsigned*)(ws + WS_CTL) + CW_BAR, MISC + 8);
#define WSP(type, off) ((type*)(args.ws + (off)))
    int ph = 0;
#ifndef PROBE_DUP
#define PROBE_DUP 0
#endif
#define PHASE_T(dupbit, trash_body, ...) if (lo <= ph && ph < hi) { if ((PROBE_DUP >> (dupbit)) & 1) { trash_body; xcd_barrier(bar); } __VA_ARGS__; if (ph + 1 < hi) xcd_barrier(bar); } ++ph;
#define PHASE(dupbit, ...) if (lo <= ph && ph < hi) { __VA_ARGS__; if ((PROBE_DUP >> (dupbit)) & 1) { xcd_barrier(bar); __VA_ARGS__; } if (ph + 1 < hi) xcd_barrier(bar); } ++ph;

    PHASE(0, { Ptrs p; p.x = args.in[0]; p.a_w_in = args.in[1]; p.a_w_out = args.in[4]; p.b_w_kv = args.in[5]; p.b_w_q = args.in[6]; p.b_w_out = args.in[8]; p.w_gate = args.in[14]; p.w_up = args.in[15]; p.w_down = args.in[16]; p.w_rg = args.in[10]; p.w_re = args.in[12]; p.ws = args.ws;
               prologue_phase(lds, p, vcu, G); })

    for (int L = 0; L < DEPTH; ++L) {
        if (L < NA) {
            PHASE(1, { pg8::DenseSched S; S.init(T, 4 * D, D, G, bx); pg8::EpiHgrn E{WSP(bf16_t, WS_QB), WSP(bf16_t, WS_KB), WSP(bf16_t, WS_VB), WSP(bf16_t, WS_GT), WSP(float, WS_GL), args.in[2], L, 0};
                       pg8::gemm_phase<pg8::EpiHgrn, pg8::DenseSched>(lds, WSP(bf16_t, WS_XB2), WSP(bf16_t, WS_WIN) + (size_t)L * 4 * D * D, D, 0, S, E); })
#define HGARGS HgArgs{WSP(bf16_t, WS_QB), WSP(bf16_t, WS_KB), WSP(bf16_t, WS_VB), WSP(bf16_t, WS_GT), WSP(bf16_t, WS_OF), WSP(bf16_t, WS_UT), WSP(bf16_t, WS_SST), WSP(bf16_t, WS_OG), WSP(float, WS_GL), WSP(float, WS_DG), args.in[3] + (size_t)L * D, WSP(bf16_t, WS_QB)}
            PHASE_T(6, { HgArgs ha = HGARGS; ha.Qt = WSP(bf16_t, WS_TRASH); ha.OI = WSP(bf16_t, WS_TRASH + 32 * MiB); ha.UT = WSP(bf16_t, WS_TRASH + 64 * MiB); ha.Dg = WSP(float, WS_TRASH + 128 * MiB); h1_phase(lds, ha, vcu, G); },
                    { const HgArgs ha = HGARGS; h1_phase(lds, ha, vcu, G); })
            PHASE(3, { const HgArgs ha = HGARGS; h2_phase(ha, vcu, G); })
            PHASE(3, { const HgArgs ha = HGARGS; h3_phase(ha, vcu, G); })
            PHASE(1, { pg8::DenseSched S; S.init(T, D, D, G, bx); pg8::EpiStore E{WSP(bf16_t, WS_HM), WSP(bf16_t, WS_HM), D, 1 << 30, 1.0f, 0};
                       pg8::gemm_phase<pg8::EpiStore, pg8::DenseSched>(lds, WSP(bf16_t, WS_OG), WSP(bf16_t, WS_WOUT) + (size_t)L * D * D, D, 0, S, E); })
        } else {
            const int j = L - NA;
            PHASE(1, { if (j == 0) { pg8::DenseHalfSched S; S.init(T, 2 * KVW, D, G, vcu); pg8::EpiStore E{WSP(bf16_t, WS_KC), WSP(bf16_t, WS_VC), KVW, 1, 1.0f, 0};
                                     pg8::gemm_phase<pg8::EpiStore, pg8::DenseHalfSched>(lds, WSP(bf16_t, WS_XB2), WSP(bf16_t, WS_WKV), D, 0, S, E); }
                       pg8::DenseSched S; S.init(T, D, D, G, bx); pg8::EpiStore E{WSP(bf16_t, WS_QB), WSP(bf16_t, WS_QB), D, 1 << 30, 1.0f, 0};
                       pg8::gemm_phase<pg8::EpiStore, pg8::DenseSched>(lds, WSP(bf16_t, WS_XB2), WSP(bf16_t, WS_WQ) + (size_t)j * D * D, D, 0, S, E); })
            PHASE(3, attn_phase(lds, WSP(bf16_t, WS_QB), WSP(bf16_t, WS_KC), WSP(bf16_t, WS_VC), args.in[7] + j * AT_HQ, args.in[9], WSP(bf16_t, WS_OG), vcu, G))
            PHASE(1, { pg8::DenseSched S; S.init(T, D, D, G, bx); pg8::EpiStore E{WSP(bf16_t, WS_HM), WSP(bf16_t, WS_HM), D, 1 << 30, 1.0f, 0};
                       pg8::gemm_phase<pg8::EpiStore, pg8::DenseSched>(lds, WSP(bf16_t, WS_OG), WSP(bf16_t, WS_WO) + (size_t)j * D * D, D, 0, S, E); })
        }
#define LN0_ARGS(XLO, XB, HIST, INV, TG) ln_router_phase(lds, L == 0 ? args.in[0] : nullptr, WSP(bf16_t, WS_XB2), WSP(bf16_t, WS_HM), args.in[17] + (size_t)(2 * L) * D, args.in[18] + (size_t)(2 * L) * D, XLO, XB, \
            WSP(bf16_t, WS_WR) + (size_t)L * 64 * D, WSP(bf16_t, WS_WR) + (size_t)(DEPTH + L) * 64 * D, args.in[11] + L * NGRP, args.in[13] + L * NEXP, HIST, INV, TG, vcu, G)
        PHASE_T(4, LN0_ARGS(WSP(bf16_t, WS_TRASH), WSP(bf16_t, WS_TRASH + 64 * MiB), WSP(int, WS_TRASH + 100 * MiB), WSP(int, WS_TRASH + 96 * MiB), WSP(float, WS_TRASH + 98 * MiB)),
                LN0_ARGS(WSP(bf16_t, WS_XF2), WSP(bf16_t, WS_XB), WSP(int, WS_HIST), WSP(int, WS_LIST), WSP(float, WS_TG)))
#undef LN0_ARGS
        PHASE(2, { LAS int* tab = (LAS int*)(lds + LDS_MOETAB); pg8::MoeSched S{tab, 4, G, vcu, D, 1}; S.build(tab, (LAS int*)lds, WSP(int, WS_HIST), WSP(int, WS_LIST));
                   pg8::gemm_phase<pg8::EpiMoeH, pg8::MoeSched>(lds, WSP(bf16_t, WS_XB), WSP(bf16_t, WS_WGU) + (size_t)L * NEXP * 2 * DEXP * D, D, (size_t)2 * DEXP * D * 2, S, pg8::EpiMoeH{WSP(bf16_t, WS_HS)}); })
        PHASE(2, { LAS int* tab = (LAS int*)(lds + LDS_MOETAB); pg8::MoeSched S{tab, 8, G, vcu, DEXP, 0}; S.build(tab, (LAS int*)lds, WSP(int, WS_HIST), WSP(int, WS_LIST));
                   pg8::gemm_phase<pg8::EpiMoeY, pg8::MoeSched>(lds, WSP(bf16_t, WS_HS), WSP(bf16_t, WS_WD) + (size_t)L * NEXP * D * DEXP, DEXP, (size_t)D * DEXP * 2, S, pg8::EpiMoeY{WSP(bf16_t, WS_Y), WSP(float, WS_TG), S}); })
        PHASE_T(5, ln2_phase(WSP(bf16_t, WS_XB), WSP(bf16_t, WS_Y), args.in[17] + (size_t)(2 * L + 1) * D, args.in[18] + (size_t)(2 * L + 1) * D, WSP(bf16_t, WS_TRASH), nullptr, vcu, G),
                ln2_phase(WSP(bf16_t, WS_XB), WSP(bf16_t, WS_Y), args.in[17] + (size_t)(2 * L + 1) * D, args.in[18] + (size_t)(2 * L + 1) * D, WSP(bf16_t, WS_XB2), L == DEPTH - 1 ? args.out : nullptr, vcu, G))
    }
#undef HGARGS
#undef WSP
#undef PHASE
#undef PHASE_T
}

#ifndef MK_PER_PHASE
#define MK_PER_PHASE 0
#endif
extern "C" void kernel_launch(void* const* d_in, const int* in_sizes, int n_in, void* d_out, int out_size, void* d_ws, size_t ws_size, hipStream_t stream) {
    static int grid = 0;
    if (grid == 0) {
        if (n_in != 19 || out_size != T * D || ws_size < WS_END) { fprintf(stderr, "kernel_launch: unexpected arguments (n_in %d, out %d, ws %zu < %zu)\n", n_in, out_size, ws_size, (size_t)WS_END); grid = -1; return; }
        int dev = 0, cus = 0, per_cu = 0;
        if (hipGetDevice(&dev) != hipSuccess || hipDeviceGetAttribute(&cus, hipDeviceAttributeMultiprocessorCount, dev) != hipSuccess) { grid = -1; return; }
        if (hipFuncSetAttribute((const void*)mega_fwd, hipFuncAttributeMaxDynamicSharedMemorySize, LDS_BYTES) != hipSuccess) { fprintf(stderr, "kernel_launch: hipFuncSetAttribute failed\n"); grid = -1; return; }
        if (hipOccupancyMaxActiveBlocksPerMultiprocessor(&per_cu, (const void*)mega_fwd, 512, LDS_BYTES) != hipSuccess || per_cu < 1) { fprintf(stderr, "kernel_launch: occupancy query reports %d\n", per_cu); }
        (void)hipGetLastError();
        grid = cus;
        if (grid != 256) { fprintf(stderr, "kernel_launch: built for 256 CUs (the routing tables assume 256 workgroups of 32 token rows); this device reports %d\n", cus); grid = -1; return; }
    }
    if (grid < 0) return;
    (void)hipMemsetAsync((char*)d_ws + WS_CTL, 0, CTL_BYTES, stream);
    MegaArgs a{};
    for (int i = 0; i < 19; ++i) a.in[i] = (const float*)d_in[i];
    a.out = (float*)d_out; a.ws = (unsigned char*)d_ws;
#if MK_PER_PHASE
    for (int ph = 0; ph < N_PHASES; ++ph) { a.ph_lo = ph; a.ph_hi = ph + 1; hipLaunchKernelGGL(mega_fwd, dim3(grid), dim3(512), LDS_BYTES, stream, a); }
#else
    a.ph_lo = 0; a.ph_hi = N_PHASES;
    hipLaunchKernelGGL(mega_fwd, dim3(grid), dim3(512), LDS_BYTES, stream, a);
#endif
}
```

```cpp
#include <hip/hip_runtime.h>
#include <cstdio>
#include <cstdint>

typedef unsigned short bf16_t;
typedef short bf16x8 __attribute__((ext_vector_type(8)));
typedef float f32x4 __attribute__((ext_vector_type(4)));

constexpr int BATCH = 4, SEQ = 2048, D = 2048, T = BATCH * SEQ, DEPTH = 4, NA = 2;
constexpr int HG_H = 16, HG_DK = 128;
constexpr int AT_HD = 64, AT_HQ = 32, AT_HKV = 4, AT_G = 8, KVW = AT_HKV * AT_HD;
constexpr int NGRP = 4, EPG = 8, NEXP = 32, DEXP = 512;
constexpr float ALPHA = 1.6817928305074290f;
constexpr float LN_EPS = 1e-5f, RMS_EPS = 1e-6f;

constexpr size_t MiB = 1u << 20;
constexpr size_t WS_CTL = 0, CTL_BYTES = 1 * MiB;
constexpr size_t WS_XF = 1 * MiB;
constexpr size_t WS_XB2 = WS_XF;
constexpr size_t WS_XB = WS_XF + 64 * MiB;
constexpr size_t WS_QB = WS_XB + 32 * MiB;
constexpr size_t WS_KB = WS_QB + 32 * MiB;
constexpr size_t WS_VB = WS_KB + 32 * MiB;
constexpr size_t WS_GT = WS_VB + 32 * MiB;
constexpr size_t WS_GL = WS_GT + 32 * MiB;
constexpr size_t WS_OF = WS_GL + 64 * MiB;
constexpr size_t WS_OG = WS_OF + 64 * MiB;
constexpr size_t WS_HM = WS_OG + 32 * MiB;
constexpr size_t WS_KC = WS_HM + 32 * MiB;
constexpr size_t WS_VC = WS_KC + 4 * MiB;
constexpr size_t WS_LIST = WS_VC + 4 * MiB;
constexpr size_t WS_TG = WS_LIST + 1 * MiB;
constexpr size_t WS_HS = WS_TG + 1 * MiB;
constexpr size_t WS_Y = WS_HS + 24 * MiB;
constexpr size_t WS_WIN = WS_Y + 64 * MiB;
constexpr size_t WS_WOUT = WS_WIN + 64 * MiB;
constexpr size_t WS_WKV = WS_WOUT + 16 * MiB;
constexpr size_t WS_WQ = WS_WKV + 2 * MiB;
constexpr size_t WS_WO = WS_WQ + 16 * MiB;
constexpr size_t WS_WGU = WS_WO + 16 * MiB;
constexpr size_t WS_WD = WS_WGU + 512 * MiB;
constexpr size_t WS_UT = WS_WD + 256 * MiB;
constexpr size_t WS_SST = WS_UT + 64 * MiB;
constexpr size_t WS_DG = WS_SST + 64 * MiB;
constexpr size_t WS_WR = WS_DG + 1 * MiB;
constexpr size_t WS_XF2 = WS_WR + 2 * MiB;
constexpr size_t WS_HIST = WS_XF2 + 64 * MiB;
constexpr size_t WS_SLOT = WS_HIST + 1 * MiB;
constexpr size_t WS_TRASH = WS_SLOT + 1 * MiB;
constexpr size_t WS_END = WS_TRASH + 256 * MiB;
constexpr int CW_CNT = 1024;

__device__ __forceinline__ unsigned f2bf(float f) { unsigned u = __builtin_bit_cast(unsigned, f); return (u + 0x7fffu + ((u >> 16) & 1u)) >> 16; }
__device__ __forceinline__ float bf2f(bf16_t b) { return __builtin_bit_cast(float, ((unsigned)b) << 16); }
typedef unsigned u32x2 __attribute__((ext_vector_type(2)));
__device__ __forceinline__ f32x4 bf4(const u32x2 w) { f32x4 r; r[0] = __builtin_bit_cast(float, w.x << 16); r[1] = __builtin_bit_cast(float, w.x & 0xffff0000u); r[2] = __builtin_bit_cast(float, w.y << 16); r[3] = __builtin_bit_cast(float, w.y & 0xffff0000u); return r; }
__device__ __forceinline__ float wave_sum(float v) {
#pragma unroll
    for (int o = 1; o < 64; o <<= 1) v += __shfl_xor(v, o);
    return v;
}
__device__ __forceinline__ float wave_max(float v) {
#pragma unroll
    for (int o = 1; o < 64; o <<= 1) v = fmaxf(v, __shfl_xor(v, o));
    return v;
}
__device__ __forceinline__ float sigmoidf_(float x) { return 1.0f / (1.0f + __expf(-x)); }
__device__ __forceinline__ int opaque_tid() { int t = threadIdx.x; asm volatile("" : "+v"(t)); return t; }

#define LAS __attribute__((address_space(3)))
typedef unsigned u32x4 __attribute__((ext_vector_type(4)));
namespace pg8 {
constexpr int BM = 256, BK = 64, HALF = 128, HTB = HALF * BK * 2, STAGE_BYTES = 8 * HTB;
__host__ __device__ __forceinline__ int lds_byte(int r, int c) { const int st = (r >> 4) * 2 + (c >> 5), rr = r & 15, cc = c & 31, ob = rr * 64 + cc * 2; return st * 1024 + (ob ^ (((ob >> 9) & 1) << 5)); }
__host__ __device__ __forceinline__ void stage_rc(int b, int& R, int& C) { const int st = b / 1024, sb = b % 1024, swz = sb ^ (((sb >> 9) & 1) << 5); R = (st >> 1) * 16 + swz / 64; C = (st & 1) * 32 + (swz % 64) / 2; }
__host__ __device__ __forceinline__ int perm32(int rho) { const int n = rho >> 4, i = rho & 15; return 8 * (i >> 2) + 4 * n + (i & 3); }
struct Unit { int r0, pn, e, rows, tm, ui; };
typedef float f32x2_ __attribute__((ext_vector_type(2)));
typedef __bf16 bf16x2_ __attribute__((ext_vector_type(2)));
__device__ __forceinline__ unsigned cvt_pk_bf16(float lo, float hi) { const f32x2_ v = {lo, hi}; return __builtin_bit_cast(unsigned, __builtin_convertvector(v, bf16x2_)); }

struct DenseSched {
    int nM, nN, nwg, G, c, K;
    __device__ __forceinline__ void init(int M, int N, int K_, int G_, int c_) { nM = M / BM; nN = N / BM; nwg = nM * nN; G = G_; c = c_; K = K_; }
    __device__ __forceinline__ bool next(int i, Unit& u) const {
        const long L = (long)i * G + c; if (L >= nwg) return false;
        int wgid = (int)L; { const int q = nwg / 8, r = nwg % 8, xcd = wgid % 8, off = wgid / 8; wgid = (xcd < r ? xcd * (q + 1) : r * (q + 1) + (xcd - r) * q) + off; }
        const int nig = 8 * nN, gid = wgid / nig, fm = gid * 8, gsz = (nM - fm) < 8 ? (nM - fm) : 8;
        u.r0 = (fm + ((wgid % nig) % gsz)) * BM; u.pn = (wgid % nig) / gsz; u.e = 0; u.rows = 256; u.tm = 0; u.ui = i; return true;
    }
    __device__ __forceinline__ unsigned a_off(const Unit& u, int half, int R) const { return (unsigned)((u.r0 + half * 128 + R) * K) * 2u; }
};
struct DenseHalfSched {
    int nN, nwg, G, c, K;
    __device__ __forceinline__ void init(int M, int N, int K_, int G_, int c_) { nN = N / BM; nwg = (M / HALF) * nN; G = G_; c = c_; K = K_; }
    __device__ __forceinline__ bool next(int i, Unit& u) const { const int L = i * G + c; if (L >= nwg) return false; u.r0 = (L / nN) * HALF; u.pn = L % nN; u.e = 0; u.rows = HALF; u.tm = 0; u.ui = i; return true; }
    __device__ __forceinline__ unsigned a_off(const Unit& u, int half, int R) const { return (unsigned)((u.r0 + half * 128 + R) * K) * 2u; }
};

template <class Epi, class Sched>
__device__ __forceinline__ void gemm_phase(LAS unsigned char* lds, const bf16_t* A, const bf16_t* Bt, int K, size_t bstride, const Sched& S, const Epi& E) {
    const int tid = opaque_tid(), wid = __builtin_amdgcn_readfirstlane(tid >> 6), lane = tid & 63, wr = wid >> 2, wc = wid & 3, fr = lane & 15, fq = lane >> 4;
    const int nt = K / BK;
    int sR[2], sC2[2]; unsigned voffB[2];
#pragma unroll
    for (int i = 0; i < 2; ++i) { int R, C; stage_rc(tid * 16 + i * 8192, R, C); const int Rb = (R & ~31) + perm32(R & 31); sR[i] = R; sC2[i] = C * 2; voffB[i] = (unsigned)(Rb * K + C) * 2u; }
    const size_t kstep = (size_t)(BK * 2);
    const size_t hstep = (size_t)HALF * K * 2;
    const size_t tstep = 2 * hstep;
    const unsigned ldsw = (unsigned)wid * 1024u;
    const int aoff = lds_byte(wr * 64 + fr, fq * 8), boff = lds_byte(wc * 32 + fr, fq * 8);
#define PG8_SA(b, h) (((b) * 2 + (h)) * HTB)
#define PG8_SB(b, h) ((4 + (b) * 2 + (h)) * HTB)
#define PG8_STAGE(bufoff, gbase, voff) do { _Pragma("unroll") for (int _i = 0; _i < 2; ++_i) \
        __builtin_amdgcn_global_load_lds((const unsigned*)((const char*)(gbase) + (voff)[_i]), (LAS unsigned*)(lds + (bufoff) + ldsw + _i * 8192), 16, 0, 0); } while (0)
#define PG8_LDA(dst, b, h) do { _Pragma("unroll") for (int m = 0; m < 4; ++m) _Pragma("unroll") for (int k = 0; k < 2; ++k) dst[m][k] = *(const LAS bf16x8*)(lds + PG8_SA(b, h) + aoff + m * 2048 + k * 1024); } while (0)
#define PG8_LDB(dst, b, h) do { _Pragma("unroll") for (int n = 0; n < 2; ++n) _Pragma("unroll") for (int k = 0; k < 2; ++k) dst[n][k] = *(const LAS bf16x8*)(lds + PG8_SB(b, h) + boff + n * 2048 + k * 1024); } while (0)
#define PG8_MMA(ai, bj, At, Bt_) do { __builtin_amdgcn_s_setprio(1); _Pragma("unroll") for (int m = 0; m < 4; ++m) _Pragma("unroll") for (int n = 0; n < 2; ++n) _Pragma("unroll") for (int k = 0; k < 2; ++k) \
        acc[ai][bj][m][n] = __builtin_amdgcn_mfma_f32_16x16x32_bf16(Bt_[n][k], At[m][k], acc[ai][bj][m][n], 0, 0, 0); __builtin_amdgcn_s_setprio(0); } while (0)
#define PG8_WAIT_V(n) asm volatile("s_waitcnt vmcnt(" #n ")" ::: "memory")
#define PG8_WAIT_L(n) asm volatile("s_waitcnt lgkmcnt(" #n ")" ::: "memory")
#define PG8_BAR __builtin_amdgcn_s_barrier()
#define PG8_SCHED __builtin_amdgcn_sched_barrier(0)
    Unit cur, nxt; int ui = 0;
    if (!S.next(0, cur)) return;
    f32x4 acc[2][2][4][2];
#pragma unroll
    for (int a = 0; a < 2; ++a)
#pragma unroll
        for (int b = 0; b < 2; ++b)
#pragma unroll
            for (int m = 0; m < 4; ++m)
#pragma unroll
                for (int n = 0; n < 2; ++n) acc[a][b][m][n] = (f32x4){0.f, 0.f, 0.f, 0.f};
    bf16x8 At[4][2], B0[2][2], B1[2][2];
    unsigned voffA0[2], voffA1[2];
#pragma unroll
    for (int i = 0; i < 2; ++i) { voffA0[i] = S.a_off(cur, 0, sR[i]) + sC2[i]; voffA1[i] = S.a_off(cur, 1, sR[i]) + sC2[i]; }
    const char* const Ab = (const char*)A;
    const char* cB = (const char*)Bt + (size_t)cur.e * bstride + (size_t)cur.pn * tstep;
    PG8_STAGE(PG8_SB(0, 0), cB, voffB); PG8_STAGE(PG8_SB(0, 1), cB + hstep, voffB); PG8_STAGE(PG8_SA(0, 0), Ab, voffA0); PG8_STAGE(PG8_SA(0, 1), Ab, voffA1);
    if (wr == 1) PG8_BAR;
    PG8_WAIT_V(2); PG8_BAR;
    PG8_STAGE(PG8_SB(1, 0), cB + kstep, voffB); PG8_STAGE(PG8_SA(1, 0), Ab + kstep, voffA0); PG8_STAGE(PG8_SB(1, 1), cB + hstep + kstep, voffB);
    PG8_WAIT_V(6); PG8_BAR;
    for (;;) {
        const bool has_next = S.next(ui + 1, nxt);
        const bool full = cur.rows > HALF;
        const char* nB = has_next ? (const char*)Bt + (size_t)nxt.e * bstride + (size_t)nxt.pn * tstep : cB;
        for (int t = 0; t < nt; t += 2) {
            const bool last = (t == nt - 2);
            const char* a1 = Ab + (size_t)(t + 1) * kstep;
            const char* a2 = last ? Ab : Ab + (size_t)(t + 2) * kstep; const char* b2 = last ? nB : cB + (size_t)(t + 2) * kstep;
            const char* a3 = a2 + kstep; const char* b3 = b2 + kstep;
            PG8_LDB(B0, 0, 0); PG8_LDB(B1, 0, 1); PG8_SCHED; PG8_LDA(At, 0, 0); PG8_STAGE(PG8_SA(1, 1), a1, voffA1);
            if (last && has_next) {
#pragma unroll
                for (int i = 0; i < 2; ++i) { voffA0[i] = S.a_off(nxt, 0, sR[i]) + sC2[i]; voffA1[i] = S.a_off(nxt, 1, sR[i]) + sC2[i]; }
            }
            PG8_WAIT_V(8); PG8_WAIT_L(0); PG8_BAR; PG8_MMA(0, 0, At, B0); PG8_MMA(0, 1, At, B1); PG8_BAR; PG8_SCHED;
            if (full) PG8_LDA(At, 0, 1); PG8_STAGE(PG8_SB(0, 0), b2, voffB); PG8_STAGE(PG8_SB(0, 1), b2 + hstep, voffB); PG8_STAGE(PG8_SA(0, 0), a2, voffA0);
            PG8_WAIT_V(8); PG8_WAIT_L(0); PG8_BAR; if (full) { PG8_MMA(1, 0, At, B0); PG8_MMA(1, 1, At, B1); } PG8_BAR; PG8_SCHED;
            PG8_LDB(B0, 1, 0); PG8_LDB(B1, 1, 1); PG8_SCHED; PG8_LDA(At, 1, 0); PG8_STAGE(PG8_SA(0, 1), a2, voffA1);
            PG8_WAIT_V(8); PG8_WAIT_L(0); PG8_BAR; PG8_MMA(0, 0, At, B0); PG8_MMA(0, 1, At, B1); PG8_BAR; PG8_SCHED;
            if (full) PG8_LDA(At, 1, 1); PG8_STAGE(PG8_SB(1, 0), b3, voffB); PG8_STAGE(PG8_SB(1, 1), b3 + hstep, voffB); PG8_STAGE(PG8_SA(1, 0), a3, voffA0);
            PG8_WAIT_V(8); PG8_WAIT_L(0); PG8_BAR; if (full) { PG8_MMA(1, 0, At, B0); PG8_MMA(1, 1, At, B1); } PG8_BAR; PG8_SCHED;
        }
        if (wr == 0) PG8_BAR;
        E(acc, cur, wr, wc, fr, fq);
        if (!has_next) break;
#pragma unroll
        for (int a = 0; a < 2; ++a)
#pragma unroll
            for (int b = 0; b < 2; ++b)
#pragma unroll
                for (int m = 0; m < 4; ++m)
#pragma unroll
                    for (int n = 0; n < 2; ++n) acc[a][b][m][n] = (f32x4){0.f, 0.f, 0.f, 0.f};
        cur = nxt; cB = nB; ++ui;
        if (wr == 1) PG8_BAR;
    }
    PG8_WAIT_V(0);
    PG8_BAR;
#undef PG8_SA
#undef PG8_SB
#undef PG8_STAGE
#undef PG8_LDA
#undef PG8_LDB
#undef PG8_MMA
#undef PG8_WAIT_V
#undef PG8_WAIT_L
#undef PG8_BAR
#undef PG8_SCHED
}

#define PG8_ROWS_COLS const int row0 = u.r0 + wr * 64 + fr; const int col0 = wc * 32 + 8 * fq
__device__ __forceinline__ u32x4 pack8(const f32x4 v0, const f32x4 v1) { u32x4 w; w.x = cvt_pk_bf16(v0[0], v0[1]); w.y = cvt_pk_bf16(v0[2], v0[3]); w.z = cvt_pk_bf16(v1[0], v1[1]); w.w = cvt_pk_bf16(v1[2], v1[3]); return w; }
struct EpiStore {
    bf16_t* O; bf16_t* O2; int ldc, split; float scale; int pad;
    __device__ __forceinline__ void operator()(const f32x4 (&acc)[2][2][4][2], const Unit& u, int wr, int wc, int fr, int fq) const {
        PG8_ROWS_COLS; bf16_t* base = u.pn >= split ? O2 + (size_t)(u.pn - split) * BM : O + (size_t)u.pn * BM;
#pragma unroll
        for (int ai = 0; ai < 2; ++ai) if (ai * HALF < u.rows)
#pragma unroll
            for (int m = 0; m < 4; ++m) { bf16_t* rowp = base + (size_t)(row0 + ai * HALF + m * 16) * ldc + col0;
#pragma unroll
                for (int bj = 0; bj < 2; ++bj) *(u32x4*)(rowp + bj * HALF) = pack8(acc[ai][bj][m][0] * scale, acc[ai][bj][m][1] * scale); }
    }
};
struct EpiHgrn {
    bf16_t *Qb, *Kb, *Vb, *Gt; float* Gl; const float* lbraw; int layer, pad;
    __device__ __forceinline__ void operator()(const f32x4 (&acc)[2][2][4][2], const Unit& u, int wr, int wc, int fr, int fq) const {
        PG8_ROWS_COLS; const int seg = u.pn >> 3, ct = (u.pn & 7) * BM + col0;
        if (seg == 0 || seg == 2) { bf16_t* base = (seg == 0 ? Qb : Vb) + ct;
#pragma unroll
            for (int ai = 0; ai < 2; ++ai)
#pragma unroll
                for (int m = 0; m < 4; ++m) { bf16_t* rowp = base + (size_t)(row0 + ai * HALF + m * 16) * D;
#pragma unroll
                    for (int bj = 0; bj < 2; ++bj) *(u32x4*)(rowp + bj * HALF) = pack8(acc[ai][bj][m][0], acc[ai][bj][m][1]); }
        } else if (seg == 3) {
#pragma unroll
            for (int ai = 0; ai < 2; ++ai)
#pragma unroll
                for (int m = 0; m < 4; ++m) { bf16_t* rowp = Gt + ct + (size_t)(row0 + ai * HALF + m * 16) * D;
#pragma unroll
                    for (int bj = 0; bj < 2; ++bj) { f32x4 v[2];
#pragma unroll
                        for (int n = 0; n < 2; ++n)
#pragma unroll
                            for (int j = 0; j < 4; ++j) { const float x = acc[ai][bj][m][n][j]; v[n][j] = x * sigmoidf_(x); }
                        *(u32x4*)(rowp + bj * HALF) = pack8(v[0], v[1]); } }
        } else {
#pragma unroll
            for (int bj = 0; bj < 2; ++bj) { float lb[8];
#pragma unroll
                for (int j = 0; j < 8; ++j) { const int c = ct + bj * HALF + j; lb[j] = layer == 0 ? 0.f : sigmoidf_(lbraw[D + c] - lbraw[c]); }
#pragma unroll
                for (int ai = 0; ai < 2; ++ai)
#pragma unroll
                    for (int m = 0; m < 4; ++m) { const size_t o = (size_t)(row0 + ai * HALF + m * 16) * D + ct + bj * HALF; f32x4 kv[2], gv[2];
#pragma unroll
                        for (int n = 0; n < 2; ++n)
#pragma unroll
                            for (int j = 0; j < 4; ++j) { const float l = lb[4 * n + j], sg = sigmoidf_(acc[ai][bj][m][n][j]); gv[n][j] = __log2f(fmaxf(l + (1.f - l) * sg, 1e-30f));   kv[n][j] = (1.f - l) * (1.f - sg); }
                        *(u32x4*)(Kb + o) = pack8(kv[0], kv[1]); *(f32x4*)(Gl + o) = gv[0]; *(f32x4*)(Gl + o + 4) = gv[1]; } }
        }
    }
};


constexpr int MOE_MAXU = 4, MT_TILE = 0, MT_FULL = 40, MT_TAIL = 80, MT_CNT = 120, MT_ROWS = 160, MOE_TAB_INTS = MT_ROWS + 256 * MOE_MAXU;
struct MoeSched {
    const LAS int* tab; int NT, G, c, K, gather;
    __device__ __forceinline__ bool next(int i, Unit& u) const {
        int L = i * G + c; const int FT = tab[MT_FULL + 32] * NT; int e = 0, tm;
        if (L < FT) { const int k = L / NT; u.pn = L - k * NT; while (tab[MT_FULL + e + 1] <= k) ++e; tm = k - tab[MT_FULL + e]; }
        else { L -= FT; if (L >= tab[MT_TAIL + 32] * NT) return false; const int k = L / NT; u.pn = L - k * NT; while (tab[MT_TAIL + e + 1] <= k) ++e; tm = tab[MT_TILE + e + 1] - tab[MT_TILE + e] - 1; }
        u.r0 = (tab[MT_TILE + e] + tm) * 256; u.e = e; u.tm = tm; const int left = tab[MT_CNT + e] - 256 * tm; u.rows = left < 256 ? left : 256; u.ui = i; return true;
    }
    __device__ __forceinline__ int entry(const Unit& u, int r) const {
        const int a = tab[MT_ROWS + 256 * u.ui + r]; return a >= 0 ? a : tab[MT_ROWS + 256 * u.ui];
    }
    __device__ __forceinline__ unsigned a_off(const Unit& u, int half, int R) const {
        if (gather) return (unsigned)((entry(u, half * 128 + R) >> 1) * K) * 2u;
        return (unsigned)((u.r0 + half * 128 + R) * K) * 2u;
    }
    __device__ __forceinline__ void build_tables(LAS int* t, LAS int* scr, const int* hist) const {
        const int tid = opaque_tid(), lane = tid & 63;
        { const int e = tid & 31, part = tid >> 5; int sum = 0;
#pragma unroll
          for (int b = part * 16; b < part * 16 + 16; ++b) sum += hist[b * 32 + e];
          scr[tid] = sum; }
        __syncthreads();
        if (tid < 64) { int cn = 0;
            if (lane < 32) {
#pragma unroll
                for (int part = 0; part < 16; ++part) cn += scr[part * 32 + lane]; }
            const int nt = (cn + 255) >> 8, tail = (nt > 0 && cn - 256 * (nt - 1) <= 128) ? 1 : 0;
            int p = nt, pf = nt - tail, pt = tail;
#pragma unroll
            for (int o = 1; o < 32; o <<= 1) { const int a = __shfl_up(p, o), b = __shfl_up(pf, o), c2 = __shfl_up(pt, o); if (lane >= o) { p += a; pf += b; pt += c2; } }
            if (lane < 32) { t[MT_CNT + lane] = cn; t[MT_TILE + lane] = p - nt; t[MT_FULL + lane] = pf - (nt - tail); t[MT_TAIL + lane] = pt - tail; }
            if (lane == 31) { t[MT_TILE + 32] = p; t[MT_FULL + 32] = pf; t[MT_TAIL + 32] = pt; } }
        __syncthreads();
    }
    __device__ __forceinline__ void build_rows(LAS int* t, LAS int* scr, const int* hist, const int* inv) const {
        const int tid = opaque_tid(), lane = tid & 63, wv = tid >> 6;
        for (int i = 0; i < MOE_MAXU; ++i) { Unit u; if (!next(i, u)) break;
            int hv = 0, incl = 0;
            if (tid < 256) { hv = hist[tid * 32 + u.e]; incl = hv;
#pragma unroll
                for (int o = 1; o < 64; o <<= 1) { const int tv = __shfl_up(incl, o); if (lane >= o) incl += tv; }
                if (lane == 63) scr[wv] = incl; }
            __syncthreads();
            if (tid < 256) { int off = 0; for (int w2 = 0; w2 < wv; ++w2) off += scr[w2]; scr[512 + tid] = off + incl - hv; if (tid == 255) scr[512 + 256] = off + incl; }
            __syncthreads();
            if (tid < 256) { const int pos = 256 * u.tm + tid; int ent = -1;
                if (pos < t[MT_CNT + u.e]) { int lo = 0, hi = 256;
                    while (hi - lo > 1) { const int mid = (lo + hi) >> 1; if (scr[512 + mid] <= pos) lo = mid; else hi = mid; }
                    ent = inv[(lo * 32 + u.e) * 32 + (pos - scr[512 + lo])]; }
                t[MT_ROWS + 256 * i + tid] = ent; }
            __syncthreads();
        }
    }
};
struct EpiMoeH {
    bf16_t* Hs; int* slot_ent; MoeSched S;
    __device__ __forceinline__ void operator()(const f32x4 (&acc)[2][2][4][2], const Unit& u, int wr, int wc, int fr, int fq) const {
        const int col0 = u.pn * 128 + wc * 32 + 8 * fq;
#pragma unroll
        for (int ai = 0; ai < 2; ++ai)
#pragma unroll
            for (int m = 0; m < 4; ++m) { const int rl = ai * HALF + wr * 64 + m * 16 + fr; f32x4 v[2];
#pragma unroll
                for (int n = 0; n < 2; ++n)
#pragma unroll
                    for (int j = 0; j < 4; ++j) { const float g = acc[ai][0][m][n][j]; v[n][j] = g * sigmoidf_(g) * acc[ai][1][m][n][j]; }
                if (rl < u.rows) { *(u32x4*)(Hs + (size_t)(u.r0 + rl) * DEXP + col0) = pack8(v[0], v[1]); if (u.pn == 0 && wc == 0 && fq == 0) slot_ent[u.r0 + rl] = S.entry(u, rl); } }
    }
};
struct EpiMoeY {
    bf16_t* Y; const float* tg; const int* slot_ent;
    __device__ __forceinline__ void operator()(const f32x4 (&acc)[2][2][4][2], const Unit& u, int wr, int wc, int fr, int fq) const {
        const int col0 = u.pn * BM + wc * 32 + 8 * fq;
#pragma unroll
        for (int ai = 0; ai < 2; ++ai)
#pragma unroll
            for (int m = 0; m < 4; ++m) { const int rl = ai * HALF + wr * 64 + m * 16 + fr;
                if (rl < u.rows) { const int a = slot_ent[u.r0 + rl]; const float g = tg[a]; bf16_t* rowp = Y + (size_t)a * D + col0;
#pragma unroll
                    for (int bj = 0; bj < 2; ++bj) *(u32x4*)(rowp + bj * HALF) = pack8(acc[ai][bj][m][0] * g, acc[ai][bj][m][1] * g); } }
    }
};

__device__ __forceinline__ void transpose_item(const float* W, int K, int N, bf16_t* WT, int dst_row0, LAS float* scr, int kb, int nb, int lane) {
    const int k0 = 64 * kb, n0 = 32 * nb;
    float tmp[32]; const float* src = W + (size_t)(k0 + (lane >> 5)) * N + n0 + (lane & 31);
#pragma unroll
    for (int i = 0; i < 32; ++i) tmp[i] = src[(size_t)(2 * i) * N];
#pragma unroll
    for (int i = 0; i < 32; ++i) scr[(2 * i + (lane >> 5)) * 33 + (lane & 31)] = tmp[i];
    asm volatile("s_waitcnt lgkmcnt(0)" ::: "memory");
    const int c = lane & 7;
#pragma unroll
    for (int j = 0; j < 4; ++j) { const int n = (lane >> 3) + 8 * j; const LAS float* sp = scr + (8 * c) * 33 + n;
        u32x4 o; o.x = cvt_pk_bf16(sp[0 * 33], sp[1 * 33]); o.y = cvt_pk_bf16(sp[2 * 33], sp[3 * 33]); o.z = cvt_pk_bf16(sp[4 * 33], sp[5 * 33]); o.w = cvt_pk_bf16(sp[6 * 33], sp[7 * 33]);
        *(u32x4*)(WT + (size_t)(dst_row0 + n) * K + k0 + 8 * c) = o; }
    asm volatile("s_waitcnt lgkmcnt(0)" ::: "memory");
}
}

typedef short s16x4 __attribute__((ext_vector_type(4)));
typedef LAS s16x4 lds_s16x4;
constexpr int HRS = 272, ARS = 144;
constexpr int H1_QH = 0, H1_KH0 = H1_QH + 64 * HRS, H1_KH1 = H1_KH0 + 16 * HRS, H1_KH2 = H1_KH1 + 32 * HRS, H1_KH3 = H1_KH2 + 48 * HRS, H1_KT = H1_KH3 + 64 * HRS,
              H1_VS = H1_KT + 64 * HRS, H1_AS = H1_VS + 64 * HRS, H1_TOT = H1_AS + 64 * ARS, H1_BYTES = H1_TOT + 4096;
constexpr int NUNIT = BATCH * HG_H * (SEQ / 64);
__device__ __forceinline__ bf16x8 tr_frag16(const LAS unsigned char* tile, int rs, int r0, int c0, int lane) {
    const int g = lane >> 4, i = lane & 15, q = i >> 2, p = i & 3;
    const LAS unsigned char* a = tile + (r0 + 8 * g + q) * rs + (c0 + 4 * p) * 2;
    const s16x4 lo = __builtin_amdgcn_ds_read_tr16_b64_v4i16((lds_s16x4*)a);
    const s16x4 hi = __builtin_amdgcn_ds_read_tr16_b64_v4i16((lds_s16x4*)(a + 4 * rs));
    return (bf16x8){lo[0], lo[1], lo[2], lo[3], hi[0], hi[1], hi[2], hi[3]};
}
__device__ __forceinline__ bf16x8 row_frag16(const LAS unsigned char* tile, int rs, int r0, int c0, int lane) {
    return *(const LAS bf16x8*)(tile + (r0 + (lane & 15)) * rs + (c0 + 8 * (lane >> 4)) * 2);
}
#define MFMA16(a, b, c) __builtin_amdgcn_mfma_f32_16x16x32_bf16((a), (b), (c), 0, 0, 0)
__device__ __forceinline__ u32x2 pack4(const f32x4 v) { u32x2 r; r.x = pg8::cvt_pk_bf16(v[0], v[1]); r.y = pg8::cvt_pk_bf16(v[2], v[3]); return r; }

struct HgArgs { bf16_t *Qb, *Kb, *Vb, *Gt, *OI, *UT, *Sst, *Og; float *Gl, *Dg; const float* ng; bf16_t* Qt; };

typedef float f32x2 __attribute__((ext_vector_type(2)));
__device__ __forceinline__ f32x2 exp2v(const f32x2 x) { f32x2 r; r.x = __builtin_amdgcn_exp2f(x.x); r.y = __builtin_amdgcn_exp2f(x.y); return r; }
__device__ __forceinline__ f32x2 bf2v(unsigned w) { f32x2 r; r.x = __builtin_bit_cast(float, w << 16); r.y = __builtin_bit_cast(float, w & 0xffff0000u); return r; }
__device__ __forceinline__ unsigned v2bf(const f32x2 v) { return pg8::cvt_pk_bf16(v.x, v.y); }
struct H1In { f32x2 g[8]; unsigned q[8], k[8]; u32x4 v[2]; };
__device__ __forceinline__ void h1_load(H1In& in, const HgArgs& a, int unit, int tid) {
    const int bh = unit >> 5, c = unit & 31, b = bh >> 4, h = bh & 15, cp = tid & 63, tq = tid >> 6;
    const size_t gbase = ((size_t)b * SEQ + c * 64) * D + h * 128;
#pragma unroll
    for (int i = 0; i < 8; ++i) { const size_t go = gbase + (size_t)(8 * tq + i) * D + 2 * cp; in.g[i] = *(const f32x2*)(a.Gl + go); in.q[i] = *(const unsigned*)(a.Qb + go); in.k[i] = *(const unsigned*)(a.Kb + go); }
#pragma unroll
    for (int i = 0; i < 2; ++i) { const int id = tid + 512 * i, r = id >> 4, ck = id & 15; in.v[i] = *(const u32x4*)(a.Vb + gbase + (size_t)r * D + ck * 8); }
}
__device__ __forceinline__ void h1_phase(LAS unsigned char* lds, const HgArgs& a, int vcu, int G) {
    const int tid = opaque_tid(), lane = tid & 63, wid = __builtin_amdgcn_readfirstlane(tid >> 6);
    const int cp = lane, tq = wid, J = wid >> 1, half = wid & 1;
    LAS f32x2* tot8 = (LAS f32x2*)(lds + H1_TOT);
    H1In in;
    if (vcu < NUNIT) h1_load(in, a, vcu, tid);
    for (int unit = vcu; unit < NUNIT; unit += G) {
        const int bh = unit >> 5, c = unit & 31, b = bh >> 4, h = bh & 15;
        const size_t gbase = ((size_t)b * SEQ + c * 64) * D + h * 128;
        f32x2 L[8]; { f32x2 l = {0.f, 0.f};
#pragma unroll
            for (int i = 0; i < 8; ++i) { l += in.g[i]; L[i] = l; } }
        tot8[tq * 64 + cp] = L[7];
#pragma unroll
        for (int i = 0; i < 2; ++i) { const int id = tid + 512 * i, r = id >> 4, ck = id & 15; *(LAS u32x4*)(lds + H1_VS + r * HRS + ck * 16) = in.v[i]; }
        for (int id = tid; id < 64 * ARS / 16; id += 512) *(LAS u32x4*)(lds + H1_AS + id * 16) = (u32x4){0u, 0u, 0u, 0u};
        __syncthreads();
        f32x2 tj[4];
#pragma unroll
        for (int M = 0; M < 4; ++M) tj[M] = tot8[(2 * M) * 64 + cp] + tot8[(2 * M + 1) * 64 + cp];
        f32x2 off = {0.f, 0.f}; if (half) off = tot8[(tq - 1) * 64 + cp];
        f32x2 aJ = {0.f, 0.f};
#pragma unroll
        for (int M = 0; M < 3; ++M) if (M < J) aJ += tj[M];
        const f32x2 PA = exp2v(aJ), L15 = tj[J == 0 ? 0 : J == 1 ? 1 : J == 2 ? 2 : 3];
        f32x2 cI[5];
#pragma unroll
        for (int I = 1; I <= 4; ++I) { f32x2 sx = {0.f, 0.f};
#pragma unroll
            for (int M = 1; M < 4; ++M) if (M > J && M < I) sx += tj[M];
            cI[I] = exp2v(sx); }
        const int khJ = J == 0 ? H1_KH0 : J == 1 ? H1_KH1 : J == 2 ? H1_KH2 : H1_KH3;
#pragma unroll
        for (int i = 0; i < 8; ++i) {
            const int t = 8 * tq + i; const int lo = t * HRS + cp * 4;
            const f32x2 q = bf2v(in.q[i]), k = bf2v(in.k[i]), Li = L[i] + off;
            const f32x2 ep = exp2v(Li), nl = -Li, en = exp2v((f32x2){fminf(nl.x, 80.f), fminf(nl.y, 80.f)}), rem = exp2v(L15 - Li);
            const f32x2 qh = q * ep, kr = k * rem;
            *(LAS unsigned*)(lds + H1_QH + lo) = v2bf(qh);
            *(unsigned*)(a.Qt + gbase + (size_t)t * D + 2 * cp) = v2bf(qh * PA);
            *(LAS unsigned*)(lds + khJ + lo) = v2bf(k * en);
#pragma unroll
            for (int I = 1; I <= 4; ++I) if (I > J) { constexpr int offs[5] = {H1_KH0, H1_KH1, H1_KH2, H1_KH3, H1_KT}; *(LAS unsigned*)(lds + offs[I] + lo) = v2bf(kr * cI[I]); }
        }
        if (J == 0 && half == 0) *(f32x2*)(a.Dg + (size_t)unit * 128 + 2 * cp) = exp2v((tj[0] + tj[1]) + (tj[2] + tj[3]));
        __syncthreads();
        if (unit + G < NUNIT) h1_load(in, a, unit + G, tid);
        for (int blk = wid; blk < 10; blk += 8) {
            const int I = blk < 1 ? 0 : blk < 3 ? 1 : blk < 6 ? 2 : 3, Jb = blk - (I * (I + 1)) / 2;
            const int khI = I == 0 ? H1_KH0 : I == 1 ? H1_KH1 : I == 2 ? H1_KH2 : H1_KH3;
            f32x4 acc = {0.f, 0.f, 0.f, 0.f};
#pragma unroll
            for (int ks = 0; ks < 4; ++ks) acc = MFMA16(row_frag16(lds + khI, HRS, 16 * Jb, 32 * ks, lane), row_frag16(lds + H1_QH, HRS, 16 * I, 32 * ks, lane), acc);
            const int tl = 16 * I + (lane & 15), s0 = 16 * Jb + 4 * (lane >> 4);
#pragma unroll
            for (int r = 0; r < 4; ++r) if (s0 + r > tl) acc[r] = 0.f;
            *(LAS u32x2*)(lds + H1_AS + tl * ARS + s0 * 2) = pack4(acc);
        }
        __syncthreads();
        {
            bf16x8 vtr[2];
#pragma unroll
            for (int ks = 0; ks < 2; ++ks) vtr[ks] = tr_frag16(lds + H1_VS, HRS, 32 * ks, 16 * wid, lane);
#pragma unroll
            for (int rb = 0; rb < 4; ++rb) { f32x4 acc = {0.f, 0.f, 0.f, 0.f};
#pragma unroll
                for (int ks = 0; ks < 2; ++ks) if (!(ks == 1 && rb < 2)) acc = MFMA16(vtr[ks], row_frag16(lds + H1_AS, ARS, 16 * rb, 32 * ks, lane), acc);
                *(u32x2*)(a.OI + gbase + (size_t)(16 * rb + (lane & 15)) * D + 16 * wid + 4 * (lane >> 4)) = pack4(acc); }
#pragma unroll
            for (int cb = 0; cb < 8; ++cb) { f32x4 acc = {0.f, 0.f, 0.f, 0.f};
#pragma unroll
                for (int ks = 0; ks < 2; ++ks) acc = MFMA16(tr_frag16(lds + H1_KT, HRS, 32 * ks, 16 * cb, lane), vtr[ks], acc);
                *(u32x2*)(a.UT + ((size_t)unit * 128 + 16 * wid + (lane & 15)) * 128 + 16 * cb + 4 * (lane >> 4)) = pack4(acc); }
        }
        __syncthreads();
    }
}
__device__ __forceinline__ void h2_phase(const HgArgs& a, int vcu, int G) {
    for (int item = vcu * 512 + opaque_tid(); item < BATCH * HG_H * 2048; item += G * 512) {
        const int bh = item >> 11, vec = item & 2047, ch0 = (vec & 15) * 8;
        f32x4 s0 = {0.f, 0.f, 0.f, 0.f}, s1 = {0.f, 0.f, 0.f, 0.f};
#pragma unroll 1
        for (int c0 = 0; c0 < 32; c0 += 8) {
            u32x4 uu[8]; f32x4 d0[8], d1[8];
#pragma unroll
            for (int k = 0; k < 8; ++k) { const size_t u = (size_t)bh * 32 + c0 + k; uu[k] = *(const u32x4*)(a.UT + u * 16384 + vec * 8); d0[k] = *(const f32x4*)(a.Dg + u * 128 + ch0); d1[k] = *(const f32x4*)(a.Dg + u * 128 + ch0 + 4); }
#pragma unroll
            for (int k = 0; k < 8; ++k) { const size_t u = (size_t)bh * 32 + c0 + k;
                *(u32x4*)(a.Sst + u * 16384 + vec * 8) = pg8::pack8(s0, s1);
                u32x2 lo2, hi2; lo2.x = uu[k].x; lo2.y = uu[k].y; hi2.x = uu[k].z; hi2.y = uu[k].w;
                s0 = d0[k] * s0 + bf4(lo2); s1 = d1[k] * s1 + bf4(hi2); }
        }
    }
}
__device__ __forceinline__ void h3_phase(const HgArgs& a, int vcu, int G) {
    const int tid = opaque_tid(), lane = tid & 63, wid = __builtin_amdgcn_readfirstlane(tid >> 6);
    for (int pair = vcu; pair < NUNIT / 2; pair += G) {
        const int unit = pair * 2 + (wid >> 2), rb = wid & 3;
        const int bh = unit >> 5, c = unit & 31, b = bh >> 4, h = bh & 15;
        const size_t ro = ((size_t)b * SEQ + c * 64 + 16 * rb + (lane & 15)) * D + h * 128;
        bf16x8 qf[4];
#pragma unroll
        for (int ks = 0; ks < 4; ++ks) qf[ks] = *(const bf16x8*)(a.Qt + ro + 32 * ks + 8 * (lane >> 4));
        f32x4 o[8]; float ss = 0.f;
#pragma unroll
        for (int cb = 0; cb < 8; ++cb) { f32x4 acc = {0.f, 0.f, 0.f, 0.f};
            const bf16_t* sp = a.Sst + ((size_t)unit * 128 + 16 * cb + (lane & 15)) * 128 + 8 * (lane >> 4);
#pragma unroll
            for (int ks = 0; ks < 4; ++ks) acc = MFMA16(*(const bf16x8*)(sp + 32 * ks), qf[ks], acc);
            const uint2 oi = *(const uint2*)(a.OI + ro + 16 * cb + 4 * (lane >> 4));
            acc[0] += bf2f((bf16_t)(oi.x & 0xffff)); acc[1] += bf2f((bf16_t)(oi.x >> 16)); acc[2] += bf2f((bf16_t)(oi.y & 0xffff)); acc[3] += bf2f((bf16_t)(oi.y >> 16));
            o[cb] = acc; ss += (acc[0] * acc[0] + acc[1] * acc[1]) + (acc[2] * acc[2] + acc[3] * acc[3]); }
        ss += __shfl_xor(ss, 16); ss += __shfl_xor(ss, 32);
        const float r = 1.0f / sqrtf(ss * (1.f / 128.f) + RMS_EPS);
#pragma unroll
        for (int cb = 0; cb < 8; ++cb) { const int vc = 16 * cb + 4 * (lane >> 4); const float4 g = *(const float4*)(a.ng + h * 128 + vc); const uint2 gt = *(const uint2*)(a.Gt + ro + vc);
            f32x4 v; v[0] = o[cb][0] * r * g.x * bf2f((bf16_t)(gt.x & 0xffff)); v[1] = o[cb][1] * r * g.y * bf2f((bf16_t)(gt.x >> 16)); v[2] = o[cb][2] * r * g.z * bf2f((bf16_t)(gt.y & 0xffff)); v[3] = o[cb][3] * r * g.w * bf2f((bf16_t)(gt.y >> 16));
            *(u32x2*)(a.Og + ro + vc) = pack4(v); }
    }
}

#define XB_TMO      128
#define XB_XCNT(j)  (256  + 64 * (j))
#define XB_XSUB(j)  (1280 + 64 * (j))
#define XB_XGEN(j)  (2304 + 64 * (j))
#define XB_TOP      3328
#define XB_TOPGEN   3392
#define XCD_BAR_WORDS 3456
#define XB_SPIN_CAP (1u << 18)
__device__ __forceinline__ unsigned xb_ld(unsigned* p)              { return __hip_atomic_load(p, __ATOMIC_RELAXED, __HIP_MEMORY_SCOPE_AGENT); }
__device__ __forceinline__ unsigned xb_add(unsigned* p, unsigned v) { return __hip_atomic_fetch_add(p, v, __ATOMIC_RELAXED, __HIP_MEMORY_SCOPE_AGENT); }
__device__ __forceinline__ unsigned xb_xcc_id() { return (unsigned)__builtin_amdgcn_s_getreg((3 << 11) | 20) & 0xFu; }
#define XB_SPIN(cond, bar) do { unsigned _sp = 0; while (cond) { __builtin_amdgcn_s_sleep(1); \
    if ((++_sp & 255u) == 0u) { if (xb_ld(&(bar)[XB_TMO])) break; if (_sp > XB_SPIN_CAP) { atomicAdd(&(bar)[XB_TMO], 1u); break; } } } } while (0)
struct XcdBarrier { unsigned* bar; unsigned x; volatile LAS unsigned* st; };
__device__ __forceinline__ XcdBarrier xcd_barrier_post(unsigned* bar, volatile LAS unsigned* st) {
    XcdBarrier b; b.bar = bar; b.x = xb_xcc_id(); b.st = st;
    if (threadIdx.x == 0) (void)xb_add(&bar[XB_XCNT(b.x)], 1u);
    return b;
}
__device__ __forceinline__ void xcd_barrier_complete(unsigned* bar, unsigned x, unsigned& nloc, unsigned& nx) {
    const unsigned G = gridDim.x * gridDim.y * gridDim.z;
    unsigned sum, cnt, mine, sp = 0u;
    for (;;) {
        sum = 0u; cnt = 0u; mine = 0u;
#pragma unroll
        for (unsigned j = 0; j < 16; ++j) { const unsigned c = xb_ld(&bar[XB_XCNT(j)]); sum += c; cnt += (c > 0u) ? 1u : 0u; mine = (j == x) ? c : mine; }
        if (sum == G) break;
        __builtin_amdgcn_s_sleep(1);
        if ((++sp & 255u) == 0u) { if (xb_ld(&bar[XB_TMO])) break; if (sp > XB_SPIN_CAP) { atomicAdd(&bar[XB_TMO], 1u); break; } }
    }
    nloc = mine > 0u ? mine : 1u; nx = cnt > 0u ? cnt : 1u;
}
__device__ __forceinline__ void xcd_barrier(const XcdBarrier& b) {
    asm volatile("s_waitcnt vmcnt(0)" ::: "memory");
    __syncthreads();
    if (threadIdx.x == 0) {
        unsigned* bar = b.bar;
        __builtin_amdgcn_s_waitcnt(0);
        unsigned nloc = b.st[0], nx = b.st[1];
        if (nloc == 0u) { xcd_barrier_complete(bar, b.x, nloc, nx); b.st[0] = nloc; b.st[1] = nx; }
        const unsigned old = xb_add(&bar[XB_XSUB(b.x)], 1u);
        const unsigned gen = old / nloc;
        if (old + 1u == (gen + 1u) * nloc) {
            __builtin_amdgcn_fence(__ATOMIC_RELEASE, "agent");
            asm volatile("s_waitcnt vmcnt(0)" ::: "memory");
            const unsigned og = xb_add(&bar[XB_TOP], 1u);
            const unsigned tg = og / nx;
            if (og + 1u == (tg + 1u) * nx) xb_add(&bar[XB_TOPGEN], 1u);
            else XB_SPIN(xb_ld(&bar[XB_TOPGEN]) == tg, bar);
            __builtin_amdgcn_fence(__ATOMIC_ACQUIRE, "agent");
            xb_add(&bar[XB_XGEN(b.x)], 1u);
            asm volatile("s_waitcnt vmcnt(0)" ::: "memory");
        } else {
            XB_SPIN(xb_ld(&bar[XB_XGEN(b.x)]) == gen, bar);
            __builtin_amdgcn_fence(__ATOMIC_ACQUIRE, "agent");
            asm volatile("s_waitcnt vmcnt(0)" ::: "memory");
        }
    }
    __syncthreads();
}

struct Ptrs {
    const float *x, *a_w_in, *a_lb, *a_ng, *a_w_out, *b_w_kv, *b_w_q, *b_sinks, *b_w_out, *rel_bias, *w_rg, *b_rg, *w_re, *b_re, *w_gate, *w_up, *w_down, *ln_g, *ln_b;
    float* out; unsigned char* ws;
};
__device__ __forceinline__ void prologue_phase(LAS unsigned char* lds, const Ptrs& p, int vcu, int G) {
    const int tid = opaque_tid(), lane = tid & 63, wave = __builtin_amdgcn_readfirstlane(tid >> 6);
    LAS float* scr = (LAS float*)(lds + wave * 8448);
    const int gw = vcu * 8 + wave, NGW = G * 8;
    bf16_t* Win_t = (bf16_t*)(p.ws + WS_WIN); bf16_t* Wout_t = (bf16_t*)(p.ws + WS_WOUT); bf16_t* Wkv_t = (bf16_t*)(p.ws + WS_WKV); bf16_t* Wq_t = (bf16_t*)(p.ws + WS_WQ); bf16_t* Wo_t = (bf16_t*)(p.ws + WS_WO);
    bf16_t* Wgu_t = (bf16_t*)(p.ws + WS_WGU); bf16_t* Wd_t = (bf16_t*)(p.ws + WS_WD);
    constexpr int I_IN = 2 * 32 * 256, I_AO = 2 * 32 * 64, I_KV = 32 * 16, I_Q = 2 * 32 * 64, I_O = 2 * 32 * 64, I_G = 128 * 32 * 16, I_U = I_G, I_D = 128 * 8 * 64;
    constexpr int NITEMS = I_IN + I_AO + I_KV + I_Q + I_O + I_G + I_U + I_D;
    for (int it = gw; it < NITEMS; it += NGW) {
        int r = it;
        if (r < I_IN) { const int mat = r / (32 * 256), q = r % (32 * 256), kb = q / 256, nb = q % 256; pg8::transpose_item(p.a_w_in + (size_t)mat * D * 4 * D, D, 4 * D, Win_t + (size_t)mat * 4 * D * D, 32 * nb, scr, kb, nb, lane); continue; } r -= I_IN;
        if (r < I_AO) { const int mat = r / (32 * 64), q = r % (32 * 64), kb = q / 64, nb = q % 64; pg8::transpose_item(p.a_w_out + (size_t)mat * D * D, D, D, Wout_t + (size_t)mat * D * D, 32 * nb, scr, kb, nb, lane); continue; } r -= I_AO;
        if (r < I_KV) { const int kb = r / 16, nb = r % 16; pg8::transpose_item(p.b_w_kv, D, 2 * KVW, Wkv_t, 32 * nb, scr, kb, nb, lane); continue; } r -= I_KV;
        if (r < I_Q) { const int mat = r / (32 * 64), q = r % (32 * 64), kb = q / 64, nb = q % 64; pg8::transpose_item(p.b_w_q + (size_t)mat * D * D, D, D, Wq_t + (size_t)mat * D * D, 32 * nb, scr, kb, nb, lane); continue; } r -= I_Q;
        if (r < I_O) { const int mat = r / (32 * 64), q = r % (32 * 64), kb = q / 64, nb = q % 64; pg8::transpose_item(p.b_w_out + (size_t)mat * D * D, D, D, Wo_t + (size_t)mat * D * D, 32 * nb, scr, kb, nb, lane); continue; } r -= I_O;
        if (r < I_G + I_U) { const int up = r >= I_G; if (up) r -= I_G; const int mat = r / (32 * 16), q = r % (32 * 16), kb = q / 16, nb = q % 16;
            const int n0 = 32 * nb, drow = (n0 >> 7) * 256 + (n0 & 127) + (up ? 128 : 0);
            pg8::transpose_item((up ? p.w_up : p.w_gate) + (size_t)mat * D * DEXP, D, DEXP, Wgu_t + (size_t)mat * 2 * DEXP * D, drow, scr, kb, nb, lane); continue; } r -= I_G + I_U;
        { const int mat = r / (8 * 64), q = r % (8 * 64), kb = q / 64, nb = q % 64; pg8::transpose_item(p.w_down + (size_t)mat * DEXP * D, DEXP, D, Wd_t + (size_t)mat * D * DEXP, 32 * nb, scr, kb, nb, lane); }
    }
    { bf16_t* WRhi = (bf16_t*)(p.ws + WS_WR); bf16_t* WRlo = WRhi + (size_t)DEPTH * 64 * D;
      for (int i = vcu * 512 + tid; i < DEPTH * 64 * D; i += G * 512) { const int L = i / (64 * D), o = (i / D) % 64, d = i % D;
          const float w = o < 4 ? p.w_rg[((size_t)L * D + d) * NGRP + o] : o < 36 ? p.w_re[((size_t)L * D + d) * NEXP + (o - 4)] : 0.f;
          const unsigned hb = f2bf(w); WRhi[i] = (bf16_t)hb; WRlo[i] = (bf16_t)f2bf(w - bf2f((bf16_t)hb)); } }
    bf16_t* xb = (bf16_t*)(p.ws + WS_XB2);
    for (size_t i = (size_t)vcu * 512 + tid; i < (size_t)T * D / 4; i += (size_t)G * 512) { const float4 v = ((const float4*)p.x)[i];
        u32x2 o; o.x = pg8::cvt_pk_bf16(v.x, v.y); o.y = pg8::cvt_pk_bf16(v.z, v.w); ((u32x2*)xb)[i] = o; }
}

__device__ __forceinline__ void ln2_phase(const bf16_t* x, const bf16_t* Y, const float* lng, const float* lnb, bf16_t* xb, float* out, int vcu, int G) {
    const int tid = opaque_tid();
    for (int row = vcu * 8 + (tid >> 6); row < T; row += G * 8) {
        const int lane = opaque_tid() & 63;
        f32x4 v[8]; float s = 0.f;
#pragma unroll
        for (int j = 0; j < 8; ++j) { const int c = 4 * lane + 256 * j;
            v[j] = bf4(*(const u32x2*)(x + (size_t)row * D + c)) * ALPHA + (bf4(*(const u32x2*)(Y + (size_t)(row * 2) * D + c)) + bf4(*(const u32x2*)(Y + (size_t)(row * 2 + 1) * D + c)));
            s += (v[j][0] + v[j][1]) + (v[j][2] + v[j][3]); }
        const float mean = wave_sum(s) * (1.f / D);
        float q = 0.f;
#pragma unroll
        for (int j = 0; j < 8; ++j) { v[j] = v[j] - mean; q += (v[j][0] * v[j][0] + v[j][1] * v[j][1]) + (v[j][2] * v[j][2] + v[j][3] * v[j][3]); }
        const float rstd = 1.0f / sqrtf(wave_sum(q) * (1.f / D) + LN_EPS);
#pragma unroll
        for (int j = 0; j < 8; ++j) { const int c = 4 * lane + 256 * j; const f32x4 g = *(const f32x4*)(lng + c), bb = *(const f32x4*)(lnb + c);
            v[j] = v[j] * rstd * g + bb;
            if (out) *(f32x4*)(out + (size_t)row * D + c) = v[j];
            else { u32x2 o; o.x = pg8::cvt_pk_bf16(v[j][0], v[j][1]); o.y = pg8::cvt_pk_bf16(v[j][2], v[j][3]); *(u32x2*)(xb + (size_t)row * D + c) = o; } }
    }
}

typedef float f32x16 __attribute__((ext_vector_type(16)));
#define MFMA32(a, b, c) __builtin_amdgcn_mfma_f32_32x32x16_bf16((a), (b), (c), 0, 0, 0)
constexpr int RT_RED = 0, RT_LOG = 8 * 64 * 32 * 4, RT_HIST = RT_LOG + 32 * 64 * 4, RT_BYTES = RT_HIST + 128;
__device__ __forceinline__ void ln_router_phase(LAS unsigned char* lds, const float* xin32, const bf16_t* xin16, const bf16_t* hm, const float* lng, const float* lnb, bf16_t* xlo, bf16_t* xb,
                                                const bf16_t* WRhi, const bf16_t* WRlo, const float* brg, const float* bre, int* hist, int* inv, float* tg, int vcu, int G) {
    const int tid = opaque_tid(), lane = tid & 63, wid = __builtin_amdgcn_readfirstlane(tid >> 6);
    LAS int* lhist = (LAS int*)(lds + RT_HIST);
    if (tid < 32) lhist[tid] = 0;
    {
        const int row0 = 32 * vcu + 4 * wid;
#pragma unroll 1
        for (int r = 0; r < 4; ++r) {
            f32x4 v[8]; float s = 0.f;
#pragma unroll
            for (int j = 0; j < 8; ++j) { const int c = 4 * lane + 256 * j; const size_t go = (size_t)(row0 + r) * D + c;
                const f32x4 a = xin32 ? *(const f32x4*)(xin32 + go) : bf4(*(const u32x2*)(xin16 + go)); const f32x4 hh = bf4(*(const u32x2*)(hm + go));
                v[j] = a * ALPHA + hh; s += (v[j][0] + v[j][1]) + (v[j][2] + v[j][3]); }
            const float mean = wave_sum(s) * (1.f / D);
            float q = 0.f;
#pragma unroll
            for (int j = 0; j < 8; ++j) { v[j] = v[j] - mean; q += (v[j][0] * v[j][0] + v[j][1] * v[j][1]) + (v[j][2] * v[j][2] + v[j][3] * v[j][3]); }
            const float rstd = 1.0f / sqrtf(wave_sum(q) * (1.f / D) + LN_EPS);
#pragma unroll
            for (int j = 0; j < 8; ++j) { const int c = 4 * lane + 256 * j; const f32x4 g = *(const f32x4*)(lng + c), bb = *(const f32x4*)(lnb + c);
                v[j] = v[j] * rstd * g + bb;
                u32x2 o; o.x = pg8::cvt_pk_bf16(v[j][0], v[j][1]); o.y = pg8::cvt_pk_bf16(v[j][2], v[j][3]); *(u32x2*)(xb + (size_t)(row0 + r) * D + c) = o;
                const f32x4 lo = v[j] - bf4(o); u32x2 ol; ol.x = pg8::cvt_pk_bf16(lo[0], lo[1]); ol.y = pg8::cvt_pk_bf16(lo[2], lo[3]); *(u32x2*)(xlo + (size_t)(row0 + r) * D + c) = ol; }
        }
    }
    asm volatile("s_waitcnt vmcnt(0)" ::: "memory");
    __syncthreads();
    {
        const int r = lane & 31, h = lane >> 5;
        f32x16 acc0, acc1;
#pragma unroll
        for (int e = 0; e < 16; ++e) { acc0[e] = 0.f; acc1[e] = 0.f; }
        const size_t xo = (size_t)(32 * vcu + r) * D + 256 * wid + 8 * h;
        const size_t wo = (size_t)r * D + 256 * wid + 8 * h;
#pragma unroll 4
        for (int sx = 0; sx < 16; ++sx) {
            const bf16x8 xh = *(const bf16x8*)(xb + xo + 16 * sx), xl = *(const bf16x8*)(xlo + xo + 16 * sx);
            const bf16x8 w0h = *(const bf16x8*)(WRhi + wo + 16 * sx), w0l = *(const bf16x8*)(WRlo + wo + 16 * sx), w1h = *(const bf16x8*)(WRhi + wo + (size_t)32 * D + 16 * sx), w1l = *(const bf16x8*)(WRlo + wo + (size_t)32 * D + 16 * sx);
            acc0 = MFMA32(xh, w0h, acc0); acc0 = MFMA32(xh, w0l, acc0); acc0 = MFMA32(xl, w0h, acc0);
            acc1 = MFMA32(xh, w1h, acc1); acc1 = MFMA32(xh, w1l, acc1); acc1 = MFMA32(xl, w1h, acc1);
        }
        LAS float* red = (LAS float*)(lds + RT_RED);
#pragma unroll
        for (int g4 = 0; g4 < 4; ++g4) {
            *(LAS f32x4*)(red + ((wid * 64 + r) * 32 + 8 * g4 + 4 * h)) = (f32x4){acc0[4 * g4], acc0[4 * g4 + 1], acc0[4 * g4 + 2], acc0[4 * g4 + 3]};
            *(LAS f32x4*)(red + ((wid * 64 + 32 + r) * 32 + 8 * g4 + 4 * h)) = (f32x4){acc1[4 * g4], acc1[4 * g4 + 1], acc1[4 * g4 + 2], acc1[4 * g4 + 3]}; }
    }
    __syncthreads();
    {
        const LAS float* red = (const LAS float*)(lds + RT_RED); LAS float* lg = (LAS float*)(lds + RT_LOG);
#pragma unroll
        for (int i = 0; i < 4; ++i) { const int idx = tid + 512 * i, o = idx >> 5, row = idx & 31; float sum = 0.f;
#pragma unroll
            for (int w2 = 0; w2 < 8; ++w2) sum += red[(w2 * 64 + o) * 32 + row];
            lg[row * 64 + o] = sum; }
    }
    __syncthreads();
    if (tid < 32) {
        const LAS float* lg = (const LAS float*)(lds + RT_LOG) + tid * 64;
        int grp = 0; float gmax = lg[0] + brg[0]; float glv[4]; glv[0] = gmax;
#pragma unroll
        for (int g = 1; g < 4; ++g) { glv[g] = lg[g] + brg[g]; if (glv[g] > gmax) { gmax = glv[g]; grp = g; } }
        float gden = 0.f;
#pragma unroll
        for (int g = 0; g < 4; ++g) gden += __expf(glv[g] - gmax);
        float v0 = -3.0e38f, v1 = -3.0e38f; int i0 = 0, i1 = 0;
#pragma unroll
        for (int e = 0; e < 8; ++e) { const float val = lg[4 + grp * 8 + e] + bre[grp * 8 + e];
            if (val > v0) { v1 = v0; i1 = i0; v0 = val; i0 = e; } else if (val > v1) { v1 = val; i1 = e; } }
        const float e1 = __expf(v1 - v0), den = 1.f + e1, pg = 1.0f / gden;
        const int row = 32 * vcu + tid, ea = grp * 8 + i0, eb = grp * 8 + i1;
        const int pa = __hip_atomic_fetch_add(lhist + ea, 1, __ATOMIC_RELAXED, __HIP_MEMORY_SCOPE_WORKGROUP); inv[(vcu * 32 + ea) * 32 + pa] = row * 2; tg[row * 2] = pg / den;
        const int pb = __hip_atomic_fetch_add(lhist + eb, 1, __ATOMIC_RELAXED, __HIP_MEMORY_SCOPE_WORKGROUP); inv[(vcu * 32 + eb) * 32 + pb] = row * 2 + 1; tg[row * 2 + 1] = pg * e1 / den;
    }
    __syncthreads();
    if (tid < 32) hist[vcu * 32 + tid] = lhist[tid];
}

constexpr int KRS = 144, AT_K = 0, AT_V = 256 * KRS, AT_BIAS = 2 * 256 * KRS, AT_BYTES = AT_BIAS + 8 * 128 * 4;
__device__ __forceinline__ int t5_bucket(int n) { if (n < 16) return n; int l = 16 + (int)(__logf((float)n * (1.f / 16.f)) / 2.0794415416798357f * 16.f); return l < 31 ? l : 31; }
__device__ __forceinline__ void attn_phase(LAS unsigned char* lds, const bf16_t* Qb, const bf16_t* Kc, const bf16_t* Vc, const float* sinks, const float* relb, bf16_t* Og, int vcu, int G) {
    const int tid = opaque_tid(), lane = tid & 63, wid = __builtin_amdgcn_readfirstlane(tid >> 6), r = lane & 31, h = lane >> 5;
    LAS float* biasT = (LAS float*)(lds + AT_BIAS);
    for (int unit = vcu; unit < BATCH * AT_HKV * (SEQ / 128); unit += G) {
        const int b = unit >> 6, kvh = (unit >> 4) & 3, qblk = unit & 15, hq = kvh * 8 + wid;
        const int row0 = b * SEQ + qblk * 128;
#pragma unroll
        for (int it = 0; it < 4; ++it) { const int id = tid + 512 * it, i = id >> 3, ck = id & 7;
            u32x4 kv = {0u, 0u, 0u, 0u}, vv = {0u, 0u, 0u, 0u};
            if (qblk > 0 || i >= 128) { const size_t go = (size_t)(row0 - 128 + i) * KVW + kvh * 64 + ck * 8; kv = *(const u32x4*)(Kc + go); vv = *(const u32x4*)(Vc + go); }
            *(LAS u32x4*)(lds + AT_K + i * KRS + ck * 16) = kv; *(LAS u32x4*)(lds + AT_V + i * KRS + ck * 16) = vv; }
        for (int id = tid; id < 1024; id += 512) biasT[id] = relb[t5_bucket(id & 127) * AT_HQ + kvh * 8 + (id >> 7)];
        __syncthreads();
        const float sink = sinks[hq];
        for (int qs = 0; qs < 4; ++qs) {
            bf16x8 qf[4]; { const bf16_t* qp = Qb + (size_t)(row0 + 32 * qs + r) * D + hq * 64 + 8 * h;
#pragma unroll
                for (int ks = 0; ks < 4; ++ks) qf[ks] = *(const bf16x8*)(qp + 16 * ks); }
            f32x16 S[5];
#pragma unroll
            for (int kbi = 0; kbi < 5; ++kbi) {
#pragma unroll
                for (int e = 0; e < 16; ++e) S[kbi][e] = 0.f;
#pragma unroll
                for (int ks = 0; ks < 4; ++ks) S[kbi] = MFMA32(*(const LAS bf16x8*)(lds + AT_K + (32 * (qs + kbi) + r) * KRS + (16 * ks + 8 * h) * 2), qf[ks], S[kbi]); }
            float m = -1e30f;
#pragma unroll
            for (int kbi = 0; kbi < 5; ++kbi)
#pragma unroll
                for (int e = 0; e < 16; ++e) { const int keyb = 32 * (qs + kbi) + (e & 3) + 8 * (e >> 2) + 4 * h, dist = 128 + 32 * qs + r - keyb;
                    const bool valid = dist >= 0 && dist < 128 && (qblk > 0 || keyb >= 128);
                    const float sv = valid ? S[kbi][e] * 0.125f + biasT[wid * 128 + (dist & 127)] : -1e30f;
                    S[kbi][e] = sv; m = fmaxf(m, sv); }
            m = fmaxf(m, __shfl_xor(m, 32)); m = fmaxf(m, sink);
            float l = 0.f;
#pragma unroll
            for (int kbi = 0; kbi < 5; ++kbi)
#pragma unroll
                for (int e = 0; e < 16; ++e) { const float pv = __expf(S[kbi][e] - m); S[kbi][e] = pv; l += pv; }
            l += __shfl_xor(l, 32); l += __expf(sink - m);
            f32x16 O[2];
#pragma unroll
            for (int e = 0; e < 16; ++e) { O[0][e] = 0.f; O[1][e] = 0.f; }
            const int i16 = lane & 15, qq = i16 >> 2, pp = i16 & 3, gg = (lane >> 4) & 1;
#pragma unroll
            for (int kbi = 0; kbi < 5; ++kbi)
#pragma unroll
                for (int s2 = 0; s2 < 2; ++s2) {
                    u32x4 pk; pk.x = pg8::cvt_pk_bf16(S[kbi][8 * s2 + 0], S[kbi][8 * s2 + 1]); pk.y = pg8::cvt_pk_bf16(S[kbi][8 * s2 + 2], S[kbi][8 * s2 + 3]);
                    pk.z = pg8::cvt_pk_bf16(S[kbi][8 * s2 + 4], S[kbi][8 * s2 + 5]); pk.w = pg8::cvt_pk_bf16(S[kbi][8 * s2 + 6], S[kbi][8 * s2 + 7]);
                    const bf16x8 pf = __builtin_bit_cast(bf16x8, pk);
#pragma unroll
                    for (int db = 0; db < 2; ++db) { const LAS unsigned char* va = lds + AT_V + (32 * (qs + kbi) + 16 * s2 + 4 * h + qq) * KRS + (32 * db + 16 * gg + 4 * pp) * 2;
                        const s16x4 lo = __builtin_amdgcn_ds_read_tr16_b64_v4i16((lds_s16x4*)va), hi = __builtin_amdgcn_ds_read_tr16_b64_v4i16((lds_s16x4*)(va + 8 * KRS));
                        const bf16x8 vf = {lo[0], lo[1], lo[2], lo[3], hi[0], hi[1], hi[2], hi[3]};
                        O[db] = MFMA32(vf, pf, O[db]); } }
            const float inv = 1.0f / l;
            bf16_t* op = Og + (size_t)(row0 + 32 * qs + r) * D + hq * 64 + 4 * h;
#pragma unroll
            for (int db = 0; db < 2; ++db)
#pragma unroll
                for (int g4 = 0; g4 < 4; ++g4) { f32x4 v; v[0] = O[db][4 * g4] * inv; v[1] = O[db][4 * g4 + 1] * inv; v[2] = O[db][4 * g4 + 2] * inv; v[3] = O[db][4 * g4 + 3] * inv;
                    *(u32x2*)(op + 32 * db + 8 * g4) = pack4(v); }
        }
        __syncthreads();
    }
}

constexpr int LDS_STAGE = 0;
constexpr int LDS_MOETAB = pg8::STAGE_BYTES;
constexpr int LDS_MISC = LDS_MOETAB + pg8::MOE_TAB_INTS * 4;
constexpr int LDS_BYTES = 147456;
static_assert(RT_BYTES <= pg8::STAGE_BYTES && LDS_MISC + 256 <= LDS_BYTES && H1_BYTES <= pg8::STAGE_BYTES && 8 * 8448 <= pg8::STAGE_BYTES && AT_BYTES <= pg8::STAGE_BYTES, "LDS map");
constexpr int CW_BAR = 4096;
constexpr int N_PHASES = 1 + NA * 9 + (DEPTH - NA) * 7;

struct MegaArgs { const float* in[19]; float* out; unsigned char* ws; int ph_lo, ph_hi; };

__global__ void __launch_bounds__(512, 2) mega_fwd(MegaArgs args) {
    extern __shared__ __attribute__((aligned(16))) unsigned char lds_raw[];
    LAS unsigned char* lds = (LAS unsigned char*)lds_raw;
    volatile LAS unsigned* MISC = (volatile LAS unsigned*)(lds + LDS_MISC);
    const int tid = threadIdx.x, G = gridDim.x, bx = blockIdx.x, vcu = (G % 8 == 0) ? (bx % 8) * (G / 8) + bx / 8 : bx;
    unsigned char* const ws = args.ws;
    if (tid < 64) MISC[tid] = 0u;
    __syncthreads();
    const int lo = args.ph_lo, hi = args.ph_hi;
    XcdBarrier bar; bar.bar = (unsigned*)(ws + WS_CTL) + CW_BAR; bar.x = 0; bar.st = nullptr;
    if (hi - lo > 1) bar = xcd_barrier_post((unsigned*)(ws + WS_CTL) + CW_BAR, MISC + 8);
#define WSP(type, off) ((type*)(args.ws + (off)))
    int ph = 0;
#ifndef PROBE_DUP
#define PROBE_DUP 0
#endif
#define PHASE_T(dupbit, trash_body, ...) if (lo <= ph && ph < hi) { if ((PROBE_DUP >> (dupbit)) & 1) { trash_body; xcd_barrier(bar); } __VA_ARGS__; if (ph + 1 < hi) xcd_barrier(bar); } ++ph;
#define PHASE(dupbit, ...) if (lo <= ph && ph < hi) { __VA_ARGS__; if ((PROBE_DUP >> (dupbit)) & 1) { xcd_barrier(bar); __VA_ARGS__; } if (ph + 1 < hi) xcd_barrier(bar); } ++ph;

    PHASE(0, { Ptrs p; p.x = args.in[0]; p.a_w_in = args.in[1]; p.a_w_out = args.in[4]; p.b_w_kv = args.in[5]; p.b_w_q = args.in[6]; p.b_w_out = args.in[8]; p.w_gate = args.in[14]; p.w_up = args.in[15]; p.w_down = args.in[16]; p.w_rg = args.in[10]; p.w_re = args.in[12]; p.ws = args.ws;
               prologue_phase(lds, p, vcu, G); })

    for (int L = 0; L < DEPTH; ++L) {
        if (L < NA) {
            PHASE(1, { pg8::DenseSched S; S.init(T, 4 * D, D, G, bx); pg8::EpiHgrn E{WSP(bf16_t, WS_QB), WSP(bf16_t, WS_KB), WSP(bf16_t, WS_VB), WSP(bf16_t, WS_GT), WSP(float, WS_GL), args.in[2], L, 0};
                       pg8::gemm_phase<pg8::EpiHgrn, pg8::DenseSched>(lds, WSP(bf16_t, WS_XB2), WSP(bf16_t, WS_WIN) + (size_t)L * 4 * D * D, D, 0, S, E); })
#define HGARGS HgArgs{WSP(bf16_t, WS_QB), WSP(bf16_t, WS_KB), WSP(bf16_t, WS_VB), WSP(bf16_t, WS_GT), WSP(bf16_t, WS_OF), WSP(bf16_t, WS_UT), WSP(bf16_t, WS_SST), WSP(bf16_t, WS_OG), WSP(float, WS_GL), WSP(float, WS_DG), args.in[3] + (size_t)L * D, WSP(bf16_t, WS_QB)}
            PHASE_T(6, { HgArgs ha = HGARGS; ha.Qt = WSP(bf16_t, WS_TRASH); ha.OI = WSP(bf16_t, WS_TRASH + 32 * MiB); ha.UT = WSP(bf16_t, WS_TRASH + 64 * MiB); ha.Dg = WSP(float, WS_TRASH + 128 * MiB); h1_phase(lds, ha, vcu, G); },
                    { const HgArgs ha = HGARGS; h1_phase(lds, ha, vcu, G); })
            PHASE(3, { const HgArgs ha = HGARGS; h2_phase(ha, vcu, G); })
            PHASE(3, { const HgArgs ha = HGARGS; h3_phase(ha, vcu, G); })
            PHASE(1, { pg8::DenseSched S; S.init(T, D, D, G, bx); pg8::EpiStore E{WSP(bf16_t, WS_HM), WSP(bf16_t, WS_HM), D, 1 << 30, 1.0f, 0};
                       pg8::gemm_phase<pg8::EpiStore, pg8::DenseSched>(lds, WSP(bf16_t, WS_OG), WSP(bf16_t, WS_WOUT) + (size_t)L * D * D, D, 0, S, E); })
        } else {
            const int j = L - NA;
            PHASE(1, { if (j == 0) { pg8::DenseHalfSched S; S.init(T, 2 * KVW, D, G, vcu); pg8::EpiStore E{WSP(bf16_t, WS_KC), WSP(bf16_t, WS_VC), KVW, 1, 1.0f, 0};
                                     pg8::gemm_phase<pg8::EpiStore, pg8::DenseHalfSched>(lds, WSP(bf16_t, WS_XB2), WSP(bf16_t, WS_WKV), D, 0, S, E); }
                       pg8::DenseSched S; S.init(T, D, D, G, bx); pg8::EpiStore E{WSP(bf16_t, WS_QB), WSP(bf16_t, WS_QB), D, 1 << 30, 1.0f, 0};
                       pg8::gemm_phase<pg8::EpiStore, pg8::DenseSched>(lds, WSP(bf16_t, WS_XB2), WSP(bf16_t, WS_WQ) + (size_t)j * D * D, D, 0, S, E); })
            PHASE(3, attn_phase(lds, WSP(bf16_t, WS_QB), WSP(bf16_t, WS_KC), WSP(bf16_t, WS_VC), args.in[7] + j * AT_HQ, args.in[9], WSP(bf16_t, WS_OG), vcu, G))
            PHASE(1, { pg8::DenseSched S; S.init(T, D, D, G, bx); pg8::EpiStore E{WSP(bf16_t, WS_HM), WSP(bf16_t, WS_HM), D, 1 << 30, 1.0f, 0};
                       pg8::gemm_phase<pg8::EpiStore, pg8::DenseSched>(lds, WSP(bf16_t, WS_OG), WSP(bf16_t, WS_WO) + (size_t)j * D * D, D, 0, S, E); })
        }
#define LN0_ARGS(XLO, XB, HIST, INV, TG) ln_router_phase(lds, L == 0 ? args.in[0] : nullptr, WSP(bf16_t, WS_XB2), WSP(bf16_t, WS_HM), args.in[17] + (size_t)(2 * L) * D, args.in[18] + (size_t)(2 * L) * D, XLO, XB, \
            WSP(bf16_t, WS_WR) + (size_t)L * 64 * D, WSP(bf16_t, WS_WR) + (size_t)(DEPTH + L) * 64 * D, args.in[11] + L * NGRP, args.in[13] + L * NEXP, HIST, INV, TG, vcu, G)
        PHASE_T(4, LN0_ARGS(WSP(bf16_t, WS_TRASH), WSP(bf16_t, WS_TRASH + 64 * MiB), WSP(int, WS_TRASH + 100 * MiB), WSP(int, WS_TRASH + 96 * MiB), WSP(float, WS_TRASH + 98 * MiB)),
                LN0_ARGS(WSP(bf16_t, WS_XF2), WSP(bf16_t, WS_XB), WSP(int, WS_HIST), WSP(int, WS_LIST), WSP(float, WS_TG)))
#undef LN0_ARGS
        PHASE(2, { LAS int* tab = (LAS int*)(lds + LDS_MOETAB); pg8::MoeSched S{tab, 4, G, vcu, D, 1}; S.build_tables(tab, (LAS int*)lds, WSP(int, WS_HIST)); S.build_rows(tab, (LAS int*)lds, WSP(int, WS_HIST), WSP(int, WS_LIST));
                   pg8::gemm_phase<pg8::EpiMoeH, pg8::MoeSched>(lds, WSP(bf16_t, WS_XB), WSP(bf16_t, WS_WGU) + (size_t)L * NEXP * 2 * DEXP * D, D, (size_t)2 * DEXP * D * 2, S, pg8::EpiMoeH{WSP(bf16_t, WS_HS), WSP(int, WS_SLOT), S}); })
        PHASE(2, { LAS int* tab = (LAS int*)(lds + LDS_MOETAB); pg8::MoeSched S{tab, 8, G, vcu, DEXP, 0}; if (ph == lo) S.build_tables(tab, (LAS int*)lds, WSP(int, WS_HIST));
                   pg8::gemm_phase<pg8::EpiMoeY, pg8::MoeSched>(lds, WSP(bf16_t, WS_HS), WSP(bf16_t, WS_WD) + (size_t)L * NEXP * D * DEXP, DEXP, (size_t)D * DEXP * 2, S, pg8::EpiMoeY{WSP(bf16_t, WS_Y), WSP(float, WS_TG), WSP(int, WS_SLOT)}); })
        PHASE_T(5, ln2_phase(WSP(bf16_t, WS_XB), WSP(bf16_t, WS_Y), args.in[17] + (size_t)(2 * L + 1) * D, args.in[18] + (size_t)(2 * L + 1) * D, WSP(bf16_t, WS_TRASH), nullptr, vcu, G),
                ln2_phase(WSP(bf16_t, WS_XB), WSP(bf16_t, WS_Y), args.in[17] + (size_t)(2 * L + 1) * D, args.in[18] + (size_t)(2 * L + 1) * D, WSP(bf16_t, WS_XB2), L == DEPTH - 1 ? args.out : nullptr, vcu, G))
    }
#undef HGARGS
#undef WSP
#undef PHASE
#undef PHASE_T
}

#ifndef MK_PER_PHASE
#define MK_PER_PHASE 0
#endif
extern "C" void kernel_launch(void* const* d_in, const int* in_sizes, int n_in, void* d_out, int out_size, void* d_ws, size_t ws_size, hipStream_t stream) {
    static int grid = 0;
    if (grid == 0) {
        if (n_in != 19 || out_size != T * D || ws_size < WS_END) { fprintf(stderr, "kernel_launch: unexpected arguments (n_in %d, out %d, ws %zu < %zu)\n", n_in, out_size, ws_size, (size_t)WS_END); grid = -1; return; }
        int dev = 0, cus = 0, per_cu = 0;
        if (hipGetDevice(&dev) != hipSuccess || hipDeviceGetAttribute(&cus, hipDeviceAttributeMultiprocessorCount, dev) != hipSuccess) { grid = -1; return; }
        if (hipFuncSetAttribute((const void*)mega_fwd, hipFuncAttributeMaxDynamicSharedMemorySize, LDS_BYTES) != hipSuccess) { fprintf(stderr, "kernel_launch: hipFuncSetAttribute failed\n"); grid = -1; return; }
        if (hipOccupancyMaxActiveBlocksPerMultiprocessor(&per_cu, (const void*)mega_fwd, 512, LDS_BYTES) != hipSuccess || per_cu < 1) { fprintf(stderr, "kernel_launch: occupancy query reports %d\n", per_cu); }
        (void)hipGetLastError();
        grid = cus;
        if (grid != 256) { fprintf(stderr, "kernel_launch: built for 256 CUs (the routing tables assume 256 workgroups of 32 token rows); this device reports %d\n", cus); grid = -1; return; }
    }
    if (grid < 0) return;
    (void)hipMemsetAsync((char*)d_ws + WS_CTL, 0, CTL_BYTES, stream);
    MegaArgs a{};
    for (int i = 0; i < 19; ++i) a.in[i] = (const float*)d_in[i];
    a.out = (float*)d_out; a.ws = (unsigned char*)d_ws;
#if MK_PER_PHASE
    for (int ph = 0; ph < N_PHASES; ++ph) { a.ph_lo = ph; a.ph_hi = ph + 1; hipLaunchKernelGGL(mega_fwd, dim3(grid), dim3(512), LDS_BYTES, stream, a); }
#else
    a.ph_lo = 0; a.ph_hi = N_PHASES;
    hipLaunchKernelGGL(mega_fwd, dim3(grid), dim3(512), LDS_BYTES, stream, a);
#endif
}
```

```cpp
#include <hip/hip_runtime.h>
#include <cstdio>
#include <cstdint>

typedef unsigned short bf16_t;
typedef short bf16x8 __attribute__((ext_vector_type(8)));
typedef float f32x4 __attribute__((ext_vector_type(4)));

constexpr int BATCH = 4, SEQ = 2048, D = 2048, T = BATCH * SEQ, DEPTH = 4, NA = 2;
constexpr int HG_H = 16, HG_DK = 128;
constexpr int AT_HD = 64, AT_HQ = 32, AT_HKV = 4, AT_G = 8, KVW = AT_HKV * AT_HD;
constexpr int NGRP = 4, EPG = 8, NEXP = 32, DEXP = 512;
constexpr float ALPHA = 1.6817928305074290f;
constexpr float LN_EPS = 1e-5f, RMS_EPS = 1e-6f;

constexpr size_t MiB = 1u << 20;
constexpr size_t WS_CTL = 0, CTL_BYTES = 1 * MiB;
constexpr size_t YPLANE = (size_t)8192 * 2048 + 1088;
constexpr size_t PADB = 4352;
constexpr size_t WS_XF = 1 * MiB;
constexpr size_t WS_XB2 = WS_XF;
constexpr size_t WS_XB = WS_XF + 64 * MiB + PADB;
constexpr size_t WS_QB = WS_XB + 32 * MiB + PADB;
constexpr size_t WS_KB = WS_QB + 32 * MiB + PADB;
constexpr size_t WS_VB = WS_KB + 32 * MiB + PADB;
constexpr size_t WS_GT = WS_VB + 32 * MiB + PADB;
constexpr size_t WS_GL = WS_GT + 32 * MiB + PADB;
constexpr size_t WS_OF = WS_GL + 64 * MiB + PADB;
constexpr size_t WS_OG = WS_OF + 64 * MiB + PADB;
constexpr size_t WS_HM = WS_OG + 32 * MiB + PADB;
constexpr size_t WS_KC = WS_HM + 32 * MiB + PADB;
constexpr size_t WS_VC = WS_KC + 4 * MiB + PADB;
constexpr size_t WS_LIST = WS_VC + 4 * MiB + PADB;
constexpr size_t WS_TG = WS_LIST + 1 * MiB + PADB;
constexpr size_t WS_HS = WS_TG + 1 * MiB + PADB;
constexpr size_t WS_Y = WS_HS + 24 * MiB + PADB;
constexpr size_t WS_WIN = WS_Y + 64 * MiB + PADB;
constexpr size_t WS_WOUT = WS_WIN + 64 * MiB + PADB;
constexpr size_t WS_WKV = WS_WOUT + 16 * MiB + PADB;
constexpr size_t WS_WQ = WS_WKV + 2 * MiB + PADB;
constexpr size_t WS_WO = WS_WQ + 16 * MiB + PADB;
constexpr size_t WS_WGU = WS_WO + 16 * MiB + PADB;
constexpr size_t WS_WD = WS_WGU + 512 * MiB + PADB;
constexpr size_t WS_UT = WS_WD + 256 * MiB + PADB;
constexpr size_t WS_SST = WS_UT + 64 * MiB + PADB;
constexpr size_t WS_DG = WS_SST + 64 * MiB + PADB;
constexpr size_t WS_WR = WS_DG + 1 * MiB + PADB;
constexpr size_t WS_XF2 = WS_WR + 2 * MiB + PADB;
constexpr size_t WS_HIST = WS_XF2 + 64 * MiB + PADB;
constexpr size_t WS_SLOT = WS_HIST + 1 * MiB + PADB;
constexpr size_t WS_TRASH = WS_SLOT + 1 * MiB + PADB;
constexpr size_t WS_END = WS_TRASH + 256 * MiB;
constexpr int CW_CNT = 1024;

__device__ __forceinline__ unsigned f2bf(float f) { unsigned u = __builtin_bit_cast(unsigned, f); return (u + 0x7fffu + ((u >> 16) & 1u)) >> 16; }
__device__ __forceinline__ float bf2f(bf16_t b) { return __builtin_bit_cast(float, ((unsigned)b) << 16); }
typedef unsigned u32x2 __attribute__((ext_vector_type(2)));
__device__ __forceinline__ f32x4 bf4(const u32x2 w) { f32x4 r; r[0] = __builtin_bit_cast(float, w.x << 16); r[1] = __builtin_bit_cast(float, w.x & 0xffff0000u); r[2] = __builtin_bit_cast(float, w.y << 16); r[3] = __builtin_bit_cast(float, w.y & 0xffff0000u); return r; }
__device__ __forceinline__ float wave_sum(float v) {
#pragma unroll
    for (int o = 1; o < 64; o <<= 1) v += __shfl_xor(v, o);
    return v;
}
__device__ __forceinline__ float wave_max(float v) {
#pragma unroll
    for (int o = 1; o < 64; o <<= 1) v = fmaxf(v, __shfl_xor(v, o));
    return v;
}
__device__ __forceinline__ float sigmoidf_(float x) { return __builtin_amdgcn_rcpf(1.0f + __expf(-x)); }
__device__ __forceinline__ void lds_barrier() { asm volatile("s_waitcnt lgkmcnt(0)\n\ts_barrier" ::: "memory"); }
__device__ __forceinline__ int opaque_tid() { int t = threadIdx.x; asm volatile("" : "+v"(t)); return t; }

#define LAS __attribute__((address_space(3)))
typedef unsigned u32x4 __attribute__((ext_vector_type(4)));
namespace pg8 {
constexpr int BM = 256, BK = 64, HALF = 128, HTB = HALF * BK * 2, STAGE_BYTES = 8 * HTB;
__host__ __device__ __forceinline__ int lds_byte(int r, int c) { const int st = (r >> 4) * 2 + (c >> 5), rr = r & 15, cc = c & 31, ob = rr * 64 + cc * 2; return st * 1024 + (ob ^ (((ob >> 9) & 1) << 5)); }
__host__ __device__ __forceinline__ void stage_rc(int b, int& R, int& C) { const int st = b / 1024, sb = b % 1024, swz = sb ^ (((sb >> 9) & 1) << 5); R = (st >> 1) * 16 + swz / 64; C = (st & 1) * 32 + (swz % 64) / 2; }
__host__ __device__ __forceinline__ int perm32(int rho) { const int n = rho >> 4, i = rho & 15; return 8 * (i >> 2) + 4 * n + (i & 3); }
struct Unit { int r0, pn, e, rows, tm, ui; };
typedef float f32x2_ __attribute__((ext_vector_type(2)));
typedef __bf16 bf16x2_ __attribute__((ext_vector_type(2)));
__device__ __forceinline__ unsigned cvt_pk_bf16(float lo, float hi) { const f32x2_ v = {lo, hi}; return __builtin_bit_cast(unsigned, __builtin_convertvector(v, bf16x2_)); }

struct DenseSched {
    int nM, nN, nwg, G, c, K;
    __device__ __forceinline__ void init(int M, int N, int K_, int G_, int c_) { nM = M / BM; nN = N / BM; nwg = nM * nN; G = G_; c = c_; K = K_; }
    __device__ __forceinline__ bool next(int i, Unit& u) const {
        const long L = (long)i * G + c; if (L >= nwg) return false;
        int wgid = (int)L; { const int q = nwg / 8, r = nwg % 8, xcd = wgid % 8, off = wgid / 8; wgid = (xcd < r ? xcd * (q + 1) : r * (q + 1) + (xcd - r) * q) + off; }
        const int nig = 8 * nN, gid = wgid / nig, fm = gid * 8, gsz = (nM - fm) < 8 ? (nM - fm) : 8;
        u.r0 = (fm + ((wgid % nig) % gsz)) * BM; u.pn = (wgid % nig) / gsz; u.e = 0; u.rows = 256; u.tm = 0; u.ui = i; return true;
    }
    __device__ __forceinline__ unsigned a_off(const Unit& u, int half, int R) const { return (unsigned)((u.r0 + half * 128 + R) * K) * 2u; }
};
struct DenseHalfSched {
    int nN, nwg, G, c, K;
    __device__ __forceinline__ void init(int M, int N, int K_, int G_, int c_) { nN = N / BM; nwg = (M / HALF) * nN; G = G_; c = c_; K = K_; }
    __device__ __forceinline__ bool next(int i, Unit& u) const { const int L = i * G + c; if (L >= nwg) return false; u.r0 = (L / nN) * HALF; u.pn = L % nN; u.e = 0; u.rows = HALF; u.tm = 0; u.ui = i; return true; }
    __device__ __forceinline__ unsigned a_off(const Unit& u, int half, int R) const { return (unsigned)((u.r0 + half * 128 + R) * K) * 2u; }
};

template <class Epi, class Sched>
__device__ __forceinline__ void gemm_phase(LAS unsigned char* lds, const bf16_t* A, const bf16_t* Bt, int K, size_t bstride, const Sched& S, const Epi& E) {
    const int tid = opaque_tid(), wid = __builtin_amdgcn_readfirstlane(tid >> 6), lane = tid & 63, wr = wid >> 2, wc = wid & 3, fr = lane & 15, fq = lane >> 4;
    const int nt = K / BK;
    int sR[2], sC2[2]; unsigned voffB[2];
#pragma unroll
    for (int i = 0; i < 2; ++i) { int R, C; stage_rc(tid * 16 + i * 8192, R, C); const int Rb = (R & ~31) + perm32(R & 31); sR[i] = R; sC2[i] = C * 2; voffB[i] = (unsigned)(Rb * BK + C) * 2u; }
    const size_t kstep = (size_t)(BK * 2);
    const size_t hstep = (size_t)HALF * K * 2;
    const size_t kstepB = (size_t)BM * BK * 2, hstepB = (size_t)HALF * BK * 2;
    const size_t tstep = 2 * hstep;
    const unsigned ldsw = (unsigned)wid * 1024u;
    const int aoff = lds_byte(wr * 64 + fr, fq * 8), boff = lds_byte(wc * 32 + fr, fq * 8);
#define PG8_SA(b, h) (((b) * 2 + (h)) * HTB)
#define PG8_SB(b, h) ((4 + (b) * 2 + (h)) * HTB)
#define PG8_STAGE(bufoff, gbase, voff) do { _Pragma("unroll") for (int _i = 0; _i < 2; ++_i) \
        __builtin_amdgcn_global_load_lds((const unsigned*)((const char*)(gbase) + (voff)[_i]), (LAS unsigned*)(lds + (bufoff) + ldsw + _i * 8192), 16, 0, 0); } while (0)
#define PG8_LDA(dst, b, h) do { _Pragma("unroll") for (int m = 0; m < 4; ++m) _Pragma("unroll") for (int k = 0; k < 2; ++k) dst[m][k] = *(const LAS bf16x8*)(lds + PG8_SA(b, h) + aoff + m * 2048 + k * 1024); } while (0)
#define PG8_LDB(dst, b, h) do { _Pragma("unroll") for (int n = 0; n < 2; ++n) _Pragma("unroll") for (int k = 0; k < 2; ++k) dst[n][k] = *(const LAS bf16x8*)(lds + PG8_SB(b, h) + boff + n * 2048 + k * 1024); } while (0)
#define PG8_MMA(ai, bj, At, Bt_) do { __builtin_amdgcn_s_setprio(1); _Pragma("unroll") for (int m = 0; m < 4; ++m) _Pragma("unroll") for (int n = 0; n < 2; ++n) _Pragma("unroll") for (int k = 0; k < 2; ++k) \
        acc[ai][bj][m][n] = __builtin_amdgcn_mfma_f32_16x16x32_bf16(Bt_[n][k], At[m][k], acc[ai][bj][m][n], 0, 0, 0); __builtin_amdgcn_s_setprio(0); } while (0)
#define PG8_WAIT_V(n) asm volatile("s_waitcnt vmcnt(" #n ")" ::: "memory")
#define PG8_WAIT_L(n) asm volatile("s_waitcnt lgkmcnt(" #n ")" ::: "memory")
#define PG8_BAR __builtin_amdgcn_s_barrier()
#define PG8_SCHED __builtin_amdgcn_sched_barrier(0)
    Unit cur, nxt; int ui = 0;
    if (!S.next(0, cur)) return;
    f32x4 acc[2][2][4][2];
#pragma unroll
    for (int a = 0; a < 2; ++a)
#pragma unroll
        for (int b = 0; b < 2; ++b)
#pragma unroll
            for (int m = 0; m < 4; ++m)
#pragma unroll
                for (int n = 0; n < 2; ++n) acc[a][b][m][n] = (f32x4){0.f, 0.f, 0.f, 0.f};
    bf16x8 At[4][2], B0[2][2], B1[2][2];
    unsigned voffA0[2], voffA1[2];
#pragma unroll
    for (int i = 0; i < 2; ++i) { voffA0[i] = S.a_off(cur, 0, sR[i]) + sC2[i]; voffA1[i] = S.a_off(cur, 1, sR[i]) + sC2[i]; }
    const char* const Ab = (const char*)A;
    const char* cB = (const char*)Bt + (size_t)cur.e * bstride + (size_t)cur.pn * tstep;
    PG8_STAGE(PG8_SB(0, 0), cB, voffB); PG8_STAGE(PG8_SB(0, 1), cB + hstepB, voffB); PG8_STAGE(PG8_SA(0, 0), Ab, voffA0); PG8_STAGE(PG8_SA(0, 1), Ab, voffA1);
    if (wr == 1) PG8_BAR;
    PG8_WAIT_V(2); PG8_BAR;
    PG8_STAGE(PG8_SB(1, 0), cB + kstepB, voffB); PG8_STAGE(PG8_SA(1, 0), Ab + kstep, voffA0); PG8_STAGE(PG8_SB(1, 1), cB + hstepB + kstepB, voffB);
    PG8_WAIT_V(6); PG8_BAR;
    for (;;) {
        const bool has_next = S.next(ui + 1, nxt);
        const bool full = cur.rows > HALF;
        const char* nB = has_next ? (const char*)Bt + (size_t)nxt.e * bstride + (size_t)nxt.pn * tstep : cB;
        for (int t = 0; t < nt; t += 2) {
            const bool last = (t == nt - 2);
            const char* a1 = Ab + (size_t)(t + 1) * kstep;
            const char* a2 = last ? Ab : Ab + (size_t)(t + 2) * kstep; const char* b2 = last ? nB : cB + (size_t)(t + 2) * kstepB;
            const char* a3 = a2 + kstep; const char* b3 = b2 + kstepB;
            PG8_LDB(B0, 0, 0); PG8_LDB(B1, 0, 1); PG8_SCHED; PG8_LDA(At, 0, 0); PG8_STAGE(PG8_SA(1, 1), a1, voffA1);
            if (last && has_next) {
#pragma unroll
                for (int i = 0; i < 2; ++i) { voffA0[i] = S.a_off(nxt, 0, sR[i]) + sC2[i]; voffA1[i] = S.a_off(nxt, 1, sR[i]) + sC2[i]; }
            }
            PG8_WAIT_V(8); PG8_WAIT_L(0); PG8_BAR; PG8_MMA(0, 0, At, B0); PG8_MMA(0, 1, At, B1); PG8_BAR; PG8_SCHED;
            if (full) PG8_LDA(At, 0, 1); PG8_STAGE(PG8_SB(0, 0), b2, voffB); PG8_STAGE(PG8_SB(0, 1), b2 + hstepB, voffB); PG8_STAGE(PG8_SA(0, 0), a2, voffA0);
            PG8_WAIT_V(8); PG8_WAIT_L(0); PG8_BAR; if (full) { PG8_MMA(1, 0, At, B0); PG8_MMA(1, 1, At, B1); } PG8_BAR; PG8_SCHED;
            PG8_LDB(B0, 1, 0); PG8_LDB(B1, 1, 1); PG8_SCHED; PG8_LDA(At, 1, 0); PG8_STAGE(PG8_SA(0, 1), a2, voffA1);
            PG8_WAIT_V(8); PG8_WAIT_L(0); PG8_BAR; PG8_MMA(0, 0, At, B0); PG8_MMA(0, 1, At, B1); PG8_BAR; PG8_SCHED;
            if (full) PG8_LDA(At, 1, 1); PG8_STAGE(PG8_SB(1, 0), b3, voffB); PG8_STAGE(PG8_SB(1, 1), b3 + hstepB, voffB); PG8_STAGE(PG8_SA(1, 0), a3, voffA0);
            PG8_WAIT_V(8); PG8_WAIT_L(0); PG8_BAR; if (full) { PG8_MMA(1, 0, At, B0); PG8_MMA(1, 1, At, B1); } PG8_BAR; PG8_SCHED;
        }
        if (wr == 0) PG8_BAR;
        E(acc, cur, wr, wc, fr, fq);
        if (!has_next) break;
#pragma unroll
        for (int a = 0; a < 2; ++a)
#pragma unroll
            for (int b = 0; b < 2; ++b)
#pragma unroll
                for (int m = 0; m < 4; ++m)
#pragma unroll
                    for (int n = 0; n < 2; ++n) acc[a][b][m][n] = (f32x4){0.f, 0.f, 0.f, 0.f};
        cur = nxt; cB = nB; ++ui;
        if (wr == 1) PG8_BAR;
    }
    PG8_WAIT_V(0);
    PG8_BAR;
#undef PG8_SA
#undef PG8_SB
#undef PG8_STAGE
#undef PG8_LDA
#undef PG8_LDB
#undef PG8_MMA
#undef PG8_WAIT_V
#undef PG8_WAIT_L
#undef PG8_BAR
#undef PG8_SCHED
}

#define PG8_ROWS_COLS const int row0 = u.r0 + wr * 64 + fr; const int col0 = wc * 32 + 8 * fq
__device__ __forceinline__ u32x4 pack8(const f32x4 v0, const f32x4 v1) { u32x4 w; w.x = cvt_pk_bf16(v0[0], v0[1]); w.y = cvt_pk_bf16(v0[2], v0[3]); w.z = cvt_pk_bf16(v1[0], v1[1]); w.w = cvt_pk_bf16(v1[2], v1[3]); return w; }
struct EpiStore {
    bf16_t* O; bf16_t* O2; int ldc, split; float scale; int pad;
    __device__ __forceinline__ void operator()(const f32x4 (&acc)[2][2][4][2], const Unit& u, int wr, int wc, int fr, int fq) const {
        PG8_ROWS_COLS; bf16_t* base = u.pn >= split ? O2 + (size_t)(u.pn - split) * BM : O + (size_t)u.pn * BM;
#pragma unroll
        for (int ai = 0; ai < 2; ++ai) if (ai * HALF < u.rows)
#pragma unroll
            for (int m = 0; m < 4; ++m) { bf16_t* rowp = base + (size_t)(row0 + ai * HALF + m * 16) * ldc + col0;
#pragma unroll
                for (int bj = 0; bj < 2; ++bj) *(u32x4*)(rowp + bj * HALF) = pack8(acc[ai][bj][m][0] * scale, acc[ai][bj][m][1] * scale); }
    }
};
struct EpiHgrn {
    bf16_t* Qb;
    __device__ __forceinline__ void operator()(const f32x4 (&acc)[2][2][4][2], const Unit& u, int wr, int wc, int fr, int fq) const {
        PG8_ROWS_COLS; const int seg = u.pn >> 3, ct = (u.pn & 7) * BM + col0;
        bf16_t* base = Qb + (size_t)seg * ((size_t)T * D + PADB / 2) + ct;
#pragma unroll
        for (int ai = 0; ai < 2; ++ai)
#pragma unroll
            for (int m = 0; m < 4; ++m) { bf16_t* rowp = base + (size_t)(row0 + ai * HALF + m * 16) * D;
#pragma unroll
                for (int bj = 0; bj < 2; ++bj) *(u32x4*)(rowp + bj * HALF) = pack8(acc[ai][bj][m][0], acc[ai][bj][m][1]); }
    }
};


constexpr int MT_HL = 2048;
constexpr int MOE_MAXU = 4, MT_TILE = 0, MT_FULL = 40, MT_TAIL = 80, MT_CNT = 120, MT_ROWS = 160, MT_GATE = MT_ROWS + 256 * MOE_MAXU, MOE_TAB_INTS = MT_GATE + 256 * MOE_MAXU;
struct MoeSched {
    const LAS int* tab; int NT, G, c, K, gather, pos0, pos1;
    __device__ __forceinline__ int find_e(int base, int k) const {
        const int v = tab[base + 1 + (__lane_id() & 31)];
        return __popcll(__ballot(v <= k) & 0xffffffffull);
    }
    __device__ __forceinline__ bool next(int i, Unit& u) const {
        int L = pos0 + i * G + c; if (L >= pos1) return false; const int FT = tab[MT_FULL + 32] * NT; int e = 0, tm;
        if (L < FT) { const int k = L / NT; u.pn = L - k * NT; e = find_e(MT_FULL, k); tm = k - tab[MT_FULL + e]; }
        else { L -= FT; if (L >= tab[MT_TAIL + 32] * NT) return false; const int k = L / NT; u.pn = L - k * NT; e = find_e(MT_TAIL, k); tm = tab[MT_TILE + e + 1] - tab[MT_TILE + e] - 1; }
        u.r0 = (tab[MT_TILE + e] + tm) * 256; u.e = e; u.tm = tm; const int left = tab[MT_CNT + e] - 256 * tm; u.rows = left < 256 ? left : 256; u.ui = i; return true;
    }
    __device__ __forceinline__ int entry(const Unit& u, int r) const {
        const int a = tab[MT_ROWS + 256 * u.ui + r]; return a >= 0 ? a : tab[MT_ROWS + 256 * u.ui];
    }
    __device__ __forceinline__ unsigned a_off(const Unit& u, int half, int R) const {
        if (gather) return (unsigned)((entry(u, half * 128 + R) >> 1) * K) * 2u;
        return (unsigned)((u.r0 + half * 128 + R) * K) * 2u;
    }
    __device__ __forceinline__ void build_slots(LAS int* t, const int* slot_ent, const float* tg) const {
        const int tid = opaque_tid(), half = tid >> 8, t8 = tid & 255;
        for (int i0 = 0; i0 < MOE_MAXU; i0 += 2) { Unit u; if (!next(i0, u)) break; const bool ok = next(i0 + half, u);
            if (ok) { int a = 0; float g = 0.f; if (t8 < u.rows) { a = slot_ent[u.r0 + t8]; g = tg[a]; } t[MT_ROWS + 256 * (i0 + half) + t8] = a; ((LAS float*)t)[MT_GATE + 256 * (i0 + half) + t8] = g; } }
        __syncthreads();
    }
    __device__ __forceinline__ void build_tables(LAS int* t, LAS int* scr, const int* hist) const {
        const int tid = opaque_tid(), lane = tid & 63;
        { const int e = tid & 31, part = tid >> 5; int sum = 0;
#pragma unroll
          for (int b = part * 16; b < part * 16 + 16; ++b) { const int hv = hist[b * 32 + e]; sum += hv; scr[MT_HL + b * 32 + e] = hv; }
          scr[tid] = sum; }
        __syncthreads();
        if (tid < 64) { int cn = 0;
            if (lane < 32) {
#pragma unroll
                for (int part = 0; part < 16; ++part) cn += scr[part * 32 + lane]; }
            const int nt = (cn + 255) >> 8, tail = (nt > 0 && cn - 256 * (nt - 1) <= 128) ? 1 : 0;
            int p = nt, pf = nt - tail, pt = tail;
#pragma unroll
            for (int o = 1; o < 32; o <<= 1) { const int a = __shfl_up(p, o), b = __shfl_up(pf, o), c2 = __shfl_up(pt, o); if (lane >= o) { p += a; pf += b; pt += c2; } }
            if (lane < 32) { t[MT_CNT + lane] = cn; t[MT_TILE + lane] = p - nt; t[MT_FULL + lane] = pf - (nt - tail); t[MT_TAIL + lane] = pt - tail; }
            if (lane == 31) { t[MT_TILE + 32] = p; t[MT_FULL + 32] = pf; t[MT_TAIL + 32] = pt; } }
        __syncthreads();
    }
    __device__ __forceinline__ void build_rows(LAS int* t, LAS int* scr, const int* hist, const int* inv, bool from_lds = false) const {
        const int tid = opaque_tid(), lane = tid & 63, half = tid >> 8, t8 = tid & 255, wvh = (tid >> 6) & 3;
        LAS int* pre = scr + 512 + half * 264;
        for (int i0 = 0; i0 < MOE_MAXU; i0 += 2) { Unit u; const bool have = next(i0 + half, u);
            if (!next(i0, u) ) break;
            const bool ok = next(i0 + half, u);
            int hv = 0, incl = 0;
            if (ok) { hv = from_lds ? scr[MT_HL + t8 * 32 + u.e] : hist[t8 * 32 + u.e]; incl = hv;
#pragma unroll
                for (int o = 1; o < 64; o <<= 1) { const int tv = __shfl_up(incl, o); if (lane >= o) incl += tv; }
                if (lane == 63) scr[half * 8 + wvh] = incl; }
            __syncthreads();
            if (ok) { int off = 0; for (int w2 = 0; w2 < wvh; ++w2) off += scr[half * 8 + w2]; pre[t8] = off + incl - hv; if (t8 == 255) pre[256] = off + incl; }
            __syncthreads();
            if (ok) { const int pos = 256 * u.tm + t8; int ent = -1;
                if (pos < t[MT_CNT + u.e]) { int lo = 0, hi = 256;
                    while (hi - lo > 1) { const int mid = (lo + hi) >> 1; if (pre[mid] <= pos) lo = mid; else hi = mid; }
                    ent = inv[(lo * 32 + u.e) * 32 + (pos - pre[lo])]; }
                t[MT_ROWS + 256 * (i0 + half) + t8] = ent; }
            __syncthreads();
            (void)have;
        }
    }
};
struct EpiMoeH {
    bf16_t* Hs; int* slot_ent; MoeSched S; unsigned* done;
    __device__ __forceinline__ void operator()(const f32x4 (&acc)[2][2][4][2], const Unit& u, int wr, int wc, int fr, int fq) const {
        const int col0 = u.pn * 128 + wc * 32 + 8 * fq;
        asm volatile("" : "+v"(fr));
#pragma unroll
        for (int ai = 0; ai < 2; ++ai)
#pragma unroll
            for (int m = 0; m < 4; ++m) { const int rl = ai * HALF + wr * 64 + m * 16 + fr; f32x4 v[2];
#pragma unroll
                for (int n = 0; n < 2; ++n)
#pragma unroll
                    for (int j = 0; j < 4; ++j) { const float g = acc[ai][0][m][n][j]; v[n][j] = g * sigmoidf_(g) * acc[ai][1][m][n][j]; }
                if (rl < u.rows) { { const u32x4 w = pack8(v[0], v[1]); asm volatile("global_store_dwordx4 %0, %1, off sc1\n\ts_nop 0" :: "v"(Hs + (size_t)(u.r0 + rl) * DEXP + col0), "v"(w) : "memory"); }
                    if (u.pn == 0 && wc == 0 && fq == 0) __hip_atomic_store(slot_ent + u.r0 + rl, S.entry(u, rl), __ATOMIC_RELAXED, __HIP_MEMORY_SCOPE_AGENT); } }
        asm volatile("s_waitcnt vmcnt(0)" ::: "memory");
        __builtin_amdgcn_s_barrier();
        if (wr == 0 && wc == 0 && fr == 0 && fq == 0) (void)__hip_atomic_fetch_add(done + 64 * (u.r0 >> 8), 1u, __ATOMIC_RELAXED, __HIP_MEMORY_SCOPE_AGENT);
    }
};
struct EpiMoeY {
    bf16_t* Y; const LAS int* tab;
    __device__ __forceinline__ void operator()(const f32x4 (&acc)[2][2][4][2], const Unit& u, int wr, int wc, int fr, int fq) const {
        const int col0 = u.pn * BM + wc * 32 + 8 * fq;
#pragma unroll
        for (int ai = 0; ai < 2; ++ai)
#pragma unroll
            for (int m = 0; m < 4; ++m) { const int rl = ai * HALF + wr * 64 + m * 16 + fr;
                if (rl < u.rows) { const int a = tab[MT_ROWS + 256 * u.ui + rl]; const float g = ((const LAS float*)tab)[MT_GATE + 256 * u.ui + rl]; bf16_t* rowp = Y + (size_t)(a & 1) * YPLANE + (size_t)(a >> 1) * D + col0;
#pragma unroll
                    for (int bj = 0; bj < 2; ++bj) *(u32x4*)(rowp + bj * HALF) = pack8(acc[ai][bj][m][0] * g, acc[ai][bj][m][1] * g); } }
    }
};

struct TDesc { const float* W; bf16_t* WT; int K, N, drow, kb, nb; };
__device__ __forceinline__ void ti_load(float (&tmp)[32], const TDesc& d, int lane) {
    const float* src = d.W + (size_t)(64 * d.kb + (lane >> 5)) * d.N + 32 * d.nb + (lane & 31);
#pragma unroll
    for (int i = 0; i < 32; ++i) tmp[i] = __builtin_nontemporal_load(src + (size_t)(2 * i) * d.N);
}
__device__ __forceinline__ void ti_finish(const float (&tmp)[32], const TDesc& d, LAS float* scr, int lane) {
    const int k0 = 64 * d.kb;
#pragma unroll
    for (int i = 0; i < 32; ++i) scr[(2 * i + (lane >> 5)) * 33 + (lane & 31)] = tmp[i];
    asm volatile("s_waitcnt lgkmcnt(0)" ::: "memory");
    const int c = lane & 7;
#pragma unroll
    for (int j = 0; j < 4; ++j) { const int n = (lane >> 3) + 8 * j; const LAS float* sp = scr + (8 * c) * 33 + n;
        u32x4 o; o.x = cvt_pk_bf16(sp[0 * 33], sp[1 * 33]); o.y = cvt_pk_bf16(sp[2 * 33], sp[3 * 33]); o.z = cvt_pk_bf16(sp[4 * 33], sp[5 * 33]); o.w = cvt_pk_bf16(sp[6 * 33], sp[7 * 33]);
        const int R = d.drow + n;
        __builtin_nontemporal_store(o, (u32x4*)(d.WT + (size_t)(R >> 8) * 256 * d.K + (size_t)d.kb * (256 * 64) + (R & 255) * 64 + 8 * c)); }
    asm volatile("s_waitcnt lgkmcnt(0)" ::: "memory");
}
}

typedef short s16x4 __attribute__((ext_vector_type(4)));
typedef LAS s16x4 lds_s16x4;
constexpr int HRS = 272, ARS = 144;
constexpr int H1_QH = 0, H1_KH0 = H1_QH + 64 * HRS, H1_KH1 = H1_KH0 + 16 * HRS, H1_KH2 = H1_KH1 + 32 * HRS, H1_KH3 = H1_KH2 + 48 * HRS, H1_KT = H1_KH3 + 64 * HRS,
              H1_VS = H1_KT + 64 * HRS, H1_AS = H1_VS + 64 * HRS, H1_TOT = H1_AS + 64 * ARS, H1_BYTES = H1_TOT + 4096;
constexpr int NUNIT = BATCH * HG_H * (SEQ / 64);
__device__ __forceinline__ bf16x8 tr_frag16(const LAS unsigned char* tile, int rs, int r0, int c0, int lane) {
    const int g = lane >> 4, i = lane & 15, q = i >> 2, p = i & 3;
    const LAS unsigned char* a = tile + (r0 + 8 * g + q) * rs + (c0 + 4 * p) * 2;
    const s16x4 lo = __builtin_amdgcn_ds_read_tr16_b64_v4i16((lds_s16x4*)a);
    const s16x4 hi = __builtin_amdgcn_ds_read_tr16_b64_v4i16((lds_s16x4*)(a + 4 * rs));
    return (bf16x8){lo[0], lo[1], lo[2], lo[3], hi[0], hi[1], hi[2], hi[3]};
}
__device__ __forceinline__ bf16x8 row_frag16(const LAS unsigned char* tile, int rs, int r0, int c0, int lane) {
    return *(const LAS bf16x8*)(tile + (r0 + (lane & 15)) * rs + (c0 + 8 * (lane >> 4)) * 2);
}
#define MFMA16(a, b, c) __builtin_amdgcn_mfma_f32_16x16x32_bf16((a), (b), (c), 0, 0, 0)
__device__ __forceinline__ u32x2 pack4(const f32x4 v) { u32x2 r; r.x = pg8::cvt_pk_bf16(v[0], v[1]); r.y = pg8::cvt_pk_bf16(v[2], v[3]); return r; }

struct HgArgs { bf16_t *Qb, *Kb, *Vb, *Gt, *OI, *UT, *Sst, *Og; bf16_t* Gl; float* Dg; const float* ng; bf16_t* Qt; const float* lbraw; int layer; };

typedef float f32x2 __attribute__((ext_vector_type(2)));
__device__ __forceinline__ f32x2 exp2v(const f32x2 x) { f32x2 r; r.x = __builtin_amdgcn_exp2f(x.x); r.y = __builtin_amdgcn_exp2f(x.y); return r; }
__device__ __forceinline__ f32x2 bf2v(unsigned w) { f32x2 r; r.x = __builtin_bit_cast(float, w << 16); r.y = __builtin_bit_cast(float, w & 0xffff0000u); return r; }
__device__ __forceinline__ unsigned v2bf(const f32x2 v) { return pg8::cvt_pk_bf16(v.x, v.y); }
struct H1In { unsigned g[8], q[8]; u32x4 v[2]; };
__device__ __forceinline__ void h1_load(H1In& in, const HgArgs& a, int unit, int tid) {
    const int bh = unit >> 5, c = unit & 31, b = bh >> 4, h = bh & 15, cp = tid & 63, tq = tid >> 6;
    const size_t gbase = ((size_t)b * SEQ + c * 64) * D + h * 128;
#pragma unroll
    for (int i = 0; i < 8; ++i) { const size_t go = gbase + (size_t)(8 * tq + i) * D + 2 * cp; in.g[i] = *(const unsigned*)(a.Kb + go); in.q[i] = *(const unsigned*)(a.Qb + go); }
#pragma unroll
    for (int i = 0; i < 2; ++i) { const int id = tid + 512 * i, r = id >> 4, ck = id & 15; in.v[i] = *(const u32x4*)(a.Vb + gbase + (size_t)r * D + ck * 8); }
}
__device__ __forceinline__ int h1_unit_of(int p) { const int b = p >> 9, c = (p >> 4) & 31, h = p & 15; return ((b * 16 + h) << 5) + c; }
__device__ __forceinline__ int h3_pair_of(int p) { const int b = p >> 8, c2 = (p >> 4) & 15, h = p & 15; return ((b * 16 + h) << 4) + c2; }
__device__ __forceinline__ void h1_phase(LAS unsigned char* lds, const HgArgs& a, int vcu, int G) {
    const int tid = opaque_tid(), lane = tid & 63, wid = __builtin_amdgcn_readfirstlane(tid >> 6);
    const int cp = lane, tq = wid, J = wid >> 1, half = wid & 1;
    LAS f32x2* tot8 = (LAS f32x2*)(lds + H1_TOT);
    H1In in;
    if (vcu < NUNIT) h1_load(in, a, h1_unit_of(vcu), tid);
    for (int pu = vcu; pu < NUNIT; pu += G) { const int unit = h1_unit_of(pu);
        const int bh = unit >> 5, c = unit & 31, b = bh >> 4, h = bh & 15;
        const size_t gbase = ((size_t)b * SEQ + c * 64) * D + h * 128;
        f32x2 L[8], kk[8]; { f32x2 l = {0.f, 0.f}; f32x2 lb = {0.f, 0.f};
            if (a.layer != 0) { const int cch = h * 128 + 2 * cp; lb.x = sigmoidf_(a.lbraw[D + cch] - a.lbraw[cch]); lb.y = sigmoidf_(a.lbraw[D + cch + 1] - a.lbraw[cch + 1]); }
            const f32x2 omlb = (f32x2){1.f, 1.f} - lb;
#pragma unroll
            for (int i = 0; i < 8; ++i) { const f32x2 x = bf2v(in.g[i]); f32x2 sg; sg.x = sigmoidf_(x.x); sg.y = sigmoidf_(x.y);
                const f32x2 f = lb + omlb * sg; kk[i] = omlb * ((f32x2){1.f, 1.f} - sg);
                l.x += __log2f(fmaxf(f.x, 1e-30f)); l.y += __log2f(fmaxf(f.y, 1e-30f)); L[i] = l; } }
        tot8[tq * 64 + cp] = L[7];
#pragma unroll
        for (int i = 0; i < 2; ++i) { const int id = tid + 512 * i, r = id >> 4, ck = id & 15; *(LAS u32x4*)(lds + H1_VS + r * HRS + ck * 16) = in.v[i]; }
        for (int id = tid; id < 64 * ARS / 16; id += 512) *(LAS u32x4*)(lds + H1_AS + id * 16) = (u32x4){0u, 0u, 0u, 0u};
        lds_barrier();
        H1In in2; if (pu + G < NUNIT) h1_load(in2, a, h1_unit_of(pu + G), tid);
        f32x2 tj[4];
#pragma unroll
        for (int M = 0; M < 4; ++M) tj[M] = tot8[(2 * M) * 64 + cp] + tot8[(2 * M + 1) * 64 + cp];
        f32x2 off = {0.f, 0.f}; if (half) off = tot8[(tq - 1) * 64 + cp];
        f32x2 aJ = {0.f, 0.f};
#pragma unroll
        for (int M = 0; M < 3; ++M) if (M < J) aJ += tj[M];
        const f32x2 PA = exp2v(aJ), L15 = tj[J == 0 ? 0 : J == 1 ? 1 : J == 2 ? 2 : 3];
        f32x2 cI[5];
#pragma unroll
        for (int I = 1; I <= 4; ++I) { f32x2 sx = {0.f, 0.f};
#pragma unroll
            for (int M = 1; M < 4; ++M) if (M > J && M < I) sx += tj[M];
            cI[I] = exp2v(sx); }
        const int khJ = J == 0 ? H1_KH0 : J == 1 ? H1_KH1 : J == 2 ? H1_KH2 : H1_KH3;
#pragma unroll
        for (int i = 0; i < 8; ++i) {
            const int t = 8 * tq + i; const int lo = t * HRS + cp * 4;
            const f32x2 q = bf2v(in.q[i]), k = kk[i], Li = L[i] + off;
            const f32x2 ep = exp2v(Li), nl = -Li, en = exp2v((f32x2){fminf(nl.x, 80.f), fminf(nl.y, 80.f)}), rem = exp2v(L15 - Li);
            const f32x2 qh = q * ep, kr = k * rem;
            *(LAS unsigned*)(lds + H1_QH + lo) = v2bf(qh);
            *(unsigned*)(a.Qt + gbase + (size_t)t * D + 2 * cp) = v2bf(qh * PA);
            *(LAS unsigned*)(lds + khJ + lo) = v2bf(k * en);
#pragma unroll
            for (int I = 1; I <= 4; ++I) if (I > J) { constexpr int offs[5] = {H1_KH0, H1_KH1, H1_KH2, H1_KH3, H1_KT}; *(LAS unsigned*)(lds + offs[I] + lo) = v2bf(kr * cI[I]); }
        }
        if (J == 0 && half == 0) *(f32x2*)(a.Dg + (size_t)unit * 128 + 2 * cp) = exp2v((tj[0] + tj[1]) + (tj[2] + tj[3]));
        lds_barrier();
        for (int blk = wid; blk < 10; blk += 8) {
            const int I = blk < 1 ? 0 : blk < 3 ? 1 : blk < 6 ? 2 : 3, Jb = blk - (I * (I + 1)) / 2;
            const int khI = I == 0 ? H1_KH0 : I == 1 ? H1_KH1 : I == 2 ? H1_KH2 : H1_KH3;
            f32x4 acc = {0.f, 0.f, 0.f, 0.f};
#pragma unroll
            for (int ks = 0; ks < 4; ++ks) acc = MFMA16(row_frag16(lds + khI, HRS, 16 * Jb, 32 * ks, lane), row_frag16(lds + H1_QH, HRS, 16 * I, 32 * ks, lane), acc);
            const int tl = 16 * I + (lane & 15), s0 = 16 * Jb + 4 * (lane >> 4);
#pragma unroll
            for (int r = 0; r < 4; ++r) if (s0 + r > tl) acc[r] = 0.f;
            *(LAS u32x2*)(lds + H1_AS + tl * ARS + s0 * 2) = pack4(acc);
        }
        lds_barrier();
        {
            bf16x8 vtr[2];
#pragma unroll
            for (int ks = 0; ks < 2; ++ks) vtr[ks] = tr_frag16(lds + H1_VS, HRS, 32 * ks, 16 * wid, lane);
#pragma unroll
            for (int rb = 0; rb < 4; ++rb) { f32x4 acc = {0.f, 0.f, 0.f, 0.f};
#pragma unroll
                for (int ks = 0; ks < 2; ++ks) if (!(ks == 1 && rb < 2)) acc = MFMA16(vtr[ks], row_frag16(lds + H1_AS, ARS, 16 * rb, 32 * ks, lane), acc);
                *(u32x2*)(a.OI + gbase + (size_t)(16 * rb + (lane & 15)) * D + 16 * wid + 4 * (lane >> 4)) = pack4(acc); }
#pragma unroll
            for (int cb = 0; cb < 8; ++cb) { f32x4 acc = {0.f, 0.f, 0.f, 0.f};
#pragma unroll
                for (int ks = 0; ks < 2; ++ks) acc = MFMA16(tr_frag16(lds + H1_KT, HRS, 32 * ks, 16 * cb, lane), vtr[ks], acc);
                *(u32x2*)(a.UT + ((size_t)unit * 128 + 16 * wid + (lane & 15)) * 128 + 16 * cb + 4 * (lane >> 4)) = pack4(acc); }
        }
        lds_barrier();
        in = in2;
    }
}
__device__ __forceinline__ void h2_phase(const HgArgs& a, int vcu, int G) {
    for (int item = vcu * 512 + opaque_tid(); item < BATCH * HG_H * 2048; item += G * 512) {
        const int bh = item >> 11, vec = item & 2047, ch0 = (vec & 15) * 8;
        f32x4 s0 = {0.f, 0.f, 0.f, 0.f}, s1 = {0.f, 0.f, 0.f, 0.f};
#pragma unroll 1
        for (int c0 = 0; c0 < 32; c0 += 8) {
            u32x4 uu[8]; f32x4 d0[8], d1[8];
#pragma unroll
            for (int k = 0; k < 8; ++k) { const size_t u = (size_t)bh * 32 + c0 + k; uu[k] = __builtin_nontemporal_load((const u32x4*)(a.UT + u * 16384 + vec * 8)); d0[k] = *(const f32x4*)(a.Dg + u * 128 + ch0); d1[k] = *(const f32x4*)(a.Dg + u * 128 + ch0 + 4); }
#pragma unroll
            for (int k = 0; k < 8; ++k) { const size_t u = (size_t)bh * 32 + c0 + k;
                *(u32x4*)(a.Sst + u * 16384 + vec * 8) = pg8::pack8(s0, s1);
                u32x2 lo2, hi2; lo2.x = uu[k].x; lo2.y = uu[k].y; hi2.x = uu[k].z; hi2.y = uu[k].w;
                s0 = d0[k] * s0 + bf4(lo2); s1 = d1[k] * s1 + bf4(hi2); }
        }
    }
}
__device__ __forceinline__ void h3_phase(LAS unsigned char* lds, const HgArgs& a, int vcu, int G) {
    const int tid = opaque_tid(), lane = tid & 63, wid = __builtin_amdgcn_readfirstlane(tid >> 6), us = wid >> 2, rb = wid & 3, t4 = rb * 64 + lane;
    LAS unsigned char* tile = lds + us * (128 * HRS);
    u32x4 sreg[8];
    if (vcu < NUNIT / 2) { const bf16_t* sp = a.Sst + (size_t)(h3_pair_of(vcu) * 2 + us) * 16384;
#pragma unroll
        for (int i = 0; i < 8; ++i) sreg[i] = __builtin_nontemporal_load((const u32x4*)(sp + (t4 + 256 * i) * 8)); }
    for (int pp = vcu; pp < NUNIT / 2; pp += G) { const int pair = h3_pair_of(pp);
        const int unit = pair * 2 + us;
        const int bh = unit >> 5, c = unit & 31, b = bh >> 4, h = bh & 15;
        const size_t ro = ((size_t)b * SEQ + c * 64 + 16 * rb + (lane & 15)) * D + h * 128;
#pragma unroll
        for (int i = 0; i < 8; ++i) { const int id = t4 + 256 * i; *(LAS u32x4*)(tile + (id >> 4) * HRS + (id & 15) * 16) = sreg[i]; }
        lds_barrier();
        if (pp + G < NUNIT / 2) { const bf16_t* sp = a.Sst + (size_t)(h3_pair_of(pp + G) * 2 + us) * 16384;
#pragma unroll
            for (int i = 0; i < 8; ++i) sreg[i] = __builtin_nontemporal_load((const u32x4*)(sp + (t4 + 256 * i) * 8)); }
        bf16x8 qf[4];
#pragma unroll
        for (int ks = 0; ks < 4; ++ks) qf[ks] = *(const bf16x8*)(a.Qt + ro + 32 * ks + 8 * (lane >> 4));
        u32x2 oi[8], gt[8];
#pragma unroll
        for (int cb = 0; cb < 8; ++cb) { oi[cb] = *(const u32x2*)(a.OI + ro + 16 * cb + 4 * (lane >> 4)); gt[cb] = *(const u32x2*)(a.Gt + ro + 16 * cb + 4 * (lane >> 4)); }
        f32x4 o[8]; float ss = 0.f;
#pragma unroll
        for (int cb = 0; cb < 8; ++cb) { f32x4 acc = {0.f, 0.f, 0.f, 0.f};
#pragma unroll
            for (int ks = 0; ks < 4; ++ks) acc = MFMA16(row_frag16(tile, HRS, 16 * cb, 32 * ks, lane), qf[ks], acc);
            acc += bf4(oi[cb]);
            o[cb] = acc; ss += (acc[0] * acc[0] + acc[1] * acc[1]) + (acc[2] * acc[2] + acc[3] * acc[3]); }
        ss += __shfl_xor(ss, 16); ss += __shfl_xor(ss, 32);
        const float r = 1.0f / sqrtf(ss * (1.f / 128.f) + RMS_EPS);
#pragma unroll
        for (int cb = 0; cb < 8; ++cb) { const int vc = 16 * cb + 4 * (lane >> 4); const f32x4 g = *(const f32x4*)(a.ng + h * 128 + vc);
            f32x4 gs = bf4(gt[cb]);
#pragma unroll
            for (int j = 0; j < 4; ++j) gs[j] *= sigmoidf_(gs[j]);
            *(u32x2*)(a.Og + ro + vc) = pack4(o[cb] * r * g * gs); }
        lds_barrier();
    }
}

#define XB_TMO      128
#define XB_XCNT(j)  (256  + 64 * (j))
#define XB_XSUB(j)  (1280 + 64 * (j))
#define XB_XGEN(j)  (2304 + 64 * (j))
#define XB_TOP      3328
#define XB_TOPGEN   3392
#define XCD_BAR_WORDS 3456
#define XB_SPIN_CAP (1u << 18)
__device__ __forceinline__ unsigned xb_ld(unsigned* p)              { return __hip_atomic_load(p, __ATOMIC_RELAXED, __HIP_MEMORY_SCOPE_AGENT); }
__device__ __forceinline__ unsigned xb_add(unsigned* p, unsigned v) { return __hip_atomic_fetch_add(p, v, __ATOMIC_RELAXED, __HIP_MEMORY_SCOPE_AGENT); }
__device__ __forceinline__ unsigned xb_xcc_id() { return (unsigned)__builtin_amdgcn_s_getreg((3 << 11) | 20) & 0xFu; }
#define XB_SPIN(cond, bar) do { unsigned _sp = 0; while (cond) { __builtin_amdgcn_s_sleep(1); \
    if ((++_sp & 255u) == 0u) { if (xb_ld(&(bar)[XB_TMO])) break; if (_sp > XB_SPIN_CAP) { atomicAdd(&(bar)[XB_TMO], 1u); break; } } } } while (0)
struct XcdBarrier { unsigned* bar; unsigned x; volatile LAS unsigned* st; };
__device__ __forceinline__ XcdBarrier xcd_barrier_post(unsigned* bar, volatile LAS unsigned* st) {
    XcdBarrier b; b.bar = bar; b.x = xb_xcc_id(); b.st = st;
    if (threadIdx.x == 0) (void)xb_add(&bar[XB_XCNT(b.x)], 1u);
    return b;
}
__device__ __forceinline__ void xcd_barrier_complete(unsigned* bar, unsigned x, unsigned& nloc, unsigned& nx) {
    const unsigned G = gridDim.x * gridDim.y * gridDim.z;
    unsigned sum, cnt, mine, sp = 0u;
    for (;;) {
        sum = 0u; cnt = 0u; mine = 0u;
#pragma unroll
        for (unsigned j = 0; j < 16; ++j) { const unsigned c = xb_ld(&bar[XB_XCNT(j)]); sum += c; cnt += (c > 0u) ? 1u : 0u; mine = (j == x) ? c : mine; }
        if (sum == G) break;
        __builtin_amdgcn_s_sleep(1);
        if ((++sp & 255u) == 0u) { if (xb_ld(&bar[XB_TMO])) break; if (sp > XB_SPIN_CAP) { atomicAdd(&bar[XB_TMO], 1u); break; } }
    }
    nloc = mine > 0u ? mine : 1u; nx = cnt > 0u ? cnt : 1u;
}
__device__ __forceinline__ void xcd_barrier(const XcdBarrier& b) {
    asm volatile("s_waitcnt vmcnt(0)" ::: "memory");
    __syncthreads();
    if (threadIdx.x == 0) {
        unsigned* bar = b.bar;
        __builtin_amdgcn_s_waitcnt(0);
        unsigned nloc = b.st[0], nx = b.st[1];
        if (nloc == 0u) { xcd_barrier_complete(bar, b.x, nloc, nx); b.st[0] = nloc; b.st[1] = nx; }
        const unsigned old = xb_add(&bar[XB_XSUB(b.x)], 1u);
        const unsigned gen = old / nloc;
        if (old + 1u == (gen + 1u) * nloc) {
            __builtin_amdgcn_fence(__ATOMIC_RELEASE, "agent");
            asm volatile("s_waitcnt vmcnt(0)" ::: "memory");
            const unsigned og = xb_add(&bar[XB_TOP], 1u);
            const unsigned tg = og / nx;
            if (og + 1u == (tg + 1u) * nx) xb_add(&bar[XB_TOPGEN], 1u);
            else XB_SPIN(xb_ld(&bar[XB_TOPGEN]) == tg, bar);
            __builtin_amdgcn_fence(__ATOMIC_ACQUIRE, "agent");
            xb_add(&bar[XB_XGEN(b.x)], 1u);
            asm volatile("s_waitcnt vmcnt(0)" ::: "memory");
        } else {
            XB_SPIN(xb_ld(&bar[XB_XGEN(b.x)]) == gen, bar);
            __builtin_amdgcn_fence(__ATOMIC_ACQUIRE, "agent");
            asm volatile("s_waitcnt vmcnt(0)" ::: "memory");
        }
    }
    __syncthreads();
}

constexpr int CW_DONE = 16384;
__device__ __forceinline__ void moe_wait_tiles(const pg8::MoeSched& S, unsigned* done) {
    if (threadIdx.x < 64) { pg8::Unit u; unsigned sp = 0; unsigned* f = done; bool mine = false;
        for (int i = 0; S.next(i, u); ++i) if ((int)threadIdx.x == i) { f = done + 64 * (u.r0 >> 8); mine = true; }
        for (;;) { bool wait = false; if (mine) wait = __hip_atomic_load(f, __ATOMIC_RELAXED, __HIP_MEMORY_SCOPE_AGENT) < 4u;
            if (!__any(wait)) break; __builtin_amdgcn_s_sleep(1); if (++sp > (1u << 20)) break; }
        __builtin_amdgcn_fence(__ATOMIC_ACQUIRE, "agent"); }
    __syncthreads();
}

struct Ptrs {
    const float *x, *a_w_in, *a_lb, *a_ng, *a_w_out, *b_w_kv, *b_w_q, *b_sinks, *b_w_out, *rel_bias, *w_rg, *b_rg, *w_re, *b_re, *w_gate, *w_up, *w_down, *ln_g, *ln_b;
    float* out; unsigned char* ws;
};
__device__ __forceinline__ void prologue_phase(LAS unsigned char* lds, const Ptrs& p, int part, int bidx, int nblk) {
    const int tid = opaque_tid(), lane = tid & 63, wave = __builtin_amdgcn_readfirstlane(tid >> 6);
    LAS float* scr = (LAS float*)(lds + wave * 8448);
    const int gw = bidx * 8 + wave, NGW = nblk * 8;
    bf16_t* Win_t = (bf16_t*)(p.ws + WS_WIN); bf16_t* Wout_t = (bf16_t*)(p.ws + WS_WOUT); bf16_t* Wkv_t = (bf16_t*)(p.ws + WS_WKV); bf16_t* Wq_t = (bf16_t*)(p.ws + WS_WQ); bf16_t* Wo_t = (bf16_t*)(p.ws + WS_WO);
    bf16_t* Wgu_t = (bf16_t*)(p.ws + WS_WGU); bf16_t* Wd_t = (bf16_t*)(p.ws + WS_WD);
    constexpr int I_IN = 2 * 32 * 256, I_AO = 2 * 32 * 64, I_KV = 32 * 16, I_Q = 2 * 32 * 64, I_O = 2 * 32 * 64, I_G = 128 * 32 * 16, I_U = I_G, I_D = 128 * 8 * 64;
    constexpr int NITEMS = I_IN + I_AO + I_KV + I_Q + I_O + I_G + I_U + I_D;
    auto decode = [&](int it, pg8::TDesc& d) {
        int r = it;
        if (r < I_IN) { const int mat = r / (32 * 256), q = r % (32 * 256); d.kb = q / 256; d.nb = q % 256; d.W = p.a_w_in + (size_t)mat * D * 4 * D; d.K = D; d.N = 4 * D; d.WT = Win_t + (size_t)mat * 4 * D * D; d.drow = 32 * d.nb; return; } r -= I_IN;
        if (r < I_AO) { const int mat = r / (32 * 64), q = r % (32 * 64); d.kb = q / 64; d.nb = q % 64; d.W = p.a_w_out + (size_t)mat * D * D; d.K = D; d.N = D; d.WT = Wout_t + (size_t)mat * D * D; d.drow = 32 * d.nb; return; } r -= I_AO;
        if (r < I_KV) { d.kb = r / 16; d.nb = r % 16; d.W = p.b_w_kv; d.K = D; d.N = 2 * KVW; d.WT = Wkv_t; d.drow = 32 * d.nb; return; } r -= I_KV;
        if (r < I_Q) { const int mat = r / (32 * 64), q = r % (32 * 64); d.kb = q / 64; d.nb = q % 64; d.W = p.b_w_q + (size_t)mat * D * D; d.K = D; d.N = D; d.WT = Wq_t + (size_t)mat * D * D; d.drow = 32 * d.nb; return; } r -= I_Q;
        if (r < I_O) { const int mat = r / (32 * 64), q = r % (32 * 64); d.kb = q / 64; d.nb = q % 64; d.W = p.b_w_out + (size_t)mat * D * D; d.K = D; d.N = D; d.WT = Wo_t + (size_t)mat * D * D; d.drow = 32 * d.nb; return; } r -= I_O;
        if (r < I_G + I_U) { const int up = r >= I_G; if (up) r -= I_G; const int mat = r / (32 * 16), q = r % (32 * 16); d.kb = q / 16; d.nb = q % 16;
            const int n0 = 32 * d.nb; d.drow = (n0 >> 7) * 256 + (n0 & 127) + (up ? 128 : 0);
            d.W = (up ? p.w_up : p.w_gate) + (size_t)mat * D * DEXP; d.K = D; d.N = DEXP; d.WT = Wgu_t + (size_t)mat * 2 * DEXP * D; return; } r -= I_G + I_U;
        { const int mat = r / (8 * 64), q = r % (8 * 64); d.kb = q / 64; d.nb = q % 64; d.W = p.w_down + (size_t)mat * DEXP * D; d.K = DEXP; d.N = D; d.WT = Wd_t + (size_t)mat * D * DEXP; d.drow = 32 * d.nb; }
    };
    {
        float ta[32], tb[32]; pg8::TDesc da, db;
        const int IT0 = part == 0 ? 0 : I_IN / 2, IT1 = part == 0 ? I_IN / 2 : NITEMS;
        int it = IT0 + gw;
        if (it < IT1) { decode(it, da); pg8::ti_load(ta, da, lane); }
#pragma unroll 1
        for (; it < IT1; it += 2 * NGW) {
            const bool hb = it + NGW < IT1;
            if (hb) { decode(it + NGW, db); pg8::ti_load(tb, db, lane); }
            pg8::ti_finish(ta, da, scr, lane);
            if (it + 2 * NGW < IT1) { decode(it + 2 * NGW, da); pg8::ti_load(ta, da, lane); }
            if (hb) pg8::ti_finish(tb, db, scr, lane);
        }
    }
    if (part == 1) { bf16_t* WR = (bf16_t*)(p.ws + WS_WR);
      for (int i0 = bidx * 512 + tid; i0 < DEPTH * 64 * D; i0 += 4 * nblk * 512) { float wv[4];
#pragma unroll
          for (int k = 0; k < 4; ++k) { const int i = i0 + k * nblk * 512; const int L = i / (64 * D), o = (i / D) % 64, d = i % D;
              wv[k] = i >= DEPTH * 64 * D ? 0.f : o < 4 ? p.w_rg[((size_t)L * D + d) * NGRP + o] : o < 36 ? p.w_re[((size_t)L * D + d) * NEXP + (o - 4)] : 0.f; }
#pragma unroll
          for (int k = 0; k < 4; ++k) { const int i = i0 + k * nblk * 512; if (i < DEPTH * 64 * D) { const int L = i / (64 * D), o = (i / D) % 64, d = i % D; const float w = wv[k];
              const unsigned hb = f2bf(w); const int ksl = d >> 8, sx = (d >> 4) & 15, hh = (d >> 3) & 1, j = d & 7, cb = o >> 5, ln = (o & 31) + 32 * hh;
              const size_t base = (((((size_t)L * 8 + ksl) * 16 + sx) * 2 + cb) * 2) * 512 + ln * 8 + j;
              WR[base] = (bf16_t)hb; WR[base + 512] = (bf16_t)f2bf(w - bf2f((bf16_t)hb)); } } } }
    bf16_t* xb = (bf16_t*)(p.ws + WS_XB2);
    if (part == 0) {
        const size_t NV = (size_t)T * D / 4, step = (size_t)nblk * 512;
        for (size_t i0 = (size_t)bidx * 512 + tid; i0 < NV; i0 += 8 * step) { f32x4 v[8];
#pragma unroll
            for (int k = 0; k < 8; ++k) { const size_t i = i0 + k * step; v[k] = i < NV ? __builtin_nontemporal_load((const f32x4*)p.x + i) : (f32x4){0.f, 0.f, 0.f, 0.f}; }
#pragma unroll
            for (int k = 0; k < 8; ++k) { const size_t i = i0 + k * step; if (i < NV) { u32x2 o; o.x = pg8::cvt_pk_bf16(v[k][0], v[k][1]); o.y = pg8::cvt_pk_bf16(v[k][2], v[k][3]); ((u32x2*)xb)[i] = o; } } }
    }
}

__device__ __forceinline__ void ln2_phase(const bf16_t* x, const bf16_t* Y, const float* lng, const float* lnb, bf16_t* xb, float* out, int vcu, int G) {
    const int tid = opaque_tid();
    int row = vcu * 8 + (tid >> 6);
    u32x4 nx[4], ny0[4], ny1[4];
    if (row < T) { const int lane = tid & 63;
#pragma unroll
        for (int j = 0; j < 4; ++j) { const int c = 8 * lane + 512 * j; nx[j] = __builtin_nontemporal_load((const u32x4*)(x + (size_t)row * D + c)); ny0[j] = __builtin_nontemporal_load((const u32x4*)(Y + (size_t)row * D + c)); ny1[j] = __builtin_nontemporal_load((const u32x4*)(Y + YPLANE + (size_t)row * D + c)); } }
    for (; row < T; row += G * 8) {
        const int lane = opaque_tid() & 63;
        f32x4 v[8]; float s = 0.f;
#pragma unroll
        for (int j = 0; j < 4; ++j) {
            v[2 * j] = bf4((u32x2){nx[j].x, nx[j].y}) * ALPHA + (bf4((u32x2){ny0[j].x, ny0[j].y}) + bf4((u32x2){ny1[j].x, ny1[j].y}));
            v[2 * j + 1] = bf4((u32x2){nx[j].z, nx[j].w}) * ALPHA + (bf4((u32x2){ny0[j].z, ny0[j].w}) + bf4((u32x2){ny1[j].z, ny1[j].w}));
            s += ((v[2 * j][0] + v[2 * j][1]) + (v[2 * j][2] + v[2 * j][3])) + ((v[2 * j + 1][0] + v[2 * j + 1][1]) + (v[2 * j + 1][2] + v[2 * j + 1][3])); }
        { const int rn = row + G * 8 < T ? row + G * 8 : row;
#pragma unroll
          for (int j = 0; j < 4; ++j) { const int c = 8 * lane + 512 * j; nx[j] = __builtin_nontemporal_load((const u32x4*)(x + (size_t)rn * D + c)); ny0[j] = __builtin_nontemporal_load((const u32x4*)(Y + (size_t)rn * D + c)); ny1[j] = __builtin_nontemporal_load((const u32x4*)(Y + YPLANE + (size_t)rn * D + c)); } }
        const float mean = wave_sum(s) * (1.f / D);
        float q = 0.f;
#pragma unroll
        for (int j = 0; j < 8; ++j) { v[j] = v[j] - mean; q += (v[j][0] * v[j][0] + v[j][1] * v[j][1]) + (v[j][2] * v[j][2] + v[j][3] * v[j][3]); }
        const float rstd = 1.0f / sqrtf(wave_sum(q) * (1.f / D) + LN_EPS);
#pragma unroll
        for (int j = 0; j < 4; ++j) { const int c = 8 * lane + 512 * j;
            const f32x4 g0 = *(const f32x4*)(lng + c), g1 = *(const f32x4*)(lng + c + 4), b0 = *(const f32x4*)(lnb + c), b1 = *(const f32x4*)(lnb + c + 4);
            const f32x4 o0 = v[2 * j] * rstd * g0 + b0, o1 = v[2 * j + 1] * rstd * g1 + b1;
            if (out) { *(f32x4*)(out + (size_t)row * D + c) = o0; *(f32x4*)(out + (size_t)row * D + c + 4) = o1; }
            else *(u32x4*)(xb + (size_t)row * D + c) = pg8::pack8(o0, o1); }
    }
}

typedef float f32x16 __attribute__((ext_vector_type(16)));
#define MFMA32(a, b, c) __builtin_amdgcn_mfma_f32_32x32x16_bf16((a), (b), (c), 0, 0, 0)
constexpr int RT_XLO = 0  , RT_RED = 0  , RT_LOG = 8 * 64 * 32 * 4, RT_BYTES = 32 * 4096;
__device__ __forceinline__ void ln_router_phase(LAS unsigned char* lds, const float* xin32, const bf16_t* xin16, const bf16_t* hm, const float* lng, const float* lnb, LAS int* lhist, bf16_t* xb,
                                                const bf16_t* WR, const float* brg, const float* bre, int* hist, int* inv, float* tg, int vcu, int G) {
    const int tid = opaque_tid(), lane = tid & 63, wid = __builtin_amdgcn_readfirstlane(tid >> 6);
    if (tid < 32) lhist[tid] = 0;
    {
        const int row0 = 32 * vcu + 4 * wid;
        u32x4 nx[4], nh[4]; f32x4 nf[8];
#define LN0_LOADROW(rr) do { const int lane_ = opaque_tid() & 63; _Pragma("unroll") for (int j = 0; j < 4; ++j) { const size_t go = (size_t)(row0 + (rr)) * D + 8 * lane_ + 512 * j; nh[j] = __builtin_nontemporal_load((const u32x4*)(hm + go)); \
            if (xin32) { nf[2 * j] = __builtin_nontemporal_load((const f32x4*)(xin32 + go)); nf[2 * j + 1] = __builtin_nontemporal_load((const f32x4*)(xin32 + go + 4)); } else nx[j] = __builtin_nontemporal_load((const u32x4*)(xin16 + go)); } } while (0)
        LN0_LOADROW(0);
#pragma unroll 1
        for (int r = 0; r < 4; ++r) {
            f32x4 v[8]; float s = 0.f;
#pragma unroll
            for (int j = 0; j < 4; ++j) {
                const f32x4 a0 = xin32 ? nf[2 * j] : bf4((u32x2){nx[j].x, nx[j].y}), a1 = xin32 ? nf[2 * j + 1] : bf4((u32x2){nx[j].z, nx[j].w});
                v[2 * j] = a0 * ALPHA + bf4((u32x2){nh[j].x, nh[j].y}); v[2 * j + 1] = a1 * ALPHA + bf4((u32x2){nh[j].z, nh[j].w});
                s += ((v[2 * j][0] + v[2 * j][1]) + (v[2 * j][2] + v[2 * j][3])) + ((v[2 * j + 1][0] + v[2 * j + 1][1]) + (v[2 * j + 1][2] + v[2 * j + 1][3])); }
            if (r < 3) LN0_LOADROW(r + 1);
            const float mean = wave_sum(s) * (1.f / D);
            float q = 0.f;
#pragma unroll
            for (int j = 0; j < 8; ++j) { v[j] = v[j] - mean; q += (v[j][0] * v[j][0] + v[j][1] * v[j][1]) + (v[j][2] * v[j][2] + v[j][3] * v[j][3]); }
            const float rstd = 1.0f / sqrtf(wave_sum(q) * (1.f / D) + LN_EPS);
#pragma unroll
            for (int j = 0; j < 4; ++j) { const int c = 8 * lane + 512 * j;
                const f32x4 g0 = *(const f32x4*)(lng + c), g1 = *(const f32x4*)(lng + c + 4), b0 = *(const f32x4*)(lnb + c), b1 = *(const f32x4*)(lnb + c + 4);
                const f32x4 o0 = v[2 * j] * rstd * g0 + b0, o1 = v[2 * j + 1] * rstd * g1 + b1;
                const u32x4 o = pg8::pack8(o0, o1); *(u32x4*)(xb + (size_t)(row0 + r) * D + c) = o;
                const f32x4 l0 = o0 - bf4((u32x2){o.x, o.y}), l1 = o1 - bf4((u32x2){o.z, o.w});
                { const int rl = 4 * wid + r; *(LAS u32x4*)(lds + RT_XLO + rl * 4096 + ((lane + 64 * j) ^ (rl & 15)) * 16) = pg8::pack8(l0, l1); } }
        }
#undef LN0_LOADROW
    }
    asm volatile("s_waitcnt vmcnt(0)" ::: "memory");
    __syncthreads();
    {
        const int r = lane & 31, h = lane >> 5;
        f32x16 acc0, acc1;
#pragma unroll
        for (int e = 0; e < 16; ++e) { acc0[e] = 0.f; acc1[e] = 0.f; }
        const size_t xo = (size_t)(32 * vcu + r) * D + 256 * wid + 8 * h;
#pragma unroll 8
        for (int sx = 0; sx < 16; ++sx) {
            const bf16x8 xh = *(const bf16x8*)(xb + xo + 16 * sx), xl = *(const LAS bf16x8*)(lds + RT_XLO + r * 4096 + ((32 * wid + 2 * sx + h) ^ (r & 15)) * 16);
            const bf16_t* wp = WR + (size_t)((wid * 16 + sx) * 4) * 512 + lane * 8;
            const bf16x8 w0h = *(const bf16x8*)(wp), w0l = *(const bf16x8*)(wp + 512), w1h = *(const bf16x8*)(wp + 1024), w1l = *(const bf16x8*)(wp + 1536);
            acc0 = MFMA32(xh, w0h, acc0); acc0 = MFMA32(xh, w0l, acc0); acc0 = MFMA32(xl, w0h, acc0);
            acc1 = MFMA32(xh, w1h, acc1); acc1 = MFMA32(xh, w1l, acc1); acc1 = MFMA32(xl, w1h, acc1);
        }
        lds_barrier();
        LAS float* red = (LAS float*)(lds + RT_RED);
#pragma unroll
        for (int g4 = 0; g4 < 4; ++g4) {
            *(LAS f32x4*)(red + ((wid * 64 + r) * 32 + 8 * g4 + 4 * h)) = (f32x4){acc0[4 * g4], acc0[4 * g4 + 1], acc0[4 * g4 + 2], acc0[4 * g4 + 3]};
            *(LAS f32x4*)(red + ((wid * 64 + 32 + r) * 32 + 8 * g4 + 4 * h)) = (f32x4){acc1[4 * g4], acc1[4 * g4 + 1], acc1[4 * g4 + 2], acc1[4 * g4 + 3]}; }
    }
    __syncthreads();
    {
        const LAS float* red = (const LAS float*)(lds + RT_RED); LAS float* lg = (LAS float*)(lds + RT_LOG);
#pragma unroll
        for (int i = 0; i < 4; ++i) { const int idx = tid + 512 * i, o = idx >> 5, row = idx & 31; float sum = o < 4 ? brg[o] : o < 36 ? bre[o - 4] : 0.f;
#pragma unroll
            for (int w2 = 0; w2 < 8; ++w2) sum += red[(w2 * 64 + o) * 32 + row];
            lg[row * 64 + o] = sum; }
    }
    __syncthreads();
    if (tid < 32) {
        const LAS float* lg = (const LAS float*)(lds + RT_LOG) + tid * 64;
        int grp = 0; float gmax = lg[0]; float glv[4]; glv[0] = gmax;
#pragma unroll
        for (int g = 1; g < 4; ++g) { glv[g] = lg[g]; if (glv[g] > gmax) { gmax = glv[g]; grp = g; } }
        float gden = 0.f;
#pragma unroll
        for (int g = 0; g < 4; ++g) gden += __expf(glv[g] - gmax);
        float v0 = -3.0e38f, v1 = -3.0e38f; int i0 = 0, i1 = 0;
#pragma unroll
        for (int e = 0; e < 8; ++e) { const float val = lg[4 + grp * 8 + e];
            if (val > v0) { v1 = v0; i1 = i0; v0 = val; i0 = e; } else if (val > v1) { v1 = val; i1 = e; } }
        const float e1 = __expf(v1 - v0), den = 1.f + e1, pg = 1.0f / gden;
        const int row = 32 * vcu + tid, ea = grp * 8 + i0, eb = grp * 8 + i1;
        const int pa = __hip_atomic_fetch_add(lhist + ea, 1, __ATOMIC_RELAXED, __HIP_MEMORY_SCOPE_WORKGROUP); inv[(vcu * 32 + ea) * 32 + pa] = row * 2; tg[row * 2] = pg / den;
        const int pb = __hip_atomic_fetch_add(lhist + eb, 1, __ATOMIC_RELAXED, __HIP_MEMORY_SCOPE_WORKGROUP); inv[(vcu * 32 + eb) * 32 + pb] = row * 2 + 1; tg[row * 2 + 1] = pg * e1 / den;
    }
    __syncthreads();
    if (tid < 32) hist[vcu * 32 + tid] = lhist[tid];
}

constexpr int KRS = 144, AT_K = 0, AT_V = 256 * KRS, AT_BIAS = 2 * 256 * KRS, AT_BYTES = AT_BIAS + 8 * 192 * 4;
constexpr float LOG2E = 1.4426950408889634f;
__device__ __forceinline__ int t5_bucket(int n) { if (n < 16) return n; int l = 16 + (int)(__logf((float)n * (1.f / 16.f)) / 2.0794415416798357f * 16.f); return l < 31 ? l : 31; }
__device__ __forceinline__ void attn_phase(LAS unsigned char* lds, const bf16_t* Qb, const bf16_t* Kc, const bf16_t* Vc, const float* sinks, const float* relb, bf16_t* Og, int vcu, int G) {
    const int tid = opaque_tid(), lane = tid & 63, wid = __builtin_amdgcn_readfirstlane(tid >> 6), r = lane & 31, h = lane >> 5;
    LAS float* biasT = (LAS float*)(lds + AT_BIAS);
    for (int unit = vcu; unit < BATCH * AT_HKV * (SEQ / 128); unit += G) {
        const int b = unit >> 6, kvh = (unit >> 4) & 3, qblk = unit & 15, hq = kvh * 8 + wid;
        const int row0 = b * SEQ + qblk * 128;
#pragma unroll
        for (int it = 0; it < 4; ++it) { const int id = tid + 512 * it, i = id >> 3, ck = id & 7;
            u32x4 kv = {0u, 0u, 0u, 0u}, vv = {0u, 0u, 0u, 0u};
            if (qblk > 0 || i >= 128) { const size_t go = (size_t)(row0 - 128 + i) * KVW + kvh * 64 + ck * 8; kv = *(const u32x4*)(Kc + go); vv = *(const u32x4*)(Vc + go); }
            *(LAS u32x4*)(lds + AT_K + i * KRS + ck * 16) = kv; *(LAS u32x4*)(lds + AT_V + i * KRS + ck * 16) = vv; }
        for (int id = tid; id < 8 * 192; id += 512) { const int w = id / 192, di = id - w * 192 - 32;
            biasT[id] = (di >= 0 && di < 128) ? relb[t5_bucket(di) * AT_HQ + kvh * 8 + w] * LOG2E : 0.f; }
        lds_barrier();
        const float sink = sinks[hq] * LOG2E;
        const int rh = r - 4 * h;
        const LAS float* bl = biasT + wid * 192 + 32 + 128 + rh;
        for (int qs = 0; qs < 4; ++qs) {
            bf16x8 qf[4]; { const bf16_t* qp = Qb + (size_t)(row0 + 32 * qs + r) * D + hq * 64 + 8 * h;
#pragma unroll
                for (int ks = 0; ks < 4; ++ks) qf[ks] = *(const bf16x8*)(qp + 16 * ks); }
            f32x16 S[5];
#pragma unroll
            for (int kbi = 0; kbi < 5; ++kbi) {
#pragma unroll
                for (int e = 0; e < 16; ++e) S[kbi][e] = 0.f;
#pragma unroll
                for (int ks = 0; ks < 4; ++ks) S[kbi] = MFMA32(*(const LAS bf16x8*)(lds + AT_K + (32 * (qs + kbi) + r) * KRS + (16 * ks + 8 * h) * 2), qf[ks], S[kbi]); }
            float m = -1e30f;
#pragma unroll
            for (int kbi = 0; kbi < 5; ++kbi) { const bool blk_ok = qblk > 0 || qs + kbi >= 4;
#pragma unroll
                for (int e = 0; e < 16; ++e) { constexpr int dummy = 0; (void)dummy; const int ce = (e & 3) + 8 * (e >> 2);
                    float sv = S[kbi][e] + bl[-32 * kbi - ce];
                    if (kbi == 0) sv = (rh < ce && blk_ok) ? sv : -1e30f; else if (kbi == 4) sv = (rh >= ce) ? sv : -1e30f; else sv = blk_ok ? sv : -1e30f;
                    S[kbi][e] = sv; m = fmaxf(m, sv); } }
            m = fmaxf(m, __shfl_xor(m, 32)); m = fmaxf(m, sink);
            float l = 0.f;
#pragma unroll
            for (int kbi = 0; kbi < 5; ++kbi)
#pragma unroll
                for (int e = 0; e < 16; ++e) { const float pv = __builtin_amdgcn_exp2f(S[kbi][e] - m); S[kbi][e] = pv; l += pv; }
            l += __shfl_xor(l, 32); l += __builtin_amdgcn_exp2f(sink - m);
            f32x16 O[2];
#pragma unroll
            for (int e = 0; e < 16; ++e) { O[0][e] = 0.f; O[1][e] = 0.f; }
            const int i16 = lane & 15, qq = i16 >> 2, pp = i16 & 3, gg = (lane >> 4) & 1;
#pragma unroll
            for (int kbi = 0; kbi < 5; ++kbi)
#pragma unroll
                for (int s2 = 0; s2 < 2; ++s2) {
                    u32x4 pk; pk.x = pg8::cvt_pk_bf16(S[kbi][8 * s2 + 0], S[kbi][8 * s2 + 1]); pk.y = pg8::cvt_pk_bf16(S[kbi][8 * s2 + 2], S[kbi][8 * s2 + 3]);
                    pk.z = pg8::cvt_pk_bf16(S[kbi][8 * s2 + 4], S[kbi][8 * s2 + 5]); pk.w = pg8::cvt_pk_bf16(S[kbi][8 * s2 + 6], S[kbi][8 * s2 + 7]);
                    const bf16x8 pf = __builtin_bit_cast(bf16x8, pk);
#pragma unroll
                    for (int db = 0; db < 2; ++db) { const LAS unsigned char* va = lds + AT_V + (32 * (qs + kbi) + 16 * s2 + 4 * h + qq) * KRS + (32 * db + 16 * gg + 4 * pp) * 2;
                        const s16x4 lo = __builtin_amdgcn_ds_read_tr16_b64_v4i16((lds_s16x4*)va), hi = __builtin_amdgcn_ds_read_tr16_b64_v4i16((lds_s16x4*)(va + 8 * KRS));
                        const bf16x8 vf = {lo[0], lo[1], lo[2], lo[3], hi[0], hi[1], hi[2], hi[3]};
                        O[db] = MFMA32(vf, pf, O[db]); } }
            const float inv = 1.0f / l;
            bf16_t* op = Og + (size_t)(row0 + 32 * qs + r) * D + hq * 64 + 4 * h;
#pragma unroll
            for (int db = 0; db < 2; ++db)
#pragma unroll
                for (int g4 = 0; g4 < 4; ++g4) { f32x4 v; v[0] = O[db][4 * g4] * inv; v[1] = O[db][4 * g4 + 1] * inv; v[2] = O[db][4 * g4 + 2] * inv; v[3] = O[db][4 * g4 + 3] * inv;
                    *(u32x2*)(op + 32 * db + 8 * g4) = pack4(v); }
        }
        lds_barrier();
    }
}

constexpr int LDS_STAGE = 0;
constexpr int LDS_MOETAB = pg8::STAGE_BYTES;
constexpr int LDS_MISC = LDS_MOETAB + pg8::MOE_TAB_INTS * 4;
constexpr int LDS_BYTES = 147456;
static_assert(WS_KB == WS_QB + (size_t)T * D * 2 + PADB && WS_VB == WS_KB + (size_t)T * D * 2 + PADB && WS_GT == WS_VB + (size_t)T * D * 2 + PADB, "EpiHgrn: four equally spaced [T][D] bf16 buffers");
static_assert(RT_BYTES <= pg8::STAGE_BYTES && LDS_MISC + 256 <= LDS_BYTES && H1_BYTES <= pg8::STAGE_BYTES && 8 * 8448 <= pg8::STAGE_BYTES && AT_BYTES <= pg8::STAGE_BYTES, "LDS map");
constexpr int CW_BAR = 4096;
constexpr int N_PHASES = 1 + NA * 8 + (DEPTH - NA) * 6;

#ifndef CVT_WG
#define CVT_WG 152
#endif
struct MegaArgs { const float* in[19]; float* out; unsigned char* ws; int ph_lo, ph_hi; };

__global__ void __launch_bounds__(512, 2) mega_fwd(MegaArgs args) {
    extern __shared__ __attribute__((aligned(16))) unsigned char lds_raw[];
    LAS unsigned char* lds = (LAS unsigned char*)lds_raw;
    volatile LAS unsigned* MISC = (volatile LAS unsigned*)(lds + LDS_MISC);
    const int tid = threadIdx.x, G = gridDim.x, bx = blockIdx.x, vcu = (G % 8 == 0) ? (bx % 8) * (G / 8) + bx / 8 : bx;
    unsigned char* const ws = args.ws;
    if (tid < 64) MISC[tid] = 0u;
    __syncthreads();
    const int lo = args.ph_lo, hi = args.ph_hi;
    XcdBarrier bar; bar.bar = (unsigned*)(ws + WS_CTL) + CW_BAR; bar.x = 0; bar.st = nullptr;
    if (hi - lo > 1) bar = xcd_barrier_post((unsigned*)(ws + WS_CTL) + CW_BAR, MISC + 8);
#define WSP(type, off) ((type*)(args.ws + (off)))
    int ph = 0;
#ifndef PROBE_DUP
#define PROBE_DUP 0
#endif
#define PHASE_T(dupbit, trash_body, ...) if (lo <= ph && ph < hi) { if ((PROBE_DUP >> (dupbit)) & 1) { trash_body; xcd_barrier(bar); } __VA_ARGS__; if (ph + 1 < hi) xcd_barrier(bar); } ++ph;
#define PHASE(dupbit, ...) if (lo <= ph && ph < hi) { __VA_ARGS__; if ((PROBE_DUP >> (dupbit)) & 1) { xcd_barrier(bar); __VA_ARGS__; } if (ph + 1 < hi) xcd_barrier(bar); } ++ph;

    PHASE(0, { Ptrs p; p.x = args.in[0]; p.a_w_in = args.in[1]; p.a_w_out = args.in[4]; p.b_w_kv = args.in[5]; p.b_w_q = args.in[6]; p.b_w_out = args.in[8]; p.w_gate = args.in[14]; p.w_up = args.in[15]; p.w_down = args.in[16]; p.w_rg = args.in[10]; p.w_re = args.in[12]; p.ws = args.ws;
               prologue_phase(lds, p, 0, vcu, G); })

    for (int L = 0; L < DEPTH; ++L) {
        if (L < NA) {
            PHASE(1, { if (L == 0 && bx >= G - CVT_WG) { Ptrs p; p.x = args.in[0]; p.a_w_in = args.in[1]; p.a_w_out = args.in[4]; p.b_w_kv = args.in[5]; p.b_w_q = args.in[6]; p.b_w_out = args.in[8]; p.w_gate = args.in[14]; p.w_up = args.in[15]; p.w_down = args.in[16]; p.w_rg = args.in[10]; p.w_re = args.in[12]; p.ws = args.ws;
                           prologue_phase(lds, p, 1, bx - (G - CVT_WG), CVT_WG); }
                       else { pg8::DenseSched S; S.init(T, 4 * D, D, L == 0 ? G - CVT_WG : G, bx); pg8::EpiHgrn E{WSP(bf16_t, WS_QB)};
                              pg8::gemm_phase<pg8::EpiHgrn, pg8::DenseSched>(lds, WSP(bf16_t, WS_XB2), WSP(bf16_t, WS_WIN) + (size_t)L * 4 * D * D, D, 0, S, E); } })
#define HGARGS HgArgs{WSP(bf16_t, WS_QB), WSP(bf16_t, WS_KB), WSP(bf16_t, WS_VB), WSP(bf16_t, WS_GT), WSP(bf16_t, WS_OF), WSP(bf16_t, WS_UT), WSP(bf16_t, WS_SST), WSP(bf16_t, WS_OG), WSP(bf16_t, WS_GL), WSP(float, WS_DG), args.in[3] + (size_t)L * D, WSP(bf16_t, WS_QB), args.in[2], L}
            PHASE_T(6, { HgArgs ha = HGARGS; ha.Qt = WSP(bf16_t, WS_TRASH); ha.OI = WSP(bf16_t, WS_TRASH + 32 * MiB); ha.UT = WSP(bf16_t, WS_TRASH + 64 * MiB); ha.Dg = WSP(float, WS_TRASH + 128 * MiB); h1_phase(lds, ha, vcu, G); },
                    { const HgArgs ha = HGARGS; h1_phase(lds, ha, vcu, G); })
            PHASE(8, { const HgArgs ha = HGARGS; h2_phase(ha, vcu, G); })
            PHASE(9, { const HgArgs ha = HGARGS; h3_phase(lds, ha, vcu, G); })
            PHASE(1, { pg8::DenseSched S; S.init(T, D, D, G, bx); pg8::EpiStore E{WSP(bf16_t, WS_HM), WSP(bf16_t, WS_HM), D, 1 << 30, 1.0f, 0};
                       pg8::gemm_phase<pg8::EpiStore, pg8::DenseSched>(lds, WSP(bf16_t, WS_OG), WSP(bf16_t, WS_WOUT) + (size_t)L * D * D, D, 0, S, E); })
        } else {
            const int j = L - NA;
            PHASE(1, { if (j == 0) { pg8::DenseHalfSched S; S.init(T, 2 * KVW, D, G, vcu); pg8::EpiStore E{WSP(bf16_t, WS_KC), WSP(bf16_t, WS_VC), KVW, 1, 1.0f, 0};
                                     pg8::gemm_phase<pg8::EpiStore, pg8::DenseHalfSched>(lds, WSP(bf16_t, WS_XB2), WSP(bf16_t, WS_WKV), D, 0, S, E); }
                       pg8::DenseSched S; S.init(T, D, D, G, bx); pg8::EpiStore E{WSP(bf16_t, WS_QB), WSP(bf16_t, WS_QB), D, 1 << 30, 0.125f * LOG2E, 0};
                       pg8::gemm_phase<pg8::EpiStore, pg8::DenseSched>(lds, WSP(bf16_t, WS_XB2), WSP(bf16_t, WS_WQ) + (size_t)j * D * D, D, 0, S, E); })
            PHASE(10, attn_phase(lds, WSP(bf16_t, WS_QB), WSP(bf16_t, WS_KC), WSP(bf16_t, WS_VC), args.in[7] + j * AT_HQ, args.in[9], WSP(bf16_t, WS_OG), vcu, G))
            PHASE(1, { pg8::DenseSched S; S.init(T, D, D, G, bx); pg8::EpiStore E{WSP(bf16_t, WS_HM), WSP(bf16_t, WS_HM), D, 1 << 30, 1.0f, 0};
                       pg8::gemm_phase<pg8::EpiStore, pg8::DenseSched>(lds, WSP(bf16_t, WS_OG), WSP(bf16_t, WS_WO) + (size_t)j * D * D, D, 0, S, E); })
        }
#define LN0_ARGS(XB, HIST, INV, TG) ln_router_phase(lds, L == 0 ? args.in[0] : nullptr, WSP(bf16_t, WS_XB2), WSP(bf16_t, WS_HM), args.in[17] + (size_t)(2 * L) * D, args.in[18] + (size_t)(2 * L) * D, (LAS int*)(lds + LDS_MISC + 64), XB, \
            WSP(bf16_t, WS_WR) + (size_t)L * 2 * 64 * D, args.in[11] + L * NGRP, args.in[13] + L * NEXP, HIST, INV, TG, vcu, G)
        PHASE_T(4, LN0_ARGS(WSP(bf16_t, WS_TRASH + 64 * MiB), WSP(int, WS_TRASH + 100 * MiB), WSP(int, WS_TRASH + 96 * MiB), WSP(float, WS_TRASH + 98 * MiB)),
                LN0_ARGS(WSP(bf16_t, WS_XB), WSP(int, WS_HIST), WSP(int, WS_LIST), WSP(float, WS_TG)))
#undef LN0_ARGS
#define MOE_TAB LAS int* tab = (LAS int*)(lds + LDS_MOETAB); const int TMt = tab[pg8::MT_FULL + 32] + tab[pg8::MT_TAIL + 32], U1 = TMt * 4, R2 = U1 > G ? U1 - G : 0, ET = TMt < G / 4 ? TMt : G / 4
#define MOE_GU(S) pg8::gemm_phase<pg8::EpiMoeH, pg8::MoeSched>(lds, WSP(bf16_t, WS_XB), WSP(bf16_t, WS_WGU) + (size_t)L * NEXP * 2 * DEXP * D, D, (size_t)2 * DEXP * D * 2, S, pg8::EpiMoeH{WSP(bf16_t, WS_HS), WSP(int, WS_SLOT), S, done})
#define MOE_DN(S) pg8::gemm_phase<pg8::EpiMoeY, pg8::MoeSched>(lds, WSP(bf16_t, WS_HS), WSP(bf16_t, WS_WD) + (size_t)L * NEXP * D * DEXP, DEXP, (size_t)D * DEXP * 2, S, pg8::EpiMoeY{WSP(bf16_t, WS_Y), tab})
        PHASE(2, { { LAS int* tab0 = (LAS int*)(lds + LDS_MOETAB); pg8::MoeSched S0{tab0, 4, G, vcu, D, 1, 0, 0}; S0.build_tables(tab0, (LAS int*)lds, WSP(int, WS_HIST)); }
                   MOE_TAB; unsigned* const done = WSP(unsigned, WS_CTL) + CW_DONE + L * 96 * 64;
                   { pg8::MoeSched S{tab, 4, G, vcu, D, 1, 0, U1}; S.build_rows(tab, (LAS int*)lds, WSP(int, WS_HIST), WSP(int, WS_LIST), true); MOE_GU(S); }
                   if (vcu < R2) { }
                   else { pg8::MoeSched S{tab, 8, G - R2, vcu - R2, DEXP, 0, 0, ET * 8}; moe_wait_tiles(S, done); S.build_slots(tab, WSP(int, WS_SLOT), WSP(float, WS_TG)); MOE_DN(S); }
                   {
                     const int NB = G - R2, rem = (ET * 8) % NB, cB = vcu < R2 ? (NB - rem) + vcu : (vcu - R2 >= rem ? vcu - R2 - rem : (NB - rem) + R2 + (vcu - R2));
                     pg8::MoeSched S{tab, 8, G, cB, DEXP, 0, ET * 8, TMt * 8}; moe_wait_tiles(S, done); S.build_slots(tab, WSP(int, WS_SLOT), WSP(float, WS_TG)); MOE_DN(S); } })
#undef MOE_TAB
#undef MOE_GU
#undef MOE_DN
        PHASE_T(5, ln2_phase(WSP(bf16_t, WS_XB), WSP(bf16_t, WS_Y), args.in[17] + (size_t)(2 * L + 1) * D, args.in[18] + (size_t)(2 * L + 1) * D, WSP(bf16_t, WS_TRASH), nullptr, vcu, G),
                ln2_phase(WSP(bf16_t, WS_XB), WSP(bf16_t, WS_Y), args.in[17] + (size_t)(2 * L + 1) * D, args.in[18] + (size_t)(2 * L + 1) * D, WSP(bf16_t, WS_XB2), L == DEPTH - 1 ? args.out : nullptr, vcu, G))
    }
#undef HGARGS
#undef WSP
#undef PHASE
#undef PHASE_T
}

#ifndef MK_PER_PHASE
#define MK_PER_PHASE 0
#endif
extern "C" void kernel_launch(void* const* d_in, const int* in_sizes, int n_in, void* d_out, int out_size, void* d_ws, size_t ws_size, hipStream_t stream) {
    static int grid = 0;
    if (grid == 0) {
        if (n_in != 19 || out_size != T * D || ws_size < (PROBE_DUP ? WS_END : WS_TRASH)) { fprintf(stderr, "kernel_launch: unexpected arguments (n_in %d, out %d, ws %zu < %zu)\n", n_in, out_size, ws_size, (size_t)WS_END); grid = -1; return; }
        int dev = 0, cus = 0, per_cu = 0;
        if (hipGetDevice(&dev) != hipSuccess || hipDeviceGetAttribute(&cus, hipDeviceAttributeMultiprocessorCount, dev) != hipSuccess) { grid = -1; return; }
        if (hipFuncSetAttribute((const void*)mega_fwd, hipFuncAttributeMaxDynamicSharedMemorySize, LDS_BYTES) != hipSuccess) { fprintf(stderr, "kernel_launch: hipFuncSetAttribute failed\n"); grid = -1; return; }
        if (hipOccupancyMaxActiveBlocksPerMultiprocessor(&per_cu, (const void*)mega_fwd, 512, LDS_BYTES) != hipSuccess || per_cu < 1) { fprintf(stderr, "kernel_launch: occupancy query reports %d\n", per_cu); }
        (void)hipGetLastError();
        grid = cus;
        if (grid != 256) { fprintf(stderr, "kernel_launch: built for 256 CUs (the routing tables assume 256 workgroups of 32 token rows); this device reports %d\n", cus); grid = -1; return; }
    }
    if (grid < 0) return;
    (void)hipMemsetAsync((char*)d_ws + WS_CTL, 0, CTL_BYTES, stream);
    MegaArgs a{};
    for (int i = 0; i < 19; ++i) a.in[i] = (const float*)d_in[i];
    a.out = (float*)d_out; a.ws = (unsigned char*)d_ws;
#if MK_PER_PHASE
    for (int ph = 0; ph < N_PHASES; ++ph) { a.ph_lo = ph; a.ph_hi = ph + 1; hipLaunchKernelGGL(mega_fwd, dim3(grid), dim3(512), LDS_BYTES, stream, a); }
#else
    a.ph_lo = 0; a.ph_hi = N_PHASES;
    hipLaunchKernelGGL(mega_fwd, dim3(grid), dim3(512), LDS_BYTES, stream, a);
#endif
}
```

```cpp
#include <hip/hip_runtime.h>
#include <cstdio>
#include <cstdint>

typedef unsigned short bf16_t;
typedef short bf16x8 __attribute__((ext_vector_type(8)));
typedef float f32x4 __attribute__((ext_vector_type(4)));

constexpr int BATCH = 4, SEQ = 2048, D = 2048, T = BATCH * SEQ, DEPTH = 4, NA = 2;
constexpr int HG_H = 16, HG_DK = 128;
constexpr int AT_HD = 64, AT_HQ = 32, AT_HKV = 4, AT_G = 8, KVW = AT_HKV * AT_HD;
constexpr int NGRP = 4, EPG = 8, NEXP = 32, DEXP = 512;
constexpr float ALPHA = 1.6817928305074290f;
constexpr float LN_EPS = 1e-5f, RMS_EPS = 1e-6f;

constexpr size_t MiB = 1u << 20;
constexpr size_t WS_CTL = 0, CTL_BYTES = 1 * MiB;
constexpr size_t UTS = 16384 + 128;
constexpr size_t PADB = 4352;
constexpr size_t WS_XF = 1 * MiB;
constexpr size_t WS_XB2 = WS_XF;
constexpr size_t WS_XB = WS_XF + 64 * MiB + PADB;
constexpr size_t WS_QB = WS_XB + 32 * MiB + PADB;
constexpr size_t WS_KB = WS_QB + 32 * MiB + PADB;
constexpr size_t WS_VB = WS_KB + 32 * MiB + PADB;
constexpr size_t WS_GT = WS_VB + 32 * MiB + PADB;
constexpr size_t WS_GL = WS_GT + 32 * MiB + PADB;
constexpr size_t WS_OF = WS_GL + 64 * MiB + PADB;
constexpr size_t WS_OG = WS_OF + 64 * MiB + PADB;
constexpr size_t WS_HM = WS_OG + 32 * MiB + PADB;
constexpr size_t WS_KC = WS_HM + 32 * MiB + PADB;
constexpr size_t WS_VC = WS_KC + 4 * MiB + PADB;
constexpr size_t WS_LIST = WS_VC + 4 * MiB + PADB;
constexpr size_t WS_TG = WS_LIST + 1 * MiB + PADB;
constexpr size_t WS_HS = WS_TG + 1 * MiB + PADB;
constexpr size_t WS_Y = WS_HS + 24 * MiB + PADB;
constexpr size_t WS_WIN = WS_Y + 64 * MiB + PADB;
constexpr size_t WS_WOUT = WS_WIN + 64 * MiB + PADB;
constexpr size_t WS_WKV = WS_WOUT + 16 * MiB + PADB;
constexpr size_t WS_WQ = WS_WKV + 2 * MiB + PADB;
constexpr size_t WS_WO = WS_WQ + 16 * MiB + PADB;
constexpr size_t WS_WGU = WS_WO + 16 * MiB + PADB;
constexpr size_t WS_WD = WS_WGU + 512 * MiB + PADB;
constexpr size_t WS_UT = WS_WD + 256 * MiB + PADB;
constexpr size_t WS_SST = WS_UT + 65 * MiB + PADB;
constexpr size_t WS_DG = WS_SST + 65 * MiB + PADB;
constexpr size_t WS_WR = WS_DG + 1 * MiB + PADB;
constexpr size_t WS_XF2 = WS_WR + 2 * MiB + PADB;
constexpr size_t WS_HIST = WS_XF2 + 64 * MiB + PADB;
constexpr size_t WS_SLOT = WS_HIST + 1 * MiB + PADB;
constexpr size_t WS_TRASH = WS_SLOT + 1 * MiB + PADB;
constexpr size_t WS_END = WS_TRASH + 256 * MiB;
constexpr int CW_CNT = 1024;

__device__ __forceinline__ unsigned f2bf(float f) { unsigned u = __builtin_bit_cast(unsigned, f); return (u + 0x7fffu + ((u >> 16) & 1u)) >> 16; }
__device__ __forceinline__ float bf2f(bf16_t b) { return __builtin_bit_cast(float, ((unsigned)b) << 16); }
typedef unsigned u32x2 __attribute__((ext_vector_type(2)));
__device__ __forceinline__ f32x4 bf4(const u32x2 w) { f32x4 r; r[0] = __builtin_bit_cast(float, w.x << 16); r[1] = __builtin_bit_cast(float, w.x & 0xffff0000u); r[2] = __builtin_bit_cast(float, w.y << 16); r[3] = __builtin_bit_cast(float, w.y & 0xffff0000u); return r; }
__device__ __forceinline__ float wave_sum(float v) {
#pragma unroll
    for (int o = 1; o < 64; o <<= 1) v += __shfl_xor(v, o);
    return v;
}
__device__ __forceinline__ float wave_max(float v) {
#pragma unroll
    for (int o = 1; o < 64; o <<= 1) v = fmaxf(v, __shfl_xor(v, o));
    return v;
}
__device__ __forceinline__ float sigmoidf_(float x) { return __builtin_amdgcn_rcpf(1.0f + __expf(-x)); }
__device__ __forceinline__ void lds_barrier() { asm volatile("s_waitcnt lgkmcnt(0)\n\ts_barrier" ::: "memory"); }
__device__ __forceinline__ int opaque_tid() { int t = threadIdx.x; asm volatile("" : "+v"(t)); return t; }

#define LAS __attribute__((address_space(3)))
typedef unsigned u32x4 __attribute__((ext_vector_type(4)));
namespace pg8 {
constexpr int BM = 256, BK = 64, HALF = 128, HTB = HALF * BK * 2, STAGE_BYTES = 8 * HTB;
__host__ __device__ __forceinline__ int lds_byte(int r, int c) { const int st = (r >> 4) * 2 + (c >> 5), rr = r & 15, cc = c & 31, ob = rr * 64 + cc * 2; return st * 1024 + (ob ^ (((ob >> 9) & 1) << 5)); }
__host__ __device__ __forceinline__ void stage_rc(int b, int& R, int& C) { const int st = b / 1024, sb = b % 1024, swz = sb ^ (((sb >> 9) & 1) << 5); R = (st >> 1) * 16 + swz / 64; C = (st & 1) * 32 + (swz % 64) / 2; }
__host__ __device__ __forceinline__ int perm32(int rho) { const int n = rho >> 4, i = rho & 15; return 8 * (i >> 2) + 4 * n + (i & 3); }
struct Unit { int r0, pn, e, rows, tm, ui; };
typedef float f32x2_ __attribute__((ext_vector_type(2)));
typedef __bf16 bf16x2_ __attribute__((ext_vector_type(2)));
__device__ __forceinline__ unsigned cvt_pk_bf16(float lo, float hi) { const f32x2_ v = {lo, hi}; return __builtin_bit_cast(unsigned, __builtin_convertvector(v, bf16x2_)); }

struct DenseSched {
    int nM, nN, nwg, G, c, K;
    __device__ __forceinline__ void init(int M, int N, int K_, int G_, int c_) { nM = M / BM; nN = N / BM; nwg = nM * nN; G = G_; c = c_; K = K_; }
    __device__ __forceinline__ bool next(int i, Unit& u) const {
        const long L = (long)i * G + c; if (L >= nwg) return false;
        int wgid = (int)L; { const int q = nwg / 8, r = nwg % 8, xcd = wgid % 8, off = wgid / 8; wgid = (xcd < r ? xcd * (q + 1) : r * (q + 1) + (xcd - r) * q) + off; }
        const int nig = 8 * nN, gid = wgid / nig, fm = gid * 8, gsz = (nM - fm) < 8 ? (nM - fm) : 8;
        u.r0 = (fm + ((wgid % nig) % gsz)) * BM; u.pn = (wgid % nig) / gsz; u.e = 0; u.rows = 256; u.tm = 0; u.ui = i; return true;
    }
    __device__ __forceinline__ unsigned a_off(const Unit& u, int half, int R) const { return (unsigned)((u.r0 + half * 128 + R) * K) * 2u; }
};
struct DenseHalfSched {
    int nN, nwg, G, c, K;
    __device__ __forceinline__ void init(int M, int N, int K_, int G_, int c_) { nN = N / BM; nwg = (M / HALF) * nN; G = G_; c = c_; K = K_; }
    __device__ __forceinline__ bool next(int i, Unit& u) const { const int L = i * G + c; if (L >= nwg) return false; u.r0 = (L / nN) * HALF; u.pn = L % nN; u.e = 0; u.rows = HALF; u.tm = 0; u.ui = i; return true; }
    __device__ __forceinline__ unsigned a_off(const Unit& u, int half, int R) const { return (unsigned)((u.r0 + half * 128 + R) * K) * 2u; }
};

template <class Epi, class Sched>
__device__ __forceinline__ void gemm_phase(LAS unsigned char* lds, const bf16_t* A, const bf16_t* Bt, int K, size_t bstride, const Sched& S, const Epi& E) {
    const int tid = opaque_tid(), wid = __builtin_amdgcn_readfirstlane(tid >> 6), lane = tid & 63, wr = wid >> 2, wc = wid & 3, fr = lane & 15, fq = lane >> 4;
    const int nt = K / BK;
    int sR[2], sC2[2]; unsigned voffB[2];
#pragma unroll
    for (int i = 0; i < 2; ++i) { int R, C; stage_rc(tid * 16 + i * 8192, R, C); const int Rb = (R & ~31) + perm32(R & 31); sR[i] = R; sC2[i] = C * 2; voffB[i] = (unsigned)(Rb * BK + C) * 2u; }
    const size_t kstep = (size_t)(BK * 2);
    const size_t hstep = (size_t)HALF * K * 2;
    const size_t kstepB = (size_t)BM * BK * 2, hstepB = (size_t)HALF * BK * 2;
    const size_t tstep = 2 * hstep;
    const unsigned ldsw = (unsigned)wid * 1024u;
    const int aoff = lds_byte(wr * 64 + fr, fq * 8), boff = lds_byte(wc * 32 + fr, fq * 8);
#define PG8_SA(b, h) (((b) * 2 + (h)) * HTB)
#define PG8_SB(b, h) ((4 + (b) * 2 + (h)) * HTB)
#define PG8_STAGE(bufoff, gbase, voff) do { _Pragma("unroll") for (int _i = 0; _i < 2; ++_i) \
        __builtin_amdgcn_global_load_lds((const unsigned*)((const char*)(gbase) + (voff)[_i]), (LAS unsigned*)(lds + (bufoff) + ldsw + _i * 8192), 16, 0, 0); } while (0)
#define PG8_LDA(dst, b, h) do { _Pragma("unroll") for (int m = 0; m < 4; ++m) _Pragma("unroll") for (int k = 0; k < 2; ++k) dst[m][k] = *(const LAS bf16x8*)(lds + PG8_SA(b, h) + aoff + m * 2048 + k * 1024); } while (0)
#define PG8_LDB(dst, b, h) do { _Pragma("unroll") for (int n = 0; n < 2; ++n) _Pragma("unroll") for (int k = 0; k < 2; ++k) dst[n][k] = *(const LAS bf16x8*)(lds + PG8_SB(b, h) + boff + n * 2048 + k * 1024); } while (0)
#define PG8_MMA(ai, bj, At, Bt_) do { __builtin_amdgcn_s_setprio(1); _Pragma("unroll") for (int m = 0; m < 4; ++m) _Pragma("unroll") for (int n = 0; n < 2; ++n) _Pragma("unroll") for (int k = 0; k < 2; ++k) \
        acc[ai][bj][m][n] = __builtin_amdgcn_mfma_f32_16x16x32_bf16(Bt_[n][k], At[m][k], acc[ai][bj][m][n], 0, 0, 0); __builtin_amdgcn_s_setprio(0); } while (0)
#define PG8_WAIT_V(n) asm volatile("s_waitcnt vmcnt(" #n ")" ::: "memory")
#define PG8_WAIT_L(n) asm volatile("s_waitcnt lgkmcnt(" #n ")" ::: "memory")
#define PG8_BAR __builtin_amdgcn_s_barrier()
#define PG8_SCHED __builtin_amdgcn_sched_barrier(0)
    Unit cur, nxt; int ui = 0;
    if (!S.next(0, cur)) return;
    f32x4 acc[2][2][4][2];
#pragma unroll
    for (int a = 0; a < 2; ++a)
#pragma unroll
        for (int b = 0; b < 2; ++b)
#pragma unroll
            for (int m = 0; m < 4; ++m)
#pragma unroll
                for (int n = 0; n < 2; ++n) acc[a][b][m][n] = (f32x4){0.f, 0.f, 0.f, 0.f};
    bf16x8 At[4][2], B0[2][2], B1[2][2];
    unsigned voffA0[2], voffA1[2];
#pragma unroll
    for (int i = 0; i < 2; ++i) { voffA0[i] = S.a_off(cur, 0, sR[i]) + sC2[i]; voffA1[i] = S.a_off(cur, 1, sR[i]) + sC2[i]; }
    const char* const Ab = (const char*)A;
    const char* cB = (const char*)Bt + (size_t)cur.e * bstride + (size_t)cur.pn * tstep;
    PG8_STAGE(PG8_SB(0, 0), cB, voffB); PG8_STAGE(PG8_SB(0, 1), cB + hstepB, voffB); PG8_STAGE(PG8_SA(0, 0), Ab, voffA0); PG8_STAGE(PG8_SA(0, 1), Ab, voffA1);
    if (wr == 1) PG8_BAR;
    PG8_WAIT_V(2); PG8_BAR;
    PG8_STAGE(PG8_SB(1, 0), cB + kstepB, voffB); PG8_STAGE(PG8_SA(1, 0), Ab + kstep, voffA0); PG8_STAGE(PG8_SB(1, 1), cB + hstepB + kstepB, voffB);
    PG8_WAIT_V(6); PG8_BAR;
    for (;;) {
        const bool has_next = S.next(ui + 1, nxt);
        const bool full = cur.rows > HALF;
        const char* nB = has_next ? (const char*)Bt + (size_t)nxt.e * bstride + (size_t)nxt.pn * tstep : cB;
        for (int t = 0; t < nt; t += 2) {
            const bool last = (t == nt - 2);
            const char* a1 = Ab + (size_t)(t + 1) * kstep;
            const char* a2 = last ? Ab : Ab + (size_t)(t + 2) * kstep; const char* b2 = last ? nB : cB + (size_t)(t + 2) * kstepB;
            const char* a3 = a2 + kstep; const char* b3 = b2 + kstepB;
            PG8_LDB(B0, 0, 0); PG8_LDB(B1, 0, 1); PG8_SCHED; PG8_LDA(At, 0, 0); PG8_STAGE(PG8_SA(1, 1), a1, voffA1);
            if (last && has_next) {
#pragma unroll
                for (int i = 0; i < 2; ++i) { voffA0[i] = S.a_off(nxt, 0, sR[i]) + sC2[i]; voffA1[i] = S.a_off(nxt, 1, sR[i]) + sC2[i]; }
            }
            PG8_WAIT_V(8); PG8_WAIT_L(0); PG8_BAR; PG8_MMA(0, 0, At, B0); PG8_MMA(0, 1, At, B1); PG8_BAR; PG8_SCHED;
            if (full) PG8_LDA(At, 0, 1); PG8_STAGE(PG8_SB(0, 0), b2, voffB); PG8_STAGE(PG8_SB(0, 1), b2 + hstepB, voffB); PG8_STAGE(PG8_SA(0, 0), a2, voffA0);
            PG8_WAIT_V(8); PG8_WAIT_L(0); PG8_BAR; if (full) { PG8_MMA(1, 0, At, B0); PG8_MMA(1, 1, At, B1); } PG8_BAR; PG8_SCHED;
            PG8_LDB(B0, 1, 0); PG8_LDB(B1, 1, 1); PG8_SCHED; PG8_LDA(At, 1, 0); PG8_STAGE(PG8_SA(0, 1), a2, voffA1);
            PG8_WAIT_V(8); PG8_WAIT_L(0); PG8_BAR; PG8_MMA(0, 0, At, B0); PG8_MMA(0, 1, At, B1); PG8_BAR; PG8_SCHED;
            if (full) PG8_LDA(At, 1, 1); PG8_STAGE(PG8_SB(1, 0), b3, voffB); PG8_STAGE(PG8_SB(1, 1), b3 + hstepB, voffB); PG8_STAGE(PG8_SA(1, 0), a3, voffA0);
            PG8_WAIT_V(8); PG8_WAIT_L(0); PG8_BAR; if (full) { PG8_MMA(1, 0, At, B0); PG8_MMA(1, 1, At, B1); } PG8_BAR; PG8_SCHED;
        }
        if (wr == 0) PG8_BAR;
        E(acc, cur, wr, wc, fr, fq);
        if (!has_next) break;
#pragma unroll
        for (int a = 0; a < 2; ++a)
#pragma unroll
            for (int b = 0; b < 2; ++b)
#pragma unroll
                for (int m = 0; m < 4; ++m)
#pragma unroll
                    for (int n = 0; n < 2; ++n) acc[a][b][m][n] = (f32x4){0.f, 0.f, 0.f, 0.f};
        cur = nxt; cB = nB; ++ui;
        if (wr == 1) PG8_BAR;
    }
    PG8_WAIT_V(0);
    PG8_BAR;
#undef PG8_SA
#undef PG8_SB
#undef PG8_STAGE
#undef PG8_LDA
#undef PG8_LDB
#undef PG8_MMA
#undef PG8_WAIT_V
#undef PG8_WAIT_L
#undef PG8_BAR
#undef PG8_SCHED
}

#define PG8_ROWS_COLS const int row0 = u.r0 + wr * 64 + fr; const int col0 = wc * 32 + 8 * fq
__device__ __forceinline__ u32x4 pack8(const f32x4 v0, const f32x4 v1) { u32x4 w; w.x = cvt_pk_bf16(v0[0], v0[1]); w.y = cvt_pk_bf16(v0[2], v0[3]); w.z = cvt_pk_bf16(v1[0], v1[1]); w.w = cvt_pk_bf16(v1[2], v1[3]); return w; }
struct EpiStore {
    bf16_t* O; bf16_t* O2; int ldc, split; float scale; int pad;
    __device__ __forceinline__ void operator()(const f32x4 (&acc)[2][2][4][2], const Unit& u, int wr, int wc, int fr, int fq) const {
        PG8_ROWS_COLS; bf16_t* base = u.pn >= split ? O2 + (size_t)(u.pn - split) * BM : O + (size_t)u.pn * BM;
#pragma unroll
        for (int ai = 0; ai < 2; ++ai) if (ai * HALF < u.rows)
#pragma unroll
            for (int m = 0; m < 4; ++m) { bf16_t* rowp = base + (size_t)(row0 + ai * HALF + m * 16) * ldc + col0;
#pragma unroll
                for (int bj = 0; bj < 2; ++bj) *(u32x4*)(rowp + bj * HALF) = pack8(acc[ai][bj][m][0] * scale, acc[ai][bj][m][1] * scale); }
    }
};
struct EpiHgrn {
    bf16_t* Qb;
    __device__ __forceinline__ void operator()(const f32x4 (&acc)[2][2][4][2], const Unit& u, int wr, int wc, int fr, int fq) const {
        PG8_ROWS_COLS; const int seg = u.pn >> 3, ct = (u.pn & 7) * BM + col0;
        bf16_t* base = Qb + (size_t)seg * ((size_t)T * D + PADB / 2) + ct;
#pragma unroll
        for (int ai = 0; ai < 2; ++ai)
#pragma unroll
            for (int m = 0; m < 4; ++m) { bf16_t* rowp = base + (size_t)(row0 + ai * HALF + m * 16) * D;
#pragma unroll
                for (int bj = 0; bj < 2; ++bj) *(u32x4*)(rowp + bj * HALF) = pack8(acc[ai][bj][m][0], acc[ai][bj][m][1]); }
    }
};


constexpr int MT_HL = 2048;
constexpr int MOE_MAXU = 4, MT_TILE = 0, MT_FULL = 40, MT_TAIL = 80, MT_CNT = 120, MT_ROWS = 160, MT_GATE = MT_ROWS + 256 * MOE_MAXU, MOE_TAB_INTS = MT_GATE + 256 * MOE_MAXU;
struct MoeSched {
    const LAS int* tab; int NT, G, c, K, gather, pos0, pos1;
    __device__ __forceinline__ int find_e(int base, int k) const {
        const int v = tab[base + 1 + (__lane_id() & 31)];
        return __popcll(__ballot(v <= k) & 0xffffffffull);
    }
    __device__ __forceinline__ bool next(int i, Unit& u) const {
        int L = pos0 + i * G + c; if (L >= pos1) return false; const int FT = tab[MT_FULL + 32] * NT; int e = 0, tm;
        if (L < FT) { const int k = L / NT; u.pn = L - k * NT; e = find_e(MT_FULL, k); tm = k - tab[MT_FULL + e]; }
        else { L -= FT; if (L >= tab[MT_TAIL + 32] * NT) return false; const int k = L / NT; u.pn = L - k * NT; e = find_e(MT_TAIL, k); tm = tab[MT_TILE + e + 1] - tab[MT_TILE + e] - 1; }
        u.r0 = (tab[MT_TILE + e] + tm) * 256; u.e = e; u.tm = tm; const int left = tab[MT_CNT + e] - 256 * tm; u.rows = left < 256 ? left : 256; u.ui = i; return true;
    }
    __device__ __forceinline__ int entry(const Unit& u, int r) const {
        const int a = tab[MT_ROWS + 256 * u.ui + r]; return a >= 0 ? a : tab[MT_ROWS + 256 * u.ui];
    }
    __device__ __forceinline__ unsigned a_off(const Unit& u, int half, int R) const {
        if (gather) return (unsigned)((entry(u, half * 128 + R) >> 1) * K) * 2u;
        return (unsigned)((u.r0 + half * 128 + R) * K) * 2u;
    }
    __device__ __forceinline__ void build_slots(LAS int* t, const int* slot_ent, const float* tg) const {
        const int tid = opaque_tid(), half = tid >> 8, t8 = tid & 255;
        for (int i0 = 0; i0 < MOE_MAXU; i0 += 2) { Unit u; if (!next(i0, u)) break; const bool ok = next(i0 + half, u);
            if (ok) { int a = 0; float g = 0.f; if (t8 < u.rows) { a = slot_ent[u.r0 + t8]; g = tg[a]; } t[MT_ROWS + 256 * (i0 + half) + t8] = a; ((LAS float*)t)[MT_GATE + 256 * (i0 + half) + t8] = g; } }
        __syncthreads();
    }
    __device__ __forceinline__ void build_tables(LAS int* t, LAS int* scr, const int* hist) const {
        const int tid = opaque_tid(), lane = tid & 63;
        { const int e = tid & 31, part = tid >> 5; int sum = 0;
#pragma unroll
          for (int b = part * 16; b < part * 16 + 16; ++b) { const int hv = hist[b * 32 + e]; sum += hv; scr[MT_HL + b * 32 + e] = hv; }
          scr[tid] = sum; }
        __syncthreads();
        if (tid < 64) { int cn = 0;
            if (lane < 32) {
#pragma unroll
                for (int part = 0; part < 16; ++part) cn += scr[part * 32 + lane]; }
            const int nt = (cn + 255) >> 8, tail = (nt > 0 && cn - 256 * (nt - 1) <= 128) ? 1 : 0;
            int p = nt, pf = nt - tail, pt = tail;
#pragma unroll
            for (int o = 1; o < 32; o <<= 1) { const int a = __shfl_up(p, o), b = __shfl_up(pf, o), c2 = __shfl_up(pt, o); if (lane >= o) { p += a; pf += b; pt += c2; } }
            if (lane < 32) { t[MT_CNT + lane] = cn; t[MT_TILE + lane] = p - nt; t[MT_FULL + lane] = pf - (nt - tail); t[MT_TAIL + lane] = pt - tail; }
            if (lane == 31) { t[MT_TILE + 32] = p; t[MT_FULL + 32] = pf; t[MT_TAIL + 32] = pt; } }
        __syncthreads();
    }
    __device__ __forceinline__ void build_rows(LAS int* t, LAS int* scr, const int* hist, const int* inv, bool from_lds = false) const {
        const int tid = opaque_tid(), lane = tid & 63, half = tid >> 8, t8 = tid & 255, wvh = (tid >> 6) & 3;
        LAS int* pre = scr + 512 + half * 264;
        for (int i0 = 0; i0 < MOE_MAXU; i0 += 2) { Unit u; const bool have = next(i0 + half, u);
            if (!next(i0, u) ) break;
            const bool ok = next(i0 + half, u);
            int hv = 0, incl = 0;
            if (ok) { hv = from_lds ? scr[MT_HL + t8 * 32 + u.e] : hist[t8 * 32 + u.e]; incl = hv;
#pragma unroll
                for (int o = 1; o < 64; o <<= 1) { const int tv = __shfl_up(incl, o); if (lane >= o) incl += tv; }
                if (lane == 63) scr[half * 8 + wvh] = incl; }
            __syncthreads();
            if (ok) { int off = 0; for (int w2 = 0; w2 < wvh; ++w2) off += scr[half * 8 + w2]; pre[t8] = off + incl - hv; if (t8 == 255) pre[256] = off + incl; }
            __syncthreads();
            if (ok) { const int pos = 256 * u.tm + t8; int ent = -1;
                if (pos < t[MT_CNT + u.e]) { int lo = 0, hi = 256;
                    while (hi - lo > 1) { const int mid = (lo + hi) >> 1; if (pre[mid] <= pos) lo = mid; else hi = mid; }
                    ent = inv[(lo * 32 + u.e) * 32 + (pos - pre[lo])]; }
                t[MT_ROWS + 256 * (i0 + half) + t8] = ent; }
            __syncthreads();
            (void)have;
        }
    }
};
struct EpiMoeH {
    bf16_t* Hs; int* slot_ent; MoeSched S; unsigned* done;
    __device__ __forceinline__ void operator()(const f32x4 (&acc)[2][2][4][2], const Unit& u, int wr, int wc, int fr, int fq) const {
        const int col0 = u.pn * 128 + wc * 32 + 8 * fq;
        asm volatile("" : "+v"(fr));
#pragma unroll
        for (int ai = 0; ai < 2; ++ai)
#pragma unroll
            for (int m = 0; m < 4; ++m) { const int rl = ai * HALF + wr * 64 + m * 16 + fr; f32x4 v[2];
#pragma unroll
                for (int n = 0; n < 2; ++n)
#pragma unroll
                    for (int j = 0; j < 4; ++j) { const float g = acc[ai][0][m][n][j]; v[n][j] = g * sigmoidf_(g) * acc[ai][1][m][n][j]; }
                if (rl < u.rows) { { const u32x4 w = pack8(v[0], v[1]); asm volatile("global_store_dwordx4 %0, %1, off sc1\n\ts_nop 0" :: "v"(Hs + (size_t)(u.r0 + rl) * DEXP + col0), "v"(w) : "memory"); }
                    if (u.pn == 0 && wc == 0 && fq == 0) __hip_atomic_store(slot_ent + u.r0 + rl, S.entry(u, rl), __ATOMIC_RELAXED, __HIP_MEMORY_SCOPE_AGENT); } }
        asm volatile("s_waitcnt vmcnt(0)" ::: "memory");
        __builtin_amdgcn_s_barrier();
        if (wr == 0 && wc == 0 && fr == 0 && fq == 0) (void)__hip_atomic_fetch_add(done + 64 * (u.r0 >> 8), 1u, __ATOMIC_RELAXED, __HIP_MEMORY_SCOPE_AGENT);
    }
};
struct EpiMoeY {
    bf16_t* Y; const LAS int* tab;
    __device__ __forceinline__ void operator()(const f32x4 (&acc)[2][2][4][2], const Unit& u, int wr, int wc, int fr, int fq) const {
        const int col0 = u.pn * BM + wc * 32 + 8 * fq;
#pragma unroll
        for (int ai = 0; ai < 2; ++ai)
#pragma unroll
            for (int m = 0; m < 4; ++m) { const int rl = ai * HALF + wr * 64 + m * 16 + fr;
                if (rl < u.rows) { const int a = tab[MT_ROWS + 256 * u.ui + rl]; const float g = ((const LAS float*)tab)[MT_GATE + 256 * u.ui + rl]; bf16_t* rowp = Y + (size_t)a * D + col0;
#pragma unroll
                    for (int bj = 0; bj < 2; ++bj) *(u32x4*)(rowp + bj * HALF) = pack8(acc[ai][bj][m][0] * g, acc[ai][bj][m][1] * g); } }
    }
};

struct TDesc { const float* W; bf16_t* WT; int K, N, drow, kb, nb; };
__device__ __forceinline__ void ti_load(float (&tmp)[32], const TDesc& d, int lane) {
    const float* src = d.W + (size_t)(64 * d.kb + (lane >> 5)) * d.N + 32 * d.nb + (lane & 31);
#pragma unroll
    for (int i = 0; i < 32; ++i) tmp[i] = __builtin_nontemporal_load(src + (size_t)(2 * i) * d.N);
}
__device__ __forceinline__ void ti_finish(const float (&tmp)[32], const TDesc& d, LAS float* scr, int lane) {
    const int k0 = 64 * d.kb;
#pragma unroll
    for (int i = 0; i < 32; ++i) scr[(2 * i + (lane >> 5)) * 33 + (lane & 31)] = tmp[i];
    asm volatile("s_waitcnt lgkmcnt(0)" ::: "memory");
    const int c = lane & 7;
#pragma unroll
    for (int j = 0; j < 4; ++j) { const int n = (lane >> 3) + 8 * j; const LAS float* sp = scr + (8 * c) * 33 + n;
        u32x4 o; o.x = cvt_pk_bf16(sp[0 * 33], sp[1 * 33]); o.y = cvt_pk_bf16(sp[2 * 33], sp[3 * 33]); o.z = cvt_pk_bf16(sp[4 * 33], sp[5 * 33]); o.w = cvt_pk_bf16(sp[6 * 33], sp[7 * 33]);
        const int R = d.drow + n;
        __builtin_nontemporal_store(o, (u32x4*)(d.WT + (size_t)(R >> 8) * 256 * d.K + (size_t)d.kb * (256 * 64) + (R & 255) * 64 + 8 * c)); }
    asm volatile("s_waitcnt lgkmcnt(0)" ::: "memory");
}
}

typedef short s16x4 __attribute__((ext_vector_type(4)));
typedef LAS s16x4 lds_s16x4;
constexpr int HRS = 272, ARS = 144;
constexpr int H1_QH = 0, H1_KH0 = H1_QH + 64 * HRS, H1_KH1 = H1_KH0 + 16 * HRS, H1_KH2 = H1_KH1 + 32 * HRS, H1_KH3 = H1_KH2 + 48 * HRS, H1_KT = H1_KH3 + 64 * HRS,
              H1_VS = H1_KT + 64 * HRS, H1_AS = H1_VS + 64 * HRS, H1_TOT = H1_AS + 64 * ARS, H1_BYTES = H1_TOT + 4096;
constexpr int NUNIT = BATCH * HG_H * (SEQ / 64);
__device__ __forceinline__ bf16x8 tr_frag16(const LAS unsigned char* tile, int rs, int r0, int c0, int lane) {
    const int g = lane >> 4, i = lane & 15, q = i >> 2, p = i & 3;
    const LAS unsigned char* a = tile + (r0 + 8 * g + q) * rs + (c0 + 4 * p) * 2;
    const s16x4 lo = __builtin_amdgcn_ds_read_tr16_b64_v4i16((lds_s16x4*)a);
    const s16x4 hi = __builtin_amdgcn_ds_read_tr16_b64_v4i16((lds_s16x4*)(a + 4 * rs));
    return (bf16x8){lo[0], lo[1], lo[2], lo[3], hi[0], hi[1], hi[2], hi[3]};
}
__device__ __forceinline__ bf16x8 row_frag16(const LAS unsigned char* tile, int rs, int r0, int c0, int lane) {
    return *(const LAS bf16x8*)(tile + (r0 + (lane & 15)) * rs + (c0 + 8 * (lane >> 4)) * 2);
}
#define MFMA16(a, b, c) __builtin_amdgcn_mfma_f32_16x16x32_bf16((a), (b), (c), 0, 0, 0)
__device__ __forceinline__ u32x2 pack4(const f32x4 v) { u32x2 r; r.x = pg8::cvt_pk_bf16(v[0], v[1]); r.y = pg8::cvt_pk_bf16(v[2], v[3]); return r; }

struct HgArgs { bf16_t *Qb, *Kb, *Vb, *Gt, *OI, *UT, *Sst, *Og; bf16_t* Gl; float* Dg; const float* ng; bf16_t* Qt; const float* lbraw; int layer; };

typedef float f32x2 __attribute__((ext_vector_type(2)));
__device__ __forceinline__ f32x2 exp2v(const f32x2 x) { f32x2 r; r.x = __builtin_amdgcn_exp2f(x.x); r.y = __builtin_amdgcn_exp2f(x.y); return r; }
__device__ __forceinline__ f32x2 bf2v(unsigned w) { f32x2 r; r.x = __builtin_bit_cast(float, w << 16); r.y = __builtin_bit_cast(float, w & 0xffff0000u); return r; }
__device__ __forceinline__ unsigned v2bf(const f32x2 v) { return pg8::cvt_pk_bf16(v.x, v.y); }
struct H1In { unsigned g[8], q[8]; u32x4 v[2]; };
__device__ __forceinline__ void h1_load(H1In& in, const HgArgs& a, int unit, int tid) {
    const int bh = unit >> 5, c = unit & 31, b = bh >> 4, h = bh & 15, cp = tid & 63, tq = tid >> 6;
    const size_t gbase = ((size_t)b * SEQ + c * 64) * D + h * 128;
#pragma unroll
    for (int i = 0; i < 8; ++i) { const size_t go = gbase + (size_t)(8 * tq + i) * D + 2 * cp; in.g[i] = *(const unsigned*)(a.Kb + go); in.q[i] = *(const unsigned*)(a.Qb + go); }
#pragma unroll
    for (int i = 0; i < 2; ++i) { const int id = tid + 512 * i, r = id >> 4, ck = id & 15; in.v[i] = *(const u32x4*)(a.Vb + gbase + (size_t)r * D + ck * 8); }
}
__device__ __forceinline__ int h1_unit_of(int p) { const int b = p >> 9, c = (p >> 4) & 31, h = p & 15; return ((b * 16 + h) << 5) + c; }
__device__ __forceinline__ int h3_pair_of(int p) { const int b = p >> 8, c2 = (p >> 4) & 15, h = p & 15; return ((b * 16 + h) << 4) + c2; }
__device__ __forceinline__ void h1_phase(LAS unsigned char* lds, const HgArgs& a, int vcu, int G) {
    const int tid = opaque_tid(), lane = tid & 63, wid = __builtin_amdgcn_readfirstlane(tid >> 6);
    const int cp = lane, tq = wid, J = wid >> 1, half = wid & 1;
    LAS f32x2* tot8 = (LAS f32x2*)(lds + H1_TOT);
    H1In in;
    if (vcu < NUNIT) h1_load(in, a, h1_unit_of(vcu), tid);
    for (int pu = vcu; pu < NUNIT; pu += G) { const int unit = h1_unit_of(pu);
        const int bh = unit >> 5, c = unit & 31, b = bh >> 4, h = bh & 15;
        const size_t gbase = ((size_t)b * SEQ + c * 64) * D + h * 128;
        f32x2 L[8], kk[8]; { f32x2 l = {0.f, 0.f}; f32x2 lb = {0.f, 0.f};
            if (a.layer != 0) { const int cch = h * 128 + 2 * cp; lb.x = sigmoidf_(a.lbraw[D + cch] - a.lbraw[cch]); lb.y = sigmoidf_(a.lbraw[D + cch + 1] - a.lbraw[cch + 1]); }
            const f32x2 omlb = (f32x2){1.f, 1.f} - lb;
#pragma unroll
            for (int i = 0; i < 8; ++i) { const f32x2 x = bf2v(in.g[i]); f32x2 sg; sg.x = sigmoidf_(x.x); sg.y = sigmoidf_(x.y);
                const f32x2 f = lb + omlb * sg; kk[i] = omlb * ((f32x2){1.f, 1.f} - sg);
                l.x += __log2f(fmaxf(f.x, 1e-30f)); l.y += __log2f(fmaxf(f.y, 1e-30f)); L[i] = l; } }
        tot8[tq * 64 + cp] = L[7];
#pragma unroll
        for (int i = 0; i < 2; ++i) { const int id = tid + 512 * i, r = id >> 4, ck = id & 15; *(LAS u32x4*)(lds + H1_VS + r * HRS + ck * 16) = in.v[i]; }
        for (int id = tid; id < 64 * ARS / 16; id += 512) *(LAS u32x4*)(lds + H1_AS + id * 16) = (u32x4){0u, 0u, 0u, 0u};
        lds_barrier();
        H1In in2; if (pu + G < NUNIT) h1_load(in2, a, h1_unit_of(pu + G), tid);
        f32x2 tj[4];
#pragma unroll
        for (int M = 0; M < 4; ++M) tj[M] = tot8[(2 * M) * 64 + cp] + tot8[(2 * M + 1) * 64 + cp];
        f32x2 off = {0.f, 0.f}; if (half) off = tot8[(tq - 1) * 64 + cp];
        f32x2 aJ = {0.f, 0.f};
#pragma unroll
        for (int M = 0; M < 3; ++M) if (M < J) aJ += tj[M];
        const f32x2 PA = exp2v(aJ), L15 = tj[J == 0 ? 0 : J == 1 ? 1 : J == 2 ? 2 : 3];
        f32x2 cI[5];
#pragma unroll
        for (int I = 1; I <= 4; ++I) { f32x2 sx = {0.f, 0.f};
#pragma unroll
            for (int M = 1; M < 4; ++M) if (M > J && M < I) sx += tj[M];
            cI[I] = exp2v(sx); }
        const int khJ = J == 0 ? H1_KH0 : J == 1 ? H1_KH1 : J == 2 ? H1_KH2 : H1_KH3;
#pragma unroll
        for (int i = 0; i < 8; ++i) {
            const int t = 8 * tq + i; const int lo = t * HRS + cp * 4;
            const f32x2 q = bf2v(in.q[i]), k = kk[i], Li = L[i] + off;
            const f32x2 ep = exp2v(Li), nl = -Li, en = exp2v((f32x2){fminf(nl.x, 80.f), fminf(nl.y, 80.f)}), rem = exp2v(L15 - Li);
            const f32x2 qh = q * ep, kr = k * rem;
            *(LAS unsigned*)(lds + H1_QH + lo) = v2bf(qh);
            *(unsigned*)(a.Qt + gbase + (size_t)t * D + 2 * cp) = v2bf(qh * PA);
            *(LAS unsigned*)(lds + khJ + lo) = v2bf(k * en);
#pragma unroll
            for (int I = 1; I <= 4; ++I) if (I > J) { constexpr int offs[5] = {H1_KH0, H1_KH1, H1_KH2, H1_KH3, H1_KT}; *(LAS unsigned*)(lds + offs[I] + lo) = v2bf(kr * cI[I]); }
        }
        if (J == 0 && half == 0) *(f32x2*)(a.Dg + (size_t)unit * 128 + 2 * cp) = exp2v((tj[0] + tj[1]) + (tj[2] + tj[3]));
        lds_barrier();
        for (int blk = wid; blk < 10; blk += 8) {
            const int I = blk < 1 ? 0 : blk < 3 ? 1 : blk < 6 ? 2 : 3, Jb = blk - (I * (I + 1)) / 2;
            const int khI = I == 0 ? H1_KH0 : I == 1 ? H1_KH1 : I == 2 ? H1_KH2 : H1_KH3;
            f32x4 acc = {0.f, 0.f, 0.f, 0.f};
#pragma unroll
            for (int ks = 0; ks < 4; ++ks) acc = MFMA16(row_frag16(lds + khI, HRS, 16 * Jb, 32 * ks, lane), row_frag16(lds + H1_QH, HRS, 16 * I, 32 * ks, lane), acc);
            const int tl = 16 * I + (lane & 15), s0 = 16 * Jb + 4 * (lane >> 4);
#pragma unroll
            for (int r = 0; r < 4; ++r) if (s0 + r > tl) acc[r] = 0.f;
            *(LAS u32x2*)(lds + H1_AS + tl * ARS + s0 * 2) = pack4(acc);
        }
        lds_barrier();
        {
            bf16x8 vtr[2];
#pragma unroll
            for (int ks = 0; ks < 2; ++ks) vtr[ks] = tr_frag16(lds + H1_VS, HRS, 32 * ks, 16 * wid, lane);
#pragma unroll
            for (int rb = 0; rb < 4; ++rb) { f32x4 acc = {0.f, 0.f, 0.f, 0.f};
#pragma unroll
                for (int ks = 0; ks < 2; ++ks) if (!(ks == 1 && rb < 2)) acc = MFMA16(vtr[ks], row_frag16(lds + H1_AS, ARS, 16 * rb, 32 * ks, lane), acc);
                *(u32x2*)(a.OI + gbase + (size_t)(16 * rb + (lane & 15)) * D + 16 * wid + 4 * (lane >> 4)) = pack4(acc); }
#pragma unroll
            for (int cb = 0; cb < 8; ++cb) { f32x4 acc = {0.f, 0.f, 0.f, 0.f};
#pragma unroll
                for (int ks = 0; ks < 2; ++ks) acc = MFMA16(tr_frag16(lds + H1_KT, HRS, 32 * ks, 16 * cb, lane), vtr[ks], acc);
                *(u32x2*)(a.UT + (size_t)unit * UTS + (16 * wid + (lane & 15)) * 128 + 16 * cb + 4 * (lane >> 4)) = pack4(acc); }
        }
        lds_barrier();
        in = in2;
    }
}
__device__ __forceinline__ void h2_phase(const HgArgs& a, int vcu, int G) {
    for (int item = vcu * 512 + opaque_tid(); item < BATCH * HG_H * 2048; item += G * 512) {
        const int bh = item >> 11, vec = item & 2047, ch0 = (vec & 15) * 8;
        f32x4 s0 = {0.f, 0.f, 0.f, 0.f}, s1 = {0.f, 0.f, 0.f, 0.f};
#pragma unroll 1
        for (int c0 = 0; c0 < 32; c0 += 8) {
            u32x4 uu[8]; f32x4 d0[8], d1[8];
#pragma unroll
            for (int k = 0; k < 8; ++k) { const size_t u = (size_t)bh * 32 + c0 + k; uu[k] = __builtin_nontemporal_load((const u32x4*)(a.UT + u * UTS + vec * 8)); d0[k] = *(const f32x4*)(a.Dg + u * 128 + ch0); d1[k] = *(const f32x4*)(a.Dg + u * 128 + ch0 + 4); }
#pragma unroll
            for (int k = 0; k < 8; ++k) { const size_t u = (size_t)bh * 32 + c0 + k;
                *(u32x4*)(a.Sst + u * UTS + vec * 8) = pg8::pack8(s0, s1);
                u32x2 lo2, hi2; lo2.x = uu[k].x; lo2.y = uu[k].y; hi2.x = uu[k].z; hi2.y = uu[k].w;
                s0 = d0[k] * s0 + bf4(lo2); s1 = d1[k] * s1 + bf4(hi2); }
        }
    }
}
__device__ __forceinline__ void h3_phase(LAS unsigned char* lds, const HgArgs& a, int vcu, int G) {
    const int tid = opaque_tid(), lane = tid & 63, wid = __builtin_amdgcn_readfirstlane(tid >> 6), us = wid >> 2, rb = wid & 3, t4 = rb * 64 + lane;
    LAS unsigned char* tile = lds + us * (128 * HRS);
    u32x4 sreg[8];
    if (vcu < NUNIT / 2) { const bf16_t* sp = a.Sst + (size_t)(h3_pair_of(vcu) * 2 + us) * UTS;
#pragma unroll
        for (int i = 0; i < 8; ++i) sreg[i] = __builtin_nontemporal_load((const u32x4*)(sp + (t4 + 256 * i) * 8)); }
    for (int pp = vcu; pp < NUNIT / 2; pp += G) { const int pair = h3_pair_of(pp);
        const int unit = pair * 2 + us;
        const int bh = unit >> 5, c = unit & 31, b = bh >> 4, h = bh & 15;
        const size_t ro = ((size_t)b * SEQ + c * 64 + 16 * rb + (lane & 15)) * D + h * 128;
#pragma unroll
        for (int i = 0; i < 8; ++i) { const int id = t4 + 256 * i; *(LAS u32x4*)(tile + (id >> 4) * HRS + (id & 15) * 16) = sreg[i]; }
        lds_barrier();
        if (pp + G < NUNIT / 2) { const bf16_t* sp = a.Sst + (size_t)(h3_pair_of(pp + G) * 2 + us) * UTS;
#pragma unroll
            for (int i = 0; i < 8; ++i) sreg[i] = __builtin_nontemporal_load((const u32x4*)(sp + (t4 + 256 * i) * 8)); }
        bf16x8 qf[4];
#pragma unroll
        for (int ks = 0; ks < 4; ++ks) qf[ks] = *(const bf16x8*)(a.Qt + ro + 32 * ks + 8 * (lane >> 4));
        u32x2 oi[8], gt[8];
#pragma unroll
        for (int cb = 0; cb < 8; ++cb) { oi[cb] = *(const u32x2*)(a.OI + ro + 16 * cb + 4 * (lane >> 4)); gt[cb] = *(const u32x2*)(a.Gt + ro + 16 * cb + 4 * (lane >> 4)); }
        f32x4 o[8]; float ss = 0.f;
#pragma unroll
        for (int cb = 0; cb < 8; ++cb) { f32x4 acc = {0.f, 0.f, 0.f, 0.f};
#pragma unroll
            for (int ks = 0; ks < 4; ++ks) acc = MFMA16(row_frag16(tile, HRS, 16 * cb, 32 * ks, lane), qf[ks], acc);
            acc += bf4(oi[cb]);
            o[cb] = acc; ss += (acc[0] * acc[0] + acc[1] * acc[1]) + (acc[2] * acc[2] + acc[3] * acc[3]); }
        ss += __shfl_xor(ss, 16); ss += __shfl_xor(ss, 32);
        const float r = 1.0f / sqrtf(ss * (1.f / 128.f) + RMS_EPS);
#pragma unroll
        for (int cb = 0; cb < 8; ++cb) { const int vc = 16 * cb + 4 * (lane >> 4); const f32x4 g = *(const f32x4*)(a.ng + h * 128 + vc);
            f32x4 gs = bf4(gt[cb]);
#pragma unroll
            for (int j = 0; j < 4; ++j) gs[j] *= sigmoidf_(gs[j]);
            *(u32x2*)(a.Og + ro + vc) = pack4(o[cb] * r * g * gs); }
        lds_barrier();
    }
}

#define XB_TMO      128
#define XB_XCNT(j)  (256  + 64 * (j))
#define XB_XSUB(j)  (1280 + 64 * (j))
#define XB_XGEN(j)  (2304 + 64 * (j))
#define XB_TOP      3328
#define XB_TOPGEN   3392
#define XCD_BAR_WORDS 3456
#define XB_SPIN_CAP (1u << 18)
__device__ __forceinline__ unsigned xb_ld(unsigned* p)              { return __hip_atomic_load(p, __ATOMIC_RELAXED, __HIP_MEMORY_SCOPE_AGENT); }
__device__ __forceinline__ unsigned xb_add(unsigned* p, unsigned v) { return __hip_atomic_fetch_add(p, v, __ATOMIC_RELAXED, __HIP_MEMORY_SCOPE_AGENT); }
__device__ __forceinline__ unsigned xb_xcc_id() { return (unsigned)__builtin_amdgcn_s_getreg((3 << 11) | 20) & 0xFu; }
#define XB_SPIN(cond, bar) do { unsigned _sp = 0; while (cond) { __builtin_amdgcn_s_sleep(1); \
    if ((++_sp & 255u) == 0u) { if (xb_ld(&(bar)[XB_TMO])) break; if (_sp > XB_SPIN_CAP) { atomicAdd(&(bar)[XB_TMO], 1u); break; } } } } while (0)
struct XcdBarrier { unsigned* bar; unsigned x; volatile LAS unsigned* st; };
__device__ __forceinline__ XcdBarrier xcd_barrier_post(unsigned* bar, volatile LAS unsigned* st) {
    XcdBarrier b; b.bar = bar; b.x = xb_xcc_id(); b.st = st;
    if (threadIdx.x == 0) (void)xb_add(&bar[XB_XCNT(b.x)], 1u);
    return b;
}
__device__ __forceinline__ void xcd_barrier_complete(unsigned* bar, unsigned x, unsigned& nloc, unsigned& nx) {
    const unsigned G = gridDim.x * gridDim.y * gridDim.z;
    unsigned sum, cnt, mine, sp = 0u;
    for (;;) {
        sum = 0u; cnt = 0u; mine = 0u;
#pragma unroll
        for (unsigned j = 0; j < 16; ++j) { const unsigned c = xb_ld(&bar[XB_XCNT(j)]); sum += c; cnt += (c > 0u) ? 1u : 0u; mine = (j == x) ? c : mine; }
        if (sum == G) break;
        __builtin_amdgcn_s_sleep(1);
        if ((++sp & 255u) == 0u) { if (xb_ld(&bar[XB_TMO])) break; if (sp > XB_SPIN_CAP) { atomicAdd(&bar[XB_TMO], 1u); break; } }
    }
    nloc = mine > 0u ? mine : 1u; nx = cnt > 0u ? cnt : 1u;
}
__device__ __forceinline__ void xcd_barrier(const XcdBarrier& b) {
    asm volatile("s_waitcnt vmcnt(0)" ::: "memory");
    __syncthreads();
    if (threadIdx.x == 0) {
        unsigned* bar = b.bar;
        __builtin_amdgcn_s_waitcnt(0);
        unsigned nloc = b.st[0], nx = b.st[1];
        if (nloc == 0u) { xcd_barrier_complete(bar, b.x, nloc, nx); b.st[0] = nloc; b.st[1] = nx; }
        const unsigned old = xb_add(&bar[XB_XSUB(b.x)], 1u);
        const unsigned gen = old / nloc;
        if (old + 1u == (gen + 1u) * nloc) {
            __builtin_amdgcn_fence(__ATOMIC_RELEASE, "agent");
            asm volatile("s_waitcnt vmcnt(0)" ::: "memory");
            const unsigned og = xb_add(&bar[XB_TOP], 1u);
            const unsigned tg = og / nx;
            if (og + 1u == (tg + 1u) * nx) xb_add(&bar[XB_TOPGEN], 1u);
            else XB_SPIN(xb_ld(&bar[XB_TOPGEN]) == tg, bar);
            __builtin_amdgcn_fence(__ATOMIC_ACQUIRE, "agent");
            xb_add(&bar[XB_XGEN(b.x)], 1u);
            asm volatile("s_waitcnt vmcnt(0)" ::: "memory");
        } else {
            XB_SPIN(xb_ld(&bar[XB_XGEN(b.x)]) == gen, bar);
            __builtin_amdgcn_fence(__ATOMIC_ACQUIRE, "agent");
            asm volatile("s_waitcnt vmcnt(0)" ::: "memory");
        }
    }
    __syncthreads();
}

constexpr int CW_DONE = 16384;
__device__ __forceinline__ void moe_wait_tiles(const pg8::MoeSched& S, unsigned* done) {
    if (threadIdx.x < 64) { pg8::Unit u; unsigned sp = 0; unsigned* f = done; bool mine = false;
        for (int i = 0; S.next(i, u); ++i) if ((int)threadIdx.x == i) { f = done + 64 * (u.r0 >> 8); mine = true; }
        for (;;) { bool wait = false; if (mine) wait = __hip_atomic_load(f, __ATOMIC_RELAXED, __HIP_MEMORY_SCOPE_AGENT) < 4u;
            if (!__any(wait)) break; __builtin_amdgcn_s_sleep(1); if (++sp > (1u << 20)) break; }
        __builtin_amdgcn_fence(__ATOMIC_ACQUIRE, "agent"); }
    __syncthreads();
}

struct Ptrs {
    const float *x, *a_w_in, *a_lb, *a_ng, *a_w_out, *b_w_kv, *b_w_q, *b_sinks, *b_w_out, *rel_bias, *w_rg, *b_rg, *w_re, *b_re, *w_gate, *w_up, *w_down, *ln_g, *ln_b;
    float* out; unsigned char* ws;
};
__device__ __forceinline__ void prologue_phase(LAS unsigned char* lds, const Ptrs& p, int part, int bidx, int nblk) {
    const int tid = opaque_tid(), lane = tid & 63, wave = __builtin_amdgcn_readfirstlane(tid >> 6);
    LAS float* scr = (LAS float*)(lds + wave * 8448);
    const int gw = bidx * 8 + wave, NGW = nblk * 8;
    bf16_t* Win_t = (bf16_t*)(p.ws + WS_WIN); bf16_t* Wout_t = (bf16_t*)(p.ws + WS_WOUT); bf16_t* Wkv_t = (bf16_t*)(p.ws + WS_WKV); bf16_t* Wq_t = (bf16_t*)(p.ws + WS_WQ); bf16_t* Wo_t = (bf16_t*)(p.ws + WS_WO);
    bf16_t* Wgu_t = (bf16_t*)(p.ws + WS_WGU); bf16_t* Wd_t = (bf16_t*)(p.ws + WS_WD);
    constexpr int I_IN = 2 * 32 * 256, I_AO = 2 * 32 * 64, I_KV = 32 * 16, I_Q = 2 * 32 * 64, I_O = 2 * 32 * 64, I_G = 128 * 32 * 16, I_U = I_G, I_D = 128 * 8 * 64;
    constexpr int NITEMS = I_IN + I_AO + I_KV + I_Q + I_O + I_G + I_U + I_D;
    auto decode = [&](int it, pg8::TDesc& d) {
        int r = it;
        if (r < I_IN) { const int mat = r / (32 * 256), q = r % (32 * 256); d.kb = q / 256; d.nb = q % 256; d.W = p.a_w_in + (size_t)mat * D * 4 * D; d.K = D; d.N = 4 * D; d.WT = Win_t + (size_t)mat * 4 * D * D; d.drow = 32 * d.nb; return; } r -= I_IN;
        if (r < I_AO) { const int mat = r / (32 * 64), q = r % (32 * 64); d.kb = q / 64; d.nb = q % 64; d.W = p.a_w_out + (size_t)mat * D * D; d.K = D; d.N = D; d.WT = Wout_t + (size_t)mat * D * D; d.drow = 32 * d.nb; return; } r -= I_AO;
        if (r < I_KV) { d.kb = r / 16; d.nb = r % 16; d.W = p.b_w_kv; d.K = D; d.N = 2 * KVW; d.WT = Wkv_t; d.drow = 32 * d.nb; return; } r -= I_KV;
        if (r < I_Q) { const int mat = r / (32 * 64), q = r % (32 * 64); d.kb = q / 64; d.nb = q % 64; d.W = p.b_w_q + (size_t)mat * D * D; d.K = D; d.N = D; d.WT = Wq_t + (size_t)mat * D * D; d.drow = 32 * d.nb; return; } r -= I_Q;
        if (r < I_O) { const int mat = r / (32 * 64), q = r % (32 * 64); d.kb = q / 64; d.nb = q % 64; d.W = p.b_w_out + (size_t)mat * D * D; d.K = D; d.N = D; d.WT = Wo_t + (size_t)mat * D * D; d.drow = 32 * d.nb; return; } r -= I_O;
        if (r < I_G + I_U) { const int up = r >= I_G; if (up) r -= I_G; const int mat = r / (32 * 16), q = r % (32 * 16); d.kb = q / 16; d.nb = q % 16;
            const int n0 = 32 * d.nb; d.drow = (n0 >> 7) * 256 + (n0 & 127) + (up ? 128 : 0);
            d.W = (up ? p.w_up : p.w_gate) + (size_t)mat * D * DEXP; d.K = D; d.N = DEXP; d.WT = Wgu_t + (size_t)mat * 2 * DEXP * D; return; } r -= I_G + I_U;
        { const int mat = r / (8 * 64), q = r % (8 * 64); d.kb = q / 64; d.nb = q % 64; d.W = p.w_down + (size_t)mat * DEXP * D; d.K = DEXP; d.N = D; d.WT = Wd_t + (size_t)mat * D * DEXP; d.drow = 32 * d.nb; }
    };
    {
        float ta[32], tb[32]; pg8::TDesc da, db;
        const int IT0 = part == 0 ? 0 : I_IN / 2, IT1 = part == 0 ? I_IN / 2 : NITEMS;
        int it = IT0 + gw;
        if (it < IT1) { decode(it, da); pg8::ti_load(ta, da, lane); }
#pragma unroll 1
        for (; it < IT1; it += 2 * NGW) {
            const bool hb = it + NGW < IT1;
            if (hb) { decode(it + NGW, db); pg8::ti_load(tb, db, lane); }
            pg8::ti_finish(ta, da, scr, lane);
            if (it + 2 * NGW < IT1) { decode(it + 2 * NGW, da); pg8::ti_load(ta, da, lane); }
            if (hb) pg8::ti_finish(tb, db, scr, lane);
        }
    }
    if (part == 1) { bf16_t* WR = (bf16_t*)(p.ws + WS_WR);
      for (int i0 = bidx * 512 + tid; i0 < DEPTH * 64 * D; i0 += 4 * nblk * 512) { float wv[4];
#pragma unroll
          for (int k = 0; k < 4; ++k) { const int i = i0 + k * nblk * 512; const int L = i / (64 * D), o = (i / D) % 64, d = i % D;
              wv[k] = i >= DEPTH * 64 * D ? 0.f : o < 4 ? p.w_rg[((size_t)L * D + d) * NGRP + o] : o < 36 ? p.w_re[((size_t)L * D + d) * NEXP + (o - 4)] : 0.f; }
#pragma unroll
          for (int k = 0; k < 4; ++k) { const int i = i0 + k * nblk * 512; if (i < DEPTH * 64 * D) { const int L = i / (64 * D), o = (i / D) % 64, d = i % D; const float w = wv[k];
              const unsigned hb = f2bf(w); const int ksl = d >> 8, sx = (d >> 4) & 15, hh = (d >> 3) & 1, j = d & 7, cb = o >> 5, ln = (o & 31) + 32 * hh;
              const size_t base = (((((size_t)L * 8 + ksl) * 16 + sx) * 2 + cb) * 2) * 512 + ln * 8 + j;
              WR[base] = (bf16_t)hb; WR[base + 512] = (bf16_t)f2bf(w - bf2f((bf16_t)hb)); } } } }
    bf16_t* xb = (bf16_t*)(p.ws + WS_XB2);
    if (part == 0) {
        const size_t NV = (size_t)T * D / 4, step = (size_t)nblk * 512;
        for (size_t i0 = (size_t)bidx * 512 + tid; i0 < NV; i0 += 8 * step) { f32x4 v[8];
#pragma unroll
            for (int k = 0; k < 8; ++k) { const size_t i = i0 + k * step; v[k] = i < NV ? __builtin_nontemporal_load((const f32x4*)p.x + i) : (f32x4){0.f, 0.f, 0.f, 0.f}; }
#pragma unroll
            for (int k = 0; k < 8; ++k) { const size_t i = i0 + k * step; if (i < NV) { u32x2 o; o.x = pg8::cvt_pk_bf16(v[k][0], v[k][1]); o.y = pg8::cvt_pk_bf16(v[k][2], v[k][3]); ((u32x2*)xb)[i] = o; } } }
    }
}

__device__ __forceinline__ void ln2_phase(const bf16_t* x, const bf16_t* Y, const float* lng, const float* lnb, bf16_t* xb, float* out, int vcu, int G) {
    const int tid = opaque_tid();
    int row = vcu * 8 + (tid >> 6);
    u32x4 nx[4], ny0[4], ny1[4];
    if (row < T) { const int lane = tid & 63;
#pragma unroll
        for (int j = 0; j < 4; ++j) { const int c = 8 * lane + 512 * j; nx[j] = __builtin_nontemporal_load((const u32x4*)(x + (size_t)row * D + c)); ny0[j] = __builtin_nontemporal_load((const u32x4*)(Y + (size_t)(row * 2) * D + c)); ny1[j] = __builtin_nontemporal_load((const u32x4*)(Y + (size_t)(row * 2 + 1) * D + c)); } }
    for (; row < T; row += G * 8) {
        const int lane = opaque_tid() & 63;
        f32x4 v[8]; float s = 0.f;
#pragma unroll
        for (int j = 0; j < 4; ++j) {
            v[2 * j] = bf4((u32x2){nx[j].x, nx[j].y}) * ALPHA + (bf4((u32x2){ny0[j].x, ny0[j].y}) + bf4((u32x2){ny1[j].x, ny1[j].y}));
            v[2 * j + 1] = bf4((u32x2){nx[j].z, nx[j].w}) * ALPHA + (bf4((u32x2){ny0[j].z, ny0[j].w}) + bf4((u32x2){ny1[j].z, ny1[j].w}));
            s += ((v[2 * j][0] + v[2 * j][1]) + (v[2 * j][2] + v[2 * j][3])) + ((v[2 * j + 1][0] + v[2 * j + 1][1]) + (v[2 * j + 1][2] + v[2 * j + 1][3])); }
        { const int rn = row + G * 8 < T ? row + G * 8 : row;
#pragma unroll
          for (int j = 0; j < 4; ++j) { const int c = 8 * lane + 512 * j; nx[j] = __builtin_nontemporal_load((const u32x4*)(x + (size_t)rn * D + c)); ny0[j] = __builtin_nontemporal_load((const u32x4*)(Y + (size_t)(rn * 2) * D + c)); ny1[j] = __builtin_nontemporal_load((const u32x4*)(Y + (size_t)(rn * 2 + 1) * D + c)); } }
        const float mean = wave_sum(s) * (1.f / D);
        float q = 0.f;
#pragma unroll
        for (int j = 0; j < 8; ++j) { v[j] = v[j] - mean; q += (v[j][0] * v[j][0] + v[j][1] * v[j][1]) + (v[j][2] * v[j][2] + v[j][3] * v[j][3]); }
        const float rstd = 1.0f / sqrtf(wave_sum(q) * (1.f / D) + LN_EPS);
#pragma unroll
        for (int j = 0; j < 4; ++j) { const int c = 8 * lane + 512 * j;
            const f32x4 g0 = *(const f32x4*)(lng + c), g1 = *(const f32x4*)(lng + c + 4), b0 = *(const f32x4*)(lnb + c), b1 = *(const f32x4*)(lnb + c + 4);
            const f32x4 o0 = v[2 * j] * rstd * g0 + b0, o1 = v[2 * j + 1] * rstd * g1 + b1;
            if (out) { *(f32x4*)(out + (size_t)row * D + c) = o0; *(f32x4*)(out + (size_t)row * D + c + 4) = o1; }
            else *(u32x4*)(xb + (size_t)row * D + c) = pg8::pack8(o0, o1); }
    }
}

typedef float f32x16 __attribute__((ext_vector_type(16)));
#define MFMA32(a, b, c) __builtin_amdgcn_mfma_f32_32x32x16_bf16((a), (b), (c), 0, 0, 0)
constexpr int RT_XLO = 0  , RT_RED = 0  , RT_LOG = 8 * 64 * 32 * 4, RT_BYTES = 32 * 4096;
__device__ __forceinline__ void ln_router_phase(LAS unsigned char* lds, const float* xin32, const bf16_t* xin16, const bf16_t* hm, const float* lng, const float* lnb, LAS int* lhist, bf16_t* xb,
                                                const bf16_t* WR, const float* brg, const float* bre, int* hist, int* inv, float* tg, int vcu, int G) {
    const int tid = opaque_tid(), lane = tid & 63, wid = __builtin_amdgcn_readfirstlane(tid >> 6);
    if (tid < 32) lhist[tid] = 0;
    {
        const int row0 = 32 * vcu + 4 * wid;
        u32x4 nx[4], nh[4]; f32x4 nf[8];
#define LN0_LOADROW(rr) do { const int lane_ = opaque_tid() & 63; _Pragma("unroll") for (int j = 0; j < 4; ++j) { const size_t go = (size_t)(row0 + (rr)) * D + 8 * lane_ + 512 * j; nh[j] = __builtin_nontemporal_load((const u32x4*)(hm + go)); \
            if (xin32) { nf[2 * j] = __builtin_nontemporal_load((const f32x4*)(xin32 + go)); nf[2 * j + 1] = __builtin_nontemporal_load((const f32x4*)(xin32 + go + 4)); } else nx[j] = __builtin_nontemporal_load((const u32x4*)(xin16 + go)); } } while (0)
        LN0_LOADROW(0);
#pragma unroll 1
        for (int r = 0; r < 4; ++r) {
            f32x4 v[8]; float s = 0.f;
#pragma unroll
            for (int j = 0; j < 4; ++j) {
                const f32x4 a0 = xin32 ? nf[2 * j] : bf4((u32x2){nx[j].x, nx[j].y}), a1 = xin32 ? nf[2 * j + 1] : bf4((u32x2){nx[j].z, nx[j].w});
                v[2 * j] = a0 * ALPHA + bf4((u32x2){nh[j].x, nh[j].y}); v[2 * j + 1] = a1 * ALPHA + bf4((u32x2){nh[j].z, nh[j].w});
                s += ((v[2 * j][0] + v[2 * j][1]) + (v[2 * j][2] + v[2 * j][3])) + ((v[2 * j + 1][0] + v[2 * j + 1][1]) + (v[2 * j + 1][2] + v[2 * j + 1][3])); }
            if (r < 3) LN0_LOADROW(r + 1);
            const float mean = wave_sum(s) * (1.f / D);
            float q = 0.f;
#pragma unroll
            for (int j = 0; j < 8; ++j) { v[j] = v[j] - mean; q += (v[j][0] * v[j][0] + v[j][1] * v[j][1]) + (v[j][2] * v[j][2] + v[j][3] * v[j][3]); }
            const float rstd = 1.0f / sqrtf(wave_sum(q) * (1.f / D) + LN_EPS);
#pragma unroll
            for (int j = 0; j < 4; ++j) { const int c = 8 * lane + 512 * j;
                const f32x4 g0 = *(const f32x4*)(lng + c), g1 = *(const f32x4*)(lng + c + 4), b0 = *(const f32x4*)(lnb + c), b1 = *(const f32x4*)(lnb + c + 4);
                const f32x4 o0 = v[2 * j] * rstd * g0 + b0, o1 = v[2 * j + 1] * rstd * g1 + b1;
                const u32x4 o = pg8::pack8(o0, o1); *(u32x4*)(xb + (size_t)(row0 + r) * D + c) = o;
                const f32x4 l0 = o0 - bf4((u32x2){o.x, o.y}), l1 = o1 - bf4((u32x2){o.z, o.w});
                { const int rl = 4 * wid + r; *(LAS u32x4*)(lds + RT_XLO + rl * 4096 + ((lane + 64 * j) ^ (rl & 15)) * 16) = pg8::pack8(l0, l1); } }
        }
#undef LN0_LOADROW
    }
    asm volatile("s_waitcnt vmcnt(0)" ::: "memory");
    __syncthreads();
    {
        const int r = lane & 31, h = lane >> 5;
        f32x16 acc0, acc1;
#pragma unroll
        for (int e = 0; e < 16; ++e) { acc0[e] = 0.f; acc1[e] = 0.f; }
        const size_t xo = (size_t)(32 * vcu + r) * D + 256 * wid + 8 * h;
#pragma unroll 8
        for (int sx = 0; sx < 16; ++sx) {
            const bf16x8 xh = *(const bf16x8*)(xb + xo + 16 * sx), xl = *(const LAS bf16x8*)(lds + RT_XLO + r * 4096 + ((32 * wid + 2 * sx + h) ^ (r & 15)) * 16);
            const bf16_t* wp = WR + (size_t)((wid * 16 + sx) * 4) * 512 + lane * 8;
            const bf16x8 w0h = *(const bf16x8*)(wp), w0l = *(const bf16x8*)(wp + 512), w1h = *(const bf16x8*)(wp + 1024), w1l = *(const bf16x8*)(wp + 1536);
            acc0 = MFMA32(xh, w0h, acc0); acc0 = MFMA32(xh, w0l, acc0); acc0 = MFMA32(xl, w0h, acc0);
            acc1 = MFMA32(xh, w1h, acc1); acc1 = MFMA32(xh, w1l, acc1); acc1 = MFMA32(xl, w1h, acc1);
        }
        lds_barrier();
        LAS float* red = (LAS float*)(lds + RT_RED);
#pragma unroll
        for (int g4 = 0; g4 < 4; ++g4) {
            *(LAS f32x4*)(red + ((wid * 64 + r) * 32 + 8 * g4 + 4 * h)) = (f32x4){acc0[4 * g4], acc0[4 * g4 + 1], acc0[4 * g4 + 2], acc0[4 * g4 + 3]};
            *(LAS f32x4*)(red + ((wid * 64 + 32 + r) * 32 + 8 * g4 + 4 * h)) = (f32x4){acc1[4 * g4], acc1[4 * g4 + 1], acc1[4 * g4 + 2], acc1[4 * g4 + 3]}; }
    }
    __syncthreads();
    {
        const LAS float* red = (const LAS float*)(lds + RT_RED); LAS float* lg = (LAS float*)(lds + RT_LOG);
#pragma unroll
        for (int i = 0; i < 4; ++i) { const int idx = tid + 512 * i, o = idx >> 5, row = idx & 31; float sum = o < 4 ? brg[o] : o < 36 ? bre[o - 4] : 0.f;
#pragma unroll
            for (int w2 = 0; w2 < 8; ++w2) sum += red[(w2 * 64 + o) * 32 + row];
            lg[row * 64 + o] = sum; }
    }
    __syncthreads();
    if (tid < 32) {
        const LAS float* lg = (const LAS float*)(lds + RT_LOG) + tid * 64;
        int grp = 0; float gmax = lg[0]; float glv[4]; glv[0] = gmax;
#pragma unroll
        for (int g = 1; g < 4; ++g) { glv[g] = lg[g]; if (glv[g] > gmax) { gmax = glv[g]; grp = g; } }
        float gden = 0.f;
#pragma unroll
        for (int g = 0; g < 4; ++g) gden += __expf(glv[g] - gmax);
        float v0 = -3.0e38f, v1 = -3.0e38f; int i0 = 0, i1 = 0;
#pragma unroll
        for (int e = 0; e < 8; ++e) { const float val = lg[4 + grp * 8 + e];
            if (val > v0) { v1 = v0; i1 = i0; v0 = val; i0 = e; } else if (val > v1) { v1 = val; i1 = e; } }
        const float e1 = __expf(v1 - v0), den = 1.f + e1, pg = 1.0f / gden;
        const int row = 32 * vcu + tid, ea = grp * 8 + i0, eb = grp * 8 + i1;
        const int pa = __hip_atomic_fetch_add(lhist + ea, 1, __ATOMIC_RELAXED, __HIP_MEMORY_SCOPE_WORKGROUP); inv[(vcu * 32 + ea) * 32 + pa] = row * 2; tg[row * 2] = pg / den;
        const int pb = __hip_atomic_fetch_add(lhist + eb, 1, __ATOMIC_RELAXED, __HIP_MEMORY_SCOPE_WORKGROUP); inv[(vcu * 32 + eb) * 32 + pb] = row * 2 + 1; tg[row * 2 + 1] = pg * e1 / den;
    }
    __syncthreads();
    if (tid < 32) hist[vcu * 32 + tid] = lhist[tid];
}

constexpr int KRS = 144, AT_K = 0, AT_V = 256 * KRS, AT_BIAS = 2 * 256 * KRS, AT_BYTES = AT_BIAS + 8 * 192 * 4;
constexpr float LOG2E = 1.4426950408889634f;
__device__ __forceinline__ int t5_bucket(int n) { if (n < 16) return n; int l = 16 + (int)(__logf((float)n * (1.f / 16.f)) / 2.0794415416798357f * 16.f); return l < 31 ? l : 31; }
__device__ __forceinline__ void attn_phase(LAS unsigned char* lds, const bf16_t* Qb, const bf16_t* Kc, const bf16_t* Vc, const float* sinks, const float* relb, bf16_t* Og, int vcu, int G) {
    const int tid = opaque_tid(), lane = tid & 63, wid = __builtin_amdgcn_readfirstlane(tid >> 6), r = lane & 31, h = lane >> 5;
    LAS float* biasT = (LAS float*)(lds + AT_BIAS);
    for (int unit = vcu; unit < BATCH * AT_HKV * (SEQ / 128); unit += G) {
        const int b = unit >> 6, kvh = (unit >> 4) & 3, qblk = unit & 15, hq = kvh * 8 + wid;
        const int row0 = b * SEQ + qblk * 128;
#pragma unroll
        for (int it = 0; it < 4; ++it) { const int id = tid + 512 * it, i = id >> 3, ck = id & 7;
            u32x4 kv = {0u, 0u, 0u, 0u}, vv = {0u, 0u, 0u, 0u};
            if (qblk > 0 || i >= 128) { const size_t go = (size_t)(row0 - 128 + i) * KVW + kvh * 64 + ck * 8; kv = *(const u32x4*)(Kc + go); vv = *(const u32x4*)(Vc + go); }
            *(LAS u32x4*)(lds + AT_K + i * KRS + ck * 16) = kv; *(LAS u32x4*)(lds + AT_V + i * KRS + ck * 16) = vv; }
        for (int id = tid; id < 8 * 192; id += 512) { const int w = id / 192, di = id - w * 192 - 32;
            biasT[id] = (di >= 0 && di < 128) ? relb[t5_bucket(di) * AT_HQ + kvh * 8 + w] * LOG2E : 0.f; }
        lds_barrier();
        const float sink = sinks[hq] * LOG2E;
        const int rh = r - 4 * h;
        const LAS float* bl = biasT + wid * 192 + 32 + 128 + rh;
        for (int qs = 0; qs < 4; ++qs) {
            bf16x8 qf[4]; { const bf16_t* qp = Qb + (size_t)(row0 + 32 * qs + r) * D + hq * 64 + 8 * h;
#pragma unroll
                for (int ks = 0; ks < 4; ++ks) qf[ks] = *(const bf16x8*)(qp + 16 * ks); }
            f32x16 S[5];
#pragma unroll
            for (int kbi = 0; kbi < 5; ++kbi) {
#pragma unroll
                for (int e = 0; e < 16; ++e) S[kbi][e] = 0.f;
#pragma unroll
                for (int ks = 0; ks < 4; ++ks) S[kbi] = MFMA32(*(const LAS bf16x8*)(lds + AT_K + (32 * (qs + kbi) + r) * KRS + (16 * ks + 8 * h) * 2), qf[ks], S[kbi]); }
            float m = -1e30f;
#pragma unroll
            for (int kbi = 0; kbi < 5; ++kbi) { const bool blk_ok = qblk > 0 || qs + kbi >= 4;
#pragma unroll
                for (int e = 0; e < 16; ++e) { constexpr int dummy = 0; (void)dummy; const int ce = (e & 3) + 8 * (e >> 2);
                    float sv = S[kbi][e] + bl[-32 * kbi - ce];
                    if (kbi == 0) sv = (rh < ce && blk_ok) ? sv : -1e30f; else if (kbi == 4) sv = (rh >= ce) ? sv : -1e30f; else sv = blk_ok ? sv : -1e30f;
                    S[kbi][e] = sv; m = fmaxf(m, sv); } }
            m = fmaxf(m, __shfl_xor(m, 32)); m = fmaxf(m, sink);
            float l = 0.f;
#pragma unroll
            for (int kbi = 0; kbi < 5; ++kbi)
#pragma unroll
                for (int e = 0; e < 16; ++e) { const float pv = __builtin_amdgcn_exp2f(S[kbi][e] - m); S[kbi][e] = pv; l += pv; }
            l += __shfl_xor(l, 32); l += __builtin_amdgcn_exp2f(sink - m);
            f32x16 O[2];
#pragma unroll
            for (int e = 0; e < 16; ++e) { O[0][e] = 0.f; O[1][e] = 0.f; }
            const int i16 = lane & 15, qq = i16 >> 2, pp = i16 & 3, gg = (lane >> 4) & 1;
#pragma unroll
            for (int kbi = 0; kbi < 5; ++kbi)
#pragma unroll
                for (int s2 = 0; s2 < 2; ++s2) {
                    u32x4 pk; pk.x = pg8::cvt_pk_bf16(S[kbi][8 * s2 + 0], S[kbi][8 * s2 + 1]); pk.y = pg8::cvt_pk_bf16(S[kbi][8 * s2 + 2], S[kbi][8 * s2 + 3]);
                    pk.z = pg8::cvt_pk_bf16(S[kbi][8 * s2 + 4], S[kbi][8 * s2 + 5]); pk.w = pg8::cvt_pk_bf16(S[kbi][8 * s2 + 6], S[kbi][8 * s2 + 7]);
                    const bf16x8 pf = __builtin_bit_cast(bf16x8, pk);
#pragma unroll
                    for (int db = 0; db < 2; ++db) { const LAS unsigned char* va = lds + AT_V + (32 * (qs + kbi) + 16 * s2 + 4 * h + qq) * KRS + (32 * db + 16 * gg + 4 * pp) * 2;
                        const s16x4 lo = __builtin_amdgcn_ds_read_tr16_b64_v4i16((lds_s16x4*)va), hi = __builtin_amdgcn_ds_read_tr16_b64_v4i16((lds_s16x4*)(va + 8 * KRS));
                        const bf16x8 vf = {lo[0], lo[1], lo[2], lo[3], hi[0], hi[1], hi[2], hi[3]};
                        O[db] = MFMA32(vf, pf, O[db]); } }
            const float inv = 1.0f / l;
            bf16_t* op = Og + (size_t)(row0 + 32 * qs + r) * D + hq * 64 + 4 * h;
#pragma unroll
            for (int db = 0; db < 2; ++db)
#pragma unroll
                for (int g4 = 0; g4 < 4; ++g4) { f32x4 v; v[0] = O[db][4 * g4] * inv; v[1] = O[db][4 * g4 + 1] * inv; v[2] = O[db][4 * g4 + 2] * inv; v[3] = O[db][4 * g4 + 3] * inv;
                    *(u32x2*)(op + 32 * db + 8 * g4) = pack4(v); }
        }
        lds_barrier();
    }
}

constexpr int LDS_STAGE = 0;
constexpr int LDS_MOETAB = pg8::STAGE_BYTES;
constexpr int LDS_MISC = LDS_MOETAB + pg8::MOE_TAB_INTS * 4;
constexpr int LDS_BYTES = 147456;
static_assert(WS_KB == WS_QB + (size_t)T * D * 2 + PADB && WS_VB == WS_KB + (size_t)T * D * 2 + PADB && WS_GT == WS_VB + (size_t)T * D * 2 + PADB, "EpiHgrn: four equally spaced [T][D] bf16 buffers");
static_assert(RT_BYTES <= pg8::STAGE_BYTES && LDS_MISC + 256 <= LDS_BYTES && H1_BYTES <= pg8::STAGE_BYTES && 8 * 8448 <= pg8::STAGE_BYTES && AT_BYTES <= pg8::STAGE_BYTES, "LDS map");
constexpr int CW_BAR = 4096;
constexpr int N_PHASES = 1 + NA * 8 + (DEPTH - NA) * 6;

#ifndef CVT_WG
#define CVT_WG 152
#endif
struct MegaArgs { const float* in[19]; float* out; unsigned char* ws; int ph_lo, ph_hi; };

__global__ void __launch_bounds__(512, 2) mega_fwd(MegaArgs args) {
    extern __shared__ __attribute__((aligned(16))) unsigned char lds_raw[];
    LAS unsigned char* lds = (LAS unsigned char*)lds_raw;
    volatile LAS unsigned* MISC = (volatile LAS unsigned*)(lds + LDS_MISC);
    const int tid = threadIdx.x, G = gridDim.x, bx = blockIdx.x, vcu = (G % 8 == 0) ? (bx % 8) * (G / 8) + bx / 8 : bx;
    unsigned char* const ws = args.ws;
    if (tid < 64) MISC[tid] = 0u;
    __syncthreads();
    const int lo = args.ph_lo, hi = args.ph_hi;
    XcdBarrier bar; bar.bar = (unsigned*)(ws + WS_CTL) + CW_BAR; bar.x = 0; bar.st = nullptr;
    if (hi - lo > 1) bar = xcd_barrier_post((unsigned*)(ws + WS_CTL) + CW_BAR, MISC + 8);
#define WSP(type, off) ((type*)(args.ws + (off)))
    int ph = 0;
#ifndef PROBE_DUP
#define PROBE_DUP 0
#endif
#define PHASE_T(dupbit, trash_body, ...) if (lo <= ph && ph < hi) { if ((PROBE_DUP >> (dupbit)) & 1) { trash_body; xcd_barrier(bar); } __VA_ARGS__; if (ph + 1 < hi) xcd_barrier(bar); } ++ph;
#define PHASE(dupbit, ...) if (lo <= ph && ph < hi) { __VA_ARGS__; if ((PROBE_DUP >> (dupbit)) & 1) { xcd_barrier(bar); __VA_ARGS__; } if (ph + 1 < hi) xcd_barrier(bar); } ++ph;

    PHASE(0, { Ptrs p; p.x = args.in[0]; p.a_w_in = args.in[1]; p.a_w_out = args.in[4]; p.b_w_kv = args.in[5]; p.b_w_q = args.in[6]; p.b_w_out = args.in[8]; p.w_gate = args.in[14]; p.w_up = args.in[15]; p.w_down = args.in[16]; p.w_rg = args.in[10]; p.w_re = args.in[12]; p.ws = args.ws;
               prologue_phase(lds, p, 0, vcu, G); })

    for (int L = 0; L < DEPTH; ++L) {
        if (L < NA) {
            PHASE(1, { if (L == 0 && bx >= G - CVT_WG) { Ptrs p; p.x = args.in[0]; p.a_w_in = args.in[1]; p.a_w_out = args.in[4]; p.b_w_kv = args.in[5]; p.b_w_q = args.in[6]; p.b_w_out = args.in[8]; p.w_gate = args.in[14]; p.w_up = args.in[15]; p.w_down = args.in[16]; p.w_rg = args.in[10]; p.w_re = args.in[12]; p.ws = args.ws;
                           prologue_phase(lds, p, 1, bx - (G - CVT_WG), CVT_WG); }
                       else { pg8::DenseSched S; S.init(T, 4 * D, D, L == 0 ? G - CVT_WG : G, bx); pg8::EpiHgrn E{WSP(bf16_t, WS_QB)};
                              pg8::gemm_phase<pg8::EpiHgrn, pg8::DenseSched>(lds, WSP(bf16_t, WS_XB2), WSP(bf16_t, WS_WIN) + (size_t)L * 4 * D * D, D, 0, S, E); } })
#define HGARGS HgArgs{WSP(bf16_t, WS_QB), WSP(bf16_t, WS_KB), WSP(bf16_t, WS_VB), WSP(bf16_t, WS_GT), WSP(bf16_t, WS_OF), WSP(bf16_t, WS_UT), WSP(bf16_t, WS_SST), WSP(bf16_t, WS_OG), WSP(bf16_t, WS_GL), WSP(float, WS_DG), args.in[3] + (size_t)L * D, WSP(bf16_t, WS_QB), args.in[2], L}
            PHASE_T(6, { HgArgs ha = HGARGS; ha.Qt = WSP(bf16_t, WS_TRASH); ha.OI = WSP(bf16_t, WS_TRASH + 32 * MiB); ha.UT = WSP(bf16_t, WS_TRASH + 64 * MiB); ha.Dg = WSP(float, WS_TRASH + 128 * MiB); h1_phase(lds, ha, vcu, G); },
                    { const HgArgs ha = HGARGS; h1_phase(lds, ha, vcu, G); })
            PHASE(8, { const HgArgs ha = HGARGS; h2_phase(ha, vcu, G); })
            PHASE(9, { const HgArgs ha = HGARGS; h3_phase(lds, ha, vcu, G); })
            PHASE(1, { pg8::DenseSched S; S.init(T, D, D, G, bx); pg8::EpiStore E{WSP(bf16_t, WS_HM), WSP(bf16_t, WS_HM), D, 1 << 30, 1.0f, 0};
                       pg8::gemm_phase<pg8::EpiStore, pg8::DenseSched>(lds, WSP(bf16_t, WS_OG), WSP(bf16_t, WS_WOUT) + (size_t)L * D * D, D, 0, S, E); })
        } else {
            const int j = L - NA;
            PHASE(1, { if (j == 0) { pg8::DenseHalfSched S; S.init(T, 2 * KVW, D, G, vcu); pg8::EpiStore E{WSP(bf16_t, WS_KC), WSP(bf16_t, WS_VC), KVW, 1, 1.0f, 0};
                                     pg8::gemm_phase<pg8::EpiStore, pg8::DenseHalfSched>(lds, WSP(bf16_t, WS_XB2), WSP(bf16_t, WS_WKV), D, 0, S, E); }
                       pg8::DenseSched S; S.init(T, D, D, G, bx); pg8::EpiStore E{WSP(bf16_t, WS_QB), WSP(bf16_t, WS_QB), D, 1 << 30, 0.125f * LOG2E, 0};
                       pg8::gemm_phase<pg8::EpiStore, pg8::DenseSched>(lds, WSP(bf16_t, WS_XB2), WSP(bf16_t, WS_WQ) + (size_t)j * D * D, D, 0, S, E); })
            PHASE(10, attn_phase(lds, WSP(bf16_t, WS_QB), WSP(bf16_t, WS_KC), WSP(bf16_t, WS_VC), args.in[7] + j * AT_HQ, args.in[9], WSP(bf16_t, WS_OG), vcu, G))
            PHASE(1, { pg8::DenseSched S; S.init(T, D, D, G, bx); pg8::EpiStore E{WSP(bf16_t, WS_HM), WSP(bf16_t, WS_HM), D, 1 << 30, 1.0f, 0};
                       pg8::gemm_phase<pg8::EpiStore, pg8::DenseSched>(lds, WSP(bf16_t, WS_OG), WSP(bf16_t, WS_WO) + (size_t)j * D * D, D, 0, S, E); })
        }
#define LN0_ARGS(XB, HIST, INV, TG) ln_router_phase(lds, L == 0 ? args.in[0] : nullptr, WSP(bf16_t, WS_XB2), WSP(bf16_t, WS_HM), args.in[17] + (size_t)(2 * L) * D, args.in[18] + (size_t)(2 * L) * D, (LAS int*)(lds + LDS_MISC + 64), XB, \
            WSP(bf16_t, WS_WR) + (size_t)L * 2 * 64 * D, args.in[11] + L * NGRP, args.in[13] + L * NEXP, HIST, INV, TG, vcu, G)
        PHASE_T(4, LN0_ARGS(WSP(bf16_t, WS_TRASH + 64 * MiB), WSP(int, WS_TRASH + 100 * MiB), WSP(int, WS_TRASH + 96 * MiB), WSP(float, WS_TRASH + 98 * MiB)),
                LN0_ARGS(WSP(bf16_t, WS_XB), WSP(int, WS_HIST), WSP(int, WS_LIST), WSP(float, WS_TG)))
#undef LN0_ARGS
#define MOE_TAB LAS int* tab = (LAS int*)(lds + LDS_MOETAB); const int TMt = tab[pg8::MT_FULL + 32] + tab[pg8::MT_TAIL + 32], U1 = TMt * 4, R2 = U1 > G ? U1 - G : 0, ET = TMt < G / 4 ? TMt : G / 4
#define MOE_GU(S) pg8::gemm_phase<pg8::EpiMoeH, pg8::MoeSched>(lds, WSP(bf16_t, WS_XB), WSP(bf16_t, WS_WGU) + (size_t)L * NEXP * 2 * DEXP * D, D, (size_t)2 * DEXP * D * 2, S, pg8::EpiMoeH{WSP(bf16_t, WS_HS), WSP(int, WS_SLOT), S, done})
#define MOE_DN(S) pg8::gemm_phase<pg8::EpiMoeY, pg8::MoeSched>(lds, WSP(bf16_t, WS_HS), WSP(bf16_t, WS_WD) + (size_t)L * NEXP * D * DEXP, DEXP, (size_t)D * DEXP * 2, S, pg8::EpiMoeY{WSP(bf16_t, WS_Y), tab})
        PHASE(2, { { LAS int* tab0 = (LAS int*)(lds + LDS_MOETAB); pg8::MoeSched S0{tab0, 4, G, vcu, D, 1, 0, 0}; S0.build_tables(tab0, (LAS int*)lds, WSP(int, WS_HIST)); }
                   MOE_TAB; unsigned* const done = WSP(unsigned, WS_CTL) + CW_DONE + L * 96 * 64;
                   { pg8::MoeSched S{tab, 4, G, vcu, D, 1, 0, U1}; S.build_rows(tab, (LAS int*)lds, WSP(int, WS_HIST), WSP(int, WS_LIST), true); MOE_GU(S); }
                   if (vcu < R2) { }
                   else { pg8::MoeSched S{tab, 8, G - R2, vcu - R2, DEXP, 0, 0, ET * 8}; moe_wait_tiles(S, done); S.build_slots(tab, WSP(int, WS_SLOT), WSP(float, WS_TG)); MOE_DN(S); }
                   {
                     const int NB = G - R2, rem = (ET * 8) % NB, cB = vcu < R2 ? (NB - rem) + vcu : (vcu - R2 >= rem ? vcu - R2 - rem : (NB - rem) + R2 + (vcu - R2));
                     pg8::MoeSched S{tab, 8, G, cB, DEXP, 0, ET * 8, TMt * 8}; moe_wait_tiles(S, done); S.build_slots(tab, WSP(int, WS_SLOT), WSP(float, WS_TG)); MOE_DN(S); } })
#undef MOE_TAB
#undef MOE_GU
#undef MOE_DN
        PHASE_T(5, ln2_phase(WSP(bf16_t, WS_XB), WSP(bf16_t, WS_Y), args.in[17] + (size_t)(2 * L + 1) * D, args.in[18] + (size_t)(2 * L + 1) * D, WSP(bf16_t, WS_TRASH), nullptr, vcu, G),
                ln2_phase(WSP(bf16_t, WS_XB), WSP(bf16_t, WS_Y), args.in[17] + (size_t)(2 * L + 1) * D, args.in[18] + (size_t)(2 * L + 1) * D, WSP(bf16_t, WS_XB2), L == DEPTH - 1 ? args.out : nullptr, vcu, G))
    }
#undef HGARGS
#undef WSP
#undef PHASE
#undef PHASE_T
}

#ifndef MK_PER_PHASE
#define MK_PER_PHASE 0
#endif
extern "C" void kernel_launch(void* const* d_in, const int* in_sizes, int n_in, void* d_out, int out_size, void* d_ws, size_t ws_size, hipStream_t stream) {
    static int grid = 0;
    if (grid == 0) {
        if (n_in != 19 || out_size != T * D || ws_size < (PROBE_DUP ? WS_END : WS_TRASH)) { fprintf(stderr, "kernel_launch: unexpected arguments (n_in %d, out %d, ws %zu < %zu)\n", n_in, out_size, ws_size, (size_t)WS_END); grid = -1; return; }
        int dev = 0, cus = 0, per_cu = 0;
        if (hipGetDevice(&dev) != hipSuccess || hipDeviceGetAttribute(&cus, hipDeviceAttributeMultiprocessorCount, dev) != hipSuccess) { grid = -1; return; }
        if (hipFuncSetAttribute((const void*)mega_fwd, hipFuncAttributeMaxDynamicSharedMemorySize, LDS_BYTES) != hipSuccess) { fprintf(stderr, "kernel_launch: hipFuncSetAttribute failed\n"); grid = -1; return; }
        if (hipOccupancyMaxActiveBlocksPerMultiprocessor(&per_cu, (const void*)mega_fwd, 512, LDS_BYTES) != hipSuccess || per_cu < 1) { fprintf(stderr, "kernel_launch: occupancy query reports %d\n", per_cu); }
        (void)hipGetLastError();
        grid = cus;
        if (grid != 256) { fprintf(stderr, "kernel_launch: built for 256 CUs (the routing tables assume 256 workgroups of 32 token rows); this device reports %d\n", cus); grid = -1; return; }
    }
    if (grid < 0) return;
    (void)hipMemsetAsync((char*)d_ws + WS_CTL, 0, CTL_BYTES, stream);
    MegaArgs a{};
    for (int i = 0; i < 19; ++i) a.in[i] = (const float*)d_in[i];
    a.out = (float*)d_out; a.ws = (unsigned char*)d_ws;
#if MK_PER_PHASE
    for (int ph = 0; ph < N_PHASES; ++ph) { a.ph_lo = ph; a.ph_hi = ph + 1; hipLaunchKernelGGL(mega_fwd, dim3(grid), dim3(512), LDS_BYTES, stream, a); }
#else
    a.ph_lo = 0; a.ph_hi = N_PHASES;
    hipLaunchKernelGGL(mega_fwd, dim3(grid), dim3(512), LDS_BYTES, stream, a);
#endif
}
```
